# Optimizing an MI355X kernel written in HIP

```python
import math
import jax, jax.numpy as jnp
from jax import lax
import numpy as np

D_MODEL = 1024
BATCH = 8
SEQ = 4096
DEPTH = 1

D_MIX = D_MODEL
D_RWKV = D_MIX // 2
D_SSM = D_MIX - D_RWKV
HEAD_DIM = 64
N_RWKV_HEADS = D_RWKV // HEAD_DIM
DECAY_LORA = 64
AAA_LORA = 64
GATE_LORA = 128
N_SHIFT = 3 * D_RWKV + DECAY_LORA + AAA_LORA + GATE_LORA
D_IN = N_SHIFT + D_SSM
SSM_GROUP = 16
N_SSM_GROUPS = D_SSM // SSM_GROUP
SSM_STATE = 64
DT_MIN = 1e-3
DT_MAX = 1e-1
N_EXPERTS = 32
TOP_K = 4
D_FF = D_MODEL
SWIGLU_ALPHA = 1.702
SWIGLU_LIMIT = 7.0
NORM_EPS = 1e-5
LN_X_EPS = 64e-5

kernel_name = "hymba_rwkv7_s5_moe_block"


def rmsnorm(x, g):
    x32 = x.astype(jnp.float32)
    y = x32 * lax.rsqrt(jnp.mean(x32 * x32, axis=-1, keepdims=True) + NORM_EPS)
    return (y * g.astype(jnp.float32)).astype(x.dtype)


def token_shift(p):
    return jnp.pad(p[:, :-1], ((0, 0), (1, 0), (0, 0)))


def rwkv7_recurrence(r, w, k, v, kk, b):
    bsz, _, h, n = r.shape
    xs = tuple(jnp.moveaxis(t.astype(jnp.float32), 1, 0) for t in (r, w, k, v, kk, b))

    def step(S, inp):
        r_t, w_t, k_t, v_t, kk_t, b_t = inp
        sa = jnp.einsum('bhvk,bhk->bhv', S, -kk_t)
        S = S * w_t[:, :, None, :] + sa[..., None] * b_t[:, :, None, :] + v_t[..., None] * k_t[:, :, None, :]
        y = jnp.einsum('bhvk,bhk->bhv', S, r_t)
        return S, y

    S0 = jnp.zeros((bsz, h, n, n), jnp.float32)
    _, y = lax.scan(step, S0, xs)
    return jnp.moveaxis(y, 0, 1)


def rwkv7_mix(p, w0, w_up, a0, a_up, g_up, k_k, k_a, r_k, ln_w, ln_b):
    bsz, t_len, _ = p.shape
    H, N = N_RWKV_HEADS, HEAD_DIM
    c1 = 3 * D_RWKV
    r, k, v, w_lr, a_lr, g_lr = jnp.split(
        p, [D_RWKV, 2 * D_RWKV, c1, c1 + DECAY_LORA, c1 + DECAY_LORA + AAA_LORA], axis=-1)
    log_w = -jax.nn.softplus(-(w0 + jnp.tanh(w_lr) @ w_up)) - 0.5
    decay = jnp.exp(-jnp.exp(log_w.astype(jnp.float32)))
    a = jax.nn.sigmoid(a0 + a_lr @ a_up)
    g = jax.nn.sigmoid(g_lr) @ g_up

    def heads(t):
        return t.reshape(bsz, t_len, H, N)

    kk = heads(k * k_k).astype(jnp.float32)
    kk = kk / jnp.maximum(jnp.sqrt(jnp.sum(kk * kk, axis=-1, keepdims=True)), 1e-12)
    k = k * (1.0 + (a - 1.0) * k_a)
    y = rwkv7_recurrence(heads(r), heads(decay), heads(k), heads(v), kk, kk * heads(a))
    mu = jnp.mean(y, axis=-1, keepdims=True)
    var = jnp.mean(jnp.square(y - mu), axis=-1, keepdims=True)
    y = ((y - mu) * lax.rsqrt(var + LN_X_EPS)).reshape(bsz, t_len, D_RWKV) * ln_w + ln_b
    bonus = jnp.sum(heads(r) * heads(k) * r_k, axis=-1, keepdims=True) * heads(v)
    y = (y + bonus.reshape(bsz, t_len, D_RWKV)) * g
    return y.astype(p.dtype)


def s5_mix(u, lambda_re, lambda_im, log_step, b_re, b_im, c_re, c_im, d_skip, w_glu, b_glu):
    bsz, t_len, _ = u.shape
    G, P, M = N_SSM_GROUPS, SSM_STATE, SSM_GROUP
    f32 = jnp.float32
    u32 = u.astype(f32)
    ug = u32.reshape(bsz, t_len, G, M)
    lam_re = jnp.minimum(lambda_re.astype(f32), -1e-4)
    lam_im = lambda_im.astype(f32)
    dt = jnp.exp(log_step.astype(f32))[:, None]
    mag = jnp.exp(lam_re * dt)
    lb_re = mag * jnp.cos(lam_im * dt)
    lb_im = mag * jnp.sin(lam_im * dt)
    den = lam_re * lam_re + lam_im * lam_im
    num_re = lb_re - 1.0
    z_re = (num_re * lam_re + lb_im * lam_im) / den
    z_im = (lb_im * lam_re - num_re * lam_im) / den
    b_re32, b_im32 = b_re.astype(f32), b_im.astype(f32)
    bb_re = z_re[..., None] * b_re32 - z_im[..., None] * b_im32
    bb_im = z_re[..., None] * b_im32 + z_im[..., None] * b_re32
    bu_re = jnp.einsum('btgm,gpm->tbgp', ug, bb_re)
    bu_im = jnp.einsum('btgm,gpm->tbgp', ug, bb_im)
    a_re = jnp.broadcast_to(lb_re[None, None], (t_len, 1, G, P))
    a_im = jnp.broadcast_to(lb_im[None, None], (t_len, 1, G, P))

    def combine(e1, e2):
        a1r, a1i, b1r, b1i = e1
        a2r, a2i, b2r, b2i = e2
        return (a1r * a2r - a1i * a2i,
                a1r * a2i + a1i * a2r,
                a2r * b1r - a2i * b1i + b2r,
                a2r * b1i + a2i * b1r + b2i)

    _, _, s_re, s_im = lax.associative_scan(combine, (a_re, a_im, bu_re, bu_im), axis=0)
    y = (jnp.einsum('tbgp,gmp->btgm', s_re, c_re.astype(f32))
         - jnp.einsum('tbgp,gmp->btgm', s_im, c_im.astype(f32)))
    y = y.reshape(bsz, t_len, D_SSM) + d_skip.astype(f32) * u32
    y = jax.nn.gelu(y)
    y = y * jax.nn.sigmoid(y @ w_glu.astype(f32) + b_glu.astype(f32))
    return y


def moe_ffn(h, router_w, router_b, w1, b1, w2, b2):
    bsz, t_len, d = h.shape
    ht = h.reshape(-1, d)
    logits = (ht @ router_w + router_b).astype(jnp.float32)
    top_val, top_idx = lax.top_k(logits, TOP_K)
    gates = jax.nn.softmax(top_val, axis=-1)
    comb = jnp.einsum('nk,nke->ne', gates, jax.nn.one_hot(top_idx, N_EXPERTS, dtype=jnp.float32))
    out = jnp.zeros((ht.shape[0], d), jnp.float32)
    for e in range(N_EXPERTS):
        hu = ht @ w1[e] + b1[e]
        x_glu = jnp.minimum(hu[:, 0::2], SWIGLU_LIMIT)
        x_lin = jnp.clip(hu[:, 1::2], -SWIGLU_LIMIT, SWIGLU_LIMIT)
        act = x_glu * jax.nn.sigmoid(SWIGLU_ALPHA * x_glu) * (x_lin + 1.0)
        out = out + comb[:, e:e + 1] * (act @ w2[e] + b2[e])
    return out.reshape(bsz, t_len, d).astype(h.dtype)


def setup_inputs(seed: int = 0) -> dict:
    key = jax.random.key(seed)
    ks = jax.random.split(key, 40)
    L = DEPTH
    f32 = jnp.float32

    def nrm(i, shape, scale):
        return scale * jax.random.normal(ks[i], shape, f32)

    def gain(i, shape):
        return 1.0 + nrm(i, shape, 0.02)

    x = nrm(0, (BATCH, SEQ, D_MODEL), 1.0)
    norm1_g = gain(1, (L, D_MODEL))
    w_in = nrm(2, (L, D_MODEL, D_IN), D_MODEL ** -0.5)
    mu_shift = jax.random.uniform(ks[3], (L, N_SHIFT), f32)
    ratio = jnp.arange(L, dtype=f32)[:, None] / max(DEPTH - 1, 1)
    frac = jnp.arange(D_RWKV, dtype=f32)[None, :] / (D_RWKV - 1)
    w0 = -7.0 + 5.0 * frac ** (0.85 + jnp.sqrt(ratio)) + 0.5 + nrm(4, (L, D_RWKV), 0.02)
    w_up = nrm(5, (L, DECAY_LORA, D_RWKV), 0.1 * DECAY_LORA ** -0.5)
    a0 = nrm(6, (L, D_RWKV), 0.1)
    a_up = nrm(7, (L, AAA_LORA, D_RWKV), 0.1 * AAA_LORA ** -0.5)
    g_up = nrm(8, (L, GATE_LORA, D_RWKV), GATE_LORA ** -0.5)
    k_k = 0.85 + nrm(9, (L, D_RWKV), 0.02)
    k_a = 1.0 + nrm(10, (L, D_RWKV), 0.02)
    r_k = -0.04 + nrm(11, (L, N_RWKV_HEADS, HEAD_DIM), 0.02)
    ln_x_w = gain(12, (L, D_RWKV))
    ln_x_b = nrm(13, (L, D_RWKV), 0.01)
    lambda_re = -0.5 + nrm(14, (L, N_SSM_GROUPS, SSM_STATE), 0.01)
    lambda_im = (jnp.pi * jnp.arange(SSM_STATE, dtype=f32))[None, None, :] + nrm(15, (L, N_SSM_GROUPS, SSM_STATE), 0.01)
    log_step = jax.random.uniform(ks[16], (L, N_SSM_GROUPS), f32, math.log(DT_MIN), math.log(DT_MAX))
    b_re = nrm(17, (L, N_SSM_GROUPS, SSM_STATE, SSM_GROUP), (2 * SSM_GROUP) ** -0.5)
    b_im = nrm(18, (L, N_SSM_GROUPS, SSM_STATE, SSM_GROUP), (2 * SSM_GROUP) ** -0.5)
    c_re = nrm(19, (L, N_SSM_GROUPS, SSM_GROUP, SSM_STATE), (2 * SSM_STATE) ** -0.5)
    c_im = nrm(20, (L, N_SSM_GROUPS, SSM_GROUP, SSM_STATE), (2 * SSM_STATE) ** -0.5)
    d_skip = nrm(21, (L, D_SSM), 1.0)
    w_glu = nrm(22, (L, D_SSM, D_SSM), D_SSM ** -0.5)
    b_glu = nrm(23, (L, D_SSM), 0.01)
    beta_ssm = gain(24, (L, D_SSM))
    w_out = nrm(25, (L, D_MIX, D_MODEL), D_MIX ** -0.5)
    norm2_g = gain(26, (L, D_MODEL))
    router_w = nrm(27, (L, D_MODEL, N_EXPERTS), D_MODEL ** -0.5)
    router_b = nrm(28, (L, N_EXPERTS), 0.01)
    w1 = nrm(29, (L, N_EXPERTS, D_MODEL, 2 * D_FF), D_MODEL ** -0.5)
    b1 = nrm(30, (L, N_EXPERTS, 2 * D_FF), 0.01)
    w2 = nrm(31, (L, N_EXPERTS, D_FF, D_MODEL), D_FF ** -0.5)
    b2 = nrm(32, (L, N_EXPERTS, D_MODEL), 0.01)
    final_g = gain(33, (D_MODEL,))
    return {"x": x, "norm1_g": norm1_g, "w_in": w_in, "mu_shift": mu_shift,
            "w0": w0, "w_up": w_up, "a0": a0, "a_up": a_up, "g_up": g_up,
            "k_k": k_k, "k_a": k_a, "r_k": r_k, "ln_x_w": ln_x_w, "ln_x_b": ln_x_b,
            "lambda_re": lambda_re, "lambda_im": lambda_im, "log_step": log_step,
            "b_re": b_re, "b_im": b_im, "c_re": c_re, "c_im": c_im, "d_skip": d_skip,
            "w_glu": w_glu, "b_glu": b_glu, "beta_ssm": beta_ssm, "w_out": w_out,
            "norm2_g": norm2_g, "router_w": router_w, "router_b": router_b,
            "w1": w1, "b1": b1, "w2": w2, "b2": b2, "final_g": final_g}


def reference(x, norm1_g, w_in, mu_shift, w0, w_up, a0, a_up, g_up, k_k, k_a, r_k,
              ln_x_w, ln_x_b, lambda_re, lambda_im, log_step, b_re, b_im, c_re, c_im,
              d_skip, w_glu, b_glu, beta_ssm, w_out, norm2_g, router_w, router_b,
              w1, b1, w2, b2, final_g):
    for l in range(DEPTH):
        h = rmsnorm(x, norm1_g[l])
        proj = h @ w_in[l]
        ps, u = proj[..., :N_SHIFT], proj[..., N_SHIFT:]
        ps = ps + mu_shift[l] * (token_shift(ps) - ps)
        y_rwkv = rwkv7_mix(ps, w0[l], w_up[l], a0[l], a_up[l], g_up[l], k_k[l], k_a[l], r_k[l],
                           ln_x_w[l], ln_x_b[l])
        y_ssm = rmsnorm(s5_mix(u, lambda_re[l], lambda_im[l], log_step[l], b_re[l], b_im[l],
                               c_re[l], c_im[l], d_skip[l], w_glu[l], b_glu[l]), beta_ssm[l])
        mixed = jnp.concatenate([y_rwkv.astype(x.dtype), y_ssm.astype(x.dtype)], axis=-1)
        x = x + mixed @ w_out[l]
        x = x + moe_ffn(rmsnorm(x, norm2_g[l]), router_w[l], router_b[l], w1[l], b1[l], w2[l], b2[l])
    return rmsnorm(x, final_g)
```

```cpp
#include <hip/hip_runtime.h>
#include <cstdio>
#include <cstdint>

#define LAS __attribute__((address_space(3)))
typedef unsigned short bf16_t;
typedef short bf16x8 __attribute__((ext_vector_type(8)));
typedef float f32x4 __attribute__((ext_vector_type(4)));
typedef float f32x2 __attribute__((ext_vector_type(2)));
typedef float f32x16 __attribute__((ext_vector_type(16)));
typedef unsigned u32x4 __attribute__((ext_vector_type(4)));
typedef unsigned u32x2 __attribute__((ext_vector_type(2)));

__device__ __forceinline__ unsigned cvt_pk_bf16(float lo, float hi) { unsigned r; asm volatile("v_cvt_pk_bf16_f32 %0, %1, %2" : "=v"(r) : "v"(lo), "v"(hi)); return r; }
__device__ __forceinline__ float bflo(unsigned w) { return __uint_as_float(w << 16); }
__device__ __forceinline__ float bfhi(unsigned w) { return __uint_as_float(w & 0xffff0000u); }
__device__ __forceinline__ float bf2f(bf16_t b) { return __uint_as_float(((unsigned)b) << 16); }
__device__ __forceinline__ bf16_t f2bf(float f) { return (bf16_t)(cvt_pk_bf16(f, 0.f) & 0xffffu); }
__device__ __forceinline__ float wave_sum(float v) {
#pragma unroll
    for (int o = 32; o >= 1; o >>= 1) v += __shfl_xor(v, o);
    return v;
}
__device__ __forceinline__ float sigmoidf_(float x) { return 1.0f / (1.0f + __expf(-x)); }
__device__ __forceinline__ int lane_id() { int l; asm volatile("v_mbcnt_lo_u32_b32 %0, -1, 0\n\tv_mbcnt_hi_u32_b32 %0, -1, %0" : "=v"(l)); return l; }
#define LDS_WAIT() asm volatile("s_waitcnt lgkmcnt(0)" ::: "memory")
#define VM_WAIT() asm volatile("s_waitcnt vmcnt(0)" ::: "memory")

namespace pg8 {
constexpr int BM = 256, BK = 64, HALF = 128, HTB = HALF * BK * 2, STAGE_BYTES = 8 * HTB, NXCD = 8, WGM = 8;
__host__ __device__ __forceinline__ int lds_byte(int r, int c) { const int st = (r >> 4) * 2 + (c >> 5), rr = r & 15, cc = c & 31, ob = rr * 64 + cc * 2; return st * 1024 + (ob ^ (((ob >> 9) & 1) << 5)); }
__host__ __device__ __forceinline__ void stage_rc(int b, int& R, int& C) { const int st = b / 1024, sb = b % 1024, swz = sb ^ (((sb >> 9) & 1) << 5); R = (st >> 1) * 16 + swz / 64; C = (st & 1) * 32 + (swz % 64) / 2; }
__host__ __device__ __forceinline__ int perm32(int rho) { const int n = rho >> 4, i = rho & 15; return 8 * (i >> 2) + 4 * n + (i & 3); }

struct Unit { int pm, pn; };
struct Gemm { const bf16_t* A; const bf16_t* Bt; int M, N, K; };

struct StaticOrder {
    int nM, nN, nwg, G, c;
    __host__ __device__ void init(int M, int N, int G_, int c_) { nM = M / BM; nN = N / BM; nwg = nM * nN; G = G_; c = c_; }
    __host__ __device__ bool next(int i, Unit& u) const {
        const long L = (long)i * G + c; if (L >= nwg) return false;
        int wgid = (int)L; { const int q = nwg / NXCD, r = nwg % NXCD, xcd = wgid % NXCD, off = wgid / NXCD; wgid = (xcd < r ? xcd * (q + 1) : r * (q + 1) + (xcd - r) * q) + off; }
        const int nig = WGM * nN, gid = wgid / nig, fm = gid * WGM, gsz = (nM - fm) < WGM ? (nM - fm) : WGM;
        u.pm = fm + ((wgid % nig) % gsz); u.pn = (wgid % nig) / gsz; return true;
    }
    __device__ __forceinline__ int arow(const Unit& u, int r) const { return u.pm * BM + r; }
};

template <class Epi, class Sched, bool ALIGN_EPI, bool GATHER>
__device__ __forceinline__ void gemm_phase(LAS unsigned char* lds, const Gemm g, const Sched& S, const Epi& E, const int wid) {
    const int lane = lane_id(), tid = wid * 64 + lane, wr = wid >> 2, wc = wid & 3, fr = lane & 15, fq = lane >> 4;
    const int K = g.K, nt = K / BK;
    int Rst[2], Cst[2];
    unsigned voffB[2], vAc[2][2], vAn[2][2];
#pragma unroll
    for (int i = 0; i < 2; ++i) { int R, C; stage_rc(tid * 16 + i * 8192, R, C); const int Rb = Epi::PERM ? ((R & ~31) + perm32(R & 31)) : R;
        Rst[i] = R; Cst[i] = C; voffB[i] = (unsigned)(Rb * K + C) * 2u; }
    const size_t kstep = (size_t)(BK * 2);
    const size_t hstep = (size_t)HALF * K * 2;
    const size_t tstep = 2 * hstep;
    const unsigned ldsw = (unsigned)wid * 1024u;
    const int aoff = lds_byte(wr * 64 + fr, fq * 8), boff = lds_byte(wc * 32 + fr, fq * 8);
#define PG8_SA(b, h) (((b) * 2 + (h)) * HTB)
#define PG8_SB(b, h) ((4 + (b) * 2 + (h)) * HTB)
#define PG8_STAGE(bufoff, gbase, voff) do { _Pragma("unroll") for (int _i = 0; _i < 2; ++_i) \
        __builtin_amdgcn_global_load_lds((const unsigned*)((const char*)(gbase) + (voff)[_i]), (LAS unsigned*)(lds + (bufoff) + ldsw + _i * 8192), 16, 0, 0); } while (0)
#define PG8_STAGE_SEL(bufoff, gbase, va, vb, sel) do { _Pragma("unroll") for (int _i = 0; _i < 2; ++_i) \
        __builtin_amdgcn_global_load_lds((const unsigned*)((const char*)(gbase) + ((sel) ? (vb)[_i] : (va)[_i])), (LAS unsigned*)(lds + (bufoff) + ldsw + _i * 8192), 16, 0, 0); } while (0)
#define PG8_LDA(dst, b, h) do { _Pragma("unroll") for (int m = 0; m < 4; ++m) _Pragma("unroll") for (int k = 0; k < 2; ++k) dst[m][k] = *(const LAS bf16x8*)(lds + PG8_SA(b, h) + aoff + m * 2048 + k * 1024); } while (0)
#define PG8_LDB(dst, b, h) do { _Pragma("unroll") for (int n = 0; n < 2; ++n) _Pragma("unroll") for (int k = 0; k < 2; ++k) dst[n][k] = *(const LAS bf16x8*)(lds + PG8_SB(b, h) + boff + n * 2048 + k * 1024); } while (0)
#define PG8_MMA(ai, bj, At, Bt) do { __builtin_amdgcn_s_setprio(1); _Pragma("unroll") for (int m = 0; m < 4; ++m) _Pragma("unroll") for (int n = 0; n < 2; ++n) _Pragma("unroll") for (int k = 0; k < 2; ++k) \
        acc[ai][bj][m][n] = __builtin_amdgcn_mfma_f32_16x16x32_bf16(Bt[n][k], At[m][k], acc[ai][bj][m][n], 0, 0, 0); __builtin_amdgcn_s_setprio(0); } while (0)
#define PG8_WAIT_V(n) asm volatile("s_waitcnt vmcnt(" #n ")" ::: "memory")
#define PG8_WAIT_L(n) asm volatile("s_waitcnt lgkmcnt(" #n ")" ::: "memory")
#define PG8_BAR __builtin_amdgcn_s_barrier()
#define PG8_SCHED __builtin_amdgcn_sched_barrier(0)
#define PG8_LOADOFF(dst, unit) do { _Pragma("unroll") for (int _h = 0; _h < 2; ++_h) _Pragma("unroll") for (int _i = 0; _i < 2; ++_i) \
        dst[_h][_i] = GATHER ? ((unsigned)S.arow(unit, _h * HALF + Rst[_i]) * (unsigned)(K * 2) + (unsigned)(Cst[_i] * 2)) : ((unsigned)((_h * HALF + Rst[_i]) * K + Cst[_i]) * 2u); } while (0)
    Unit cur, nxt; int ui = 0;
    if (!S.next(0, cur)) return;
    f32x4 acc[2][2][4][2];
#pragma unroll
    for (int a = 0; a < 2; ++a)
#pragma unroll
        for (int b = 0; b < 2; ++b)
#pragma unroll
            for (int m = 0; m < 4; ++m)
#pragma unroll
                for (int n = 0; n < 2; ++n) acc[a][b][m][n] = (f32x4){0.f, 0.f, 0.f, 0.f};
    bf16x8 At[4][2], B0[2][2], B1[2][2];
    const char* cA = GATHER ? (const char*)g.A : (const char*)g.A + (size_t)cur.pm * tstep; const char* cB = (const char*)g.Bt + (size_t)cur.pn * tstep;
    PG8_LOADOFF(vAc, cur);
    if (GATHER) { Unit u1; if (S.next(1, u1)) PG8_LOADOFF(vAn, u1); else PG8_LOADOFF(vAn, cur); } else { PG8_LOADOFF(vAn, cur); }
    PG8_STAGE(PG8_SB(0, 0), cB, voffB); PG8_STAGE(PG8_SB(0, 1), cB + hstep, voffB); PG8_STAGE(PG8_SA(0, 0), cA, vAc[0]); PG8_STAGE(PG8_SA(0, 1), cA, vAc[1]);
    if (wr == 1) PG8_BAR;
    PG8_WAIT_V(2); PG8_BAR;
    PG8_STAGE(PG8_SB(1, 0), cB + kstep, voffB); PG8_STAGE(PG8_SA(1, 0), cA + kstep, vAc[0]); PG8_STAGE(PG8_SB(1, 1), cB + hstep + kstep, voffB);
    PG8_WAIT_V(6); PG8_BAR;
    for (;;) {
        const bool has_next = S.next(ui + 1, nxt);
        const char* nA = GATHER ? cA : (has_next ? (const char*)g.A + (size_t)nxt.pm * tstep : cA); const char* nB = has_next ? (const char*)g.Bt + (size_t)nxt.pn * tstep : cB;
        const bool usen = GATHER && has_next;
        for (int t = 0; t < nt; t += 2) {
            const bool last = (t == nt - 2);
            const char* a1 = cA + (size_t)(t + 1) * kstep;
            const char* a2 = last ? nA : cA + (size_t)(t + 2) * kstep; const char* b2 = last ? nB : cB + (size_t)(t + 2) * kstep;
            const char* a3 = a2 + kstep; const char* b3 = b2 + kstep;
            const bool sel = last && usen;
            PG8_LDB(B0, 0, 0); PG8_LDB(B1, 0, 1); PG8_SCHED; PG8_LDA(At, 0, 0); PG8_STAGE(PG8_SA(1, 1), a1, vAc[1]);
            PG8_WAIT_V(8); PG8_WAIT_L(0); PG8_BAR; PG8_MMA(0, 0, At, B0); PG8_MMA(0, 1, At, B1); PG8_BAR; PG8_SCHED;
            PG8_LDA(At, 0, 1); PG8_STAGE(PG8_SB(0, 0), b2, voffB); PG8_STAGE(PG8_SB(0, 1), b2 + hstep, voffB); PG8_STAGE_SEL(PG8_SA(0, 0), a2, vAc[0], vAn[0], sel);
            PG8_WAIT_V(8); PG8_WAIT_L(0); PG8_BAR; PG8_MMA(1, 0, At, B0); PG8_MMA(1, 1, At, B1); PG8_BAR; PG8_SCHED;
            PG8_LDB(B0, 1, 0); PG8_LDB(B1, 1, 1); PG8_SCHED; PG8_LDA(At, 1, 0); PG8_STAGE_SEL(PG8_SA(0, 1), a2, vAc[1], vAn[1], sel);
            PG8_WAIT_V(8); PG8_WAIT_L(0); PG8_BAR; PG8_MMA(0, 0, At, B0); PG8_MMA(0, 1, At, B1); PG8_BAR; PG8_SCHED;
            PG8_LDA(At, 1, 1); PG8_STAGE(PG8_SB(1, 0), b3, voffB); PG8_STAGE(PG8_SB(1, 1), b3 + hstep, voffB); PG8_STAGE_SEL(PG8_SA(1, 0), a3, vAc[0], vAn[0], sel);
            PG8_WAIT_V(8); PG8_WAIT_L(0); PG8_BAR; PG8_MMA(1, 0, At, B0); PG8_MMA(1, 1, At, B1); PG8_BAR; PG8_SCHED;
        }
        if constexpr (ALIGN_EPI) { if (wr == 0) PG8_BAR; }
        E(acc, cur, wr, wc, fr, fq);
        if (!has_next) break;
#pragma unroll
        for (int a = 0; a < 2; ++a)
#pragma unroll
            for (int b = 0; b < 2; ++b)
#pragma unroll
                for (int m = 0; m < 4; ++m)
#pragma unroll
                    for (int n = 0; n < 2; ++n) acc[a][b][m][n] = (f32x4){0.f, 0.f, 0.f, 0.f};
        cur = nxt; cA = nA; cB = nB; ++ui;
        if (GATHER) {
#pragma unroll
            for (int _h = 0; _h < 2; ++_h)
#pragma unroll
                for (int _i = 0; _i < 2; ++_i) vAc[_h][_i] = vAn[_h][_i];
            Unit u2; if (S.next(ui + 1, u2)) PG8_LOADOFF(vAn, u2);
        }
        if constexpr (ALIGN_EPI) { if (wr == 1) PG8_BAR; }
    }
    PG8_WAIT_V(0);
    if constexpr (!ALIGN_EPI) { if (wr == 0) PG8_BAR; }
    PG8_BAR;
#undef PG8_SA
#undef PG8_SB
#undef PG8_STAGE
#undef PG8_STAGE_SEL
#undef PG8_LDA
#undef PG8_LDB
#undef PG8_MMA
#undef PG8_WAIT_V
#undef PG8_WAIT_L
#undef PG8_BAR
#undef PG8_SCHED
#undef PG8_LOADOFF
}
}
#define XB_TMO      128
#define XB_XCNT(j)  (256  + 64 * (j))
#define XB_XSUB(j)  (1280 + 64 * (j))
#define XB_XGEN(j)  (2304 + 64 * (j))
#define XB_TOP      3328
#define XB_TOPGEN   3392
#define XCD_BAR_WORDS 3456
#define XB_SPIN_CAP (1u << 18)

__device__ __forceinline__ unsigned xb_ld(unsigned* p)              { return __hip_atomic_load(p, __ATOMIC_RELAXED, __HIP_MEMORY_SCOPE_AGENT); }
__device__ __forceinline__ unsigned xb_add(unsigned* p, unsigned v) { return __hip_atomic_fetch_add(p, v, __ATOMIC_RELAXED, __HIP_MEMORY_SCOPE_AGENT); }
__device__ __forceinline__ unsigned xb_xcc_id() { return (unsigned)__builtin_amdgcn_s_getreg((3 << 11) | 20) & 0xFu; }
#define XB_SPIN(cond, bar) do { unsigned _sp = 0; while (cond) { __builtin_amdgcn_s_sleep(1); \
    if ((++_sp & 255u) == 0u) { if (xb_ld(&(bar)[XB_TMO])) break; if (_sp > XB_SPIN_CAP) { atomicAdd(&(bar)[XB_TMO], 1u); break; } } } } while (0)

struct XcdBarrier {
    unsigned* bar; unsigned x;
    volatile LAS unsigned* st;
};

__device__ __forceinline__ XcdBarrier xcd_barrier_post(unsigned* bar, volatile LAS unsigned* st) {
    XcdBarrier b; b.bar = bar; b.x = xb_xcc_id(); b.st = st;
    if (threadIdx.x == 0) (void)xb_add(&bar[XB_XCNT(b.x)], 1u);
    return b;
}
__device__ __forceinline__ void xcd_barrier_complete(unsigned* bar, unsigned x, unsigned& nloc, unsigned& nx) {
    const unsigned G = gridDim.x * gridDim.y * gridDim.z;
    unsigned sum, cnt, mine, sp = 0u;
    for (;;) {
        sum = 0u; cnt = 0u; mine = 0u;
#pragma unroll
        for (unsigned j = 0; j < 16; ++j) { const unsigned c = xb_ld(&bar[XB_XCNT(j)]); sum += c; cnt += (c > 0u) ? 1u : 0u; mine = (j == x) ? c : mine; }
        if (sum == G) break;
        __builtin_amdgcn_s_sleep(1);
        if ((++sp & 255u) == 0u) { if (xb_ld(&bar[XB_TMO])) break; if (sp > XB_SPIN_CAP) { atomicAdd(&bar[XB_TMO], 1u); break; } }
    }
    nloc = mine > 0u ? mine : 1u; nx = cnt > 0u ? cnt : 1u;
}

__device__ __forceinline__ void xcd_barrier(const XcdBarrier& b, const bool t0) {
    asm volatile("s_waitcnt vmcnt(0)" ::: "memory");
    __syncthreads();
    if (t0) {
        unsigned* bar = b.bar;
        __builtin_amdgcn_s_waitcnt(0);
        unsigned nloc = b.st[0], nx = b.st[1];
        if (nloc == 0u) { xcd_barrier_complete(bar, b.x, nloc, nx); b.st[0] = nloc; b.st[1] = nx; }
        const unsigned old = xb_add(&bar[XB_XSUB(b.x)], 1u);
        const unsigned gen = old / nloc;
        if (old + 1u == (gen + 1u) * nloc) {
            __builtin_amdgcn_fence(__ATOMIC_RELEASE, "agent");
            asm volatile("s_waitcnt vmcnt(0)" ::: "memory");
            const unsigned og = xb_add(&bar[XB_TOP], 1u);
            const unsigned tg = og / nx;
            if (og + 1u == (tg + 1u) * nx) xb_add(&bar[XB_TOPGEN], 1u);
            else XB_SPIN(xb_ld(&bar[XB_TOPGEN]) == tg, bar);
            __builtin_amdgcn_fence(__ATOMIC_ACQUIRE, "agent");
            xb_add(&bar[XB_XGEN(b.x)], 1u);
            asm volatile("s_waitcnt vmcnt(0)" ::: "memory");
        } else {
            XB_SPIN(xb_ld(&bar[XB_XGEN(b.x)]) == gen, bar);
            __builtin_amdgcn_fence(__ATOMIC_ACQUIRE, "agent");
            asm volatile("s_waitcnt vmcnt(0)" ::: "memory");
        }
    }
    __syncthreads();
}

constexpr int DM = 1024, NBATCH = 8, SEQ = 4096, NTOK = NBATCH * SEQ;
constexpr int DIN = 2304, DR = 512, DSSM = 512, NH = 8, HD = 64;
constexpr int COL_K = 512, COL_V = 1024, COL_LORA = 1536, COL_U = 1792;
constexpr int NE = 32, DFF = 1024, CAP = 32768, MAXTILES = 544;
constexpr int OPS_STRIDE = 388;
constexpr int NWAVES = 8, GRID = 256, NGW = GRID * NWAVES;
constexpr size_t MiB = 1u << 20;
constexpr size_t WS_CTL = 0, CTL_ZERO_BYTES = 1 * MiB;
constexpr size_t WS_WINT = 1 * MiB, WS_LORAB = 6 * MiB, WS_WGLUT = 7 * MiB, WS_WOUTT = 8 * MiB;
constexpr size_t WS_B1G = 10 * MiB, WS_B1L = 10 * MiB + 128 * 1024, WS_RWP = 10 * MiB + 256 * 1024, WS_RSTD1 = 10 * MiB + 512 * 1024;
constexpr size_t WS_SSQ = 11 * MiB, WS_EID = 12 * MiB, WS_GATE = 12 * MiB + 512 * 1024, WS_RELPOS = 13 * MiB, WS_STOK = 14 * MiB;
constexpr size_t WS_W2T = 20 * MiB, WS_W1T = 84 * MiB, WS_XB = 212 * MiB;
constexpr size_t WS_PROJ = 276 * MiB, WS_LORAIN = 420 * MiB, WS_LORAW = 436 * MiB, WS_LORAA = 500 * MiB, WS_LORAG = 564 * MiB, WS_OPS = 628 * MiB, WS_SRS = 1016 * MiB, WS_END = 1020 * MiB;
constexpr size_t WS_YRAW = WS_LORAW, WS_YGELU = WS_LORAA, WS_YGLU = WS_LORAA + 32 * MiB, WS_MIXED = WS_PROJ, WS_ACT = WS_OPS, WS_YSORT = WS_PROJ;
static_assert(WS_LORAA - WS_LORAW == (size_t)NTOK * 512 * 4 && WS_LORAG - WS_LORAA == (size_t)NTOK * 512 * 4, "lora buffers contiguous");
static_assert(WS_OPS + (size_t)64 * 4096 * OPS_STRIDE * 4 <= WS_SRS, "ops fits");
constexpr int CW_TMO = 0, CW_BAR = 4096, CW_GCOUNT = 16384;
constexpr int LDS_BYTES = 163840, TAB_OFF = 131072, MISC_OFF = 159744;
constexpr int TAB_SRC = TAB_OFF, TAB_VAL = TAB_OFF + MAXTILES * 4, TAB_E = TAB_OFF + 2 * MAXTILES * 4, TAB_BASE = TAB_OFF + 3 * MAXTILES * 4;

struct Params { const float* in[34]; float* out; unsigned char* ws; };
enum { I_X = 0, I_N1G, I_WIN, I_MU, I_W0, I_WUP, I_A0, I_AUP, I_GUP, I_KK, I_KA, I_RK, I_LNW, I_LNB, I_LRE, I_LIM, I_LSTEP, I_BRE, I_BIM, I_CRE, I_CIM, I_DSKIP, I_WGLU, I_BGLU, I_BETA, I_WOUT, I_N2G, I_RW, I_RB, I_W1, I_B1, I_W2, I_B2, I_FG };

using pg8::Unit; using pg8::HALF; using pg8::BM;
struct EpiProj {
    static constexpr bool PERM = true;
    bf16_t* O; int ldc; const float* rs;
    __device__ __forceinline__ void operator()(const f32x4 (&acc)[2][2][4][2], const Unit& u, int wr, int wc, int fr, int fq) const {
        const int row0 = u.pm * BM + wr * 64 + fr, col0 = u.pn * BM + wc * 32 + 8 * fq;
#pragma unroll
        for (int ai = 0; ai < 2; ++ai)
#pragma unroll
            for (int m = 0; m < 4; ++m) { const int row = row0 + ai * HALF + m * 16; const float s = rs[row]; bf16_t* rowp = O + (size_t)row * ldc + col0;
#pragma unroll
                for (int bj = 0; bj < 2; ++bj) { const f32x4 v0 = acc[ai][bj][m][0] * s, v1 = acc[ai][bj][m][1] * s;
                    u32x4 w; w.x = cvt_pk_bf16(v0[0], v0[1]); w.y = cvt_pk_bf16(v0[2], v0[3]); w.z = cvt_pk_bf16(v1[0], v1[1]); w.w = cvt_pk_bf16(v1[2], v1[3]);
                    *(u32x4*)(rowp + bj * HALF) = w; } }
    }
};
struct EpiLora {
    static constexpr bool PERM = false;
    float* bw; float* ba; float* bg;
    __device__ __forceinline__ void operator()(const f32x4 (&acc)[2][2][4][2], const Unit& u, int wr, int wc, int fr, int fq) const {
        const int kind = u.pn >> 1; const int row0 = u.pm * BM + wr * 64 + fr, cc0 = (u.pn & 1) * 256 + wc * 32 + 4 * fq;
        float* base = bw + (size_t)kind * ((size_t)NTOK * 512);
#pragma unroll
        for (int ai = 0; ai < 2; ++ai)
#pragma unroll
            for (int m = 0; m < 4; ++m) { float* rowp = base + (size_t)(row0 + ai * HALF + m * 16) * 512 + cc0;
#pragma unroll
                for (int bj = 0; bj < 2; ++bj)
#pragma unroll
                    for (int n = 0; n < 2; ++n) *(f32x4*)(rowp + bj * HALF + n * 16) = acc[ai][bj][m][n]; }
    }
};
struct EpiGlu {
    static constexpr bool PERM = true;
    const bf16_t* Y; bf16_t* O; const float* bias; float* ssq;
    __device__ __forceinline__ void operator()(const f32x4 (&acc)[2][2][4][2], const Unit& u, int wr, int wc, int fr, int fq) const {
        const int row0 = u.pm * BM + wr * 64 + fr, col0 = u.pn * BM + wc * 32 + 8 * fq;
        f32x4 bv[2][2];
#pragma unroll
        for (int bj = 0; bj < 2; ++bj)
#pragma unroll
            for (int n = 0; n < 2; ++n) bv[bj][n] = *(const f32x4*)(bias + col0 + bj * HALF + 4 * n);
#pragma unroll
        for (int ai = 0; ai < 2; ++ai)
#pragma unroll
            for (int m = 0; m < 4; ++m) { const int row = row0 + ai * HALF + m * 16; float sq = 0.f;
#pragma unroll
                for (int bj = 0; bj < 2; ++bj) { const size_t off = (size_t)row * 512 + col0 + bj * HALF; const u32x4 yv = *(const u32x4*)(Y + off);
                    const f32x4 z0 = acc[ai][bj][m][0] + bv[bj][0], z1 = acc[ai][bj][m][1] + bv[bj][1];
                    float o[8]; o[0] = bflo(yv.x) * sigmoidf_(z0[0]); o[1] = bfhi(yv.x) * sigmoidf_(z0[1]); o[2] = bflo(yv.y) * sigmoidf_(z0[2]); o[3] = bfhi(yv.y) * sigmoidf_(z0[3]);
                    o[4] = bflo(yv.z) * sigmoidf_(z1[0]); o[5] = bfhi(yv.z) * sigmoidf_(z1[1]); o[6] = bflo(yv.w) * sigmoidf_(z1[2]); o[7] = bfhi(yv.w) * sigmoidf_(z1[3]);
#pragma unroll
                    for (int j = 0; j < 8; ++j) sq += o[j] * o[j];
                    u32x4 w; w.x = cvt_pk_bf16(o[0], o[1]); w.y = cvt_pk_bf16(o[2], o[3]); w.z = cvt_pk_bf16(o[4], o[5]); w.w = cvt_pk_bf16(o[6], o[7]);
                    *(u32x4*)(O + off) = w; }
                sq += __shfl_xor(sq, 16); sq += __shfl_xor(sq, 32);
                if (fq == 0) ssq[(size_t)row * 8 + u.pn * 4 + wc] = sq; }
    }
};
struct EpiOut {
    static constexpr bool PERM = false;
    const float* X; float* X1; bf16_t* X1B;
    __device__ __forceinline__ void operator()(const f32x4 (&acc)[2][2][4][2], const Unit& u, int wr, int wc, int fr, int fq) const {
        const int row0 = u.pm * BM + wr * 64 + fr, col0 = u.pn * BM + wc * 32 + 4 * fq;
#pragma unroll
        for (int ai = 0; ai < 2; ++ai)
#pragma unroll
            for (int m = 0; m < 4; ++m) { const size_t off = (size_t)(row0 + ai * HALF + m * 16) * DM + col0;
#pragma unroll
                for (int bj = 0; bj < 2; ++bj)
#pragma unroll
                    for (int n = 0; n < 2; ++n) { const size_t o2 = off + bj * HALF + n * 16; const f32x4 v = *(const f32x4*)(X + o2) + acc[ai][bj][m][n];
                        *(f32x4*)(X1 + o2) = v; u32x2 w; w.x = cvt_pk_bf16(v[0], v[1]); w.y = cvt_pk_bf16(v[2], v[3]); *(u32x2*)(X1B + o2) = w; } }
    }
};
struct EpiSwiglu {
    static constexpr bool PERM = true;
    bf16_t* O; const float* b1g; const float* b1l; const float* srs; const LAS int* tsrc; const LAS int* tval;
    __device__ __forceinline__ void operator()(const f32x4 (&acc)[2][2][4][2], const Unit& u, int wr, int wc, int fr, int fq) const {
        const int e = u.pn >> 3, pnl = u.pn & 7; const int r0 = wr * 64 + fr, o0 = pnl * 128 + wc * 32 + 8 * fq;
        const int src = tsrc[u.pm], nval = tval[u.pm];
        f32x4 bg[2], bl[2];
#pragma unroll
        for (int n = 0; n < 2; ++n) { bg[n] = *(const f32x4*)(b1g + e * DFF + o0 + 4 * n); bl[n] = *(const f32x4*)(b1l + e * DFF + o0 + 4 * n); }
#pragma unroll
        for (int ai = 0; ai < 2; ++ai)
#pragma unroll
            for (int m = 0; m < 4; ++m) { const int r = r0 + ai * HALF + m * 16; const float s = r < nval ? srs[src + r] : 0.f;
                float o[8];
#pragma unroll
                for (int n = 0; n < 2; ++n)
#pragma unroll
                    for (int j = 0; j < 4; ++j) { const float gl = fminf(acc[ai][0][m][n][j] * s + bg[n][j], 7.0f); const float li = fminf(fmaxf(acc[ai][1][m][n][j] * s + bl[n][j], -7.0f), 7.0f);
                        o[4 * n + j] = gl * sigmoidf_(1.702f * gl) * (li + 1.0f); }
                u32x4 w; w.x = cvt_pk_bf16(o[0], o[1]); w.y = cvt_pk_bf16(o[2], o[3]); w.z = cvt_pk_bf16(o[4], o[5]); w.w = cvt_pk_bf16(o[6], o[7]);
                *(u32x4*)(O + (size_t)(u.pm * BM + r) * DFF + o0) = w; }
    }
};
struct EpiMoe2 {
    static constexpr bool PERM = true;
    bf16_t* O; const float* b2;
    __device__ __forceinline__ void operator()(const f32x4 (&acc)[2][2][4][2], const Unit& u, int wr, int wc, int fr, int fq) const {
        const int e = u.pn >> 2, pnl = u.pn & 3; const int row0 = u.pm * BM + wr * 64 + fr, col0 = pnl * BM + wc * 32 + 8 * fq;
        f32x4 bv[2][2];
#pragma unroll
        for (int bj = 0; bj < 2; ++bj)
#pragma unroll
            for (int n = 0; n < 2; ++n) bv[bj][n] = *(const f32x4*)(b2 + e * DM + col0 + bj * HALF + 4 * n);
#pragma unroll
        for (int ai = 0; ai < 2; ++ai)
#pragma unroll
            for (int m = 0; m < 4; ++m) { bf16_t* rowp = O + (size_t)(row0 + ai * HALF + m * 16) * DM + col0;
#pragma unroll
                for (int bj = 0; bj < 2; ++bj) { const f32x4 v0 = acc[ai][bj][m][0] + bv[bj][0], v1 = acc[ai][bj][m][1] + bv[bj][1];
                    u32x4 w; w.x = cvt_pk_bf16(v0[0], v0[1]); w.y = cvt_pk_bf16(v0[2], v0[3]); w.z = cvt_pk_bf16(v1[0], v1[1]); w.w = cvt_pk_bf16(v1[2], v1[3]);
                    *(u32x4*)(rowp + bj * HALF) = w; } }
    }
};
struct MoeOrder {
    int G, c, NT, ntiles; const LAS int* tsrc; const LAS int* tval; const LAS int* te; const int* stok;
    __device__ __forceinline__ bool next(int i, Unit& u) const {
        const int L = i * G + c, xcd = L & 7, j = L >> 3; const int mt = (j / NT) * 8 + xcd; if (mt >= ntiles) return false;
        u.pm = mt; u.pn = te[mt] * NT + (j % NT); return true; }
    __device__ __forceinline__ int arow(const Unit& u, int r) const { return r < tval[u.pm] ? stok[tsrc[u.pm] + r] : 0; }
};
struct KsOne { __device__ __forceinline__ float operator()(int) const { return 1.f; } };
struct KsVec { const float* g; __device__ __forceinline__ float operator()(int k) const { return g[k]; } };
struct KsOut { const float* beta; __device__ __forceinline__ float operator()(int k) const { return k < DR ? 1.f : beta[k - DR]; } };
struct RmId { int off; __device__ __forceinline__ int operator()(int c) const { return off + c; } };
struct RmW1 { int e; __device__ __forceinline__ int operator()(int c) const { const int o = c >> 1, bj = c & 1; return e * 2048 + (o >> 7) * 256 + bj * 128 + (o & 127); } };
template <class KS, class RM>
__device__ __forceinline__ void tr_item(const float* src, int N, int k0, int c0, bf16_t* dst, int ldk, const KS ks, const RM rm, LAS float* scr, int lane) {
#pragma unroll 4
    for (int it = 0; it < 16; ++it) { const int r = it * 4 + (lane >> 4); const f32x4 v = *(const f32x4*)(src + (size_t)(k0 + r) * N + c0 + 4 * (lane & 15)); const float s = ks(k0 + r);
        LAS float* d = scr + r * 65 + 4 * (lane & 15); d[0] = v[0] * s; d[1] = v[1] * s; d[2] = v[2] * s; d[3] = v[3] * s; }
    LDS_WAIT();
    const int c = lane & 7;
#pragma unroll
    for (int jj = 0; jj < 8; ++jj) { const int n = (lane >> 3) + 8 * jj; const LAS float* s = scr + (8 * c) * 65 + n;
        u32x4 o; o.x = cvt_pk_bf16(s[0 * 65], s[1 * 65]); o.y = cvt_pk_bf16(s[2 * 65], s[3 * 65]); o.z = cvt_pk_bf16(s[4 * 65], s[5 * 65]); o.w = cvt_pk_bf16(s[6 * 65], s[7 * 65]);
        *(u32x4*)(dst + (size_t)rm(c0 + n) * ldk + k0 + 8 * c) = o; }
    LDS_WAIT();
}
__device__ __forceinline__ void p0_prologue(const Params& p, LAS unsigned char* lds, int wave, int lane) {
    unsigned char* ws = p.ws;
    LAS float* scr = (LAS float*)(lds + wave * 16640);
    const int gw = blockIdx.x * NWAVES + wave;
    bf16_t* W1T = (bf16_t*)(ws + WS_W1T); bf16_t* W2T = (bf16_t*)(ws + WS_W2T); bf16_t* WinT = (bf16_t*)(ws + WS_WINT); bf16_t* WoutT = (bf16_t*)(ws + WS_WOUTT); bf16_t* WgluT = (bf16_t*)(ws + WS_WGLUT);
    constexpr int I_1 = NE * 16 * 32, I_2 = NE * 16 * 16, I_IN = 16 * 36, I_OUT = 16 * 16, I_GLU = 8 * 8, NITEMS = I_1 + I_2 + I_IN + I_OUT + I_GLU;
    for (int it = gw; it < NITEMS; it += NGW) {
        int r = it;
        if (r < I_1) { const int e = r >> 9, q = r & 511, kb = q >> 5, nb = q & 31; tr_item(p.in[I_W1] + (size_t)e * DM * 2048, 2048, kb * 64, nb * 64, W1T, DM, KsVec{p.in[I_N2G]}, RmW1{e}, scr, lane); continue; } r -= I_1;
        if (r < I_2) { const int e = r >> 8, q = r & 255, kb = q >> 4, nb = q & 15; tr_item(p.in[I_W2] + (size_t)e * DFF * DM, DM, kb * 64, nb * 64, W2T, DFF, KsOne{}, RmId{e * DM}, scr, lane); continue; } r -= I_2;
        if (r < I_IN) { const int kb = r / 36, nb = r % 36; tr_item(p.in[I_WIN], DIN, kb * 64, nb * 64, WinT, DM, KsVec{p.in[I_N1G]}, RmId{0}, scr, lane); continue; } r -= I_IN;
        if (r < I_OUT) { const int kb = r >> 4, nb = r & 15; tr_item(p.in[I_WOUT], DM, kb * 64, nb * 64, WoutT, DM, KsOut{p.in[I_BETA]}, RmId{0}, scr, lane); continue; } r -= I_OUT;
        { const int kb = r >> 3, nb = r & 7; tr_item(p.in[I_WGLU], DSSM, kb * 64, nb * 64, WgluT, DSSM, KsOne{}, RmId{0}, scr, lane); }
    }
    { const float* x = p.in[I_X]; bf16_t* xb = (bf16_t*)(ws + WS_XB); float* rs = (float*)(ws + WS_RSTD1);
      for (int m = gw; m < NTOK; m += NGW) { const f32x4* xr = (const f32x4*)(x + (size_t)m * DM) + lane; f32x4 v[4]; float s = 0.f;
#pragma unroll
          for (int j = 0; j < 4; ++j) { v[j] = xr[64 * j]; s += (v[j][0] * v[j][0] + v[j][1] * v[j][1]) + (v[j][2] * v[j][2] + v[j][3] * v[j][3]); }
          s = wave_sum(s); if (lane == 0) rs[m] = 1.0f / sqrtf(s * (1.0f / DM) + 1e-5f);
          u32x2* o8 = (u32x2*)(xb + (size_t)m * DM) + lane;
#pragma unroll
          for (int j = 0; j < 4; ++j) { u32x2 w; w.x = cvt_pk_bf16(v[j][0], v[j][1]); w.y = cvt_pk_bf16(v[j][2], v[j][3]); o8[64 * j] = w; } } }
    const int gt = blockIdx.x * (NWAVES * 64) + wave * 64 + lane, NT_ = GRID * NWAVES * 64;
    { float* b1g = (float*)(ws + WS_B1G); float* b1l = (float*)(ws + WS_B1L); const float* b1 = p.in[I_B1];
      for (int i = gt; i < NE * DFF; i += NT_) { const int e = i >> 10, o = i & 1023; b1g[i] = b1[e * 2048 + 2 * o]; b1l[i] = b1[e * 2048 + 2 * o + 1]; } }
    { float* rwp = (float*)(ws + WS_RWP); const float* rw = p.in[I_RW]; const float* g2 = p.in[I_N2G];
      for (int i = gt; i < DM * NE; i += NT_) rwp[i] = g2[i >> 5] * rw[i]; }
    { bf16_t* LB = (bf16_t*)(ws + WS_LORAB); const float* wup = p.in[I_WUP]; const float* aup = p.in[I_AUP]; const float* gup = p.in[I_GUP];
      for (int i = gt; i < 1536 * 256; i += NT_) { const int n = i >> 8, k = i & 255; float v = 0.f;
          if (n < 512) { if (k < 64) v = wup[k * 512 + n]; } else if (n < 1024) { if (k >= 64 && k < 128) v = aup[(k - 64) * 512 + (n - 512)]; } else { if (k >= 128) v = gup[(k - 128) * 512 + (n - 1024)]; }
          LB[i] = f2bf(v); } }
}
__device__ __forceinline__ void p2_lora_in(const Params& p, int wave, int lane) {
    const bf16_t* proj = (const bf16_t*)(p.ws + WS_PROJ); bf16_t* li = (bf16_t*)(p.ws + WS_LORAIN); const float* mu = p.in[I_MU] + COL_LORA;
    const int gt = blockIdx.x * (NWAVES * 64) + wave * 64 + lane, NT_ = GRID * NWAVES * 64;
    for (int idx = gt; idx < NTOK * 32; idx += NT_) { const int tok = idx >> 5, c = (idx & 31) * 8;
        const bf16_t* pr = proj + (size_t)tok * DIN + COL_LORA + c; const u32x4 cur = *(const u32x4*)pr; u32x4 prv = (u32x4){0u, 0u, 0u, 0u}; if (tok & (SEQ - 1)) prv = *(const u32x4*)(pr - DIN);
        float v[8], q[8];
        v[0] = bflo(cur.x); v[1] = bfhi(cur.x); v[2] = bflo(cur.y); v[3] = bfhi(cur.y); v[4] = bflo(cur.z); v[5] = bfhi(cur.z); v[6] = bflo(cur.w); v[7] = bfhi(cur.w);
        q[0] = bflo(prv.x); q[1] = bfhi(prv.x); q[2] = bflo(prv.y); q[3] = bfhi(prv.y); q[4] = bflo(prv.z); q[5] = bfhi(prv.z); q[6] = bflo(prv.w); q[7] = bfhi(prv.w);
#pragma unroll
        for (int j = 0; j < 8; ++j) { float s = v[j] + mu[c + j] * (q[j] - v[j]); if (c < 64) s = tanhf(s); else if (c >= 128) s = sigmoidf_(s); v[j] = s; }
        u32x4 w; w.x = cvt_pk_bf16(v[0], v[1]); w.y = cvt_pk_bf16(v[2], v[3]); w.z = cvt_pk_bf16(v[4], v[5]); w.w = cvt_pk_bf16(v[6], v[7]);
        *(u32x4*)(li + (size_t)tok * 256 + c) = w; }
}
__device__ __forceinline__ void p4_prep(const Params& p, int wave, int lane) {
    const bf16_t* proj = (const bf16_t*)(p.ws + WS_PROJ); const float* lw = (const float*)(p.ws + WS_LORAW); const float* la = (const float*)(p.ws + WS_LORAA); float* ops = (float*)(p.ws + WS_OPS);
    const float* mu = p.in[I_MU]; const float* kkw = p.in[I_KK]; const float* kaw = p.in[I_KA]; const float* rkw = p.in[I_RK];
    const int gw = blockIdx.x * NWAVES + wave;
    for (int pr = gw; pr < NTOK * NH; pr += NGW) { const int tok = pr >> 3, h = pr & 7, col = h * HD + lane; const bool first = (tok & (SEQ - 1)) == 0;
        const bf16_t* row = proj + (size_t)tok * DIN;
        const float pr_ = bf2f(row[col]), pk_ = bf2f(row[COL_K + col]), pv_ = bf2f(row[COL_V + col]);
        const float qr_ = first ? 0.f : bf2f(row[col - DIN]), qk_ = first ? 0.f : bf2f(row[COL_K + col - DIN]), qv_ = first ? 0.f : bf2f(row[COL_V + col - DIN]);
        const float r = pr_ + mu[col] * (qr_ - pr_), kraw = pk_ + mu[COL_K + col] * (qk_ - pk_), v = pv_ + mu[COL_V + col] * (qv_ - pv_);
        const float a = sigmoidf_(p.in[I_A0][col] + la[(size_t)tok * DR + col]);
        float w; { const float z = -(p.in[I_W0][col] + lw[(size_t)tok * DR + col]); const float sp = fmaxf(z, 0.f) + __logf(1.0f + __expf(-fabsf(z))); w = __expf(-__expf(-sp - 0.5f)); }
        float kk = kraw * kkw[col]; const float nrm = sqrtf(wave_sum(kk * kk)); kk = kk / fmaxf(nrm, 1e-12f);
        const float kmod = kraw * (1.0f + (a - 1.0f) * kaw[col]), b = kk * a;
        const float br = wave_sum(b * r), kr = wave_sum(kmod * r), rk = wave_sum(r * kmod * rkw[col]);
        float* o = ops + ((size_t)((tok >> 12) * NH + h) * SEQ + (tok & (SEQ - 1))) * OPS_STRIDE;
        *(f32x2*)(o + 2 * lane) = (f32x2){-kk, w * r}; o[128 + lane] = w; o[192 + lane] = b; o[256 + lane] = kmod; o[320 + lane] = v;
        if (lane == 0) *(f32x4*)(o + 384) = (f32x4){br, kr, rk, 0.f}; }
}
template <int CTRL> __device__ __forceinline__ float dpp_mov(float x) { return __int_as_float(__builtin_amdgcn_update_dpp(0, __float_as_int(x), CTRL, 0xF, 0xF, true)); }
__device__ __forceinline__ float rowsum16(float x) { x += dpp_mov<0xB1>(x); x += dpp_mov<0x4E>(x); x += dpp_mov<0x141>(x); x += dpp_mov<0x140>(x); return x; }
constexpr int RW_BLK = 16, RW_BLKB = RW_BLK * OPS_STRIDE * 4, RW_BUFB = 25600, RW_NPC = 25;
__device__ __forceinline__ void rwkv_dma(const char* gs, LAS unsigned char* dst, int wave, int lane) {
    for (int pc = wave; pc < RW_NPC; pc += NWAVES) __builtin_amdgcn_global_load_lds((const unsigned*)(gs + pc * 1024 + lane * 16), (LAS unsigned*)(dst + pc * 1024), 16, 0, 0);
}
__device__ __forceinline__ void p5_rwkv(const Params& p, LAS unsigned char* lds, int wave, int lane) {
    const int wg = blockIdx.x, bh = wg >> 1, half = wg & 1, rg = lane >> 4, j = lane & 15, row = half * 32 + wave * 4 + rg, b = bh >> 3, h = bh & 7;
    const char* src = (const char*)((const float*)(p.ws + WS_OPS) + (size_t)bh * SEQ * OPS_STRIDE);
    float* yraw = (float*)(p.ws + WS_YRAW);
    f32x2 S01 = (f32x2){0.f, 0.f}, S23 = (f32x2){0.f, 0.f};
    rwkv_dma(src, lds, wave, lane);
    VM_WAIT(); __syncthreads();
    for (int n = 0; n < SEQ / RW_BLK; ++n) {
        const int buf = n & 1;
        if (n + 1 < SEQ / RW_BLK) rwkv_dma(src + (size_t)(n + 1) * RW_BLKB, lds + (buf ^ 1) * RW_BUFB, wave, lane);
        const LAS unsigned char* bp = lds + buf * RW_BUFB;
        float ykeep = 0.f;
#pragma unroll
        for (int s = 0; s < RW_BLK; ++s) {
            const LAS unsigned char* sp = bp + s * (OPS_STRIDE * 4);
            const f32x4 pa = *(const LAS f32x4*)(sp + j * 32), pb = *(const LAS f32x4*)(sp + j * 32 + 16);
            const f32x4 w4 = *(const LAS f32x4*)(sp + 512 + j * 16), b4 = *(const LAS f32x4*)(sp + 768 + j * 16), k4 = *(const LAS f32x4*)(sp + 1024 + j * 16);
            const float vv = *(const LAS float*)(sp + 1280 + row * 4);
            const f32x2 sc = *(const LAS f32x2*)(sp + 1536);
            f32x2 acc = (f32x2){S01.x, S01.x} * (f32x2){pa[0], pa[1]};
            acc = (f32x2){S01.y, S01.y} * (f32x2){pa[2], pa[3]} + acc;
            acc = (f32x2){S23.x, S23.x} * (f32x2){pb[0], pb[1]} + acc;
            acc = (f32x2){S23.y, S23.y} * (f32x2){pb[2], pb[3]} + acc;
            const float sa = rowsum16(acc.x), yd = rowsum16(acc.y);
            const float y = yd + sa * sc.x + vv * sc.y;
            const f32x2 sa2 = (f32x2){sa, sa}, vv2 = (f32x2){vv, vv};
            S01 = S01 * (f32x2){w4[0], w4[1]} + (sa2 * (f32x2){b4[0], b4[1]} + vv2 * (f32x2){k4[0], k4[1]});
            S23 = S23 * (f32x2){w4[2], w4[3]} + (sa2 * (f32x2){b4[2], b4[3]} + vv2 * (f32x2){k4[2], k4[3]});
            ykeep = (j == s) ? y : ykeep;
        }
        yraw[((size_t)(b * SEQ + n * RW_BLK + j)) * DR + h * HD + row] = ykeep;
        VM_WAIT(); __syncthreads();
    }
}
__device__ __forceinline__ float gelu_tanh(float y) { const float t = 0.7978845608028654f * (y + 0.044715f * y * y * y); const float th = 1.0f - 2.0f / (1.0f + __expf(2.0f * t)); return 0.5f * y * (1.0f + th); }
__device__ __forceinline__ void p5_s5(const Params& p, LAS unsigned char* lds, int wave, int lane) {
    const int sq = wave >> 2, wq = wave & 3, q = (blockIdx.x - 128) * 2 + sq, b = q >> 5, g = q & 31;
    LAS unsigned char* L = lds + sq * 65536; LAS float* bu = (LAS float*)L; LAS unsigned char* st = L + 32768;
    const float dt = expf(p.in[I_LSTEP][g]);
    float lbr, lbi;
    { const int pp = lane; const float lre = fminf(p.in[I_LRE][g * 64 + pp], -1e-4f), lim = p.in[I_LIM][g * 64 + pp]; const float mag = expf(lre * dt), ang = lim * dt; lbr = mag * cosf(ang); lbi = mag * sinf(ang); }
    bf16x8 Bop;
    { const int c = 32 * wq + (lane & 31), pp = c & 63, isim = c >> 6; const float lre = fminf(p.in[I_LRE][g * 64 + pp], -1e-4f), lim = p.in[I_LIM][g * 64 + pp];
      const float mag = expf(lre * dt), ang = lim * dt, cr = mag * cosf(ang), ci = mag * sinf(ang), den = lre * lre + lim * lim, nre = cr - 1.0f;
      const float zre = (nre * lre + ci * lim) / den, zim = (ci * lre - nre * lim) / den;
      const float* bre = p.in[I_BRE] + (size_t)(g * 64 + pp) * 16 + 8 * (lane >> 5); const float* bim = p.in[I_BIM] + (size_t)(g * 64 + pp) * 16 + 8 * (lane >> 5);
      float t[8];
#pragma unroll
      for (int jj = 0; jj < 8; ++jj) t[jj] = isim ? (zre * bim[jj] + zim * bre[jj]) : (zre * bre[jj] - zim * bim[jj]);
      u32x4 w; w.x = cvt_pk_bf16(t[0], t[1]); w.y = cvt_pk_bf16(t[2], t[3]); w.z = cvt_pk_bf16(t[4], t[5]); w.w = cvt_pk_bf16(t[6], t[7]); Bop = __builtin_bit_cast(bf16x8, w); }
    bf16x8 Bout[4];
#pragma unroll
    for (int ks = 0; ks < 4; ++ks) { const int m = lane & 15; float t[8];
#pragma unroll
        for (int jj = 0; jj < 8; ++jj) { const int k = 32 * ks + 8 * (lane >> 4) + jj, pp = k >> 1; t[jj] = (k & 1) ? -p.in[I_CIM][(size_t)(g * 16 + m) * 64 + pp] : p.in[I_CRE][(size_t)(g * 16 + m) * 64 + pp]; }
        u32x4 w; w.x = cvt_pk_bf16(t[0], t[1]); w.y = cvt_pk_bf16(t[2], t[3]); w.z = cvt_pk_bf16(t[4], t[5]); w.w = cvt_pk_bf16(t[6], t[7]); Bout[ks] = __builtin_bit_cast(bf16x8, w); }
    const float dsk = p.in[I_DSKIP][g * 16 + (lane & 15)];
    const bf16_t* ubase = (const bf16_t*)(p.ws + WS_PROJ) + (size_t)b * SEQ * DIN + COL_U + g * 16;
    bf16_t* yg = (bf16_t*)(p.ws + WS_YGELU) + (size_t)b * SEQ * DSSM + g * 16;
    const size_t aoffs = (size_t)(lane & 31) * DIN + 8 * (lane >> 5);
    bf16x8 A0 = *(const bf16x8*)(ubase + aoffs), A1 = *(const bf16x8*)(ubase + aoffs + (size_t)32 * DIN);
    float sre = 0.f, sim = 0.f;
    for (int tile = 0; tile < SEQ / 64; ++tile) { const int t0 = tile * 64;
        const f32x16 z16 = {0.f, 0.f, 0.f, 0.f, 0.f, 0.f, 0.f, 0.f, 0.f, 0.f, 0.f, 0.f, 0.f, 0.f, 0.f, 0.f};
        const f32x16 d0 = __builtin_amdgcn_mfma_f32_32x32x16_bf16(A0, Bop, z16, 0, 0, 0), d1 = __builtin_amdgcn_mfma_f32_32x32x16_bf16(A1, Bop, z16, 0, 0, 0);
        { const int c = 32 * wq + (lane & 31), pp = c & 63, isim = c >> 6;
#pragma unroll
          for (int r = 0; r < 16; ++r) { const int rw = (r & 3) + 8 * (r >> 2) + 4 * (lane >> 5); bu[(rw * 64 + pp) * 2 + isim] = d0[r]; bu[((rw + 32) * 64 + pp) * 2 + isim] = d1[r]; } }
        if (tile + 1 < SEQ / 64) { A0 = *(const bf16x8*)(ubase + (size_t)(t0 + 64) * DIN + aoffs); A1 = *(const bf16x8*)(ubase + (size_t)(t0 + 96) * DIN + aoffs); }
        __syncthreads();
        if (wq == 0) {
#pragma unroll 8
            for (int t = 0; t < 64; ++t) { const f32x2 x = *(const LAS f32x2*)(bu + (t * 64 + lane) * 2); const float nr = lbr * sre - lbi * sim + x.x, ni = lbr * sim + lbi * sre + x.y; sre = nr; sim = ni;
                *(LAS unsigned*)(st + t * 272 + lane * 4) = cvt_pk_bf16(sre, sim); } }
        __syncthreads();
        f32x4 acc = (f32x4){0.f, 0.f, 0.f, 0.f};
#pragma unroll
        for (int ks = 0; ks < 4; ++ks) { const bf16x8 a = *(const LAS bf16x8*)(st + (16 * wq + (lane & 15)) * 272 + (32 * ks + 8 * (lane >> 4)) * 2); acc = __builtin_amdgcn_mfma_f32_16x16x32_bf16(a, Bout[ks], acc, 0, 0, 0); }
#pragma unroll
        for (int r = 0; r < 4; ++r) { const int tok = t0 + 16 * wq + 4 * (lane >> 4) + r, m = lane & 15; const float u = bf2f(ubase[(size_t)tok * DIN + m]);
            yg[(size_t)tok * DSSM + m] = f2bf(gelu_tanh(acc[r] + dsk * u)); }
    }
}
__device__ __forceinline__ void p7_mix(const Params& p, int wave, int lane) {
    const float* yraw = (const float*)(p.ws + WS_YRAW); const float* ops = (const float*)(p.ws + WS_OPS); const float* lg = (const float*)(p.ws + WS_LORAG); bf16_t* mixed = (bf16_t*)(p.ws + WS_MIXED);
    const float* lnw = p.in[I_LNW]; const float* lnb = p.in[I_LNB];
    const int gw = blockIdx.x * NWAVES + wave;
    for (int pr = gw; pr < NTOK * NH; pr += NGW) { const int tok = pr >> 3, h = pr & 7, col = h * HD + lane;
        const float y = yraw[(size_t)tok * DR + col]; const float mu = wave_sum(y) * (1.0f / 64.0f), d = y - mu, var = wave_sum(d * d) * (1.0f / 64.0f);
        const float yn = d * (1.0f / sqrtf(var + 64e-5f)) * lnw[col] + lnb[col];
        const float* o = ops + ((size_t)((tok >> 12) * NH + h) * SEQ + (tok & (SEQ - 1))) * OPS_STRIDE;
        const float v = o[320 + lane], rk = o[386], g = lg[(size_t)tok * DR + col];
        mixed[(size_t)tok * DM + col] = f2bf((yn + rk * v) * g); }
    const bf16_t* yglu = (const bf16_t*)(p.ws + WS_YGLU); const float* ssq = (const float*)(p.ws + WS_SSQ);
    for (int tok = gw; tok < NTOK; tok += NGW) { const f32x4 s0 = *(const f32x4*)(ssq + (size_t)tok * 8), s1 = *(const f32x4*)(ssq + (size_t)tok * 8 + 4);
        const float ss = ((s0[0] + s0[1]) + (s0[2] + s0[3])) + ((s1[0] + s1[1]) + (s1[2] + s1[3])); const float rs = 1.0f / sqrtf(ss * (1.0f / DSSM) + 1e-5f);
        const u32x4 yv = *(const u32x4*)(yglu + (size_t)tok * DSSM + 8 * lane);
        u32x4 w; w.x = cvt_pk_bf16(bflo(yv.x) * rs, bfhi(yv.x) * rs); w.y = cvt_pk_bf16(bflo(yv.y) * rs, bfhi(yv.y) * rs); w.z = cvt_pk_bf16(bflo(yv.z) * rs, bfhi(yv.z) * rs); w.w = cvt_pk_bf16(bflo(yv.w) * rs, bfhi(yv.w) * rs);
        *(u32x4*)(mixed + (size_t)tok * DM + DR + 8 * lane) = w; }
}
constexpr int RT_ROW = 36;
constexpr int RT_HIST = 147456, RT_BASE = RT_HIST + 128, RT_ETAB = RT_HIST + 256, RT_RS = RT_HIST + 256 + 2048;
__device__ __forceinline__ void p9_router(const Params& p, LAS unsigned char* lds, int wave, int lane) {
    const float* x1 = p.out; const float* rwp = (const float*)(p.ws + WS_RWP); const float* rb = p.in[I_RB];
    int* eid = (int*)(p.ws + WS_EID); float* gate = (float*)(p.ws + WS_GATE); int* relpos = (int*)(p.ws + WS_RELPOS); int* stok = (int*)(p.ws + WS_STOK); float* srs = (float*)(p.ws + WS_SRS);
    unsigned* gcount = (unsigned*)(p.ws + WS_CTL) + CW_GCOUNT;
    const int tid = wave * 64 + lane;
    LAS unsigned* hist = (LAS unsigned*)(lds + RT_HIST); LAS unsigned* base = (LAS unsigned*)(lds + RT_BASE); LAS unsigned* etab = (LAS unsigned*)(lds + RT_ETAB); LAS float* rsl = (LAS float*)(lds + RT_RS);
#pragma unroll
    for (int c = 0; c < 16; ++c) { const int i4 = tid + 512 * c, k = i4 >> 3, e4 = i4 & 7; *(LAS f32x4*)(lds + k * (RT_ROW * 4) + e4 * 16) = *(const f32x4*)(rwp + (size_t)i4 * 4); }
    if (tid < 32) hist[tid] = 0u;
    __syncthreads();
    const int e_own = lane >> 1; const float rbias = rb[e_own];
    for (int i = 0; i < 16; ++i) { const int tl = wave * 16 + i, tok = blockIdx.x * 128 + tl;
        const float* xr = x1 + (size_t)tok * DM; float xv[16]; float ss = 0.f;
#pragma unroll
        for (int c = 0; c < 16; ++c) { xv[c] = xr[lane + 64 * c]; ss += xv[c] * xv[c]; }
        float pl[32];
#pragma unroll
        for (int e = 0; e < 32; ++e) pl[e] = 0.f;
#pragma unroll
        for (int c = 0; c < 16; ++c) { const LAS f32x4* wrow = (const LAS f32x4*)(lds + (lane + 64 * c) * (RT_ROW * 4));
#pragma unroll
            for (int e4 = 0; e4 < 8; ++e4) { const f32x4 w = wrow[e4]; pl[4 * e4 + 0] += xv[c] * w[0]; pl[4 * e4 + 1] += xv[c] * w[1]; pl[4 * e4 + 2] += xv[c] * w[2]; pl[4 * e4 + 3] += xv[c] * w[3]; } }
        ss = wave_sum(ss); const float rstd = 1.0f / sqrtf(ss * (1.0f / DM) + 1e-5f);
        const bool b5 = (lane & 32) != 0, b4 = (lane & 16) != 0, b3 = (lane & 8) != 0, b2 = (lane & 4) != 0, b1 = (lane & 2) != 0;
        float q16[16], q8[8], q4[4], q2[2];
#pragma unroll
        for (int k = 0; k < 16; ++k) { const float keep = b5 ? pl[k + 16] : pl[k], send = b5 ? pl[k] : pl[k + 16]; q16[k] = keep + __shfl_xor(send, 32); }
#pragma unroll
        for (int k = 0; k < 8; ++k) { const float keep = b4 ? q16[k + 8] : q16[k], send = b4 ? q16[k] : q16[k + 8]; q8[k] = keep + __shfl_xor(send, 16); }
#pragma unroll
        for (int k = 0; k < 4; ++k) { const float keep = b3 ? q8[k + 4] : q8[k], send = b3 ? q8[k] : q8[k + 4]; q4[k] = keep + __shfl_xor(send, 8); }
#pragma unroll
        for (int k = 0; k < 2; ++k) { const float keep = b2 ? q4[k + 2] : q4[k], send = b2 ? q4[k] : q4[k + 2]; q2[k] = keep + __shfl_xor(send, 4); }
        float q1; { const float keep = b1 ? q2[1] : q2[0], send = b1 ? q2[0] : q2[1]; q1 = keep + __shfl_xor(send, 2); }
        q1 += __shfl_xor(q1, 1);
        const float logit = q1 * rstd + rbias;
        const bool even = (lane & 1) == 0;
        float cur = even ? logit : -3.0e38f; int rank = -1; float topv[4];
#pragma unroll
        for (int k = 0; k < 4; ++k) { float m = cur;
#pragma unroll
            for (int o = 32; o >= 1; o >>= 1) m = fmaxf(m, __shfl_xor(m, o));
            const unsigned long long bm = __ballot(cur == m); const int l0 = __ffsll((long long)bm) - 1;
            if (lane == l0) { rank = k; cur = -3.0e38f; }
            topv[k] = m; }
        const float sum = 1.0f + __expf(topv[1] - topv[0]) + __expf(topv[2] - topv[0]) + __expf(topv[3] - topv[0]);
        if (rank >= 0) { const unsigned lr = atomicAdd((unsigned*)&hist[e_own], 1u); eid[(size_t)tok * 4 + rank] = e_own; gate[(size_t)tok * 4 + rank] = __expf(logit - topv[0]) / sum; etab[tl * 4 + rank] = (lr << 5) | (unsigned)e_own; }
        if (lane == 0) rsl[tl] = rstd;
    }
    __syncthreads();
    if (tid < 32) { const unsigned hc = hist[tid]; base[tid] = hc ? atomicAdd(&gcount[tid], hc) : 0u; }
    __syncthreads();
    { const int tl = tid >> 2, k = tid & 3, tok = blockIdx.x * 128 + tl; const unsigned pk = etab[tid]; const int e = pk & 31; const unsigned rel = base[e] + (pk >> 5);
      relpos[(size_t)tok * 4 + k] = (int)rel; stok[(size_t)e * CAP + rel] = tok; srs[(size_t)e * CAP + rel] = rsl[tl]; }
}
__device__ __forceinline__ void moe_tables(const Params& p, LAS unsigned char* lds, const bool t0) {
    const unsigned* gcount = (const unsigned*)(p.ws + WS_CTL) + CW_GCOUNT;
    LAS int* tsrc = (LAS int*)(lds + TAB_SRC); LAS int* tval = (LAS int*)(lds + TAB_VAL); LAS int* te = (LAS int*)(lds + TAB_E); LAS int* tbase = (LAS int*)(lds + TAB_BASE);
    if (t0) { int tb = 0;
        for (int e = 0; e < NE; ++e) { const int c = (int)__hip_atomic_load(&gcount[e], __ATOMIC_RELAXED, __HIP_MEMORY_SCOPE_AGENT); const int nt = (c + 255) >> 8; tbase[e] = tb;
            for (int lt = 0; lt < nt; ++lt) { tsrc[tb + lt] = e * CAP + lt * 256; const int rem = c - lt * 256; tval[tb + lt] = rem < 256 ? rem : 256; te[tb + lt] = e; }
            tb += nt; }
        tbase[NE] = tb; }
    __syncthreads();
}
__device__ __forceinline__ void p12_combine(const Params& p, LAS unsigned char* lds, int wave, int lane) {
    float* x1 = p.out; const bf16_t* ys = (const bf16_t*)(p.ws + WS_YSORT); const int* eid = (const int*)(p.ws + WS_EID); const float* gate = (const float*)(p.ws + WS_GATE); const int* relpos = (const int*)(p.ws + WS_RELPOS);
    const float* fg = p.in[I_FG]; const LAS int* tbase = (const LAS int*)(lds + TAB_BASE);
    const int gw = blockIdx.x * NWAVES + wave;
    f32x4 gv[4];
#pragma unroll
    for (int j = 0; j < 4; ++j) gv[j] = *(const f32x4*)(fg + 4 * lane + 256 * j);
    for (int tok = gw; tok < NTOK; tok += NGW) { f32x4 v[4];
#pragma unroll
        for (int j = 0; j < 4; ++j) v[j] = *(const f32x4*)(x1 + (size_t)tok * DM + 4 * lane + 256 * j);
#pragma unroll
        for (int k = 0; k < 4; ++k) { const int e = eid[(size_t)tok * 4 + k]; const float gt = gate[(size_t)tok * 4 + k]; const int rp = relpos[(size_t)tok * 4 + k]; const bf16_t* yr = ys + ((size_t)tbase[e] * 256 + rp) * DM + 4 * lane;
#pragma unroll
            for (int j = 0; j < 4; ++j) { const u32x2 w = *(const u32x2*)(yr + 256 * j); v[j][0] += gt * bflo(w.x); v[j][1] += gt * bfhi(w.x); v[j][2] += gt * bflo(w.y); v[j][3] += gt * bfhi(w.y); } }
        float ss = 0.f;
#pragma unroll
        for (int j = 0; j < 4; ++j) ss += (v[j][0] * v[j][0] + v[j][1] * v[j][1]) + (v[j][2] * v[j][2] + v[j][3] * v[j][3]);
        ss = wave_sum(ss); const float rs = 1.0f / sqrtf(ss * (1.0f / DM) + 1e-5f);
#pragma unroll
        for (int j = 0; j < 4; ++j) *(f32x4*)(x1 + (size_t)tok * DM + 4 * lane + 256 * j) = v[j] * rs * gv[j]; }
}
#ifndef N_PHASES
#define N_PHASES 13
#endif
struct Args { Params p; int ph_lo, ph_hi; };
__global__ void __launch_bounds__(NWAVES * 64, 2) hymba_fwd(Args a) {
    extern __shared__ __attribute__((aligned(16))) unsigned char lds_raw[];
    LAS unsigned char* lds = (LAS unsigned char*)lds_raw;
    const Params& p = a.p;
    const int wave = __builtin_amdgcn_readfirstlane((int)threadIdx.x >> 6);
    volatile LAS unsigned* misc = (volatile LAS unsigned*)(lds + MISC_OFF);
    if (threadIdx.x < 4) misc[threadIdx.x] = 0u;
    __syncthreads();
    unsigned* ctl = (unsigned*)(p.ws + WS_CTL);
    XcdBarrier bar = xcd_barrier_post(ctl + CW_BAR, misc);
    const int lo = a.ph_lo, hi = a.ph_hi;
#ifndef PH_MASK
#define PH_MASK 0x1FFF
#endif
#define IN(k) ((((PH_MASK) >> (k)) & 1) && lo <= (k) && (k) < hi)
#define SEAM(k) do { if (IN(k) && IN((k) + 1)) xcd_barrier(bar, wave == 0 && lane_id() == 0); } while (0)
#define LN lane_id()
    unsigned char* ws = p.ws;
    if (IN(0)) { p0_prologue(p, lds, wave, LN); } SEAM(0);
    if (IN(1)) { pg8::Gemm g{(const bf16_t*)(ws + WS_XB), (const bf16_t*)(ws + WS_WINT), NTOK, DIN, DM}; pg8::StaticOrder S; S.init(NTOK, DIN, GRID, (int)blockIdx.x);
        EpiProj E{(bf16_t*)(ws + WS_PROJ), DIN, (const float*)(ws + WS_RSTD1)}; pg8::gemm_phase<EpiProj, pg8::StaticOrder, true, false>(lds, g, S, E, wave); } SEAM(1);
    if (IN(2)) { p2_lora_in(p, wave, LN); } SEAM(2);
    if (IN(3)) { pg8::Gemm g{(const bf16_t*)(ws + WS_LORAIN), (const bf16_t*)(ws + WS_LORAB), NTOK, 1536, 256}; pg8::StaticOrder S; S.init(NTOK, 1536, GRID, (int)blockIdx.x);
        EpiLora E{(float*)(ws + WS_LORAW), (float*)(ws + WS_LORAA), (float*)(ws + WS_LORAG)}; pg8::gemm_phase<EpiLora, pg8::StaticOrder, true, false>(lds, g, S, E, wave); } SEAM(3);
    if (IN(4)) { p4_prep(p, wave, LN); } SEAM(4);
    if (IN(5)) { if (blockIdx.x < 128) p5_rwkv(p, lds, wave, LN); else p5_s5(p, lds, wave, LN); } SEAM(5);
    if (IN(6)) { pg8::Gemm g{(const bf16_t*)(ws + WS_YGELU), (const bf16_t*)(ws + WS_WGLUT), NTOK, DSSM, DSSM}; pg8::StaticOrder S; S.init(NTOK, DSSM, GRID, (int)blockIdx.x);
        EpiGlu E{(const bf16_t*)(ws + WS_YGELU), (bf16_t*)(ws + WS_YGLU), p.in[I_BGLU], (float*)(ws + WS_SSQ)}; pg8::gemm_phase<EpiGlu, pg8::StaticOrder, false, false>(lds, g, S, E, wave); } SEAM(6);
    if (IN(7)) { p7_mix(p, wave, LN); } SEAM(7);
    if (IN(8)) { pg8::Gemm g{(const bf16_t*)(ws + WS_MIXED), (const bf16_t*)(ws + WS_WOUTT), NTOK, DM, DM}; pg8::StaticOrder S; S.init(NTOK, DM, GRID, (int)blockIdx.x);
        EpiOut E{p.in[I_X], p.out, (bf16_t*)(ws + WS_XB)}; pg8::gemm_phase<EpiOut, pg8::StaticOrder, true, false>(lds, g, S, E, wave); } SEAM(8);
    if (IN(9)) { p9_router(p, lds, wave, LN); } SEAM(9);
    if (IN(10) || IN(11) || IN(12)) moe_tables(p, lds, wave == 0 && lane_id() == 0);
    if (IN(10)) { MoeOrder S{GRID, (int)blockIdx.x, 8, ((const LAS int*)(lds + TAB_BASE))[NE], (const LAS int*)(lds + TAB_SRC), (const LAS int*)(lds + TAB_VAL), (const LAS int*)(lds + TAB_E), (const int*)(ws + WS_STOK)};
        pg8::Gemm g{(const bf16_t*)(ws + WS_XB), (const bf16_t*)(ws + WS_W1T), 0, 0, DM};
        EpiSwiglu E{(bf16_t*)(ws + WS_ACT), (const float*)(ws + WS_B1G), (const float*)(ws + WS_B1L), (const float*)(ws + WS_SRS), (const LAS int*)(lds + TAB_SRC), (const LAS int*)(lds + TAB_VAL)};
        pg8::gemm_phase<EpiSwiglu, MoeOrder, true, true>(lds, g, S, E, wave); } SEAM(10);
    if (IN(11)) { MoeOrder S{GRID, (int)blockIdx.x, 4, ((const LAS int*)(lds + TAB_BASE))[NE], (const LAS int*)(lds + TAB_SRC), (const LAS int*)(lds + TAB_VAL), (const LAS int*)(lds + TAB_E), (const int*)(ws + WS_STOK)};
        pg8::Gemm g{(const bf16_t*)(ws + WS_ACT), (const bf16_t*)(ws + WS_W2T), 0, 0, DFF};
        EpiMoe2 E{(bf16_t*)(ws + WS_YSORT), p.in[I_B2]}; pg8::gemm_phase<EpiMoe2, MoeOrder, true, false>(lds, g, S, E, wave); } SEAM(11);
    if (IN(12)) { p12_combine(p, lds, wave, LN); }
#undef IN
#undef SEAM
#undef LN
}
#ifndef MK_SPLIT
#define MK_SPLIT 0
#endif
extern "C" void kernel_launch(void* const* d_in, const int* in_sizes, int n_in, void* d_out, int out_size, void* d_ws, size_t ws_size, hipStream_t stream) {
    static int ready = 0;
    if (ready == 0) {
        if (n_in != 34 || out_size != NTOK * DM || ws_size < WS_END) { fprintf(stderr, "kernel_launch: unexpected shapes (n_in %d, out %d, ws %zu); nothing launched\n", n_in, out_size, ws_size); ready = -1; return; }
        if (hipFuncSetAttribute((const void*)hymba_fwd, hipFuncAttributeMaxDynamicSharedMemorySize, LDS_BYTES) != hipSuccess) { fprintf(stderr, "kernel_launch: hipFuncSetAttribute failed\n"); ready = -1; return; }
        int per_cu = 0; if (hipOccupancyMaxActiveBlocksPerMultiprocessor(&per_cu, (const void*)hymba_fwd, NWAVES * 64, LDS_BYTES) != hipSuccess || per_cu < 1) fprintf(stderr, "kernel_launch: occupancy query says %d\n", per_cu);
        (void)hipGetLastError();
        ready = 1;
    }
    if (ready < 0) return;
    (void)hipMemsetAsync((char*)d_ws + WS_CTL, 0, CTL_ZERO_BYTES, stream);
    Args a{};
    for (int i = 0; i < 34; ++i) a.p.in[i] = (const float*)d_in[i];
    a.p.out = (float*)d_out; a.p.ws = (unsigned char*)d_ws;
#if MK_SPLIT
    for (int ph = 0; ph < N_PHASES; ++ph) { a.ph_lo = ph; a.ph_hi = ph + 1; hipLaunchKernelGGL(hymba_fwd, dim3(GRID), dim3(NWAVES * 64), LDS_BYTES, stream, a); }
#else
    a.ph_lo = 0; a.ph_hi = N_PHASES; hipLaunchKernelGGL(hymba_fwd, dim3(GRID), dim3(NWAVES * 64), LDS_BYTES, stream, a);
#endif
}
```

```cpp
#include <hip/hip_runtime.h>
#include <cstdio>
#include <cstdint>

#define LAS __attribute__((address_space(3)))
typedef unsigned short bf16_t;
typedef short bf16x8 __attribute__((ext_vector_type(8)));
typedef float f32x4 __attribute__((ext_vector_type(4)));
typedef float f32x2 __attribute__((ext_vector_type(2)));
typedef float f32x16 __attribute__((ext_vector_type(16)));
typedef unsigned u32x4 __attribute__((ext_vector_type(4)));
typedef unsigned u32x2 __attribute__((ext_vector_type(2)));

__device__ __forceinline__ unsigned cvt_pk_bf16(float lo, float hi) { unsigned r; asm volatile("v_cvt_pk_bf16_f32 %0, %1, %2" : "=v"(r) : "v"(lo), "v"(hi)); return r; }
__device__ __forceinline__ float bflo(unsigned w) { return __uint_as_float(w << 16); }
__device__ __forceinline__ float bfhi(unsigned w) { return __uint_as_float(w & 0xffff0000u); }
__device__ __forceinline__ float bf2f(bf16_t b) { return __uint_as_float(((unsigned)b) << 16); }
__device__ __forceinline__ bf16_t f2bf(float f) { return (bf16_t)(cvt_pk_bf16(f, 0.f) & 0xffffu); }
__device__ __forceinline__ float wave_sum(float v) {
#pragma unroll
    for (int o = 32; o >= 1; o >>= 1) v += __shfl_xor(v, o);
    return v;
}
__device__ __forceinline__ float sigmoidf_(float x) { return 1.0f / (1.0f + __expf(-x)); }
__device__ __forceinline__ int lane_id() { int l; asm volatile("v_mbcnt_lo_u32_b32 %0, -1, 0\n\tv_mbcnt_hi_u32_b32 %0, -1, %0" : "=v"(l)); return l; }
#define LDS_WAIT() asm volatile("s_waitcnt lgkmcnt(0)" ::: "memory")
#define VM_WAIT() asm volatile("s_waitcnt vmcnt(0)" ::: "memory")

namespace pg8 {
constexpr int BM = 256, BK = 64, HALF = 128, HTB = HALF * BK * 2, STAGE_BYTES = 8 * HTB, NXCD = 8, WGM = 8;
__host__ __device__ __forceinline__ int lds_byte(int r, int c) { const int st = (r >> 4) * 2 + (c >> 5), rr = r & 15, cc = c & 31, ob = rr * 64 + cc * 2; return st * 1024 + (ob ^ (((ob >> 9) & 1) << 5)); }
__host__ __device__ __forceinline__ void stage_rc(int b, int& R, int& C) { const int st = b / 1024, sb = b % 1024, swz = sb ^ (((sb >> 9) & 1) << 5); R = (st >> 1) * 16 + swz / 64; C = (st & 1) * 32 + (swz % 64) / 2; }
__host__ __device__ __forceinline__ int perm32(int rho) { const int n = rho >> 4, i = rho & 15; return 8 * (i >> 2) + 4 * n + (i & 3); }

struct Unit { int pm, pn; };
struct Gemm { const bf16_t* A; const bf16_t* Bt; int M, N, K; };

struct StaticOrder {
    int nM, nN, nwg, G, c;
    __host__ __device__ void init(int M, int N, int G_, int c_) { nM = M / BM; nN = N / BM; nwg = nM * nN; G = G_; c = c_; }
    __host__ __device__ bool next(int i, Unit& u) const {
        const long L = (long)i * G + c; if (L >= nwg) return false;
        int wgid = (int)L; { const int q = nwg / NXCD, r = nwg % NXCD, xcd = wgid % NXCD, off = wgid / NXCD; wgid = (xcd < r ? xcd * (q + 1) : r * (q + 1) + (xcd - r) * q) + off; }
        const int nig = WGM * nN, gid = wgid / nig, fm = gid * WGM, gsz = (nM - fm) < WGM ? (nM - fm) : WGM;
        u.pm = fm + ((wgid % nig) % gsz); u.pn = (wgid % nig) / gsz; return true;
    }
    __device__ __forceinline__ int arow(const Unit& u, int r) const { return u.pm * BM + r; }
};

template <class Epi, class Sched, bool ALIGN_EPI, bool GATHER>
__device__ __forceinline__ void gemm_phase(LAS unsigned char* lds, const Gemm g, const Sched& S, const Epi& E, const int wid) {
    const int lane = lane_id(), tid = wid * 64 + lane, wr = wid >> 2, wc = wid & 3, fr = lane & 15, fq = lane >> 4;
    const int K = g.K, nt = K / BK;
    int Rst[2], Cst[2];
    unsigned voffB[2], vAc[2][2], vAn[2][2];
#pragma unroll
    for (int i = 0; i < 2; ++i) { int R, C; stage_rc(tid * 16 + i * 8192, R, C); const int Rb = Epi::PERM ? ((R & ~31) + perm32(R & 31)) : R;
        Rst[i] = R; Cst[i] = C; voffB[i] = (unsigned)(Rb * K + C) * 2u; }
    const size_t kstep = (size_t)(BK * 2);
    const size_t hstep = (size_t)HALF * K * 2;
    const size_t tstep = 2 * hstep;
    const unsigned ldsw = (unsigned)wid * 1024u;
    const int aoff = lds_byte(wr * 64 + fr, fq * 8), boff = lds_byte(wc * 32 + fr, fq * 8);
#define PG8_SA(b, h) (((b) * 2 + (h)) * HTB)
#define PG8_SB(b, h) ((4 + (b) * 2 + (h)) * HTB)
#define PG8_STAGE(bufoff, gbase, voff) do { _Pragma("unroll") for (int _i = 0; _i < 2; ++_i) \
        __builtin_amdgcn_global_load_lds((const unsigned*)((const char*)(gbase) + (voff)[_i]), (LAS unsigned*)(lds + (bufoff) + ldsw + _i * 8192), 16, 0, 0); } while (0)
#define PG8_STAGE_SEL(bufoff, gbase, va, vb, sel) do { _Pragma("unroll") for (int _i = 0; _i < 2; ++_i) \
        __builtin_amdgcn_global_load_lds((const unsigned*)((const char*)(gbase) + ((sel) ? (vb)[_i] : (va)[_i])), (LAS unsigned*)(lds + (bufoff) + ldsw + _i * 8192), 16, 0, 0); } while (0)
#define PG8_LDA(dst, b, h) do { _Pragma("unroll") for (int m = 0; m < 4; ++m) _Pragma("unroll") for (int k = 0; k < 2; ++k) dst[m][k] = *(const LAS bf16x8*)(lds + PG8_SA(b, h) + aoff + m * 2048 + k * 1024); } while (0)
#define PG8_LDB(dst, b, h) do { _Pragma("unroll") for (int n = 0; n < 2; ++n) _Pragma("unroll") for (int k = 0; k < 2; ++k) dst[n][k] = *(const LAS bf16x8*)(lds + PG8_SB(b, h) + boff + n * 2048 + k * 1024); } while (0)
#define PG8_MMA(ai, bj, At, Bt) do { __builtin_amdgcn_s_setprio(1); _Pragma("unroll") for (int m = 0; m < 4; ++m) _Pragma("unroll") for (int n = 0; n < 2; ++n) _Pragma("unroll") for (int k = 0; k < 2; ++k) \
        acc[ai][bj][m][n] = __builtin_amdgcn_mfma_f32_16x16x32_bf16(Bt[n][k], At[m][k], acc[ai][bj][m][n], 0, 0, 0); __builtin_amdgcn_s_setprio(0); } while (0)
#define PG8_WAIT_V(n) asm volatile("s_waitcnt vmcnt(" #n ")" ::: "memory")
#define PG8_WAIT_L(n) asm volatile("s_waitcnt lgkmcnt(" #n ")" ::: "memory")
#define PG8_BAR __builtin_amdgcn_s_barrier()
#define PG8_SCHED __builtin_amdgcn_sched_barrier(0)
#define PG8_LOADOFF(dst, unit) do { _Pragma("unroll") for (int _h = 0; _h < 2; ++_h) _Pragma("unroll") for (int _i = 0; _i < 2; ++_i) \
        dst[_h][_i] = GATHER ? ((unsigned)S.arow(unit, _h * HALF + Rst[_i]) * (unsigned)(K * 2) + (unsigned)(Cst[_i] * 2)) : ((unsigned)((_h * HALF + Rst[_i]) * K + Cst[_i]) * 2u); } while (0)
    Unit cur, nxt; int ui = 0;
    if (!S.next(0, cur)) return;
    f32x4 acc[2][2][4][2];
#pragma unroll
    for (int a = 0; a < 2; ++a)
#pragma unroll
        for (int b = 0; b < 2; ++b)
#pragma unroll
            for (int m = 0; m < 4; ++m)
#pragma unroll
                for (int n = 0; n < 2; ++n) acc[a][b][m][n] = (f32x4){0.f, 0.f, 0.f, 0.f};
    bf16x8 At[4][2], B0[2][2], B1[2][2];
    const char* cA = GATHER ? (const char*)g.A : (const char*)g.A + (size_t)cur.pm * tstep; const char* cB = (const char*)g.Bt + (size_t)cur.pn * tstep;
    PG8_LOADOFF(vAc, cur);
    if (GATHER) { Unit u1; if (S.next(1, u1)) PG8_LOADOFF(vAn, u1); else PG8_LOADOFF(vAn, cur); } else { PG8_LOADOFF(vAn, cur); }
    PG8_STAGE(PG8_SB(0, 0), cB, voffB); PG8_STAGE(PG8_SB(0, 1), cB + hstep, voffB); PG8_STAGE(PG8_SA(0, 0), cA, vAc[0]); PG8_STAGE(PG8_SA(0, 1), cA, vAc[1]);
    if (wr == 1) PG8_BAR;
    PG8_WAIT_V(2); PG8_BAR;
    PG8_STAGE(PG8_SB(1, 0), cB + kstep, voffB); PG8_STAGE(PG8_SA(1, 0), cA + kstep, vAc[0]); PG8_STAGE(PG8_SB(1, 1), cB + hstep + kstep, voffB);
    PG8_WAIT_V(6); PG8_BAR;
    for (;;) {
        const bool has_next = S.next(ui + 1, nxt);
        const char* nA = GATHER ? cA : (has_next ? (const char*)g.A + (size_t)nxt.pm * tstep : cA); const char* nB = has_next ? (const char*)g.Bt + (size_t)nxt.pn * tstep : cB;
        const bool usen = GATHER && has_next;
        for (int t = 0; t < nt; t += 2) {
            const bool last = (t == nt - 2);
            const char* a1 = cA + (size_t)(t + 1) * kstep;
            const char* a2 = last ? nA : cA + (size_t)(t + 2) * kstep; const char* b2 = last ? nB : cB + (size_t)(t + 2) * kstep;
            const char* a3 = a2 + kstep; const char* b3 = b2 + kstep;
            const bool sel = last && usen;
            PG8_LDB(B0, 0, 0); PG8_LDB(B1, 0, 1); PG8_SCHED; PG8_LDA(At, 0, 0); PG8_STAGE(PG8_SA(1, 1), a1, vAc[1]);
            PG8_WAIT_V(8); PG8_WAIT_L(0); PG8_BAR; PG8_MMA(0, 0, At, B0); PG8_MMA(0, 1, At, B1); PG8_BAR; PG8_SCHED;
            PG8_LDA(At, 0, 1); PG8_STAGE(PG8_SB(0, 0), b2, voffB); PG8_STAGE(PG8_SB(0, 1), b2 + hstep, voffB); PG8_STAGE_SEL(PG8_SA(0, 0), a2, vAc[0], vAn[0], sel);
            PG8_WAIT_V(8); PG8_WAIT_L(0); PG8_BAR; PG8_MMA(1, 0, At, B0); PG8_MMA(1, 1, At, B1); PG8_BAR; PG8_SCHED;
            PG8_LDB(B0, 1, 0); PG8_LDB(B1, 1, 1); PG8_SCHED; PG8_LDA(At, 1, 0); PG8_STAGE_SEL(PG8_SA(0, 1), a2, vAc[1], vAn[1], sel);
            PG8_WAIT_V(8); PG8_WAIT_L(0); PG8_BAR; PG8_MMA(0, 0, At, B0); PG8_MMA(0, 1, At, B1); PG8_BAR; PG8_SCHED;
            PG8_LDA(At, 1, 1); PG8_STAGE(PG8_SB(1, 0), b3, voffB); PG8_STAGE(PG8_SB(1, 1), b3 + hstep, voffB); PG8_STAGE_SEL(PG8_SA(1, 0), a3, vAc[0], vAn[0], sel);
            PG8_WAIT_V(8); PG8_WAIT_L(0); PG8_BAR; PG8_MMA(1, 0, At, B0); PG8_MMA(1, 1, At, B1); PG8_BAR; PG8_SCHED;
        }
        if constexpr (ALIGN_EPI) { if (wr == 0) PG8_BAR; }
        E(acc, cur, wr, wc, fr, fq);
        if (!has_next) break;
#pragma unroll
        for (int a = 0; a < 2; ++a)
#pragma unroll
            for (int b = 0; b < 2; ++b)
#pragma unroll
                for (int m = 0; m < 4; ++m)
#pragma unroll
                    for (int n = 0; n < 2; ++n) acc[a][b][m][n] = (f32x4){0.f, 0.f, 0.f, 0.f};
        cur = nxt; cA = nA; cB = nB; ++ui;
        if (GATHER) {
#pragma unroll
            for (int _h = 0; _h < 2; ++_h)
#pragma unroll
                for (int _i = 0; _i < 2; ++_i) vAc[_h][_i] = vAn[_h][_i];
            Unit u2; if (S.next(ui + 1, u2)) PG8_LOADOFF(vAn, u2);
        }
        if constexpr (ALIGN_EPI) { if (wr == 1) PG8_BAR; }
    }
    PG8_WAIT_V(0);
    if constexpr (!ALIGN_EPI) { if (wr == 0) PG8_BAR; }
    PG8_BAR;
#undef PG8_SA
#undef PG8_SB
#undef PG8_STAGE
#undef PG8_STAGE_SEL
#undef PG8_LDA
#undef PG8_LDB
#undef PG8_MMA
#undef PG8_WAIT_V
#undef PG8_WAIT_L
#undef PG8_BAR
#undef PG8_SCHED
#undef PG8_LOADOFF
}
}
#define XB_TMO      128
#define XB_XCNT(j)  (256  + 64 * (j))
#define XB_XSUB(j)  (1280 + 64 * (j))
#define XB_XGEN(j)  (2304 + 64 * (j))
#define XB_TOP      3328
#define XB_TOPGEN   3392
#define XCD_BAR_WORDS 3456
#define XB_SPIN_CAP (1u << 18)

__device__ __forceinline__ unsigned xb_ld(unsigned* p)              { return __hip_atomic_load(p, __ATOMIC_RELAXED, __HIP_MEMORY_SCOPE_AGENT); }
__device__ __forceinline__ unsigned xb_add(unsigned* p, unsigned v) { return __hip_atomic_fetch_add(p, v, __ATOMIC_RELAXED, __HIP_MEMORY_SCOPE_AGENT); }
__device__ __forceinline__ unsigned xb_xcc_id() { return (unsigned)__builtin_amdgcn_s_getreg((3 << 11) | 20) & 0xFu; }
#define XB_SPIN(cond, bar) do { unsigned _sp = 0; while (cond) { __builtin_amdgcn_s_sleep(1); \
    if ((++_sp & 255u) == 0u) { if (xb_ld(&(bar)[XB_TMO])) break; if (_sp > XB_SPIN_CAP) { atomicAdd(&(bar)[XB_TMO], 1u); break; } } } } while (0)

struct XcdBarrier {
    unsigned* bar; unsigned x;
    volatile LAS unsigned* st;
};

__device__ __forceinline__ XcdBarrier xcd_barrier_post(unsigned* bar, volatile LAS unsigned* st) {
    XcdBarrier b; b.bar = bar; b.x = xb_xcc_id(); b.st = st;
    if (threadIdx.x == 0) (void)xb_add(&bar[XB_XCNT(b.x)], 1u);
    return b;
}
__device__ __forceinline__ void xcd_barrier_complete(unsigned* bar, unsigned x, unsigned& nloc, unsigned& nx) {
    const unsigned G = gridDim.x * gridDim.y * gridDim.z;
    unsigned sum, cnt, mine, sp = 0u;
    for (;;) {
        sum = 0u; cnt = 0u; mine = 0u;
#pragma unroll
        for (unsigned j = 0; j < 16; ++j) { const unsigned c = xb_ld(&bar[XB_XCNT(j)]); sum += c; cnt += (c > 0u) ? 1u : 0u; mine = (j == x) ? c : mine; }
        if (sum == G) break;
        __builtin_amdgcn_s_sleep(1);
        if ((++sp & 255u) == 0u) { if (xb_ld(&bar[XB_TMO])) break; if (sp > XB_SPIN_CAP) { atomicAdd(&bar[XB_TMO], 1u); break; } }
    }
    nloc = mine > 0u ? mine : 1u; nx = cnt > 0u ? cnt : 1u;
}

__device__ __forceinline__ void xcd_barrier(const XcdBarrier& b, const bool t0) {
    asm volatile("s_waitcnt vmcnt(0)" ::: "memory");
    __syncthreads();
    if (t0) {
        unsigned* bar = b.bar;
        __builtin_amdgcn_s_waitcnt(0);
        unsigned nloc = b.st[0], nx = b.st[1];
        if (nloc == 0u) { xcd_barrier_complete(bar, b.x, nloc, nx); b.st[0] = nloc; b.st[1] = nx; }
        const unsigned old = xb_add(&bar[XB_XSUB(b.x)], 1u);
        const unsigned gen = old / nloc;
        if (old + 1u == (gen + 1u) * nloc) {
            __builtin_amdgcn_fence(__ATOMIC_RELEASE, "agent");
            asm volatile("s_waitcnt vmcnt(0)" ::: "memory");
            const unsigned og = xb_add(&bar[XB_TOP], 1u);
            const unsigned tg = og / nx;
            if (og + 1u == (tg + 1u) * nx) xb_add(&bar[XB_TOPGEN], 1u);
            else XB_SPIN(xb_ld(&bar[XB_TOPGEN]) == tg, bar);
            __builtin_amdgcn_fence(__ATOMIC_ACQUIRE, "agent");
            xb_add(&bar[XB_XGEN(b.x)], 1u);
            asm volatile("s_waitcnt vmcnt(0)" ::: "memory");
        } else {
            XB_SPIN(xb_ld(&bar[XB_XGEN(b.x)]) == gen, bar);
            __builtin_amdgcn_fence(__ATOMIC_ACQUIRE, "agent");
            asm volatile("s_waitcnt vmcnt(0)" ::: "memory");
        }
    }
    __syncthreads();
}

constexpr int DM = 1024, NBATCH = 8, SEQ = 4096, NTOK = NBATCH * SEQ;
constexpr int DIN = 2304, DR = 512, DSSM = 512, NH = 8, HD = 64;
constexpr int COL_K = 512, COL_V = 1024, COL_LORA = 1536, COL_U = 1792;
constexpr int NE = 32, DFF = 1024, CAP = 32768, MAXTILES = 544;
constexpr int OPS_STRIDE = 388;
constexpr int NWAVES = 8, GRID = 256, NGW = GRID * NWAVES;
constexpr size_t MiB = 1u << 20;
constexpr size_t WS_CTL = 0, CTL_ZERO_BYTES = 1 * MiB;
constexpr size_t WS_WINT = 1 * MiB, WS_LORAB = 6 * MiB, WS_WGLUT = 7 * MiB, WS_WOUTT = 8 * MiB;
constexpr size_t WS_B1G = 10 * MiB, WS_B1L = 10 * MiB + 128 * 1024, WS_RWP = 10 * MiB + 256 * 1024, WS_RSTD1 = 10 * MiB + 512 * 1024;
constexpr size_t WS_SSQ = 11 * MiB, WS_EID = 12 * MiB, WS_GATE = 12 * MiB + 512 * 1024, WS_RELPOS = 13 * MiB, WS_STOK = 14 * MiB;
constexpr size_t WS_W2T = 20 * MiB, WS_W1T = 84 * MiB, WS_XB = 212 * MiB;
constexpr size_t WS_PROJ = 276 * MiB, WS_LORAIN = 420 * MiB, WS_LORAW = 436 * MiB, WS_LORAA = 500 * MiB, WS_LORAG = 564 * MiB, WS_OPS = 628 * MiB, WS_SRS = 1016 * MiB, WS_END = 1020 * MiB;
constexpr size_t WS_YRAW = WS_LORAW, WS_YGELU = WS_LORAA, WS_YGLU = WS_LORAA + 32 * MiB, WS_MIXED = WS_PROJ, WS_ACT = WS_OPS, WS_YSORT = WS_PROJ;
static_assert(WS_LORAA - WS_LORAW == (size_t)NTOK * 512 * 4 && WS_LORAG - WS_LORAA == (size_t)NTOK * 512 * 4, "lora buffers contiguous");
static_assert(WS_OPS + (size_t)64 * 4096 * OPS_STRIDE * 4 <= WS_SRS, "ops fits");
constexpr int CW_TMO = 0, CW_BAR = 4096, CW_GCOUNT = 16384;
constexpr int LDS_BYTES = 163840, TAB_OFF = 131072, MISC_OFF = 159744;
constexpr int TAB_SRC = TAB_OFF, TAB_VAL = TAB_OFF + MAXTILES * 4, TAB_E = TAB_OFF + 2 * MAXTILES * 4, TAB_BASE = TAB_OFF + 3 * MAXTILES * 4;

struct Params { const float* in[34]; float* out; unsigned char* ws; };
enum { I_X = 0, I_N1G, I_WIN, I_MU, I_W0, I_WUP, I_A0, I_AUP, I_GUP, I_KK, I_KA, I_RK, I_LNW, I_LNB, I_LRE, I_LIM, I_LSTEP, I_BRE, I_BIM, I_CRE, I_CIM, I_DSKIP, I_WGLU, I_BGLU, I_BETA, I_WOUT, I_N2G, I_RW, I_RB, I_W1, I_B1, I_W2, I_B2, I_FG };

using pg8::Unit; using pg8::HALF; using pg8::BM;
struct EpiProj {
    static constexpr bool PERM = true;
    bf16_t* O; int ldc; const float* rs;
    __device__ __forceinline__ void operator()(const f32x4 (&acc)[2][2][4][2], const Unit& u, int wr, int wc, int fr, int fq) const {
        const int row0 = u.pm * BM + wr * 64 + fr, col0 = u.pn * BM + wc * 32 + 8 * fq;
#pragma unroll
        for (int ai = 0; ai < 2; ++ai)
#pragma unroll
            for (int m = 0; m < 4; ++m) { const int row = row0 + ai * HALF + m * 16; const float s = rs[row]; bf16_t* rowp = O + (size_t)row * ldc + col0;
#pragma unroll
                for (int bj = 0; bj < 2; ++bj) { const f32x4 v0 = acc[ai][bj][m][0] * s, v1 = acc[ai][bj][m][1] * s;
                    u32x4 w; w.x = cvt_pk_bf16(v0[0], v0[1]); w.y = cvt_pk_bf16(v0[2], v0[3]); w.z = cvt_pk_bf16(v1[0], v1[1]); w.w = cvt_pk_bf16(v1[2], v1[3]);
                    *(u32x4*)(rowp + bj * HALF) = w; } }
    }
};
struct EpiLora {
    static constexpr bool PERM = false;
    float* bw; float* ba; float* bg;
    __device__ __forceinline__ void operator()(const f32x4 (&acc)[2][2][4][2], const Unit& u, int wr, int wc, int fr, int fq) const {
        const int kind = u.pn >> 1; const int row0 = u.pm * BM + wr * 64 + fr, cc0 = (u.pn & 1) * 256 + wc * 32 + 4 * fq;
        float* base = bw + (size_t)kind * ((size_t)NTOK * 512);
#pragma unroll
        for (int ai = 0; ai < 2; ++ai)
#pragma unroll
            for (int m = 0; m < 4; ++m) { float* rowp = base + (size_t)(row0 + ai * HALF + m * 16) * 512 + cc0;
#pragma unroll
                for (int bj = 0; bj < 2; ++bj)
#pragma unroll
                    for (int n = 0; n < 2; ++n) *(f32x4*)(rowp + bj * HALF + n * 16) = acc[ai][bj][m][n]; }
    }
};
struct EpiGlu {
    static constexpr bool PERM = true;
    const bf16_t* Y; bf16_t* O; const float* bias; float* ssq;
    __device__ __forceinline__ void operator()(const f32x4 (&acc)[2][2][4][2], const Unit& u, int wr, int wc, int fr, int fq) const {
        const int row0 = u.pm * BM + wr * 64 + fr, col0 = u.pn * BM + wc * 32 + 8 * fq;
        f32x4 bv[2][2];
#pragma unroll
        for (int bj = 0; bj < 2; ++bj)
#pragma unroll
            for (int n = 0; n < 2; ++n) bv[bj][n] = *(const f32x4*)(bias + col0 + bj * HALF + 4 * n);
#pragma unroll
        for (int ai = 0; ai < 2; ++ai)
#pragma unroll
            for (int m = 0; m < 4; ++m) { const int row = row0 + ai * HALF + m * 16; float sq = 0.f;
#pragma unroll
                for (int bj = 0; bj < 2; ++bj) { const size_t off = (size_t)row * 512 + col0 + bj * HALF; const u32x4 yv = *(const u32x4*)(Y + off);
                    const f32x4 z0 = acc[ai][bj][m][0] + bv[bj][0], z1 = acc[ai][bj][m][1] + bv[bj][1];
                    float o[8]; o[0] = bflo(yv.x) * sigmoidf_(z0[0]); o[1] = bfhi(yv.x) * sigmoidf_(z0[1]); o[2] = bflo(yv.y) * sigmoidf_(z0[2]); o[3] = bfhi(yv.y) * sigmoidf_(z0[3]);
                    o[4] = bflo(yv.z) * sigmoidf_(z1[0]); o[5] = bfhi(yv.z) * sigmoidf_(z1[1]); o[6] = bflo(yv.w) * sigmoidf_(z1[2]); o[7] = bfhi(yv.w) * sigmoidf_(z1[3]);
#pragma unroll
                    for (int j = 0; j < 8; ++j) sq += o[j] * o[j];
                    u32x4 w; w.x = cvt_pk_bf16(o[0], o[1]); w.y = cvt_pk_bf16(o[2], o[3]); w.z = cvt_pk_bf16(o[4], o[5]); w.w = cvt_pk_bf16(o[6], o[7]);
                    *(u32x4*)(O + off) = w; }
                sq += __shfl_xor(sq, 16); sq += __shfl_xor(sq, 32);
                if (fq == 0) ssq[(size_t)row * 8 + u.pn * 4 + wc] = sq; }
    }
};
struct EpiOut {
    static constexpr bool PERM = false;
    const float* X; float* X1; bf16_t* X1B;
    __device__ __forceinline__ void operator()(const f32x4 (&acc)[2][2][4][2], const Unit& u, int wr, int wc, int fr, int fq) const {
        const int row0 = u.pm * BM + wr * 64 + fr, col0 = u.pn * BM + wc * 32 + 4 * fq;
#pragma unroll
        for (int ai = 0; ai < 2; ++ai)
#pragma unroll
            for (int m = 0; m < 4; ++m) { const size_t off = (size_t)(row0 + ai * HALF + m * 16) * DM + col0;
#pragma unroll
                for (int bj = 0; bj < 2; ++bj)
#pragma unroll
                    for (int n = 0; n < 2; ++n) { const size_t o2 = off + bj * HALF + n * 16; const f32x4 v = *(const f32x4*)(X + o2) + acc[ai][bj][m][n];
                        *(f32x4*)(X1 + o2) = v; u32x2 w; w.x = cvt_pk_bf16(v[0], v[1]); w.y = cvt_pk_bf16(v[2], v[3]); *(u32x2*)(X1B + o2) = w; } }
    }
};
struct EpiSwiglu {
    static constexpr bool PERM = true;
    bf16_t* O; const float* b1g; const float* b1l; const float* srs; const LAS int* tsrc; const LAS int* tval;
    __device__ __forceinline__ void operator()(const f32x4 (&acc)[2][2][4][2], const Unit& u, int wr, int wc, int fr, int fq) const {
        const int e = u.pn >> 3, pnl = u.pn & 7; const int r0 = wr * 64 + fr, o0 = pnl * 128 + wc * 32 + 8 * fq;
        const int src = tsrc[u.pm], nval = tval[u.pm];
        f32x4 bg[2], bl[2];
#pragma unroll
        for (int n = 0; n < 2; ++n) { bg[n] = *(const f32x4*)(b1g + e * DFF + o0 + 4 * n); bl[n] = *(const f32x4*)(b1l + e * DFF + o0 + 4 * n); }
#pragma unroll
        for (int ai = 0; ai < 2; ++ai)
#pragma unroll
            for (int m = 0; m < 4; ++m) { const int r = r0 + ai * HALF + m * 16; const float s = r < nval ? srs[src + r] : 0.f;
                float o[8];
#pragma unroll
                for (int n = 0; n < 2; ++n)
#pragma unroll
                    for (int j = 0; j < 4; ++j) { const float gl = fminf(acc[ai][0][m][n][j] * s + bg[n][j], 7.0f); const float li = fminf(fmaxf(acc[ai][1][m][n][j] * s + bl[n][j], -7.0f), 7.0f);
                        o[4 * n + j] = gl * sigmoidf_(1.702f * gl) * (li + 1.0f); }
                u32x4 w; w.x = cvt_pk_bf16(o[0], o[1]); w.y = cvt_pk_bf16(o[2], o[3]); w.z = cvt_pk_bf16(o[4], o[5]); w.w = cvt_pk_bf16(o[6], o[7]);
                *(u32x4*)(O + (size_t)(u.pm * BM + r) * DFF + o0) = w; }
    }
};
struct EpiMoe2 {
    static constexpr bool PERM = true;
    bf16_t* O; const float* b2;
    __device__ __forceinline__ void operator()(const f32x4 (&acc)[2][2][4][2], const Unit& u, int wr, int wc, int fr, int fq) const {
        const int e = u.pn >> 2, pnl = u.pn & 3; const int row0 = u.pm * BM + wr * 64 + fr, col0 = pnl * BM + wc * 32 + 8 * fq;
        f32x4 bv[2][2];
#pragma unroll
        for (int bj = 0; bj < 2; ++bj)
#pragma unroll
            for (int n = 0; n < 2; ++n) bv[bj][n] = *(const f32x4*)(b2 + e * DM + col0 + bj * HALF + 4 * n);
#pragma unroll
        for (int ai = 0; ai < 2; ++ai)
#pragma unroll
            for (int m = 0; m < 4; ++m) { bf16_t* rowp = O + (size_t)(row0 + ai * HALF + m * 16) * DM + col0;
#pragma unroll
                for (int bj = 0; bj < 2; ++bj) { const f32x4 v0 = acc[ai][bj][m][0] + bv[bj][0], v1 = acc[ai][bj][m][1] + bv[bj][1];
                    u32x4 w; w.x = cvt_pk_bf16(v0[0], v0[1]); w.y = cvt_pk_bf16(v0[2], v0[3]); w.z = cvt_pk_bf16(v1[0], v1[1]); w.w = cvt_pk_bf16(v1[2], v1[3]);
                    *(u32x4*)(rowp + bj * HALF) = w; } }
    }
};
struct MoeOrder {
    int G, c, NT, ntiles; const LAS int* tsrc; const LAS int* tval; const LAS int* te; const int* stok;
    __device__ __forceinline__ bool next(int i, Unit& u) const {
        const int L = i * G + c, xcd = L & 7, j = L >> 3; const int mt = (j / NT) * 8 + xcd; if (mt >= ntiles) return false;
        u.pm = mt; u.pn = te[mt] * NT + (j % NT); return true; }
    __device__ __forceinline__ int arow(const Unit& u, int r) const { return r < tval[u.pm] ? stok[tsrc[u.pm] + r] : 0; }
};
struct KsOne { __device__ __forceinline__ float operator()(int) const { return 1.f; } };
struct KsVec { const float* g; __device__ __forceinline__ float operator()(int k) const { return g[k]; } };
struct KsOut { const float* beta; __device__ __forceinline__ float operator()(int k) const { return k < DR ? 1.f : beta[k - DR]; } };
struct RmId { int off; __device__ __forceinline__ int operator()(int c) const { return off + c; } };
struct RmW1 { int e; __device__ __forceinline__ int operator()(int c) const { const int o = c >> 1, bj = c & 1; return e * 2048 + (o >> 7) * 256 + bj * 128 + (o & 127); } };
template <class KS, class RM>
__device__ __forceinline__ void tr_item(const float* src, int N, int k0, int c0, bf16_t* dst, int ldk, const KS ks, const RM rm, LAS float* scr, int lane) {
#pragma unroll 4
    for (int it = 0; it < 16; ++it) { const int r = it * 4 + (lane >> 4); const f32x4 v = *(const f32x4*)(src + (size_t)(k0 + r) * N + c0 + 4 * (lane & 15)); const float s = ks(k0 + r);
        LAS float* d = scr + r * 65 + 4 * (lane & 15); d[0] = v[0] * s; d[1] = v[1] * s; d[2] = v[2] * s; d[3] = v[3] * s; }
    LDS_WAIT();
    const int c = lane & 7;
#pragma unroll
    for (int jj = 0; jj < 8; ++jj) { const int n = (lane >> 3) + 8 * jj; const LAS float* s = scr + (8 * c) * 65 + n;
        u32x4 o; o.x = cvt_pk_bf16(s[0 * 65], s[1 * 65]); o.y = cvt_pk_bf16(s[2 * 65], s[3 * 65]); o.z = cvt_pk_bf16(s[4 * 65], s[5 * 65]); o.w = cvt_pk_bf16(s[6 * 65], s[7 * 65]);
        *(u32x4*)(dst + (size_t)rm(c0 + n) * ldk + k0 + 8 * c) = o; }
    LDS_WAIT();
}
__device__ __forceinline__ void p0_prologue(const Params& p, LAS unsigned char* lds, int wave, int lane) {
    unsigned char* ws = p.ws;
    LAS float* scr = (LAS float*)(lds + wave * 16640);
    const int gw = blockIdx.x * NWAVES + wave;
    bf16_t* W1T = (bf16_t*)(ws + WS_W1T); bf16_t* W2T = (bf16_t*)(ws + WS_W2T); bf16_t* WinT = (bf16_t*)(ws + WS_WINT); bf16_t* WoutT = (bf16_t*)(ws + WS_WOUTT); bf16_t* WgluT = (bf16_t*)(ws + WS_WGLUT);
    constexpr int I_1 = NE * 16 * 32, I_2 = NE * 16 * 16, I_IN = 16 * 36, I_OUT = 16 * 16, I_GLU = 8 * 8, NITEMS = I_1 + I_2 + I_IN + I_OUT + I_GLU;
    for (int it = gw; it < NITEMS; it += NGW) {
        int r = it;
        if (r < I_1) { const int e = r >> 9, q = r & 511, kb = q >> 5, nb = q & 31; tr_item(p.in[I_W1] + (size_t)e * DM * 2048, 2048, kb * 64, nb * 64, W1T, DM, KsVec{p.in[I_N2G]}, RmW1{e}, scr, lane); continue; } r -= I_1;
        if (r < I_2) { const int e = r >> 8, q = r & 255, kb = q >> 4, nb = q & 15; tr_item(p.in[I_W2] + (size_t)e * DFF * DM, DM, kb * 64, nb * 64, W2T, DFF, KsOne{}, RmId{e * DM}, scr, lane); continue; } r -= I_2;
        if (r < I_IN) { const int kb = r / 36, nb = r % 36; tr_item(p.in[I_WIN], DIN, kb * 64, nb * 64, WinT, DM, KsVec{p.in[I_N1G]}, RmId{0}, scr, lane); continue; } r -= I_IN;
        if (r < I_OUT) { const int kb = r >> 4, nb = r & 15; tr_item(p.in[I_WOUT], DM, kb * 64, nb * 64, WoutT, DM, KsOut{p.in[I_BETA]}, RmId{0}, scr, lane); continue; } r -= I_OUT;
        { const int kb = r >> 3, nb = r & 7; tr_item(p.in[I_WGLU], DSSM, kb * 64, nb * 64, WgluT, DSSM, KsOne{}, RmId{0}, scr, lane); }
    }
    { const float* x = p.in[I_X]; bf16_t* xb = (bf16_t*)(ws + WS_XB); float* rs = (float*)(ws + WS_RSTD1);
      for (int m = gw; m < NTOK; m += NGW) { const f32x4* xr = (const f32x4*)(x + (size_t)m * DM) + lane; f32x4 v[4]; float s = 0.f;
#pragma unroll
          for (int j = 0; j < 4; ++j) { v[j] = xr[64 * j]; s += (v[j][0] * v[j][0] + v[j][1] * v[j][1]) + (v[j][2] * v[j][2] + v[j][3] * v[j][3]); }
          s = wave_sum(s); if (lane == 0) rs[m] = 1.0f / sqrtf(s * (1.0f / DM) + 1e-5f);
          u32x2* o8 = (u32x2*)(xb + (size_t)m * DM) + lane;
#pragma unroll
          for (int j = 0; j < 4; ++j) { u32x2 w; w.x = cvt_pk_bf16(v[j][0], v[j][1]); w.y = cvt_pk_bf16(v[j][2], v[j][3]); o8[64 * j] = w; } } }
    const int gt = blockIdx.x * (NWAVES * 64) + wave * 64 + lane, NT_ = GRID * NWAVES * 64;
    { float* b1g = (float*)(ws + WS_B1G); float* b1l = (float*)(ws + WS_B1L); const float* b1 = p.in[I_B1];
      for (int i = gt; i < NE * DFF; i += NT_) { const int e = i >> 10, o = i & 1023; b1g[i] = b1[e * 2048 + 2 * o]; b1l[i] = b1[e * 2048 + 2 * o + 1]; } }
    { float* rwp = (float*)(ws + WS_RWP); const float* rw = p.in[I_RW]; const float* g2 = p.in[I_N2G];
      for (int i = gt; i < DM * NE; i += NT_) rwp[i] = g2[i >> 5] * rw[i]; }
    { bf16_t* LB = (bf16_t*)(ws + WS_LORAB); const float* wup = p.in[I_WUP]; const float* aup = p.in[I_AUP]; const float* gup = p.in[I_GUP];
      for (int i = gt; i < 1536 * 256; i += NT_) { const int n = i >> 8, k = i & 255; float v = 0.f;
          if (n < 512) { if (k < 64) v = wup[k * 512 + n]; } else if (n < 1024) { if (k >= 64 && k < 128) v = aup[(k - 64) * 512 + (n - 512)]; } else { if (k >= 128) v = gup[(k - 128) * 512 + (n - 1024)]; }
          LB[i] = f2bf(v); } }
}
__device__ __forceinline__ void p2_lora_in(const Params& p, int wave, int lane) {
    const bf16_t* proj = (const bf16_t*)(p.ws + WS_PROJ); bf16_t* li = (bf16_t*)(p.ws + WS_LORAIN); const float* mu = p.in[I_MU] + COL_LORA;
    const int gt = blockIdx.x * (NWAVES * 64) + wave * 64 + lane, NT_ = GRID * NWAVES * 64;
    for (int idx = gt; idx < NTOK * 32; idx += NT_) { const int tok = idx >> 5, c = (idx & 31) * 8;
        const bf16_t* pr = proj + (size_t)tok * DIN + COL_LORA + c; const u32x4 cur = *(const u32x4*)pr; u32x4 prv = (u32x4){0u, 0u, 0u, 0u}; if (tok & (SEQ - 1)) prv = *(const u32x4*)(pr - DIN);
        float v[8], q[8];
        v[0] = bflo(cur.x); v[1] = bfhi(cur.x); v[2] = bflo(cur.y); v[3] = bfhi(cur.y); v[4] = bflo(cur.z); v[5] = bfhi(cur.z); v[6] = bflo(cur.w); v[7] = bfhi(cur.w);
        q[0] = bflo(prv.x); q[1] = bfhi(prv.x); q[2] = bflo(prv.y); q[3] = bfhi(prv.y); q[4] = bflo(prv.z); q[5] = bfhi(prv.z); q[6] = bflo(prv.w); q[7] = bfhi(prv.w);
#pragma unroll
        for (int j = 0; j < 8; ++j) { float s = v[j] + mu[c + j] * (q[j] - v[j]); if (c < 64) s = tanhf(s); else if (c >= 128) s = sigmoidf_(s); v[j] = s; }
        u32x4 w; w.x = cvt_pk_bf16(v[0], v[1]); w.y = cvt_pk_bf16(v[2], v[3]); w.z = cvt_pk_bf16(v[4], v[5]); w.w = cvt_pk_bf16(v[6], v[7]);
        *(u32x4*)(li + (size_t)tok * 256 + c) = w; }
}
template <int CTRL> __device__ __forceinline__ float dpp_mov(float x) { return __int_as_float(__builtin_amdgcn_update_dpp(0, __float_as_int(x), CTRL, 0xF, 0xF, true)); }
__device__ __forceinline__ float sum8(float x) { x += dpp_mov<0xB1>(x); x += dpp_mov<0x4E>(x); x += dpp_mov<0x141>(x); return x; }
__device__ __forceinline__ float rowsum16(float x) { x = sum8(x); x += dpp_mov<0x140>(x); return x; }
__device__ __forceinline__ void unpack8(const u32x4 w, float (&f)[8]) { f[0] = bflo(w.x); f[1] = bfhi(w.x); f[2] = bflo(w.y); f[3] = bfhi(w.y); f[4] = bflo(w.z); f[5] = bfhi(w.z); f[6] = bflo(w.w); f[7] = bfhi(w.w); }
__device__ __forceinline__ void ld8(const float* p_, float (&f)[8]) { const f32x4 a = *(const f32x4*)p_, b = *(const f32x4*)(p_ + 4); f[0] = a[0]; f[1] = a[1]; f[2] = a[2]; f[3] = a[3]; f[4] = b[0]; f[5] = b[1]; f[6] = b[2]; f[7] = b[3]; }
struct P4In { u32x4 cr, ck, cv, qr, qk, qv; f32x4 a0, a1, w0, w1; };
__device__ __forceinline__ void p4_load(P4In& in, const bf16_t* proj, const float* la, const float* lw, int tok, int c0) {
    const bf16_t* row = proj + (size_t)tok * DIN + c0; const bool first = (tok & (SEQ - 1)) == 0; const u32x4 z = (u32x4){0u, 0u, 0u, 0u};
    in.cr = *(const u32x4*)row; in.ck = *(const u32x4*)(row + COL_K); in.cv = *(const u32x4*)(row + COL_V);
    in.qr = first ? z : *(const u32x4*)(row - DIN); in.qk = first ? z : *(const u32x4*)(row - DIN + COL_K); in.qv = first ? z : *(const u32x4*)(row - DIN + COL_V);
    const float* pa = la + (size_t)tok * DR + c0; const float* pw = lw + (size_t)tok * DR + c0;
    in.a0 = *(const f32x4*)pa; in.a1 = *(const f32x4*)(pa + 4); in.w0 = *(const f32x4*)pw; in.w1 = *(const f32x4*)(pw + 4);
}
__device__ __forceinline__ void p4_prep(const Params& p, int wave, int lane) {
    const bf16_t* proj = (const bf16_t*)(p.ws + WS_PROJ); const float* lw = (const float*)(p.ws + WS_LORAW); const float* la = (const float*)(p.ws + WS_LORAA); float* ops = (float*)(p.ws + WS_OPS);
    const int c0 = lane * 8, h = lane >> 3, i0 = (lane & 7) * 8;
    float mur[8], muk[8], muv[8], kkw[8], kaw[8], rkw[8], a0c[8], w0c[8];
    ld8(p.in[I_MU] + c0, mur); ld8(p.in[I_MU] + COL_K + c0, muk); ld8(p.in[I_MU] + COL_V + c0, muv); ld8(p.in[I_KK] + c0, kkw); ld8(p.in[I_KA] + c0, kaw); ld8(p.in[I_RK] + c0, rkw); ld8(p.in[I_A0] + c0, a0c); ld8(p.in[I_W0] + c0, w0c);
    const int gw = blockIdx.x * NWAVES + wave;
    P4In cur, nxt; p4_load(cur, proj, la, lw, gw, c0);
    for (int tok = gw; tok < NTOK; tok += NGW) {
        if (tok + NGW < NTOK) p4_load(nxt, proj, la, lw, tok + NGW, c0);
        float cr[8], ck[8], cv[8], qr[8], qk[8], qv[8];
        unpack8(cur.cr, cr); unpack8(cur.ck, ck); unpack8(cur.cv, cv); unpack8(cur.qr, qr); unpack8(cur.qk, qk); unpack8(cur.qv, qv);
        float r[8], kraw[8], v[8], aa[8], ww[8], kk[8], km[8], bb[8]; float n2 = 0.f, br = 0.f, kr = 0.f, rk = 0.f;
#pragma unroll
        for (int j = 0; j < 8; ++j) { r[j] = cr[j] + mur[j] * (qr[j] - cr[j]); kraw[j] = ck[j] + muk[j] * (qk[j] - ck[j]); v[j] = cv[j] + muv[j] * (qv[j] - cv[j]);
            const float ap = j < 4 ? cur.a0[j & 3] : cur.a1[j & 3], wp = j < 4 ? cur.w0[j & 3] : cur.w1[j & 3];
            aa[j] = sigmoidf_(a0c[j] + ap);
            const float z = -(w0c[j] + wp); const float sp = fmaxf(z, 0.f) + __logf(1.0f + __expf(-fabsf(z))); ww[j] = __expf(-__expf(-sp - 0.5f));
            kk[j] = kraw[j] * kkw[j]; n2 += kk[j] * kk[j]; km[j] = kraw[j] * (1.0f + (aa[j] - 1.0f) * kaw[j]); }
        n2 = sum8(n2); const float inv = 1.0f / fmaxf(sqrtf(n2), 1e-12f);
#pragma unroll
        for (int j = 0; j < 8; ++j) { kk[j] *= inv; bb[j] = kk[j] * aa[j]; br += bb[j] * r[j]; kr += km[j] * r[j]; rk += r[j] * km[j] * rkw[j]; }
        br = sum8(br); kr = sum8(kr); rk = sum8(rk);
        float* o = ops + ((size_t)((tok >> 12) * NH + h) * SEQ + (tok & (SEQ - 1))) * OPS_STRIDE;
#pragma unroll
        for (int j = 0; j < 8; j += 2) *(f32x4*)(o + 2 * (i0 + j)) = (f32x4){-kk[j], ww[j] * r[j], -kk[j + 1], ww[j + 1] * r[j + 1]};
        *(f32x4*)(o + 128 + i0) = (f32x4){ww[0], ww[1], ww[2], ww[3]}; *(f32x4*)(o + 128 + i0 + 4) = (f32x4){ww[4], ww[5], ww[6], ww[7]};
        *(f32x4*)(o + 192 + i0) = (f32x4){bb[0], bb[1], bb[2], bb[3]}; *(f32x4*)(o + 192 + i0 + 4) = (f32x4){bb[4], bb[5], bb[6], bb[7]};
        *(f32x4*)(o + 256 + i0) = (f32x4){km[0], km[1], km[2], km[3]}; *(f32x4*)(o + 256 + i0 + 4) = (f32x4){km[4], km[5], km[6], km[7]};
        *(f32x4*)(o + 320 + i0) = (f32x4){v[0], v[1], v[2], v[3]}; *(f32x4*)(o + 320 + i0 + 4) = (f32x4){v[4], v[5], v[6], v[7]};
        if ((lane & 7) == 0) *(f32x4*)(o + 384) = (f32x4){br, kr, rk, 0.f};
        cur = nxt;
    }
}
constexpr int RW_BLK = 16, RW_BLKB = RW_BLK * OPS_STRIDE * 4, RW_BUFB = 25600, RW_NPC = 25;
__device__ __forceinline__ void rwkv_dma(const char* gs, LAS unsigned char* dst, int wave, int lane) {
    for (int pc = wave; pc < RW_NPC; pc += NWAVES) __builtin_amdgcn_global_load_lds((const unsigned*)(gs + pc * 1024 + lane * 16), (LAS unsigned*)(dst + pc * 1024), 16, 0, 0);
}
struct RwOp { f32x4 pa, pb, w4, b4, k4; float vv; f32x2 sc; };
template <int OFF> __device__ __forceinline__ void rw_load(RwOp& o, unsigned a32, unsigned a16, unsigned arow, unsigned asc) {
    asm volatile("ds_read_b128 %0, %7 offset:%11\n\tds_read_b128 %1, %7 offset:%12\n\tds_read_b128 %2, %8 offset:%13\n\tds_read_b128 %3, %8 offset:%14\n\tds_read_b128 %4, %8 offset:%15\n\tds_read_b32 %5, %9 offset:%16\n\tds_read_b64 %6, %10 offset:%17"
                 : "=&v"(o.pa), "=&v"(o.pb), "=&v"(o.w4), "=&v"(o.b4), "=&v"(o.k4), "=&v"(o.vv), "=&v"(o.sc)
                 : "v"(a32), "v"(a16), "v"(arow), "v"(asc), "i"(OFF), "i"(OFF + 16), "i"(OFF + 512), "i"(OFF + 768), "i"(OFF + 1024), "i"(OFF + 1280), "i"(OFF + 1536));
}
template <int N> __device__ __forceinline__ void rw_wait(RwOp& o) {
    asm volatile("s_waitcnt lgkmcnt(%7)" : "+v"(o.pa), "+v"(o.pb), "+v"(o.w4), "+v"(o.b4), "+v"(o.k4), "+v"(o.vv), "+v"(o.sc) : "i"(N));
}
__device__ __forceinline__ void rw_step(const RwOp& o, f32x2& S01, f32x2& S23, float& ykeep, const bool mine) {
    f32x2 acc0 = (f32x2){S01.x, S01.x} * (f32x2){o.pa[0], o.pa[1]}, acc1 = (f32x2){S23.x, S23.x} * (f32x2){o.pb[0], o.pb[1]};
    acc0 = (f32x2){S01.y, S01.y} * (f32x2){o.pa[2], o.pa[3]} + acc0; acc1 = (f32x2){S23.y, S23.y} * (f32x2){o.pb[2], o.pb[3]} + acc1;
    const f32x2 acc = acc0 + acc1;
    const float sa = rowsum16(acc.x), yd = rowsum16(acc.y);
    const float y = yd + sa * o.sc.x + o.vv * o.sc.y;
    const f32x2 sa2 = (f32x2){sa, sa}, vv2 = (f32x2){o.vv, o.vv};
    S01 = S01 * (f32x2){o.w4[0], o.w4[1]} + (sa2 * (f32x2){o.b4[0], o.b4[1]} + vv2 * (f32x2){o.k4[0], o.k4[1]});
    S23 = S23 * (f32x2){o.w4[2], o.w4[3]} + (sa2 * (f32x2){o.b4[2], o.b4[3]} + vv2 * (f32x2){o.k4[2], o.k4[3]});
    ykeep = mine ? y : ykeep;
}
template <int S> struct RwPairs {
    static __device__ __forceinline__ void run(RwOp& A, RwOp& B, f32x2& S01, f32x2& S23, float& yk, int j, unsigned a32, unsigned a16, unsigned arow, unsigned asc) {
        rw_load<(S + 1) * OPS_STRIDE * 4>(B, a32, a16, arow, asc);
        rw_wait<7>(A); rw_step(A, S01, S23, yk, j == S);
        if constexpr (S + 2 < RW_BLK) { rw_load<(S + 2) * OPS_STRIDE * 4>(A, a32, a16, arow, asc); rw_wait<7>(B); } else { rw_wait<0>(B); }
        rw_step(B, S01, S23, yk, j == S + 1);
        if constexpr (S + 2 < RW_BLK) RwPairs<S + 2>::run(A, B, S01, S23, yk, j, a32, a16, arow, asc);
    }
};
__device__ __forceinline__ void p5_rwkv(const Params& p, LAS unsigned char* lds, int wave, int lane) {
    const int wg = blockIdx.x, bh = wg >> 1, half = wg & 1, rg = lane >> 4, j = lane & 15, row = half * 32 + wave * 4 + rg, b = bh >> 3, h = bh & 7;
    const char* src = (const char*)((const float*)(p.ws + WS_OPS) + (size_t)bh * SEQ * OPS_STRIDE);
    float* yraw = (float*)(p.ws + WS_YRAW);
    f32x2 S01 = (f32x2){0.f, 0.f}, S23 = (f32x2){0.f, 0.f};
    rwkv_dma(src, lds, wave, lane);
    VM_WAIT(); __syncthreads();
    for (int n = 0; n < SEQ / RW_BLK; ++n) {
        const int buf = n & 1;
        if (n + 1 < SEQ / RW_BLK) rwkv_dma(src + (size_t)(n + 1) * RW_BLKB, lds + (buf ^ 1) * RW_BUFB, wave, lane);
        const LAS unsigned char* bp = lds + buf * RW_BUFB;
        float ykeep = 0.f;
        RwOp opA, opB;
        { const unsigned base = (unsigned)(size_t)bp; const unsigned a32 = base + j * 32, a16 = base + j * 16, arow = base + row * 4;
          rw_load<0>(opA, a32, a16, arow, base);
          RwPairs<0>::run(opA, opB, S01, S23, ykeep, j, a32, a16, arow, base); }
        yraw[((size_t)(b * SEQ + n * RW_BLK + j)) * DR + h * HD + row] = ykeep;
        VM_WAIT(); __syncthreads();
    }
}
__device__ __forceinline__ float gelu_tanh(float y) { const float t = 0.7978845608028654f * (y + 0.044715f * y * y * y); const float th = 1.0f - 2.0f / (1.0f + __expf(2.0f * t)); return 0.5f * y * (1.0f + th); }
__device__ __forceinline__ void p5_s5(const Params& p, LAS unsigned char* lds, int wave, int lane) {
    const int sq = wave >> 2, wq = wave & 3, q = (blockIdx.x - 128) * 2 + sq, b = q >> 5, g = q & 31;
    LAS unsigned char* L = lds + sq * 65536; LAS float* bu = (LAS float*)L; LAS unsigned char* st = L + 32768;
    const float dt = expf(p.in[I_LSTEP][g]);
    float lbr, lbi;
    { const int pp = lane; const float lre = fminf(p.in[I_LRE][g * 64 + pp], -1e-4f), lim = p.in[I_LIM][g * 64 + pp]; const float mag = expf(lre * dt), ang = lim * dt; lbr = mag * cosf(ang); lbi = mag * sinf(ang); }
    bf16x8 Bop;
    { const int c = 32 * wq + (lane & 31), pp = c & 63, isim = c >> 6; const float lre = fminf(p.in[I_LRE][g * 64 + pp], -1e-4f), lim = p.in[I_LIM][g * 64 + pp];
      const float mag = expf(lre * dt), ang = lim * dt, cr = mag * cosf(ang), ci = mag * sinf(ang), den = lre * lre + lim * lim, nre = cr - 1.0f;
      const float zre = (nre * lre + ci * lim) / den, zim = (ci * lre - nre * lim) / den;
      const float* bre = p.in[I_BRE] + (size_t)(g * 64 + pp) * 16 + 8 * (lane >> 5); const float* bim = p.in[I_BIM] + (size_t)(g * 64 + pp) * 16 + 8 * (lane >> 5);
      float t[8];
#pragma unroll
      for (int jj = 0; jj < 8; ++jj) t[jj] = isim ? (zre * bim[jj] + zim * bre[jj]) : (zre * bre[jj] - zim * bim[jj]);
      u32x4 w; w.x = cvt_pk_bf16(t[0], t[1]); w.y = cvt_pk_bf16(t[2], t[3]); w.z = cvt_pk_bf16(t[4], t[5]); w.w = cvt_pk_bf16(t[6], t[7]); Bop = __builtin_bit_cast(bf16x8, w); }
    bf16x8 Bout[4];
#pragma unroll
    for (int ks = 0; ks < 4; ++ks) { const int m = lane & 15; float t[8];
#pragma unroll
        for (int jj = 0; jj < 8; ++jj) { const int k = 32 * ks + 8 * (lane >> 4) + jj, pp = k >> 1; t[jj] = (k & 1) ? -p.in[I_CIM][(size_t)(g * 16 + m) * 64 + pp] : p.in[I_CRE][(size_t)(g * 16 + m) * 64 + pp]; }
        u32x4 w; w.x = cvt_pk_bf16(t[0], t[1]); w.y = cvt_pk_bf16(t[2], t[3]); w.z = cvt_pk_bf16(t[4], t[5]); w.w = cvt_pk_bf16(t[6], t[7]); Bout[ks] = __builtin_bit_cast(bf16x8, w); }
    const float dsk = p.in[I_DSKIP][g * 16 + (lane & 15)];
    const bf16_t* ubase = (const bf16_t*)(p.ws + WS_PROJ) + (size_t)b * SEQ * DIN + COL_U + g * 16;
    bf16_t* yg = (bf16_t*)(p.ws + WS_YGELU) + (size_t)b * SEQ * DSSM + g * 16;
    const size_t aoffs = (size_t)(lane & 31) * DIN + 8 * (lane >> 5);
    bf16x8 A0 = *(const bf16x8*)(ubase + aoffs), A1 = *(const bf16x8*)(ubase + aoffs + (size_t)32 * DIN);
    float sre = 0.f, sim = 0.f;
    for (int tile = 0; tile < SEQ / 64; ++tile) { const int t0 = tile * 64;
        const f32x16 z16 = {0.f, 0.f, 0.f, 0.f, 0.f, 0.f, 0.f, 0.f, 0.f, 0.f, 0.f, 0.f, 0.f, 0.f, 0.f, 0.f};
        const f32x16 d0 = __builtin_amdgcn_mfma_f32_32x32x16_bf16(A0, Bop, z16, 0, 0, 0), d1 = __builtin_amdgcn_mfma_f32_32x32x16_bf16(A1, Bop, z16, 0, 0, 0);
        { const int c = 32 * wq + (lane & 31), pp = c & 63, isim = c >> 6;
#pragma unroll
          for (int r = 0; r < 16; ++r) { const int rw = (r & 3) + 8 * (r >> 2) + 4 * (lane >> 5); bu[(rw * 64 + pp) * 2 + isim] = d0[r]; bu[((rw + 32) * 64 + pp) * 2 + isim] = d1[r]; } }
        if (tile + 1 < SEQ / 64) { A0 = *(const bf16x8*)(ubase + (size_t)(t0 + 64) * DIN + aoffs); A1 = *(const bf16x8*)(ubase + (size_t)(t0 + 96) * DIN + aoffs); }
        __syncthreads();
        if (wq == 0) {
            f32x2 xa[8], xb[8];
#pragma unroll
            for (int i = 0; i < 8; ++i) xa[i] = *(const LAS f32x2*)(bu + (i * 64 + lane) * 2);
#pragma unroll
            for (int blk = 0; blk < 8; blk += 2) {
#pragma unroll
                for (int i = 0; i < 8; ++i) xb[i] = *(const LAS f32x2*)(bu + (((blk + 1) * 8 + i) * 64 + lane) * 2);
                __builtin_amdgcn_sched_barrier(0);
#pragma unroll
                for (int i = 0; i < 8; ++i) { const float nr = lbr * sre - lbi * sim + xa[i].x, ni = lbr * sim + lbi * sre + xa[i].y; sre = nr; sim = ni; *(LAS unsigned*)(st + (blk * 8 + i) * 272 + lane * 4) = cvt_pk_bf16(sre, sim); }
                if (blk + 2 < 8) {
#pragma unroll
                    for (int i = 0; i < 8; ++i) xa[i] = *(const LAS f32x2*)(bu + (((blk + 2) * 8 + i) * 64 + lane) * 2); }
                __builtin_amdgcn_sched_barrier(0);
#pragma unroll
                for (int i = 0; i < 8; ++i) { const float nr = lbr * sre - lbi * sim + xb[i].x, ni = lbr * sim + lbi * sre + xb[i].y; sre = nr; sim = ni; *(LAS unsigned*)(st + ((blk + 1) * 8 + i) * 272 + lane * 4) = cvt_pk_bf16(sre, sim); }
            } }
        __syncthreads();
        f32x4 acc = (f32x4){0.f, 0.f, 0.f, 0.f};
#pragma unroll
        for (int ks = 0; ks < 4; ++ks) { const bf16x8 a = *(const LAS bf16x8*)(st + (16 * wq + (lane & 15)) * 272 + (32 * ks + 8 * (lane >> 4)) * 2); acc = __builtin_amdgcn_mfma_f32_16x16x32_bf16(a, Bout[ks], acc, 0, 0, 0); }
#pragma unroll
        for (int r = 0; r < 4; ++r) { const int tok = t0 + 16 * wq + 4 * (lane >> 4) + r, m = lane & 15; const float u = bf2f(ubase[(size_t)tok * DIN + m]);
            yg[(size_t)tok * DSSM + m] = f2bf(gelu_tanh(acc[r] + dsk * u)); }
    }
}
struct P7In { f32x4 y0, y1, v0, v1, g0, g1, s0, s1; float rk; u32x4 yg; };
__device__ __forceinline__ void p7_load(P7In& in, const float* yraw, const float* ops, const float* lg, const bf16_t* yglu, const float* ssq, int tok, int lane) {
    const int c0 = lane * 8, h = lane >> 3, i0 = (lane & 7) * 8;
    const float* py = yraw + (size_t)tok * DR + c0; in.y0 = *(const f32x4*)py; in.y1 = *(const f32x4*)(py + 4);
    const float* o = ops + ((size_t)((tok >> 12) * NH + h) * SEQ + (tok & (SEQ - 1))) * OPS_STRIDE; in.v0 = *(const f32x4*)(o + 320 + i0); in.v1 = *(const f32x4*)(o + 320 + i0 + 4); in.rk = o[386];
    const float* pg = lg + (size_t)tok * DR + c0; in.g0 = *(const f32x4*)pg; in.g1 = *(const f32x4*)(pg + 4);
    in.s0 = *(const f32x4*)(ssq + (size_t)tok * 8); in.s1 = *(const f32x4*)(ssq + (size_t)tok * 8 + 4);
    in.yg = *(const u32x4*)(yglu + (size_t)tok * DSSM + c0);
}
__device__ __forceinline__ void p7_mix(const Params& p, int wave, int lane) {
    const float* yraw = (const float*)(p.ws + WS_YRAW); const float* ops = (const float*)(p.ws + WS_OPS); const float* lg = (const float*)(p.ws + WS_LORAG); bf16_t* mixed = (bf16_t*)(p.ws + WS_MIXED);
    const bf16_t* yglu = (const bf16_t*)(p.ws + WS_YGLU); const float* ssq = (const float*)(p.ws + WS_SSQ);
    const int c0 = lane * 8;
    float lnw[8], lnb[8]; ld8(p.in[I_LNW] + c0, lnw); ld8(p.in[I_LNB] + c0, lnb);
    const int gw = blockIdx.x * NWAVES + wave;
    P7In cur, nxt; p7_load(cur, yraw, ops, lg, yglu, ssq, gw, lane);
    for (int tok = gw; tok < NTOK; tok += NGW) {
        if (tok + NGW < NTOK) p7_load(nxt, yraw, ops, lg, yglu, ssq, tok + NGW, lane);
        float y[8], v[8], g[8], o[8];
#pragma unroll
        for (int j = 0; j < 4; ++j) { y[j] = cur.y0[j]; y[j + 4] = cur.y1[j]; v[j] = cur.v0[j]; v[j + 4] = cur.v1[j]; g[j] = cur.g0[j]; g[j + 4] = cur.g1[j]; }
        float sm = 0.f;
#pragma unroll
        for (int j = 0; j < 8; ++j) sm += y[j];
        const float mu = sum8(sm) * (1.0f / 64.0f); float sq = 0.f;
#pragma unroll
        for (int j = 0; j < 8; ++j) { y[j] -= mu; sq += y[j] * y[j]; }
        const float rstd = 1.0f / sqrtf(sum8(sq) * (1.0f / 64.0f) + 64e-5f);
#pragma unroll
        for (int j = 0; j < 8; ++j) o[j] = (y[j] * rstd * lnw[j] + lnb[j] + cur.rk * v[j]) * g[j];
        u32x4 w; w.x = cvt_pk_bf16(o[0], o[1]); w.y = cvt_pk_bf16(o[2], o[3]); w.z = cvt_pk_bf16(o[4], o[5]); w.w = cvt_pk_bf16(o[6], o[7]);
        *(u32x4*)(mixed + (size_t)tok * DM + c0) = w;
        const float ss = ((cur.s0[0] + cur.s0[1]) + (cur.s0[2] + cur.s0[3])) + ((cur.s1[0] + cur.s1[1]) + (cur.s1[2] + cur.s1[3])); const float rs = 1.0f / sqrtf(ss * (1.0f / DSSM) + 1e-5f);
        float yv[8]; unpack8(cur.yg, yv);
        u32x4 w2; w2.x = cvt_pk_bf16(yv[0] * rs, yv[1] * rs); w2.y = cvt_pk_bf16(yv[2] * rs, yv[3] * rs); w2.z = cvt_pk_bf16(yv[4] * rs, yv[5] * rs); w2.w = cvt_pk_bf16(yv[6] * rs, yv[7] * rs);
        *(u32x4*)(mixed + (size_t)tok * DM + DR + c0) = w2;
        cur = nxt;
    }
}
constexpr int RT_ROW = 36;
constexpr int RT_HIST = 147456, RT_BASE = RT_HIST + 128, RT_ETAB = RT_HIST + 256, RT_RS = RT_HIST + 256 + 2048;
__device__ __forceinline__ void p9_router(const Params& p, LAS unsigned char* lds, int wave, int lane) {
    const float* x1 = p.out; const float* rwp = (const float*)(p.ws + WS_RWP); const float* rb = p.in[I_RB];
    int* eid = (int*)(p.ws + WS_EID); float* gate = (float*)(p.ws + WS_GATE); int* relpos = (int*)(p.ws + WS_RELPOS); int* stok = (int*)(p.ws + WS_STOK); float* srs = (float*)(p.ws + WS_SRS);
    unsigned* gcount = (unsigned*)(p.ws + WS_CTL) + CW_GCOUNT;
    const int tid = wave * 64 + lane;
    LAS unsigned* hist = (LAS unsigned*)(lds + RT_HIST); LAS unsigned* base = (LAS unsigned*)(lds + RT_BASE); LAS unsigned* etab = (LAS unsigned*)(lds + RT_ETAB); LAS float* rsl = (LAS float*)(lds + RT_RS);
#pragma unroll
    for (int c = 0; c < 16; ++c) { const int i4 = tid + 512 * c, k = i4 >> 3, e4 = i4 & 7; *(LAS f32x4*)(lds + k * (RT_ROW * 4) + e4 * 16) = *(const f32x4*)(rwp + (size_t)i4 * 4); }
    if (tid < 32) hist[tid] = 0u;
    __syncthreads();
    const int e_own = lane >> 1; const float rbias = rb[e_own];
    float xn[16];
    { const float* xr = x1 + (size_t)(blockIdx.x * 128 + wave * 16) * DM;
#pragma unroll
      for (int c = 0; c < 16; ++c) xn[c] = xr[lane + 64 * c]; }
    for (int i = 0; i < 16; ++i) { const int tl = wave * 16 + i, tok = blockIdx.x * 128 + tl;
        float xv[16]; float ss = 0.f;
#pragma unroll
        for (int c = 0; c < 16; ++c) { xv[c] = xn[c]; ss += xv[c] * xv[c]; }
        if (i + 1 < 16) { const float* xr = x1 + (size_t)(tok + 1) * DM;
#pragma unroll
            for (int c = 0; c < 16; ++c) xn[c] = xr[lane + 64 * c]; }
        float pl[32];
#pragma unroll
        for (int e = 0; e < 32; ++e) pl[e] = 0.f;
#pragma unroll
        for (int c = 0; c < 16; ++c) { const LAS f32x4* wrow = (const LAS f32x4*)(lds + (lane + 64 * c) * (RT_ROW * 4));
#pragma unroll
            for (int e4 = 0; e4 < 8; ++e4) { const f32x4 w = wrow[e4]; pl[4 * e4 + 0] += xv[c] * w[0]; pl[4 * e4 + 1] += xv[c] * w[1]; pl[4 * e4 + 2] += xv[c] * w[2]; pl[4 * e4 + 3] += xv[c] * w[3]; } }
        ss = wave_sum(ss); const float rstd = 1.0f / sqrtf(ss * (1.0f / DM) + 1e-5f);
        const bool b5 = (lane & 32) != 0, b4 = (lane & 16) != 0, b3 = (lane & 8) != 0, b2 = (lane & 4) != 0, b1 = (lane & 2) != 0;
        float q16[16], q8[8], q4[4], q2[2];
#pragma unroll
        for (int k = 0; k < 16; ++k) { const float keep = b5 ? pl[k + 16] : pl[k], send = b5 ? pl[k] : pl[k + 16]; q16[k] = keep + __shfl_xor(send, 32); }
#pragma unroll
        for (int k = 0; k < 8; ++k) { const float keep = b4 ? q16[k + 8] : q16[k], send = b4 ? q16[k] : q16[k + 8]; q8[k] = keep + __shfl_xor(send, 16); }
#pragma unroll
        for (int k = 0; k < 4; ++k) { const float keep = b3 ? q8[k + 4] : q8[k], send = b3 ? q8[k] : q8[k + 4]; q4[k] = keep + __shfl_xor(send, 8); }
#pragma unroll
        for (int k = 0; k < 2; ++k) { const float keep = b2 ? q4[k + 2] : q4[k], send = b2 ? q4[k] : q4[k + 2]; q2[k] = keep + __shfl_xor(send, 4); }
        float q1; { const float keep = b1 ? q2[1] : q2[0], send = b1 ? q2[0] : q2[1]; q1 = keep + __shfl_xor(send, 2); }
        q1 += __shfl_xor(q1, 1);
        const float logit = q1 * rstd + rbias;
        const bool even = (lane & 1) == 0;
        float cur = even ? logit : -3.0e38f; int rank = -1; float topv[4];
#pragma unroll
        for (int k = 0; k < 4; ++k) { float m = cur;
#pragma unroll
            for (int o = 32; o >= 1; o >>= 1) m = fmaxf(m, __shfl_xor(m, o));
            const unsigned long long bm = __ballot(cur == m); const int l0 = __ffsll((long long)bm) - 1;
            if (lane == l0) { rank = k; cur = -3.0e38f; }
            topv[k] = m; }
        const float sum = 1.0f + __expf(topv[1] - topv[0]) + __expf(topv[2] - topv[0]) + __expf(topv[3] - topv[0]);
        if (rank >= 0) { const unsigned lr = atomicAdd((unsigned*)&hist[e_own], 1u); eid[(size_t)tok * 4 + rank] = e_own; gate[(size_t)tok * 4 + rank] = __expf(logit - topv[0]) / sum; etab[tl * 4 + rank] = (lr << 5) | (unsigned)e_own; }
        if (lane == 0) rsl[tl] = rstd;
    }
    __syncthreads();
    if (tid < 32) { const unsigned hc = hist[tid]; base[tid] = hc ? atomicAdd(&gcount[tid], hc) : 0u; }
    __syncthreads();
    { const int tl = tid >> 2, k = tid & 3, tok = blockIdx.x * 128 + tl; const unsigned pk = etab[tid]; const int e = pk & 31; const unsigned rel = base[e] + (pk >> 5);
      relpos[(size_t)tok * 4 + k] = (int)rel; stok[(size_t)e * CAP + rel] = tok; srs[(size_t)e * CAP + rel] = rsl[tl]; }
}
__device__ __forceinline__ void moe_tables(const Params& p, LAS unsigned char* lds, const bool t0) {
    const unsigned* gcount = (const unsigned*)(p.ws + WS_CTL) + CW_GCOUNT;
    LAS int* tsrc = (LAS int*)(lds + TAB_SRC); LAS int* tval = (LAS int*)(lds + TAB_VAL); LAS int* te = (LAS int*)(lds + TAB_E); LAS int* tbase = (LAS int*)(lds + TAB_BASE);
    if (t0) { int tb = 0;
        for (int e = 0; e < NE; ++e) { const int c = (int)__hip_atomic_load(&gcount[e], __ATOMIC_RELAXED, __HIP_MEMORY_SCOPE_AGENT); const int nt = (c + 255) >> 8; tbase[e] = tb;
            for (int lt = 0; lt < nt; ++lt) { tsrc[tb + lt] = e * CAP + lt * 256; const int rem = c - lt * 256; tval[tb + lt] = rem < 256 ? rem : 256; te[tb + lt] = e; }
            tb += nt; }
        tbase[NE] = tb; }
    __syncthreads();
}
typedef int i32x4 __attribute__((ext_vector_type(4)));
struct P12Meta { i32x4 e, rp; f32x4 g; };
struct P12Rows { f32x4 x[4]; u32x2 y[4][4]; f32x4 g; };
__device__ __forceinline__ void p12_meta(P12Meta& m, const int* eid, const float* gate, const int* relpos, int tok) {
    m.e = *(const i32x4*)(eid + (size_t)tok * 4); m.g = *(const f32x4*)(gate + (size_t)tok * 4); m.rp = *(const i32x4*)(relpos + (size_t)tok * 4); }
__device__ __forceinline__ void p12_rows(P12Rows& r, const P12Meta& m, const float* x1, const bf16_t* ys, const LAS int* tbase, int tok, int lane) {
#pragma unroll
    for (int j = 0; j < 4; ++j) r.x[j] = *(const f32x4*)(x1 + (size_t)tok * DM + 4 * lane + 256 * j);
#pragma unroll
    for (int k = 0; k < 4; ++k) { const bf16_t* yr = ys + ((size_t)tbase[m.e[k]] * 256 + m.rp[k]) * DM + 4 * lane;
#pragma unroll
        for (int j = 0; j < 4; ++j) r.y[k][j] = *(const u32x2*)(yr + 256 * j); }
    r.g = m.g;
}
__device__ __forceinline__ void p12_combine(const Params& p, LAS unsigned char* lds, int wave, int lane) {
    float* x1 = p.out; const bf16_t* ys = (const bf16_t*)(p.ws + WS_YSORT); const int* eid = (const int*)(p.ws + WS_EID); const float* gate = (const float*)(p.ws + WS_GATE); const int* relpos = (const int*)(p.ws + WS_RELPOS);
    const float* fg = p.in[I_FG]; const LAS int* tbase = (const LAS int*)(lds + TAB_BASE);
    const int gw = blockIdx.x * NWAVES + wave;
    f32x4 gv[4];
#pragma unroll
    for (int j = 0; j < 4; ++j) gv[j] = *(const f32x4*)(fg + 4 * lane + 256 * j);
    P12Meta m0, m1; P12Rows rc, rn;
    p12_meta(m0, eid, gate, relpos, gw); p12_meta(m1, eid, gate, relpos, gw + NGW);
    p12_rows(rc, m0, x1, ys, tbase, gw, lane);
    for (int tok = gw; tok < NTOK; tok += NGW) {
        m0 = m1;
        if (tok + 2 * NGW < NTOK) p12_meta(m1, eid, gate, relpos, tok + 2 * NGW);
        if (tok + NGW < NTOK) p12_rows(rn, m0, x1, ys, tbase, tok + NGW, lane);
        f32x4 v[4];
#pragma unroll
        for (int j = 0; j < 4; ++j) v[j] = rc.x[j];
#pragma unroll
        for (int k = 0; k < 4; ++k) { const float gt = rc.g[k];
#pragma unroll
            for (int j = 0; j < 4; ++j) { const u32x2 w = rc.y[k][j]; v[j][0] += gt * bflo(w.x); v[j][1] += gt * bfhi(w.x); v[j][2] += gt * bflo(w.y); v[j][3] += gt * bfhi(w.y); } }
        float ss = 0.f;
#pragma unroll
        for (int j = 0; j < 4; ++j) ss += (v[j][0] * v[j][0] + v[j][1] * v[j][1]) + (v[j][2] * v[j][2] + v[j][3] * v[j][3]);
        ss = wave_sum(ss); const float rs = 1.0f / sqrtf(ss * (1.0f / DM) + 1e-5f);
#pragma unroll
        for (int j = 0; j < 4; ++j) *(f32x4*)(x1 + (size_t)tok * DM + 4 * lane + 256 * j) = v[j] * rs * gv[j];
        rc = rn;
    }
}
#ifndef N_PHASES
#define N_PHASES 13
#endif
struct Args { Params p; int ph_lo, ph_hi, li, pad; };
__global__ void __launch_bounds__(NWAVES * 64, 2) hymba_fwd(Args a) {
    extern __shared__ __attribute__((aligned(16))) unsigned char lds_raw[];
    LAS unsigned char* lds = (LAS unsigned char*)lds_raw;
    const Params& p = a.p;
    const int wave = __builtin_amdgcn_readfirstlane((int)threadIdx.x >> 6);
    volatile LAS unsigned* misc = (volatile LAS unsigned*)(lds + MISC_OFF);
    if (threadIdx.x < 4) misc[threadIdx.x] = 0u;
    __syncthreads();
    unsigned* ctl = (unsigned*)(p.ws + WS_CTL);
    XcdBarrier bar = xcd_barrier_post(ctl + CW_BAR + a.li * XCD_BAR_WORDS, misc);
    const int lo = a.ph_lo, hi = a.ph_hi;
#ifndef PH_MASK
#define PH_MASK 0x1FFF
#endif
#define IN(k) ((((PH_MASK) >> (k)) & 1) && lo <= (k) && (k) < hi)
#define SEAM(k) do { if (IN(k) && IN((k) + 1)) xcd_barrier(bar, wave == 0 && lane_id() == 0); } while (0)
#define LN lane_id()
    unsigned char* ws = p.ws;
    if (IN(0)) { p0_prologue(p, lds, wave, LN); } SEAM(0);
    if (IN(1)) { pg8::Gemm g{(const bf16_t*)(ws + WS_XB), (const bf16_t*)(ws + WS_WINT), NTOK, DIN, DM}; pg8::StaticOrder S; S.init(NTOK, DIN, GRID, (int)blockIdx.x);
        EpiProj E{(bf16_t*)(ws + WS_PROJ), DIN, (const float*)(ws + WS_RSTD1)}; pg8::gemm_phase<EpiProj, pg8::StaticOrder, true, false>(lds, g, S, E, wave); } SEAM(1);
    if (IN(2)) { p2_lora_in(p, wave, LN); } SEAM(2);
    if (IN(3)) { pg8::Gemm g{(const bf16_t*)(ws + WS_LORAIN), (const bf16_t*)(ws + WS_LORAB), NTOK, 1536, 256}; pg8::StaticOrder S; S.init(NTOK, 1536, GRID, (int)blockIdx.x);
        EpiLora E{(float*)(ws + WS_LORAW), (float*)(ws + WS_LORAA), (float*)(ws + WS_LORAG)}; pg8::gemm_phase<EpiLora, pg8::StaticOrder, true, false>(lds, g, S, E, wave); } SEAM(3);
    if (IN(4)) { p4_prep(p, wave, LN); } SEAM(4);
    if (IN(5)) { if (blockIdx.x < 128) p5_rwkv(p, lds, wave, LN); else p5_s5(p, lds, wave, LN); } SEAM(5);
    if (IN(6)) { pg8::Gemm g{(const bf16_t*)(ws + WS_YGELU), (const bf16_t*)(ws + WS_WGLUT), NTOK, DSSM, DSSM}; pg8::StaticOrder S; S.init(NTOK, DSSM, GRID, (int)blockIdx.x);
        EpiGlu E{(const bf16_t*)(ws + WS_YGELU), (bf16_t*)(ws + WS_YGLU), p.in[I_BGLU], (float*)(ws + WS_SSQ)}; pg8::gemm_phase<EpiGlu, pg8::StaticOrder, false, false>(lds, g, S, E, wave); } SEAM(6);
    if (IN(7)) { p7_mix(p, wave, LN); } SEAM(7);
    if (IN(8)) { pg8::Gemm g{(const bf16_t*)(ws + WS_MIXED), (const bf16_t*)(ws + WS_WOUTT), NTOK, DM, DM}; pg8::StaticOrder S; S.init(NTOK, DM, GRID, (int)blockIdx.x);
        EpiOut E{p.in[I_X], p.out, (bf16_t*)(ws + WS_XB)}; pg8::gemm_phase<EpiOut, pg8::StaticOrder, true, false>(lds, g, S, E, wave); } SEAM(8);
    if (IN(9)) { p9_router(p, lds, wave, LN); } SEAM(9);
    if (IN(10) || IN(11) || IN(12)) moe_tables(p, lds, wave == 0 && lane_id() == 0);
    if (IN(10)) { MoeOrder S{GRID, (int)blockIdx.x, 8, ((const LAS int*)(lds + TAB_BASE))[NE], (const LAS int*)(lds + TAB_SRC), (const LAS int*)(lds + TAB_VAL), (const LAS int*)(lds + TAB_E), (const int*)(ws + WS_STOK)};
        pg8::Gemm g{(const bf16_t*)(ws + WS_XB), (const bf16_t*)(ws + WS_W1T), 0, 0, DM};
        EpiSwiglu E{(bf16_t*)(ws + WS_ACT), (const float*)(ws + WS_B1G), (const float*)(ws + WS_B1L), (const float*)(ws + WS_SRS), (const LAS int*)(lds + TAB_SRC), (const LAS int*)(lds + TAB_VAL)};
        pg8::gemm_phase<EpiSwiglu, MoeOrder, true, true>(lds, g, S, E, wave); } SEAM(10);
    if (IN(11)) { MoeOrder S{GRID, (int)blockIdx.x, 4, ((const LAS int*)(lds + TAB_BASE))[NE], (const LAS int*)(lds + TAB_SRC), (const LAS int*)(lds + TAB_VAL), (const LAS int*)(lds + TAB_E), (const int*)(ws + WS_STOK)};
        pg8::Gemm g{(const bf16_t*)(ws + WS_ACT), (const bf16_t*)(ws + WS_W2T), 0, 0, DFF};
        EpiMoe2 E{(bf16_t*)(ws + WS_YSORT), p.in[I_B2]}; pg8::gemm_phase<EpiMoe2, MoeOrder, true, false>(lds, g, S, E, wave); } SEAM(11);
    if (IN(12)) { p12_combine(p, lds, wave, LN); }
#undef IN
#undef SEAM
#undef LN
}
#ifndef MK_SPLIT
#define MK_SPLIT 0
#endif
extern "C" void kernel_launch(void* const* d_in, const int* in_sizes, int n_in, void* d_out, int out_size, void* d_ws, size_t ws_size, hipStream_t stream) {
    static int ready = 0;
    if (ready == 0) {
        if (n_in != 34 || out_size != NTOK * DM || ws_size < WS_END) { fprintf(stderr, "kernel_launch: unexpected shapes (n_in %d, out %d, ws %zu); nothing launched\n", n_in, out_size, ws_size); ready = -1; return; }
        if (hipFuncSetAttribute((const void*)hymba_fwd, hipFuncAttributeMaxDynamicSharedMemorySize, LDS_BYTES) != hipSuccess) { fprintf(stderr, "kernel_launch: hipFuncSetAttribute failed\n"); ready = -1; return; }
        int per_cu = 0; if (hipOccupancyMaxActiveBlocksPerMultiprocessor(&per_cu, (const void*)hymba_fwd, NWAVES * 64, LDS_BYTES) != hipSuccess || per_cu < 1) fprintf(stderr, "kernel_launch: occupancy query says %d\n", per_cu);
        (void)hipGetLastError();
        ready = 1;
    }
    if (ready < 0) return;
    (void)hipMemsetAsync((char*)d_ws + WS_CTL, 0, CTL_ZERO_BYTES, stream);
    Args a{};
    for (int i = 0; i < 34; ++i) a.p.in[i] = (const float*)d_in[i];
    a.p.out = (float*)d_out; a.p.ws = (unsigned char*)d_ws;
#if defined(PROBE_LO)
    a.ph_lo = 0; a.ph_hi = PROBE_HI + 1; a.li = 0; hipLaunchKernelGGL(hymba_fwd, dim3(GRID), dim3(NWAVES * 64), LDS_BYTES, stream, a);
    a.ph_lo = PROBE_LO; a.ph_hi = N_PHASES; a.li = 1; hipLaunchKernelGGL(hymba_fwd, dim3(GRID), dim3(NWAVES * 64), LDS_BYTES, stream, a);
#elif MK_SPLIT
    for (int ph = 0; ph < N_PHASES; ++ph) { a.ph_lo = ph; a.ph_hi = ph + 1; a.li = 0; hipLaunchKernelGGL(hymba_fwd, dim3(GRID), dim3(NWAVES * 64), LDS_BYTES, stream, a); }
#else
    a.ph_lo = 0; a.ph_hi = N_PHASES; a.li = 0; hipLaunchKernelGGL(hymba_fwd, dim3(GRID), dim3(NWAVES * 64), LDS_BYTES, stream, a);
#endif
}
```

```cpp
#include <hip/hip_runtime.h>
#include <cstdio>
#include <cstdint>

#define LAS __attribute__((address_space(3)))
typedef unsigned short bf16_t;
typedef short bf16x8 __attribute__((ext_vector_type(8)));
typedef float f32x4 __attribute__((ext_vector_type(4)));
typedef float f32x2 __attribute__((ext_vector_type(2)));
typedef float f32x16 __attribute__((ext_vector_type(16)));
typedef unsigned u32x4 __attribute__((ext_vector_type(4)));
typedef unsigned u32x2 __attribute__((ext_vector_type(2)));

typedef __bf16 bf16x2_t __attribute__((ext_vector_type(2)));
__device__ __forceinline__ unsigned cvt_pk_bf16(float lo, float hi) { const bf16x2_t v = {(__bf16)lo, (__bf16)hi}; return __builtin_bit_cast(unsigned, v); }
__device__ __forceinline__ float bflo(unsigned w) { return __uint_as_float(w << 16); }
__device__ __forceinline__ float bfhi(unsigned w) { return __uint_as_float(w & 0xffff0000u); }
__device__ __forceinline__ float bf2f(bf16_t b) { return __uint_as_float(((unsigned)b) << 16); }
__device__ __forceinline__ bf16_t f2bf(float f) { return (bf16_t)(cvt_pk_bf16(f, 0.f) & 0xffffu); }
__device__ __forceinline__ float wave_sum(float v) {
#pragma unroll
    for (int o = 32; o >= 1; o >>= 1) v += __shfl_xor(v, o);
    return v;
}
__device__ __forceinline__ float sigmoidf_(float x) { return 1.0f / (1.0f + __expf(-x)); }
__device__ __forceinline__ int lane_id() { int l; asm volatile("v_mbcnt_lo_u32_b32 %0, -1, 0\n\tv_mbcnt_hi_u32_b32 %0, -1, %0" : "=v"(l)); return l; }
#define LDS_WAIT() asm volatile("s_waitcnt lgkmcnt(0)" ::: "memory")
#define VM_WAIT() asm volatile("s_waitcnt vmcnt(0)" ::: "memory")

namespace pg8 {
constexpr int BM = 256, BK = 64, HALF = 128, HTB = HALF * BK * 2, STAGE_BYTES = 8 * HTB, NXCD = 8, WGM = 8;
__host__ __device__ __forceinline__ int lds_byte(int r, int c) { const int st = (r >> 4) * 2 + (c >> 5), rr = r & 15, cc = c & 31, ob = rr * 64 + cc * 2; return st * 1024 + (ob ^ (((ob >> 9) & 1) << 5)); }
__host__ __device__ __forceinline__ void stage_rc(int b, int& R, int& C) { const int st = b / 1024, sb = b % 1024, swz = sb ^ (((sb >> 9) & 1) << 5); R = (st >> 1) * 16 + swz / 64; C = (st & 1) * 32 + (swz % 64) / 2; }
__host__ __device__ __forceinline__ int perm32(int rho) { const int n = rho >> 4, i = rho & 15; return 8 * (i >> 2) + 4 * n + (i & 3); }

struct Unit { int pm, pn; };
struct Gemm { const bf16_t* A; const bf16_t* Bt; int M, N, K; };

struct StaticOrder {
    int nM, nN, nwg, G, c;
    __host__ __device__ void init(int M, int N, int G_, int c_) { nM = M / BM; nN = N / BM; nwg = nM * nN; G = G_; c = c_; }
    __host__ __device__ bool next(int i, Unit& u) const {
        const long L = (long)i * G + c; if (L >= nwg) return false;
        int wgid = (int)L; { const int q = nwg / NXCD, r = nwg % NXCD, xcd = wgid % NXCD, off = wgid / NXCD; wgid = (xcd < r ? xcd * (q + 1) : r * (q + 1) + (xcd - r) * q) + off; }
        const int nig = WGM * nN, gid = wgid / nig, fm = gid * WGM, gsz = (nM - fm) < WGM ? (nM - fm) : WGM;
        u.pm = fm + ((wgid % nig) % gsz); u.pn = (wgid % nig) / gsz; return true;
    }
    __device__ __forceinline__ int arow(const Unit& u, int r) const { return u.pm * BM + r; }
};

template <class Epi, class Sched, bool ALIGN_EPI, bool GATHER>
__device__ __forceinline__ void gemm_phase(LAS unsigned char* lds, const Gemm g, const Sched& S, const Epi& E, const int wid) {
    const int lane = lane_id(), tid = wid * 64 + lane, wr = wid >> 2, wc = wid & 3, fr = lane & 15, fq = lane >> 4;
    const int K = g.K, nt = K / BK;
    int Rst[2], Cst[2];
    unsigned voffB[2], vAc[2][2], vAn[2][2];
#pragma unroll
    for (int i = 0; i < 2; ++i) { int R, C; stage_rc(tid * 16 + i * 8192, R, C); const int Rb = Epi::PERM ? ((R & ~31) + perm32(R & 31)) : R;
        Rst[i] = R; Cst[i] = C; voffB[i] = (unsigned)(Rb * K + C) * 2u; }
    const size_t kstep = (size_t)(BK * 2);
    const size_t hstep = (size_t)HALF * K * 2;
    const size_t tstep = 2 * hstep;
    const unsigned ldsw = (unsigned)wid * 1024u;
    const int aoff = lds_byte(wr * 64 + fr, fq * 8), boff = lds_byte(wc * 32 + fr, fq * 8);
#define PG8_SA(b, h) (((b) * 2 + (h)) * HTB)
#define PG8_SB(b, h) ((4 + (b) * 2 + (h)) * HTB)
#define PG8_STAGE(bufoff, gbase, voff) do { _Pragma("unroll") for (int _i = 0; _i < 2; ++_i) \
        __builtin_amdgcn_global_load_lds((const unsigned*)((const char*)(gbase) + (voff)[_i]), (LAS unsigned*)(lds + (bufoff) + ldsw + _i * 8192), 16, 0, 0); } while (0)
#define PG8_STAGE_SEL(bufoff, gbase, va, vb, sel) do { _Pragma("unroll") for (int _i = 0; _i < 2; ++_i) \
        __builtin_amdgcn_global_load_lds((const unsigned*)((const char*)(gbase) + ((sel) ? (vb)[_i] : (va)[_i])), (LAS unsigned*)(lds + (bufoff) + ldsw + _i * 8192), 16, 0, 0); } while (0)
#define PG8_LDA(dst, b, h) do { _Pragma("unroll") for (int m = 0; m < 4; ++m) _Pragma("unroll") for (int k = 0; k < 2; ++k) dst[m][k] = *(const LAS bf16x8*)(lds + PG8_SA(b, h) + aoff + m * 2048 + k * 1024); } while (0)
#define PG8_LDB(dst, b, h) do { _Pragma("unroll") for (int n = 0; n < 2; ++n) _Pragma("unroll") for (int k = 0; k < 2; ++k) dst[n][k] = *(const LAS bf16x8*)(lds + PG8_SB(b, h) + boff + n * 2048 + k * 1024); } while (0)
#define PG8_MMA(ai, bj, At, Bt) do { __builtin_amdgcn_s_setprio(1); _Pragma("unroll") for (int m = 0; m < 4; ++m) _Pragma("unroll") for (int n = 0; n < 2; ++n) _Pragma("unroll") for (int k = 0; k < 2; ++k) \
        acc[ai][bj][m][n] = __builtin_amdgcn_mfma_f32_16x16x32_bf16(Bt[n][k], At[m][k], acc[ai][bj][m][n], 0, 0, 0); __builtin_amdgcn_s_setprio(0); } while (0)
#define PG8_WAIT_V(n) asm volatile("s_waitcnt vmcnt(" #n ")" ::: "memory")
#define PG8_WAIT_L(n) asm volatile("s_waitcnt lgkmcnt(" #n ")" ::: "memory")
#define PG8_BAR __builtin_amdgcn_s_barrier()
#define PG8_SCHED __builtin_amdgcn_sched_barrier(0)
#define PG8_LOADOFF(dst, unit) do { _Pragma("unroll") for (int _h = 0; _h < 2; ++_h) _Pragma("unroll") for (int _i = 0; _i < 2; ++_i) \
        dst[_h][_i] = GATHER ? ((unsigned)S.arow(unit, _h * HALF + Rst[_i]) * (unsigned)(K * 2) + (unsigned)(Cst[_i] * 2)) : ((unsigned)((_h * HALF + Rst[_i]) * K + Cst[_i]) * 2u); } while (0)
    Unit cur, nxt; int ui = 0;
    if (!S.next(0, cur)) return;
    f32x4 acc[2][2][4][2];
#pragma unroll
    for (int a = 0; a < 2; ++a)
#pragma unroll
        for (int b = 0; b < 2; ++b)
#pragma unroll
            for (int m = 0; m < 4; ++m)
#pragma unroll
                for (int n = 0; n < 2; ++n) acc[a][b][m][n] = (f32x4){0.f, 0.f, 0.f, 0.f};
    bf16x8 At[4][2], B0[2][2], B1[2][2];
    const char* cA = GATHER ? (const char*)g.A : (const char*)g.A + (size_t)cur.pm * tstep; const char* cB = (const char*)g.Bt + (size_t)cur.pn * tstep;
    PG8_LOADOFF(vAc, cur);
    if (GATHER) { Unit u1; if (S.next(1, u1)) PG8_LOADOFF(vAn, u1); else PG8_LOADOFF(vAn, cur); } else { PG8_LOADOFF(vAn, cur); }
    PG8_STAGE(PG8_SB(0, 0), cB, voffB); PG8_STAGE(PG8_SB(0, 1), cB + hstep, voffB); PG8_STAGE(PG8_SA(0, 0), cA, vAc[0]); PG8_STAGE(PG8_SA(0, 1), cA, vAc[1]);
    if (wr == 1) PG8_BAR;
    PG8_WAIT_V(2); PG8_BAR;
    PG8_STAGE(PG8_SB(1, 0), cB + kstep, voffB); PG8_STAGE(PG8_SA(1, 0), cA + kstep, vAc[0]); PG8_STAGE(PG8_SB(1, 1), cB + hstep + kstep, voffB);
    PG8_WAIT_V(6); PG8_BAR;
    for (;;) {
        const bool has_next = S.next(ui + 1, nxt);
        const char* nA = GATHER ? cA : (has_next ? (const char*)g.A + (size_t)nxt.pm * tstep : cA); const char* nB = has_next ? (const char*)g.Bt + (size_t)nxt.pn * tstep : cB;
        const bool usen = GATHER && has_next;
        for (int t = 0; t < nt; t += 2) {
            const bool last = (t == nt - 2);
            const char* a1 = cA + (size_t)(t + 1) * kstep;
            const char* a2 = last ? nA : cA + (size_t)(t + 2) * kstep; const char* b2 = last ? nB : cB + (size_t)(t + 2) * kstep;
            const char* a3 = a2 + kstep; const char* b3 = b2 + kstep;
            const bool sel = last && usen;
            PG8_LDB(B0, 0, 0); PG8_LDB(B1, 0, 1); PG8_SCHED; PG8_LDA(At, 0, 0); PG8_STAGE(PG8_SA(1, 1), a1, vAc[1]);
            PG8_WAIT_V(8); PG8_WAIT_L(0); PG8_BAR; PG8_MMA(0, 0, At, B0); PG8_MMA(0, 1, At, B1); PG8_BAR; PG8_SCHED;
            PG8_LDA(At, 0, 1); PG8_STAGE(PG8_SB(0, 0), b2, voffB); PG8_STAGE(PG8_SB(0, 1), b2 + hstep, voffB); PG8_STAGE_SEL(PG8_SA(0, 0), a2, vAc[0], vAn[0], sel);
            PG8_WAIT_V(8); PG8_WAIT_L(0); PG8_BAR; PG8_MMA(1, 0, At, B0); PG8_MMA(1, 1, At, B1); PG8_BAR; PG8_SCHED;
            PG8_LDB(B0, 1, 0); PG8_LDB(B1, 1, 1); PG8_SCHED; PG8_LDA(At, 1, 0); PG8_STAGE_SEL(PG8_SA(0, 1), a2, vAc[1], vAn[1], sel);
            PG8_WAIT_V(8); PG8_WAIT_L(0); PG8_BAR; PG8_MMA(0, 0, At, B0); PG8_MMA(0, 1, At, B1); PG8_BAR; PG8_SCHED;
            PG8_LDA(At, 1, 1); PG8_STAGE(PG8_SB(1, 0), b3, voffB); PG8_STAGE(PG8_SB(1, 1), b3 + hstep, voffB); PG8_STAGE_SEL(PG8_SA(1, 0), a3, vAc[0], vAn[0], sel);
            PG8_WAIT_V(8); PG8_WAIT_L(0); PG8_BAR; PG8_MMA(1, 0, At, B0); PG8_MMA(1, 1, At, B1); PG8_BAR; PG8_SCHED;
        }
        if constexpr (ALIGN_EPI) { if (wr == 0) PG8_BAR; }
        E(acc, cur, wr, wc, fr, fq);
        if (!has_next) break;
#pragma unroll
        for (int a = 0; a < 2; ++a)
#pragma unroll
            for (int b = 0; b < 2; ++b)
#pragma unroll
                for (int m = 0; m < 4; ++m)
#pragma unroll
                    for (int n = 0; n < 2; ++n) acc[a][b][m][n] = (f32x4){0.f, 0.f, 0.f, 0.f};
        cur = nxt; cA = nA; cB = nB; ++ui;
        if (GATHER) {
#pragma unroll
            for (int _h = 0; _h < 2; ++_h)
#pragma unroll
                for (int _i = 0; _i < 2; ++_i) vAc[_h][_i] = vAn[_h][_i];
            Unit u2; if (S.next(ui + 1, u2)) PG8_LOADOFF(vAn, u2);
        }
        if constexpr (ALIGN_EPI) { if (wr == 1) PG8_BAR; }
    }
    PG8_WAIT_V(0);
    if constexpr (!ALIGN_EPI) { if (wr == 0) PG8_BAR; }
    PG8_BAR;
#undef PG8_SA
#undef PG8_SB
#undef PG8_STAGE
#undef PG8_STAGE_SEL
#undef PG8_LDA
#undef PG8_LDB
#undef PG8_MMA
#undef PG8_WAIT_V
#undef PG8_WAIT_L
#undef PG8_BAR
#undef PG8_SCHED
#undef PG8_LOADOFF
}
}
#define XB_TMO      128
#define XB_XCNT(j)  (256  + 64 * (j))
#define XB_XSUB(j)  (1280 + 64 * (j))
#define XB_XGEN(j)  (2304 + 64 * (j))
#define XB_TOP      3328
#define XB_TOPGEN   3392
#define XCD_BAR_WORDS 3456
#define XB_SPIN_CAP (1u << 18)

__device__ __forceinline__ unsigned xb_ld(unsigned* p)              { return __hip_atomic_load(p, __ATOMIC_RELAXED, __HIP_MEMORY_SCOPE_AGENT); }
__device__ __forceinline__ unsigned xb_add(unsigned* p, unsigned v) { return __hip_atomic_fetch_add(p, v, __ATOMIC_RELAXED, __HIP_MEMORY_SCOPE_AGENT); }
__device__ __forceinline__ unsigned xb_xcc_id() { return (unsigned)__builtin_amdgcn_s_getreg((3 << 11) | 20) & 0xFu; }
#define XB_SPIN(cond, bar) do { unsigned _sp = 0; while (cond) { __builtin_amdgcn_s_sleep(1); \
    if ((++_sp & 255u) == 0u) { if (xb_ld(&(bar)[XB_TMO])) break; if (_sp > XB_SPIN_CAP) { atomicAdd(&(bar)[XB_TMO], 1u); break; } } } } while (0)

struct XcdBarrier {
    unsigned* bar; unsigned x;
    volatile LAS unsigned* st;
};

__device__ __forceinline__ XcdBarrier xcd_barrier_post(unsigned* bar, volatile LAS unsigned* st) {
    XcdBarrier b; b.bar = bar; b.x = xb_xcc_id(); b.st = st;
    if (threadIdx.x == 0) (void)xb_add(&bar[XB_XCNT(b.x)], 1u);
    return b;
}
__device__ __forceinline__ void xcd_barrier_complete(unsigned* bar, unsigned x, unsigned& nloc, unsigned& nx) {
    const unsigned G = gridDim.x * gridDim.y * gridDim.z;
    unsigned sum, cnt, mine, sp = 0u;
    for (;;) {
        sum = 0u; cnt = 0u; mine = 0u;
#pragma unroll
        for (unsigned j = 0; j < 16; ++j) { const unsigned c = xb_ld(&bar[XB_XCNT(j)]); sum += c; cnt += (c > 0u) ? 1u : 0u; mine = (j == x) ? c : mine; }
        if (sum == G) break;
        __builtin_amdgcn_s_sleep(1);
        if ((++sp & 255u) == 0u) { if (xb_ld(&bar[XB_TMO])) break; if (sp > XB_SPIN_CAP) { atomicAdd(&bar[XB_TMO], 1u); break; } }
    }
    nloc = mine > 0u ? mine : 1u; nx = cnt > 0u ? cnt : 1u;
}

__device__ __forceinline__ void xcd_barrier(const XcdBarrier& b, const bool t0) {
    asm volatile("s_waitcnt vmcnt(0)" ::: "memory");
    __syncthreads();
    if (t0) {
        unsigned* bar = b.bar;
        __builtin_amdgcn_s_waitcnt(0);
        unsigned nloc = b.st[0], nx = b.st[1];
        if (nloc == 0u) { xcd_barrier_complete(bar, b.x, nloc, nx); b.st[0] = nloc; b.st[1] = nx; }
        const unsigned old = xb_add(&bar[XB_XSUB(b.x)], 1u);
        const unsigned gen = old / nloc;
        if (old + 1u == (gen + 1u) * nloc) {
            __builtin_amdgcn_fence(__ATOMIC_RELEASE, "agent");
            asm volatile("s_waitcnt vmcnt(0)" ::: "memory");
            const unsigned og = xb_add(&bar[XB_TOP], 1u);
            const unsigned tg = og / nx;
            if (og + 1u == (tg + 1u) * nx) xb_add(&bar[XB_TOPGEN], 1u);
            else XB_SPIN(xb_ld(&bar[XB_TOPGEN]) == tg, bar);
            __builtin_amdgcn_fence(__ATOMIC_ACQUIRE, "agent");
            xb_add(&bar[XB_XGEN(b.x)], 1u);
            asm volatile("s_waitcnt vmcnt(0)" ::: "memory");
        } else {
            XB_SPIN(xb_ld(&bar[XB_XGEN(b.x)]) == gen, bar);
            __builtin_amdgcn_fence(__ATOMIC_ACQUIRE, "agent");
            asm volatile("s_waitcnt vmcnt(0)" ::: "memory");
        }
    }
    __syncthreads();
}

constexpr int DM = 1024, NBATCH = 8, SEQ = 4096, NTOK = NBATCH * SEQ;
constexpr int DIN = 2304, DR = 512, DSSM = 512, NH = 8, HD = 64;
constexpr int COL_K = 512, COL_V = 1024, COL_LORA = 1536, COL_U = 1792;
constexpr int NE = 32, DFF = 1024, CAP = 32768, MAXTILES = 544;
constexpr int OPS_STRIDE = 388;
constexpr int NWAVES = 8, GRID = 256, NGW = GRID * NWAVES;
constexpr size_t MiB = 1u << 20;
constexpr size_t WS_CTL = 0, CTL_ZERO_BYTES = 1 * MiB;
constexpr size_t WS_WINT = 1 * MiB, WS_LORAB = 6 * MiB, WS_WGLUT = 7 * MiB, WS_WOUTT = 8 * MiB;
constexpr size_t WS_B1G = 10 * MiB, WS_B1L = 10 * MiB + 128 * 1024, WS_RWP = 10 * MiB + 256 * 1024, WS_RSTD1 = 10 * MiB + 512 * 1024;
constexpr size_t WS_SSQ = 11 * MiB, WS_EID = 12 * MiB, WS_GATE = 12 * MiB + 512 * 1024, WS_RELPOS = 13 * MiB, WS_STOK = 14 * MiB;
constexpr size_t WS_W2T = 20 * MiB, WS_W1T = 84 * MiB, WS_XB = 212 * MiB;
constexpr size_t WS_PROJ = 276 * MiB, WS_LORAIN = 420 * MiB, WS_LORAW = 436 * MiB, WS_LORAA = 500 * MiB, WS_LORAG = 564 * MiB, WS_OPS = 628 * MiB, WS_SRS = 1016 * MiB, WS_END = 1020 * MiB;
constexpr size_t WS_YRAW = WS_LORAW, WS_YGELU = WS_LORAA, WS_YGLU = WS_LORAA + 32 * MiB, WS_MIXED = WS_OPS + 200 * MiB, WS_ACT = WS_OPS, WS_YSORT = WS_PROJ;
constexpr size_t WS_QP = WS_OPS, WS_YG = WS_OPS + 64 * MiB, WS_RKB = WS_OPS + 192 * MiB;
static_assert(WS_LORAA - WS_LORAW == (size_t)NTOK * 512 * 4 && WS_LORAG - WS_LORAA == (size_t)NTOK * 512 * 4, "lora buffers contiguous");
static_assert(WS_OPS + (size_t)64 * 4096 * OPS_STRIDE * 4 <= WS_SRS, "ops fits");
constexpr int CW_TMO = 0, CW_BAR = 4096, CW_GCOUNT = 16384;
constexpr int LDS_BYTES = 163840, TAB_OFF = 131072, MISC_OFF = 159744;
constexpr int TAB_SRC = TAB_OFF, TAB_VAL = TAB_OFF + MAXTILES * 4, TAB_E = TAB_OFF + 2 * MAXTILES * 4, TAB_BASE = TAB_OFF + 3 * MAXTILES * 4;

struct Params { const float* in[34]; float* out; unsigned char* ws; };
enum { I_X = 0, I_N1G, I_WIN, I_MU, I_W0, I_WUP, I_A0, I_AUP, I_GUP, I_KK, I_KA, I_RK, I_LNW, I_LNB, I_LRE, I_LIM, I_LSTEP, I_BRE, I_BIM, I_CRE, I_CIM, I_DSKIP, I_WGLU, I_BGLU, I_BETA, I_WOUT, I_N2G, I_RW, I_RB, I_W1, I_B1, I_W2, I_B2, I_FG };

using pg8::Unit; using pg8::HALF; using pg8::BM;
struct EpiProj {
    static constexpr bool PERM = true;
    bf16_t* O; int ldc; const float* rs;
    __device__ __forceinline__ void operator()(const f32x4 (&acc)[2][2][4][2], const Unit& u, int wr, int wc, int fr, int fq) const {
        const int row0 = u.pm * BM + wr * 64 + fr, col0 = u.pn * BM + wc * 32 + 8 * fq;
#pragma unroll
        for (int ai = 0; ai < 2; ++ai)
#pragma unroll
            for (int m = 0; m < 4; ++m) { const int row = row0 + ai * HALF + m * 16; const float s = rs[row]; bf16_t* rowp = O + (size_t)row * ldc + col0;
#pragma unroll
                for (int bj = 0; bj < 2; ++bj) { const f32x4 v0 = acc[ai][bj][m][0] * s, v1 = acc[ai][bj][m][1] * s;
                    u32x4 w; w.x = cvt_pk_bf16(v0[0], v0[1]); w.y = cvt_pk_bf16(v0[2], v0[3]); w.z = cvt_pk_bf16(v1[0], v1[1]); w.w = cvt_pk_bf16(v1[2], v1[3]);
                    *(u32x4*)(rowp + bj * HALF) = w; } }
    }
};
struct EpiLora {
    static constexpr bool PERM = false;
    float* bw; float* ba; float* bg;
    __device__ __forceinline__ void operator()(const f32x4 (&acc)[2][2][4][2], const Unit& u, int wr, int wc, int fr, int fq) const {
        const int kind = u.pn >> 1; const int row0 = u.pm * BM + wr * 64 + fr, cc0 = (u.pn & 1) * 256 + wc * 32 + 4 * fq;
        float* base = bw + (size_t)kind * ((size_t)NTOK * 512);
#pragma unroll
        for (int ai = 0; ai < 2; ++ai)
#pragma unroll
            for (int m = 0; m < 4; ++m) { float* rowp = base + (size_t)(row0 + ai * HALF + m * 16) * 512 + cc0;
#pragma unroll
                for (int bj = 0; bj < 2; ++bj)
#pragma unroll
                    for (int n = 0; n < 2; ++n) *(f32x4*)(rowp + bj * HALF + n * 16) = acc[ai][bj][m][n]; }
    }
};
struct EpiGlu {
    static constexpr bool PERM = true;
    const bf16_t* Y; bf16_t* O; const float* bias; float* ssq;
    __device__ __forceinline__ void operator()(const f32x4 (&acc)[2][2][4][2], const Unit& u, int wr, int wc, int fr, int fq) const {
        const int row0 = u.pm * BM + wr * 64 + fr, col0 = u.pn * BM + wc * 32 + 8 * fq;
        f32x4 bv[2][2];
#pragma unroll
        for (int bj = 0; bj < 2; ++bj)
#pragma unroll
            for (int n = 0; n < 2; ++n) bv[bj][n] = *(const f32x4*)(bias + col0 + bj * HALF + 4 * n);
#pragma unroll
        for (int ai = 0; ai < 2; ++ai)
#pragma unroll
            for (int m = 0; m < 4; ++m) { const int row = row0 + ai * HALF + m * 16; float sq = 0.f;
#pragma unroll
                for (int bj = 0; bj < 2; ++bj) { const size_t off = (size_t)row * 512 + col0 + bj * HALF; const u32x4 yv = *(const u32x4*)(Y + off);
                    const f32x4 z0 = acc[ai][bj][m][0] + bv[bj][0], z1 = acc[ai][bj][m][1] + bv[bj][1];
                    float o[8]; o[0] = bflo(yv.x) * sigmoidf_(z0[0]); o[1] = bfhi(yv.x) * sigmoidf_(z0[1]); o[2] = bflo(yv.y) * sigmoidf_(z0[2]); o[3] = bfhi(yv.y) * sigmoidf_(z0[3]);
                    o[4] = bflo(yv.z) * sigmoidf_(z1[0]); o[5] = bfhi(yv.z) * sigmoidf_(z1[1]); o[6] = bflo(yv.w) * sigmoidf_(z1[2]); o[7] = bfhi(yv.w) * sigmoidf_(z1[3]);
#pragma unroll
                    for (int j = 0; j < 8; ++j) sq += o[j] * o[j];
                    u32x4 w; w.x = cvt_pk_bf16(o[0], o[1]); w.y = cvt_pk_bf16(o[2], o[3]); w.z = cvt_pk_bf16(o[4], o[5]); w.w = cvt_pk_bf16(o[6], o[7]);
                    *(u32x4*)(O + off) = w; }
                sq += __shfl_xor(sq, 16); sq += __shfl_xor(sq, 32);
                if (fq == 0) ssq[(size_t)row * 8 + u.pn * 4 + wc] = sq; }
    }
};
struct EpiOut {
    static constexpr bool PERM = false;
    const float* X; float* X1; bf16_t* X1B;
    __device__ __forceinline__ void operator()(const f32x4 (&acc)[2][2][4][2], const Unit& u, int wr, int wc, int fr, int fq) const {
        const int row0 = u.pm * BM + wr * 64 + fr, col0 = u.pn * BM + wc * 32 + 4 * fq;
#pragma unroll
        for (int ai = 0; ai < 2; ++ai)
#pragma unroll
            for (int m = 0; m < 4; ++m) { const size_t off = (size_t)(row0 + ai * HALF + m * 16) * DM + col0;
#pragma unroll
                for (int bj = 0; bj < 2; ++bj)
#pragma unroll
                    for (int n = 0; n < 2; ++n) { const size_t o2 = off + bj * HALF + n * 16; const f32x4 v = *(const f32x4*)(X + o2) + acc[ai][bj][m][n];
                        *(f32x4*)(X1 + o2) = v; u32x2 w; w.x = cvt_pk_bf16(v[0], v[1]); w.y = cvt_pk_bf16(v[2], v[3]); *(u32x2*)(X1B + o2) = w; } }
    }
};
struct EpiSwiglu {
    static constexpr bool PERM = true;
    bf16_t* O; const float* b1g; const float* b1l; const float* srs; const LAS int* tsrc; const LAS int* tval;
    __device__ __forceinline__ void operator()(const f32x4 (&acc)[2][2][4][2], const Unit& u, int wr, int wc, int fr, int fq) const {
        const int e = u.pn >> 3, pnl = u.pn & 7; const int r0 = wr * 64 + fr, o0 = pnl * 128 + wc * 32 + 8 * fq;
        const int src = tsrc[u.pm], nval = tval[u.pm];
        f32x4 bg[2], bl[2];
#pragma unroll
        for (int n = 0; n < 2; ++n) { bg[n] = *(const f32x4*)(b1g + e * DFF + o0 + 4 * n); bl[n] = *(const f32x4*)(b1l + e * DFF + o0 + 4 * n); }
#pragma unroll
        for (int ai = 0; ai < 2; ++ai)
#pragma unroll
            for (int m = 0; m < 4; ++m) { const int r = r0 + ai * HALF + m * 16; const float s = r < nval ? srs[src + r] : 0.f;
                float o[8];
#pragma unroll
                for (int n = 0; n < 2; ++n)
#pragma unroll
                    for (int j = 0; j < 4; ++j) { const float gl = fminf(acc[ai][0][m][n][j] * s + bg[n][j], 7.0f); const float li = fminf(fmaxf(acc[ai][1][m][n][j] * s + bl[n][j], -7.0f), 7.0f);
                        o[4 * n + j] = gl * sigmoidf_(1.702f * gl) * (li + 1.0f); }
                u32x4 w; w.x = cvt_pk_bf16(o[0], o[1]); w.y = cvt_pk_bf16(o[2], o[3]); w.z = cvt_pk_bf16(o[4], o[5]); w.w = cvt_pk_bf16(o[6], o[7]);
                *(u32x4*)(O + (size_t)(u.pm * BM + r) * DFF + o0) = w; }
    }
};
struct EpiMoe2 {
    static constexpr bool PERM = true;
    bf16_t* O; const float* b2;
    __device__ __forceinline__ void operator()(const f32x4 (&acc)[2][2][4][2], const Unit& u, int wr, int wc, int fr, int fq) const {
        const int e = u.pn >> 2, pnl = u.pn & 3; const int row0 = u.pm * BM + wr * 64 + fr, col0 = pnl * BM + wc * 32 + 8 * fq;
        f32x4 bv[2][2];
#pragma unroll
        for (int bj = 0; bj < 2; ++bj)
#pragma unroll
            for (int n = 0; n < 2; ++n) bv[bj][n] = *(const f32x4*)(b2 + e * DM + col0 + bj * HALF + 4 * n);
#pragma unroll
        for (int ai = 0; ai < 2; ++ai)
#pragma unroll
            for (int m = 0; m < 4; ++m) { bf16_t* rowp = O + (size_t)(row0 + ai * HALF + m * 16) * DM + col0;
#pragma unroll
                for (int bj = 0; bj < 2; ++bj) { const f32x4 v0 = acc[ai][bj][m][0] + bv[bj][0], v1 = acc[ai][bj][m][1] + bv[bj][1];
                    u32x4 w; w.x = cvt_pk_bf16(v0[0], v0[1]); w.y = cvt_pk_bf16(v0[2], v0[3]); w.z = cvt_pk_bf16(v1[0], v1[1]); w.w = cvt_pk_bf16(v1[2], v1[3]);
                    *(u32x4*)(rowp + bj * HALF) = w; } }
    }
};
struct MoeOrder {
    int G, c, NT, ntiles; const LAS int* tsrc; const LAS int* tval; const LAS int* te; const int* stok;
    __device__ __forceinline__ bool next(int i, Unit& u) const {
        const int L = i * G + c, xcd = L & 7, j = L >> 3; const int mt = (j / NT) * 8 + xcd; if (mt >= ntiles) return false;
        u.pm = mt; u.pn = te[mt] * NT + (j % NT); return true; }
    __device__ __forceinline__ int arow(const Unit& u, int r) const { return r < tval[u.pm] ? stok[tsrc[u.pm] + r] : 0; }
};
struct KsOne { __device__ __forceinline__ float operator()(int) const { return 1.f; } };
struct KsVec { const float* g; __device__ __forceinline__ float operator()(int k) const { return g[k]; } };
struct KsOut { const float* beta; __device__ __forceinline__ float operator()(int k) const { return k < DR ? 1.f : beta[k - DR]; } };
struct RmId { int off; __device__ __forceinline__ int operator()(int c) const { return off + c; } };
struct RmW1 { int e; __device__ __forceinline__ int operator()(int c) const { const int o = c >> 1, bj = c & 1; return e * 2048 + (o >> 7) * 256 + bj * 128 + (o & 127); } };
template <class KS, class RM>
__device__ __forceinline__ void tr_item(const float* src, int N, int k0, int c0, bf16_t* dst, int ldk, const KS ks, const RM rm, LAS float* scr, int lane) {
#pragma unroll 4
    for (int it = 0; it < 16; ++it) { const int r = it * 4 + (lane >> 4); const f32x4 v = *(const f32x4*)(src + (size_t)(k0 + r) * N + c0 + 4 * (lane & 15)); const float s = ks(k0 + r);
        LAS float* d = scr + r * 65 + 4 * (lane & 15); d[0] = v[0] * s; d[1] = v[1] * s; d[2] = v[2] * s; d[3] = v[3] * s; }
    LDS_WAIT();
    const int c = lane & 7;
#pragma unroll
    for (int jj = 0; jj < 8; ++jj) { const int n = (lane >> 3) + 8 * jj; const LAS float* s = scr + (8 * c) * 65 + n;
        u32x4 o; o.x = cvt_pk_bf16(s[0 * 65], s[1 * 65]); o.y = cvt_pk_bf16(s[2 * 65], s[3 * 65]); o.z = cvt_pk_bf16(s[4 * 65], s[5 * 65]); o.w = cvt_pk_bf16(s[6 * 65], s[7 * 65]);
        *(u32x4*)(dst + (size_t)rm(c0 + n) * ldk + k0 + 8 * c) = o; }
    LDS_WAIT();
}
__device__ __forceinline__ void p0_prologue(const Params& p, LAS unsigned char* lds, int wave, int lane) {
    unsigned char* ws = p.ws;
    LAS float* scr = (LAS float*)(lds + wave * 16640);
    const int gw = blockIdx.x * NWAVES + wave;
    bf16_t* W1T = (bf16_t*)(ws + WS_W1T); bf16_t* W2T = (bf16_t*)(ws + WS_W2T); bf16_t* WinT = (bf16_t*)(ws + WS_WINT); bf16_t* WoutT = (bf16_t*)(ws + WS_WOUTT); bf16_t* WgluT = (bf16_t*)(ws + WS_WGLUT);
    constexpr int I_1 = NE * 16 * 32, I_2 = NE * 16 * 16, I_IN = 16 * 36, I_OUT = 16 * 16, I_GLU = 8 * 8, NITEMS = I_1 + I_2 + I_IN + I_OUT + I_GLU;
    for (int it = gw; it < NITEMS; it += NGW) {
        int r = it;
        if (r < I_1) { const int e = r >> 9, q = r & 511, kb = q >> 5, nb = q & 31; tr_item(p.in[I_W1] + (size_t)e * DM * 2048, 2048, kb * 64, nb * 64, W1T, DM, KsVec{p.in[I_N2G]}, RmW1{e}, scr, lane); continue; } r -= I_1;
        if (r < I_2) { const int e = r >> 8, q = r & 255, kb = q >> 4, nb = q & 15; tr_item(p.in[I_W2] + (size_t)e * DFF * DM, DM, kb * 64, nb * 64, W2T, DFF, KsOne{}, RmId{e * DM}, scr, lane); continue; } r -= I_2;
        if (r < I_IN) { const int kb = r / 36, nb = r % 36; tr_item(p.in[I_WIN], DIN, kb * 64, nb * 64, WinT, DM, KsVec{p.in[I_N1G]}, RmId{0}, scr, lane); continue; } r -= I_IN;
        if (r < I_OUT) { const int kb = r >> 4, nb = r & 15; tr_item(p.in[I_WOUT], DM, kb * 64, nb * 64, WoutT, DM, KsOut{p.in[I_BETA]}, RmId{0}, scr, lane); continue; } r -= I_OUT;
        { const int kb = r >> 3, nb = r & 7; tr_item(p.in[I_WGLU], DSSM, kb * 64, nb * 64, WgluT, DSSM, KsOne{}, RmId{0}, scr, lane); }
    }
    { const float* x = p.in[I_X]; bf16_t* xb = (bf16_t*)(ws + WS_XB); float* rs = (float*)(ws + WS_RSTD1);
      for (int m = gw; m < NTOK; m += NGW) { const f32x4* xr = (const f32x4*)(x + (size_t)m * DM) + lane; f32x4 v[4]; float s = 0.f;
#pragma unroll
          for (int j = 0; j < 4; ++j) { v[j] = xr[64 * j]; s += (v[j][0] * v[j][0] + v[j][1] * v[j][1]) + (v[j][2] * v[j][2] + v[j][3] * v[j][3]); }
          s = wave_sum(s); if (lane == 0) rs[m] = 1.0f / sqrtf(s * (1.0f / DM) + 1e-5f);
          u32x2* o8 = (u32x2*)(xb + (size_t)m * DM) + lane;
#pragma unroll
          for (int j = 0; j < 4; ++j) { u32x2 w; w.x = cvt_pk_bf16(v[j][0], v[j][1]); w.y = cvt_pk_bf16(v[j][2], v[j][3]); o8[64 * j] = w; } } }
    const int gt = blockIdx.x * (NWAVES * 64) + wave * 64 + lane, NT_ = GRID * NWAVES * 64;
    { float* b1g = (float*)(ws + WS_B1G); float* b1l = (float*)(ws + WS_B1L); const float* b1 = p.in[I_B1];
      for (int i = gt; i < NE * DFF; i += NT_) { const int e = i >> 10, o = i & 1023; b1g[i] = b1[e * 2048 + 2 * o]; b1l[i] = b1[e * 2048 + 2 * o + 1]; } }
    { float* rwp = (float*)(ws + WS_RWP); const float* rw = p.in[I_RW]; const float* g2 = p.in[I_N2G];
      for (int i = gt; i < DM * NE; i += NT_) rwp[i] = g2[i >> 5] * rw[i]; }
    { bf16_t* LB = (bf16_t*)(ws + WS_LORAB); const float* wup = p.in[I_WUP]; const float* aup = p.in[I_AUP]; const float* gup = p.in[I_GUP];
      for (int i = gt; i < 1536 * 256; i += NT_) { const int n = i >> 8, k = i & 255; float v = 0.f;
          if (n < 512) { if (k < 64) v = wup[k * 512 + n]; } else if (n < 1024) { if (k >= 64 && k < 128) v = aup[(k - 64) * 512 + (n - 512)]; } else { if (k >= 128) v = gup[(k - 128) * 512 + (n - 1024)]; }
          LB[i] = f2bf(v); } }
}
__device__ __forceinline__ void p2_lora_in(const Params& p, int wave, int lane) {
    const bf16_t* proj = (const bf16_t*)(p.ws + WS_PROJ); bf16_t* li = (bf16_t*)(p.ws + WS_LORAIN); const float* mu = p.in[I_MU] + COL_LORA;
    const int gt = blockIdx.x * (NWAVES * 64) + wave * 64 + lane, NT_ = GRID * NWAVES * 64;
    for (int idx = gt; idx < NTOK * 32; idx += NT_) { const int tok = idx >> 5, c = (idx & 31) * 8;
        const bf16_t* pr = proj + (size_t)tok * DIN + COL_LORA + c; const u32x4 cur = *(const u32x4*)pr; u32x4 prv = (u32x4){0u, 0u, 0u, 0u}; if (tok & (SEQ - 1)) prv = *(const u32x4*)(pr - DIN);
        float v[8], q[8];
        v[0] = bflo(cur.x); v[1] = bfhi(cur.x); v[2] = bflo(cur.y); v[3] = bfhi(cur.y); v[4] = bflo(cur.z); v[5] = bfhi(cur.z); v[6] = bflo(cur.w); v[7] = bfhi(cur.w);
        q[0] = bflo(prv.x); q[1] = bfhi(prv.x); q[2] = bflo(prv.y); q[3] = bfhi(prv.y); q[4] = bflo(prv.z); q[5] = bfhi(prv.z); q[6] = bflo(prv.w); q[7] = bfhi(prv.w);
#pragma unroll
        for (int j = 0; j < 8; ++j) { float s = v[j] + mu[c + j] * (q[j] - v[j]); if (c < 64) s = tanhf(s); else if (c >= 128) s = sigmoidf_(s); v[j] = s; }
        u32x4 w; w.x = cvt_pk_bf16(v[0], v[1]); w.y = cvt_pk_bf16(v[2], v[3]); w.z = cvt_pk_bf16(v[4], v[5]); w.w = cvt_pk_bf16(v[6], v[7]);
        *(u32x4*)(li + (size_t)tok * 256 + c) = w; }
}
template <int CTRL> __device__ __forceinline__ float dpp_mov(float x) { return __int_as_float(__builtin_amdgcn_update_dpp(0, __float_as_int(x), CTRL, 0xF, 0xF, true)); }
__device__ __forceinline__ float sum8(float x) { x += dpp_mov<0xB1>(x); x += dpp_mov<0x4E>(x); x += dpp_mov<0x141>(x); return x; }
__device__ __forceinline__ float rowsum16(float x) { x = sum8(x); x += dpp_mov<0x140>(x); return x; }
__device__ __forceinline__ void unpack8(const u32x4 w, float (&f)[8]) { f[0] = bflo(w.x); f[1] = bfhi(w.x); f[2] = bflo(w.y); f[3] = bfhi(w.y); f[4] = bflo(w.z); f[5] = bfhi(w.z); f[6] = bflo(w.w); f[7] = bfhi(w.w); }
__device__ __forceinline__ void ld8(const float* p_, float (&f)[8]) { const f32x4 a = *(const f32x4*)p_, b = *(const f32x4*)(p_ + 4); f[0] = a[0]; f[1] = a[1]; f[2] = a[2]; f[3] = a[3]; f[4] = b[0]; f[5] = b[1]; f[6] = b[2]; f[7] = b[3]; }
__device__ __forceinline__ float gelu_tanh(float y) { const float t = 0.7978845608028654f * (y + 0.044715f * y * y * y); const float th = 1.0f - 2.0f / (1.0f + __expf(2.0f * t)); return 0.5f * y * (1.0f + th); }
__device__ __forceinline__ void p5_s5(const Params& p, LAS unsigned char* lds, int wave, int lane) {
    const int sq = wave >> 2, wq = wave & 3, q = (blockIdx.x - 128) * 2 + sq, b = q >> 5, g = q & 31;
    LAS unsigned char* L = lds + sq * 65536; LAS float* bu = (LAS float*)L; LAS unsigned char* st = L + 32768;
    const float dt = expf(p.in[I_LSTEP][g]);
    float lbr, lbi;
    { const int pp = lane; const float lre = fminf(p.in[I_LRE][g * 64 + pp], -1e-4f), lim = p.in[I_LIM][g * 64 + pp]; const float mag = expf(lre * dt), ang = lim * dt; lbr = mag * cosf(ang); lbi = mag * sinf(ang); }
    bf16x8 Bop;
    { const int c = 32 * wq + (lane & 31), pp = c & 63, isim = c >> 6; const float lre = fminf(p.in[I_LRE][g * 64 + pp], -1e-4f), lim = p.in[I_LIM][g * 64 + pp];
      const float mag = expf(lre * dt), ang = lim * dt, cr = mag * cosf(ang), ci = mag * sinf(ang), den = lre * lre + lim * lim, nre = cr - 1.0f;
      const float zre = (nre * lre + ci * lim) / den, zim = (ci * lre - nre * lim) / den;
      const float* bre = p.in[I_BRE] + (size_t)(g * 64 + pp) * 16 + 8 * (lane >> 5); const float* bim = p.in[I_BIM] + (size_t)(g * 64 + pp) * 16 + 8 * (lane >> 5);
      float t[8];
#pragma unroll
      for (int jj = 0; jj < 8; ++jj) t[jj] = isim ? (zre * bim[jj] + zim * bre[jj]) : (zre * bre[jj] - zim * bim[jj]);
      u32x4 w; w.x = cvt_pk_bf16(t[0], t[1]); w.y = cvt_pk_bf16(t[2], t[3]); w.z = cvt_pk_bf16(t[4], t[5]); w.w = cvt_pk_bf16(t[6], t[7]); Bop = __builtin_bit_cast(bf16x8, w); }
    bf16x8 Bout[4];
#pragma unroll
    for (int ks = 0; ks < 4; ++ks) { const int m = lane & 15; float t[8];
#pragma unroll
        for (int jj = 0; jj < 8; ++jj) { const int k = 32 * ks + 8 * (lane >> 4) + jj, pp = k >> 1; t[jj] = (k & 1) ? -p.in[I_CIM][(size_t)(g * 16 + m) * 64 + pp] : p.in[I_CRE][(size_t)(g * 16 + m) * 64 + pp]; }
        u32x4 w; w.x = cvt_pk_bf16(t[0], t[1]); w.y = cvt_pk_bf16(t[2], t[3]); w.z = cvt_pk_bf16(t[4], t[5]); w.w = cvt_pk_bf16(t[6], t[7]); Bout[ks] = __builtin_bit_cast(bf16x8, w); }
    const float dsk = p.in[I_DSKIP][g * 16 + (lane & 15)];
    const bf16_t* ubase = (const bf16_t*)(p.ws + WS_PROJ) + (size_t)b * SEQ * DIN + COL_U + g * 16;
    bf16_t* yg = (bf16_t*)(p.ws + WS_YGELU) + (size_t)b * SEQ * DSSM + g * 16;
    const size_t aoffs = (size_t)(lane & 31) * DIN + 8 * (lane >> 5);
    bf16x8 A0 = *(const bf16x8*)(ubase + aoffs), A1 = *(const bf16x8*)(ubase + aoffs + (size_t)32 * DIN);
    float sre = 0.f, sim = 0.f;
    for (int tile = 0; tile < SEQ / 64; ++tile) { const int t0 = tile * 64;
        const f32x16 z16 = {0.f, 0.f, 0.f, 0.f, 0.f, 0.f, 0.f, 0.f, 0.f, 0.f, 0.f, 0.f, 0.f, 0.f, 0.f, 0.f};
        const f32x16 d0 = __builtin_amdgcn_mfma_f32_32x32x16_bf16(A0, Bop, z16, 0, 0, 0), d1 = __builtin_amdgcn_mfma_f32_32x32x16_bf16(A1, Bop, z16, 0, 0, 0);
        { const int c = 32 * wq + (lane & 31), pp = c & 63, isim = c >> 6;
#pragma unroll
          for (int r = 0; r < 16; ++r) { const int rw = (r & 3) + 8 * (r >> 2) + 4 * (lane >> 5); bu[(rw * 64 + pp) * 2 + isim] = d0[r]; bu[((rw + 32) * 64 + pp) * 2 + isim] = d1[r]; } }
        if (tile + 1 < SEQ / 64) { A0 = *(const bf16x8*)(ubase + (size_t)(t0 + 64) * DIN + aoffs); A1 = *(const bf16x8*)(ubase + (size_t)(t0 + 96) * DIN + aoffs); }
        __syncthreads();
        if (wq == 0) {
            f32x2 xa[8], xb[8];
#pragma unroll
            for (int i = 0; i < 8; ++i) xa[i] = *(const LAS f32x2*)(bu + (i * 64 + lane) * 2);
#pragma unroll
            for (int blk = 0; blk < 8; blk += 2) {
#pragma unroll
                for (int i = 0; i < 8; ++i) xb[i] = *(const LAS f32x2*)(bu + (((blk + 1) * 8 + i) * 64 + lane) * 2);
                __builtin_amdgcn_sched_barrier(0);
#pragma unroll
                for (int i = 0; i < 8; ++i) { const float nr = lbr * sre - lbi * sim + xa[i].x, ni = lbr * sim + lbi * sre + xa[i].y; sre = nr; sim = ni; *(LAS unsigned*)(st + (blk * 8 + i) * 272 + lane * 4) = cvt_pk_bf16(sre, sim); }
                if (blk + 2 < 8) {
#pragma unroll
                    for (int i = 0; i < 8; ++i) xa[i] = *(const LAS f32x2*)(bu + (((blk + 2) * 8 + i) * 64 + lane) * 2); }
                __builtin_amdgcn_sched_barrier(0);
#pragma unroll
                for (int i = 0; i < 8; ++i) { const float nr = lbr * sre - lbi * sim + xb[i].x, ni = lbr * sim + lbi * sre + xb[i].y; sre = nr; sim = ni; *(LAS unsigned*)(st + ((blk + 1) * 8 + i) * 272 + lane * 4) = cvt_pk_bf16(sre, sim); }
            } }
        __syncthreads();
        f32x4 acc = (f32x4){0.f, 0.f, 0.f, 0.f};
#pragma unroll
        for (int ks = 0; ks < 4; ++ks) { const bf16x8 a = *(const LAS bf16x8*)(st + (16 * wq + (lane & 15)) * 272 + (32 * ks + 8 * (lane >> 4)) * 2); acc = __builtin_amdgcn_mfma_f32_16x16x32_bf16(a, Bout[ks], acc, 0, 0, 0); }
#pragma unroll
        for (int r = 0; r < 4; ++r) { const int tok = t0 + 16 * wq + 4 * (lane >> 4) + r, m = lane & 15; const float u = bf2f(ubase[(size_t)tok * DIN + m]);
            yg[(size_t)tok * DSSM + m] = f2bf(gelu_tanh(acc[r] + dsk * u)); }
    }
}
struct P7In { f32x4 y0, y1, g0, g1, s0, s1; float rk; u32x4 yg, cv, qv; };
__device__ __forceinline__ void p7_load(P7In& in, const float* yraw, const bf16_t* proj, const float* rkb, const float* lg, const bf16_t* yglu, const float* ssq, int tok, int lane) {
    const int c0 = lane * 8, h = lane >> 3;
    const float* py = yraw + (size_t)tok * DR + c0; in.y0 = *(const f32x4*)py; in.y1 = *(const f32x4*)(py + 4);
    { const bf16_t* pv = proj + (size_t)tok * DIN + COL_V + c0; in.cv = *(const u32x4*)pv; in.qv = (tok & (SEQ - 1)) ? *(const u32x4*)(pv - DIN) : (u32x4){0u, 0u, 0u, 0u}; in.rk = rkb[(size_t)tok * NH + h]; }
    const float* pg = lg + (size_t)tok * DR + c0; in.g0 = *(const f32x4*)pg; in.g1 = *(const f32x4*)(pg + 4);
    in.s0 = *(const f32x4*)(ssq + (size_t)tok * 8); in.s1 = *(const f32x4*)(ssq + (size_t)tok * 8 + 4);
    in.yg = *(const u32x4*)(yglu + (size_t)tok * DSSM + c0);
}
__device__ __forceinline__ void p7_mix(const Params& p, int wave, int lane) {
    const float* yraw = (const float*)(p.ws + WS_YRAW); const bf16_t* proj = (const bf16_t*)(p.ws + WS_PROJ); const float* rkb = (const float*)(p.ws + WS_RKB); const float* lg = (const float*)(p.ws + WS_LORAG); bf16_t* mixed = (bf16_t*)(p.ws + WS_MIXED);
    const bf16_t* yglu = (const bf16_t*)(p.ws + WS_YGLU); const float* ssq = (const float*)(p.ws + WS_SSQ);
    const int c0 = lane * 8;
    float lnw[8], lnb[8], muv[8]; ld8(p.in[I_LNW] + c0, lnw); ld8(p.in[I_LNB] + c0, lnb); ld8(p.in[I_MU] + COL_V + c0, muv);
    const int gw = blockIdx.x * NWAVES + wave;
    P7In cur, nxt; p7_load(cur, yraw, proj, rkb, lg, yglu, ssq, gw, lane);
    for (int tok = gw; tok < NTOK; tok += NGW) {
        if (tok + NGW < NTOK) p7_load(nxt, yraw, proj, rkb, lg, yglu, ssq, tok + NGW, lane);
        float y[8], v[8], g[8], o[8], cvv[8], qvv[8]; unpack8(cur.cv, cvv); unpack8(cur.qv, qvv);
#pragma unroll
        for (int j = 0; j < 4; ++j) { y[j] = cur.y0[j]; y[j + 4] = cur.y1[j]; g[j] = cur.g0[j]; g[j + 4] = cur.g1[j]; }
#pragma unroll
        for (int j = 0; j < 8; ++j) v[j] = cvv[j] + muv[j] * (qvv[j] - cvv[j]);
        float sm = 0.f;
#pragma unroll
        for (int j = 0; j < 8; ++j) sm += y[j];
        const float mu = sum8(sm) * (1.0f / 64.0f); float sq = 0.f;
#pragma unroll
        for (int j = 0; j < 8; ++j) { y[j] -= mu; sq += y[j] * y[j]; }
        const float rstd = 1.0f / sqrtf(sum8(sq) * (1.0f / 64.0f) + 64e-5f);
#pragma unroll
        for (int j = 0; j < 8; ++j) { o[j] = (y[j] * rstd * lnw[j] + lnb[j] + cur.rk * v[j]) * g[j];
#ifdef SCRUB7
            o[j] = (o[j] == o[j] && fabsf(o[j]) < 1e30f) ? o[j] : 0.f;
#endif
        }
        u32x4 w; w.x = cvt_pk_bf16(o[0], o[1]); w.y = cvt_pk_bf16(o[2], o[3]); w.z = cvt_pk_bf16(o[4], o[5]); w.w = cvt_pk_bf16(o[6], o[7]);
        *(u32x4*)(mixed + (size_t)tok * DM + c0) = w;
        const float ss = ((cur.s0[0] + cur.s0[1]) + (cur.s0[2] + cur.s0[3])) + ((cur.s1[0] + cur.s1[1]) + (cur.s1[2] + cur.s1[3])); const float rs = 1.0f / sqrtf(ss * (1.0f / DSSM) + 1e-5f);
        float yv[8]; unpack8(cur.yg, yv);
        u32x4 w2; w2.x = cvt_pk_bf16(yv[0] * rs, yv[1] * rs); w2.y = cvt_pk_bf16(yv[2] * rs, yv[3] * rs); w2.z = cvt_pk_bf16(yv[4] * rs, yv[5] * rs); w2.w = cvt_pk_bf16(yv[6] * rs, yv[7] * rs);
        *(u32x4*)(mixed + (size_t)tok * DM + DR + c0) = w2;
        cur = nxt;
    }
}
constexpr int CT = 72;
constexpr int SLOT = 64 * CT * 2;
constexpr int SL_AH = 0, SL_BH = 1, SL_KH = 2, SL_RH = 3, SL_AHT = 4, SL_BTT = 5, SL_KTT = 6, SL_VT = 7, SL_PA = 8, SL_PAT = 9, SL_TA = 10, SL_AAK = 11, SL_ARB = 12, SL_ARK = 13, SL_XT = 14, SL_UVT = 15;
constexpr int SL_PB = 0, SL_PBT = 1, SL_TB = 2, SL_WT = 11;
constexpr int LC_OFF = SL_PA * SLOT, TOT_OFF = LC_OFF + 64 * 64 * 4;
constexpr int GT_OFF = 16 * SLOT;
__device__ __forceinline__ LAS bf16_t* slot(LAS unsigned char* lds, int s) { return (LAS bf16_t*)(lds + s * SLOT); }
template <bool TR> __device__ __forceinline__ void mm2(const LAS bf16_t* X, const LAS bf16_t* YT, int mi, int ni0, int lane, f32x4 (&acc)[2]) {
    const int fr = lane & 15, fq = lane >> 4;
#pragma unroll
    for (int ks = 0; ks < 2; ++ks) { const bf16x8 a = *(const LAS bf16x8*)(X + (16 * mi + fr) * CT + 32 * ks + 8 * fq);
#pragma unroll
        for (int t = 0; t < 2; ++t) { const bf16x8 b = *(const LAS bf16x8*)(YT + (16 * (ni0 + t) + fr) * CT + 32 * ks + 8 * fq);
            acc[t] = TR ? __builtin_amdgcn_mfma_f32_16x16x32_bf16(a, b, acc[t], 0, 0, 0) : __builtin_amdgcn_mfma_f32_16x16x32_bf16(b, a, acc[t], 0, 0, 0); } }
}
__device__ __forceinline__ void st_rm(LAS bf16_t* Z, int mi, int ni, int lane, const f32x4 v) { u32x2 w; w.x = cvt_pk_bf16(v[0], v[1]); w.y = cvt_pk_bf16(v[2], v[3]); *(LAS u32x2*)(Z + (16 * mi + (lane & 15)) * CT + 16 * ni + 4 * (lane >> 4)) = w; }
__device__ __forceinline__ void st_tr(LAS bf16_t* ZT, int mi, int ni, int lane, const f32x4 v) {
#pragma unroll
    for (int r = 0; r < 4; ++r) ZT[(16 * ni + 4 * (lane >> 4) + r) * CT + 16 * mi + (lane & 15)] = f2bf(v[r]); }
__device__ __forceinline__ void st_trT(LAS bf16_t* ZT, int mi, int ni, int lane, const f32x4 v) { u32x2 w; w.x = cvt_pk_bf16(v[0], v[1]); w.y = cvt_pk_bf16(v[2], v[3]); *(LAS u32x2*)(ZT + (16 * ni + (lane & 15)) * CT + 16 * mi + 4 * (lane >> 4)) = w; }
struct PaIn { u32x4 cr, ck, cv, qr, qk, qv; f32x4 a0, a1, w0, w1; float lwr[8]; };
__device__ __forceinline__ void pa_load(PaIn& in, const bf16_t* proj, const float* la, const float* lw, int job, int wave, int lane) {
    const int bh = job >> 6, c = job & 63, b = bh >> 3, h = bh & 7; const int tok0 = b * SEQ + c * 64;
    { const int t = wave * 8 + (lane >> 3), cg = lane & 7, tok = tok0 + t; const bf16_t* row = proj + (size_t)tok * DIN + h * HD + cg * 8; const bool first = (c == 0 && t == 0); const u32x4 z = (u32x4){0u, 0u, 0u, 0u};
      in.cr = *(const u32x4*)row; in.ck = *(const u32x4*)(row + COL_K); in.cv = *(const u32x4*)(row + COL_V);
      in.qr = first ? z : *(const u32x4*)(row - DIN); in.qk = first ? z : *(const u32x4*)(row - DIN + COL_K); in.qv = first ? z : *(const u32x4*)(row - DIN + COL_V);
      const float* pa = la + (size_t)tok * DR + h * HD + cg * 8; const float* pw = lw + (size_t)tok * DR + h * HD + cg * 8;
      in.a0 = *(const f32x4*)pa; in.a1 = *(const f32x4*)(pa + 4); in.w0 = *(const f32x4*)pw; in.w1 = *(const f32x4*)(pw + 4); }
#pragma unroll
    for (int i = 0; i < 8; ++i) in.lwr[i] = lw[(size_t)(tok0 + wave * 8 + i) * DR + h * HD + lane];
}
__device__ __forceinline__ float logdecay(float x) { const float z = -x; const float sp = fmaxf(z, 0.f) + __logf(1.0f + __expf(-fabsf(z))); return -__expf(-sp - 0.5f); }
__device__ __forceinline__ void p4_chunks(const Params& p, LAS unsigned char* lds, int wave, int lane) {
    const bf16_t* proj = (const bf16_t*)(p.ws + WS_PROJ); const float* lwp = (const float*)(p.ws + WS_LORAW); const float* lap = (const float*)(p.ws + WS_LORAA);
    bf16_t* QP = (bf16_t*)(p.ws + WS_QP); float* YG = (float*)(p.ws + WS_YG); float* rkb = (float*)(p.ws + WS_RKB);
    LAS float* lct = (LAS float*)(lds + LC_OFF); LAS float* tot = (LAS float*)(lds + TOT_OFF); LAS float* gtab = (LAS float*)(lds + GT_OFF);
    const int mi = wave >> 1, ni0 = (wave & 1) * 2, fr = lane & 15, fq = lane >> 4;
    PaIn in; pa_load(in, proj, lap, lwp, blockIdx.x, wave, lane);
    for (int job = blockIdx.x; job < 64 * 64; job += GRID) {
        const int bh = job >> 6, c = job & 63, b = bh >> 3, h = bh & 7; const int tok0 = b * SEQ + c * 64;
        { const float w0k = p.in[I_W0][h * HD + lane]; float pre[8]; float run = 0.f;
#pragma unroll
          for (int i = 0; i < 8; ++i) { run += logdecay(w0k + in.lwr[i]); pre[i] = run; }
          tot[wave * 64 + lane] = run;
          __syncthreads();
          float off = 0.f;
#pragma unroll
          for (int w2 = 0; w2 < 7; ++w2) off += (w2 < wave) ? tot[w2 * 64 + lane] : 0.f;
#pragma unroll
          for (int i = 0; i < 8; ++i) lct[(wave * 8 + i) * 64 + lane] = off + pre[i]; }
        __syncthreads();
        { const int t = wave * 8 + (lane >> 3), cg = lane & 7, k0 = cg * 8, col = h * HD + k0;
          float cr[8], ck[8], cv[8], qr[8], qk[8], qv[8], lc[8], gc[8], mur[8], muk[8], muv[8], kkw[8], kaw[8], rkw[8], a0c[8], w0c[8];
          unpack8(in.cr, cr); unpack8(in.ck, ck); unpack8(in.cv, cv); unpack8(in.qr, qr); unpack8(in.qk, qk); unpack8(in.qv, qv);
          { const f32x4 x0 = *(const LAS f32x4*)(lct + t * 64 + k0), x1 = *(const LAS f32x4*)(lct + t * 64 + k0 + 4), g0 = *(const LAS f32x4*)(lct + 63 * 64 + k0), g1 = *(const LAS f32x4*)(lct + 63 * 64 + k0 + 4);
#pragma unroll
            for (int j = 0; j < 4; ++j) { lc[j] = x0[j]; lc[j + 4] = x1[j]; gc[j] = g0[j]; gc[j + 4] = g1[j]; } }
          ld8(p.in[I_MU] + col, mur); ld8(p.in[I_MU] + COL_K + col, muk); ld8(p.in[I_MU] + COL_V + col, muv); ld8(p.in[I_KK] + col, kkw); ld8(p.in[I_KA] + col, kaw); ld8(p.in[I_RK] + col, rkw); ld8(p.in[I_A0] + col, a0c); ld8(p.in[I_W0] + col, w0c);
          float ah[8], bh_[8], kh[8], rh[8], bt[8], kt[8], vv[8], kk[8]; float n2 = 0.f, rk = 0.f;
#pragma unroll
          for (int j = 0; j < 8; ++j) { const float r = cr[j] + mur[j] * (qr[j] - cr[j]), kraw = ck[j] + muk[j] * (qk[j] - ck[j]); vv[j] = cv[j] + muv[j] * (qv[j] - cv[j]);
              const float ap = j < 4 ? in.a0[j & 3] : in.a1[j & 3], wp = j < 4 ? in.w0[j & 3] : in.w1[j & 3];
              const float a = sigmoidf_(a0c[j] + ap), lw = logdecay(w0c[j] + wp);
              kk[j] = kraw * kkw[j]; n2 += kk[j] * kk[j]; const float km = kraw * (1.0f + (a - 1.0f) * kaw[j]); rk += r * km * rkw[j];
              const float e1 = __expf(lc[j]), e2 = __expf(-lc[j]), g = __expf(gc[j]);
              rh[j] = r * e1; kh[j] = km * e2; kt[j] = kh[j] * g; ah[j] = -__expf(lc[j] - lw); bh_[j] = a * e2; bt[j] = g; }
          n2 = sum8(n2); rk = sum8(rk);
#ifdef NO_INV
          const float inv = 0.125f;
#else
          const float inv = 1.0f / fmaxf(sqrtf(n2), 1e-12f);
#endif
#pragma unroll
          for (int j = 0; j < 8; ++j) { const float kn = kk[j] * inv; ah[j] *= kn; bh_[j] *= kn; bt[j] *= bh_[j]; }
          if (cg == 0) rkb[(size_t)(tok0 + t) * NH + h] = rk;
          if (t == 63) {
#pragma unroll
              for (int j = 0; j < 8; ++j) gtab[k0 + j] = __expf(gc[j]); }
          u32x4 w;
          w.x = cvt_pk_bf16(ah[0], ah[1]); w.y = cvt_pk_bf16(ah[2], ah[3]); w.z = cvt_pk_bf16(ah[4], ah[5]); w.w = cvt_pk_bf16(ah[6], ah[7]); *(LAS u32x4*)(slot(lds, SL_AH) + t * CT + k0) = w;
          w.x = cvt_pk_bf16(bh_[0], bh_[1]); w.y = cvt_pk_bf16(bh_[2], bh_[3]); w.z = cvt_pk_bf16(bh_[4], bh_[5]); w.w = cvt_pk_bf16(bh_[6], bh_[7]); *(LAS u32x4*)(slot(lds, SL_BH) + t * CT + k0) = w;
          w.x = cvt_pk_bf16(kh[0], kh[1]); w.y = cvt_pk_bf16(kh[2], kh[3]); w.z = cvt_pk_bf16(kh[4], kh[5]); w.w = cvt_pk_bf16(kh[6], kh[7]); *(LAS u32x4*)(slot(lds, SL_KH) + t * CT + k0) = w;
          w.x = cvt_pk_bf16(rh[0], rh[1]); w.y = cvt_pk_bf16(rh[2], rh[3]); w.z = cvt_pk_bf16(rh[4], rh[5]); w.w = cvt_pk_bf16(rh[6], rh[7]); *(LAS u32x4*)(slot(lds, SL_RH) + t * CT + k0) = w;
#pragma unroll
          for (int j = 0; j < 8; ++j) { slot(lds, SL_AHT)[(k0 + j) * CT + t] = f2bf(ah[j]); slot(lds, SL_BTT)[(k0 + j) * CT + t] = f2bf(bt[j]); slot(lds, SL_KTT)[(k0 + j) * CT + t] = f2bf(kt[j]); slot(lds, SL_VT)[(k0 + j) * CT + t] = f2bf(vv[j]); } }
        if (job + GRID < 64 * 64) pa_load(in, proj, lap, lwp, job + GRID, wave, lane);
        __syncthreads();
        f32x4 accT[2];
        { f32x4 acc[2];
          acc[0] = acc[1] = (f32x4){0.f, 0.f, 0.f, 0.f}; mm2<false>(slot(lds, SL_AH), slot(lds, SL_BH), mi, ni0, lane, acc);
#pragma unroll
          for (int t = 0; t < 2; ++t) { const int m = 16 * mi + fr, n = 16 * (ni0 + t) + 4 * fq;
#pragma unroll
              for (int r = 0; r < 4; ++r) acc[t][r] = (n + r < m) ? acc[t][r] : 0.f;
              st_rm(slot(lds, SL_PA), mi, ni0 + t, lane, acc[t]); st_tr(slot(lds, SL_PAT), mi, ni0 + t, lane, acc[t]);
#pragma unroll
              for (int r = 0; r < 4; ++r) accT[t][r] = acc[t][r] + ((n + r == m) ? 1.0f : 0.f);
              st_rm(slot(lds, SL_TA), mi, ni0 + t, lane, accT[t]);
#ifdef DBG_S0
              *(f32x4*)(YG + (size_t)job * 2 * 4096 + m * 64 + n) = acc[t];
#endif
              }
          acc[0] = acc[1] = (f32x4){0.f, 0.f, 0.f, 0.f}; mm2<false>(slot(lds, SL_AH), slot(lds, SL_KH), mi, ni0, lane, acc);
#pragma unroll
          for (int t = 0; t < 2; ++t) { const int m = 16 * mi + fr, n = 16 * (ni0 + t) + 4 * fq;
#pragma unroll
              for (int r = 0; r < 4; ++r) acc[t][r] = (n + r < m) ? acc[t][r] : 0.f;
              st_rm(slot(lds, SL_AAK), mi, ni0 + t, lane, acc[t]); }
          acc[0] = acc[1] = (f32x4){0.f, 0.f, 0.f, 0.f}; mm2<false>(slot(lds, SL_RH), slot(lds, SL_BH), mi, ni0, lane, acc);
#pragma unroll
          for (int t = 0; t < 2; ++t) { const int m = 16 * mi + fr, n = 16 * (ni0 + t) + 4 * fq;
#pragma unroll
              for (int r = 0; r < 4; ++r) acc[t][r] = (n + r <= m) ? acc[t][r] : 0.f;
              st_rm(slot(lds, SL_ARB), mi, ni0 + t, lane, acc[t]); }
          acc[0] = acc[1] = (f32x4){0.f, 0.f, 0.f, 0.f}; mm2<false>(slot(lds, SL_RH), slot(lds, SL_KH), mi, ni0, lane, acc);
#pragma unroll
          for (int t = 0; t < 2; ++t) { const int m = 16 * mi + fr, n = 16 * (ni0 + t) + 4 * fq;
#pragma unroll
              for (int r = 0; r < 4; ++r) acc[t][r] = (n + r <= m) ? acc[t][r] : 0.f;
              st_rm(slot(lds, SL_ARK), mi, ni0 + t, lane, acc[t]); } }
        __syncthreads();
        { f32x4 acc[2]; acc[0] = acc[1] = (f32x4){0.f, 0.f, 0.f, 0.f}; mm2<false>(slot(lds, SL_PA), slot(lds, SL_PAT), mi, ni0, lane, acc);
#pragma unroll
          for (int t = 0; t < 2; ++t) { st_rm(slot(lds, SL_PB), mi, ni0 + t, lane, acc[t]); st_tr(slot(lds, SL_PBT), mi, ni0 + t, lane, acc[t]); }
          acc[0] = acc[1] = (f32x4){0.f, 0.f, 0.f, 0.f}; mm2<true>(slot(lds, SL_AAK), slot(lds, SL_VT), mi, ni0, lane, acc);
#pragma unroll
          for (int t = 0; t < 2; ++t) st_trT(slot(lds, SL_XT), mi, ni0 + t, lane, acc[t]); }
        __syncthreads();
#pragma unroll
        for (int it = 1; it <= 5; ++it) { const bool odd = (it & 1) != 0;
            LAS bf16_t* Pr = slot(lds, odd ? SL_PB : SL_PA); LAS bf16_t* PrT = slot(lds, odd ? SL_PBT : SL_PAT); LAS bf16_t* Pw = slot(lds, odd ? SL_PA : SL_PB); LAS bf16_t* PwT = slot(lds, odd ? SL_PAT : SL_PBT);
            LAS bf16_t* Tr = slot(lds, odd ? SL_TA : SL_TB); LAS bf16_t* Tw = slot(lds, odd ? SL_TB : SL_TA);
            mm2<false>(Tr, PrT, mi, ni0, lane, accT);
#pragma unroll
            for (int t = 0; t < 2; ++t) st_rm(Tw, mi, ni0 + t, lane, accT[t]);
            if (it < 5) { f32x4 acc[2]; acc[0] = acc[1] = (f32x4){0.f, 0.f, 0.f, 0.f}; mm2<false>(Pr, PrT, mi, ni0, lane, acc);
#pragma unroll
                for (int t = 0; t < 2; ++t) { st_rm(Pw, mi, ni0 + t, lane, acc[t]); st_tr(PwT, mi, ni0 + t, lane, acc[t]); } }
            __syncthreads(); }
#ifdef DBG_EARLY
        { const int m = 16 * mi + fr;
#pragma unroll
          for (int t = 0; t < 2; ++t) { const u32x2 rr = *(const LAS u32x2*)(slot(lds, DBG_EARLY) + m * CT + 16 * (ni0 + t) + 4 * fq); *(f32x4*)(YG + (size_t)job * 2 * 4096 + m * 64 + 16 * (ni0 + t) + 4 * fq) = (f32x4){bflo(rr.x), bfhi(rr.x), bflo(rr.y), bfhi(rr.y)}; } }
#endif
#ifdef DBG_TM
        { const int m = 16 * mi + fr;
#pragma unroll
          for (int t = 0; t < 2; ++t) *(f32x4*)(YG + (size_t)job * 2 * 4096 + m * 64 + 16 * (ni0 + t) + 4 * fq) = accT[t]; }
#endif
        { f32x4 acc[2]; acc[0] = acc[1] = (f32x4){0.f, 0.f, 0.f, 0.f}; mm2<true>(slot(lds, SL_TB), slot(lds, SL_AHT), mi, ni0, lane, acc);
#pragma unroll
          for (int t = 0; t < 2; ++t) st_trT(slot(lds, SL_WT), mi, ni0 + t, lane, acc[t]);
          acc[0] = acc[1] = (f32x4){0.f, 0.f, 0.f, 0.f}; mm2<true>(slot(lds, SL_TB), slot(lds, SL_XT), mi, ni0, lane, acc);
#pragma unroll
          for (int t = 0; t < 2; ++t) st_trT(slot(lds, SL_UVT), mi, ni0 + t, lane, acc[t]); }
        __syncthreads();
        { bf16_t* qp = QP + (size_t)job * 2 * 4096; float* yg = YG + (size_t)job * 2 * 4096; const int m = 16 * mi + fr, qs = 2 * (fq & 1) + (fq >> 1);
          f32x4 acc[2];
          acc[0] = acc[1] = (f32x4){0.f, 0.f, 0.f, 0.f}; mm2<false>(slot(lds, SL_ARB), slot(lds, SL_WT), mi, ni0, lane, acc);
#pragma unroll
          for (int t = 0; t < 2; ++t) { const u32x2 rr = *(const LAS u32x2*)(slot(lds, SL_RH) + m * CT + 16 * (ni0 + t) + 4 * fq);
              u32x2 w; w.x = cvt_pk_bf16(acc[t][0] + bflo(rr.x), acc[t][1] + bfhi(rr.x)); w.y = cvt_pk_bf16(acc[t][2] + bflo(rr.y), acc[t][3] + bfhi(rr.y)); *(u32x2*)(qp + m * 64 + 16 * (ni0 + t) + 4 * qs) = w; }
          acc[0] = acc[1] = (f32x4){0.f, 0.f, 0.f, 0.f};
#if !defined(YL_V1)
#if defined(YL_V3)
          mm2<false>(slot(lds, SL_ARB), slot(lds, SL_XT), mi, ni0, lane, acc);
#elif defined(YL_V4)
          mm2<false>(slot(lds, SL_TB), slot(lds, SL_VT), mi, ni0, lane, acc);
#else
          mm2<false>(slot(lds, SL_ARB), slot(lds, SL_UVT), mi, ni0, lane, acc);
#endif
#endif
#if !defined(YL_V2)
          mm2<false>(slot(lds, SL_ARK), slot(lds, SL_VT), mi, ni0, lane, acc);
#endif

#ifdef YL_CONST
          acc[0] = acc[1] = (f32x4){1.f, 1.f, 1.f, 1.f};
#endif
#ifdef DBG_SLOT
#pragma unroll
          for (int t = 0; t < 2; ++t) { const u32x2 rr = *(const LAS u32x2*)(slot(lds, DBG_SLOT) + m * CT + 16 * (ni0 + t) + 4 * fq); acc[t] = (f32x4){bflo(rr.x), bfhi(rr.x), bflo(rr.y), bfhi(rr.y)}; }
#endif
#if !defined(DBG_S0) && !defined(DBG_TM) && !defined(DBG_EARLY)
#pragma unroll
          for (int t = 0; t < 2; ++t) *(f32x4*)(yg + m * 64 + 16 * (ni0 + t) + 4 * fq) = acc[t];
#endif
          acc[0] = acc[1] = (f32x4){0.f, 0.f, 0.f, 0.f}; mm2<false>(slot(lds, SL_BTT), slot(lds, SL_WT), mi, ni0, lane, acc);
#pragma unroll
          for (int t = 0; t < 2; ++t) { const int n = 16 * (ni0 + t) + 4 * fq; const float gm = gtab[m];
#pragma unroll
              for (int r = 0; r < 4; ++r) acc[t][r] += (n + r == m) ? gm : 0.f;
              u32x2 w; w.x = cvt_pk_bf16(acc[t][0], acc[t][1]); w.y = cvt_pk_bf16(acc[t][2], acc[t][3]); *(u32x2*)(qp + 4096 + m * 64 + 16 * (ni0 + t) + 4 * qs) = w; }
          acc[0] = acc[1] = (f32x4){0.f, 0.f, 0.f, 0.f}; mm2<false>(slot(lds, SL_BTT), slot(lds, SL_UVT), mi, ni0, lane, acc); mm2<false>(slot(lds, SL_KTT), slot(lds, SL_VT), mi, ni0, lane, acc);
#pragma unroll
          for (int t = 0; t < 2; ++t) *(f32x4*)(yg + 4096 + m * 64 + 16 * (ni0 + t) + 4 * fq) = acc[t]; }
        __syncthreads();
    }
}

constexpr int PB_BUF = 32768;
__device__ __forceinline__ void pb_dma(const bf16_t* qt, const float* yl, int jv, LAS unsigned char* dst, int wave, int lane) {
    const int rr = lane >> 3, cc = lane & 7;
#pragma unroll
    for (int q = 0; q < 2; ++q) { const int pc = wave + 8 * q;
        __builtin_amdgcn_global_load_lds((const unsigned*)((const char*)qt + pc * 1024 + rr * 128 + ((cc ^ rr) * 16)), (LAS unsigned*)(dst + pc * 1024), 16, 0, 0); }
#pragma unroll
    for (int q = 0; q < 2; ++q) { const float* base = yl + q * 4096;
        __builtin_amdgcn_global_load_lds((const unsigned*)((const char*)(base + (wave * 8 + rr) * 64 + jv * 32) + cc * 16), (LAS unsigned*)(dst + 16384 + q * 8192 + wave * 1024), 16, 0, 0); }
}
__device__ __forceinline__ void p5_seq(const Params& p, LAS unsigned char* lds, int wave, int lane) {
    const int bh = blockIdx.x >> 1, jv = blockIdx.x & 1, b = bh >> 3, h = bh & 7, r31 = lane & 31, hh = lane >> 5;
    const bf16_t* QP = (const bf16_t*)(p.ws + WS_QP) + (size_t)bh * 64 * 2 * 4096; const float* YG = (const float*)(p.ws + WS_YG) + (size_t)bh * 64 * 2 * 4096;
    float* yraw = (float*)(p.ws + WS_YRAW) + (size_t)b * SEQ * DR + h * HD + 32 * jv + r31;
    f32x16 H[2];
#pragma unroll
    for (int i = 0; i < 2; ++i)
#pragma unroll
        for (int r = 0; r < 16; ++r) H[i][r] = 0.f;
    pb_dma(QP, YG, jv, lds, wave, lane);
    VM_WAIT(); __syncthreads();
    for (int c = 0; c < 64; ++c) { const LAS unsigned char* bp = lds + (c & 1) * PB_BUF;
        if (c + 1 < 64) pb_dma(QP + (size_t)(c + 1) * 2 * 4096, YG + (size_t)(c + 1) * 2 * 4096, jv, lds + ((c + 1) & 1) * PB_BUF, wave, lane);
        if (wave == 0) {
            bf16x8 Bf[4];
#pragma unroll
            for (int i = 0; i < 2; ++i)
#pragma unroll
                for (int s2 = 0; s2 < 2; ++s2) { u32x4 w; w.x = cvt_pk_bf16(H[i][8 * s2 + 0], H[i][8 * s2 + 1]); w.y = cvt_pk_bf16(H[i][8 * s2 + 2], H[i][8 * s2 + 3]); w.z = cvt_pk_bf16(H[i][8 * s2 + 4], H[i][8 * s2 + 5]); w.w = cvt_pk_bf16(H[i][8 * s2 + 6], H[i][8 * s2 + 7]);
                    Bf[2 * i + s2] = __builtin_bit_cast(bf16x8, w); }
#pragma unroll
            for (int tt = 0; tt < 2; ++tt) { f32x16 acc; const int row = 32 * tt + r31;
#pragma unroll
                for (int r = 0; r < 16; ++r) acc[r] = *(const LAS float*)(bp + 16384 + ((32 * tt + (r & 3) + 8 * (r >> 2) + 4 * hh) * 32 + r31) * 4);
#ifndef PB_NOQ
#pragma unroll
                for (int kq = 0; kq < 4; ++kq) { const bf16x8 a = *(const LAS bf16x8*)(bp + row * 128 + (((2 * kq + hh) ^ (row & 7)) * 16)); acc = __builtin_amdgcn_mfma_f32_32x32x16_bf16(a, Bf[kq], acc, 0, 0, 0); }
#endif
#pragma unroll
                for (int r = 0; r < 16; ++r) yraw[(size_t)(c * 64 + 32 * tt + (r & 3) + 8 * (r >> 2) + 4 * hh) * DR] = acc[r]; }
            f32x16 Hn[2];
#pragma unroll
            for (int i = 0; i < 2; ++i) { const int row = 32 * i + r31;
#pragma unroll
                for (int r = 0; r < 16; ++r) Hn[i][r] = *(const LAS float*)(bp + 24576 + ((32 * i + (r & 3) + 8 * (r >> 2) + 4 * hh) * 32 + r31) * 4);
#pragma unroll
                for (int kq = 0; kq < 4; ++kq) { const bf16x8 a = *(const LAS bf16x8*)(bp + 8192 + row * 128 + (((2 * kq + hh) ^ (row & 7)) * 16)); Hn[i] = __builtin_amdgcn_mfma_f32_32x32x16_bf16(a, Bf[kq], Hn[i], 0, 0, 0); } }
#ifndef PB_NOH
            H[0] = Hn[0]; H[1] = Hn[1];
#else
            asm volatile("" :: "v"(Hn[0]), "v"(Hn[1]));
#endif
        }
        VM_WAIT(); __syncthreads();
    }
}
constexpr int RT_ROW = 36;
constexpr int RT_HIST = 147456, RT_BASE = RT_HIST + 128, RT_ETAB = RT_HIST + 256, RT_RS = RT_HIST + 256 + 2048;
__device__ __forceinline__ void p9_router(const Params& p, LAS unsigned char* lds, int wave, int lane) {
    const float* x1 = p.out; const float* rwp = (const float*)(p.ws + WS_RWP); const float* rb = p.in[I_RB];
    int* eid = (int*)(p.ws + WS_EID); float* gate = (float*)(p.ws + WS_GATE); int* relpos = (int*)(p.ws + WS_RELPOS); int* stok = (int*)(p.ws + WS_STOK); float* srs = (float*)(p.ws + WS_SRS);
    unsigned* gcount = (unsigned*)(p.ws + WS_CTL) + CW_GCOUNT;
    const int tid = wave * 64 + lane;
    LAS unsigned* hist = (LAS unsigned*)(lds + RT_HIST); LAS unsigned* base = (LAS unsigned*)(lds + RT_BASE); LAS unsigned* etab = (LAS unsigned*)(lds + RT_ETAB); LAS float* rsl = (LAS float*)(lds + RT_RS);
#pragma unroll
    for (int c = 0; c < 16; ++c) { const int i4 = tid + 512 * c, k = i4 >> 3, e4 = i4 & 7; *(LAS f32x4*)(lds + k * (RT_ROW * 4) + e4 * 16) = *(const f32x4*)(rwp + (size_t)i4 * 4); }
    if (tid < 32) hist[tid] = 0u;
    __syncthreads();
    const int e_own = lane >> 1; const float rbias = rb[e_own];
    float xn[16];
    { const float* xr = x1 + (size_t)(blockIdx.x * 128 + wave * 16) * DM;
#pragma unroll
      for (int c = 0; c < 16; ++c) xn[c] = xr[lane + 64 * c]; }
    for (int i = 0; i < 16; ++i) { const int tl = wave * 16 + i, tok = blockIdx.x * 128 + tl;
        float xv[16]; float ss = 0.f;
#pragma unroll
        for (int c = 0; c < 16; ++c) { xv[c] = xn[c]; ss += xv[c] * xv[c]; }
        if (i + 1 < 16) { const float* xr = x1 + (size_t)(tok + 1) * DM;
#pragma unroll
            for (int c = 0; c < 16; ++c) xn[c] = xr[lane + 64 * c]; }
        float pl[32];
#pragma unroll
        for (int e = 0; e < 32; ++e) pl[e] = 0.f;
#pragma unroll
        for (int c = 0; c < 16; ++c) { const LAS f32x4* wrow = (const LAS f32x4*)(lds + (lane + 64 * c) * (RT_ROW * 4));
#pragma unroll
            for (int e4 = 0; e4 < 8; ++e4) { const f32x4 w = wrow[e4]; pl[4 * e4 + 0] += xv[c] * w[0]; pl[4 * e4 + 1] += xv[c] * w[1]; pl[4 * e4 + 2] += xv[c] * w[2]; pl[4 * e4 + 3] += xv[c] * w[3]; } }
        ss = wave_sum(ss); const float rstd = 1.0f / sqrtf(ss * (1.0f / DM) + 1e-5f);
        const bool b5 = (lane & 32) != 0, b4 = (lane & 16) != 0, b3 = (lane & 8) != 0, b2 = (lane & 4) != 0, b1 = (lane & 2) != 0;
        float q16[16], q8[8], q4[4], q2[2];
#pragma unroll
        for (int k = 0; k < 16; ++k) { const float keep = b5 ? pl[k + 16] : pl[k], send = b5 ? pl[k] : pl[k + 16]; q16[k] = keep + __shfl_xor(send, 32); }
#pragma unroll
        for (int k = 0; k < 8; ++k) { const float keep = b4 ? q16[k + 8] : q16[k], send = b4 ? q16[k] : q16[k + 8]; q8[k] = keep + __shfl_xor(send, 16); }
#pragma unroll
        for (int k = 0; k < 4; ++k) { const float keep = b3 ? q8[k + 4] : q8[k], send = b3 ? q8[k] : q8[k + 4]; q4[k] = keep + __shfl_xor(send, 8); }
#pragma unroll
        for (int k = 0; k < 2; ++k) { const float keep = b2 ? q4[k + 2] : q4[k], send = b2 ? q4[k] : q4[k + 2]; q2[k] = keep + __shfl_xor(send, 4); }
        float q1; { const float keep = b1 ? q2[1] : q2[0], send = b1 ? q2[0] : q2[1]; q1 = keep + __shfl_xor(send, 2); }
        q1 += __shfl_xor(q1, 1);
        float logit = q1 * rstd + rbias; logit = (logit == logit) ? fminf(fmaxf(logit, -1.0e30f), 1.0e30f) : -1.0e30f;
        const bool even = (lane & 1) == 0;
        float cur = even ? logit : -3.0e38f; int rank = -1; float topv[4];
#pragma unroll
        for (int k = 0; k < 4; ++k) { float m = cur;
#pragma unroll
            for (int o = 32; o >= 1; o >>= 1) m = fmaxf(m, __shfl_xor(m, o));
            const unsigned long long bm = __ballot(cur == m); const int l0 = __ffsll((long long)bm) - 1;
            if (lane == l0) { rank = k; cur = -3.0e38f; }
            topv[k] = m; }
        const float sum = 1.0f + __expf(topv[1] - topv[0]) + __expf(topv[2] - topv[0]) + __expf(topv[3] - topv[0]);
        if (rank >= 0) { const unsigned lr = atomicAdd((unsigned*)&hist[e_own], 1u); eid[(size_t)tok * 4 + rank] = e_own; gate[(size_t)tok * 4 + rank] = __expf(logit - topv[0]) / sum; etab[tl * 4 + rank] = (lr << 5) | (unsigned)e_own; }
        if (lane == 0) rsl[tl] = rstd;
    }
    __syncthreads();
    if (tid < 32) { const unsigned hc = hist[tid]; base[tid] = hc ? atomicAdd(&gcount[tid], hc) : 0u; }
    __syncthreads();
    { const int tl = tid >> 2, k = tid & 3, tok = blockIdx.x * 128 + tl; const unsigned pk = etab[tid]; const int e = pk & 31; const unsigned rel = base[e] + (pk >> 5);
      relpos[(size_t)tok * 4 + k] = (int)rel; stok[(size_t)e * CAP + rel] = tok; srs[(size_t)e * CAP + rel] = rsl[tl]; }
}
__device__ __forceinline__ void moe_tables(const Params& p, LAS unsigned char* lds, const bool t0) {
    const unsigned* gcount = (const unsigned*)(p.ws + WS_CTL) + CW_GCOUNT;
    LAS int* tsrc = (LAS int*)(lds + TAB_SRC); LAS int* tval = (LAS int*)(lds + TAB_VAL); LAS int* te = (LAS int*)(lds + TAB_E); LAS int* tbase = (LAS int*)(lds + TAB_BASE);
    if (t0) { int tb = 0;
        for (int e = 0; e < NE; ++e) { const int c = (int)__hip_atomic_load(&gcount[e], __ATOMIC_RELAXED, __HIP_MEMORY_SCOPE_AGENT); const int nt = (c + 255) >> 8; tbase[e] = tb;
            for (int lt = 0; lt < nt; ++lt) { tsrc[tb + lt] = e * CAP + lt * 256; const int rem = c - lt * 256; tval[tb + lt] = rem < 256 ? rem : 256; te[tb + lt] = e; }
            tb += nt; }
        tbase[NE] = tb; }
    __syncthreads();
}
typedef int i32x4 __attribute__((ext_vector_type(4)));
struct P12Meta { i32x4 e, rp; f32x4 g; };
struct P12Rows { f32x4 x[4]; u32x2 y[4][4]; f32x4 g; };
__device__ __forceinline__ void p12_meta(P12Meta& m, const int* eid, const float* gate, const int* relpos, int tok) {
    m.e = *(const i32x4*)(eid + (size_t)tok * 4); m.g = *(const f32x4*)(gate + (size_t)tok * 4); m.rp = *(const i32x4*)(relpos + (size_t)tok * 4); }
__device__ __forceinline__ void p12_rows(P12Rows& r, const P12Meta& m, const float* x1, const bf16_t* ys, const LAS int* tbase, int tok, int lane) {
#pragma unroll
    for (int j = 0; j < 4; ++j) r.x[j] = *(const f32x4*)(x1 + (size_t)tok * DM + 4 * lane + 256 * j);
#pragma unroll
    for (int k = 0; k < 4; ++k) { const bf16_t* yr = ys + ((size_t)tbase[m.e[k]] * 256 + m.rp[k]) * DM + 4 * lane;
#pragma unroll
        for (int j = 0; j < 4; ++j) r.y[k][j] = *(const u32x2*)(yr + 256 * j); }
    r.g = m.g;
}
__device__ __forceinline__ void p12_combine(const Params& p, LAS unsigned char* lds, int wave, int lane) {
    float* x1 = p.out; const bf16_t* ys = (const bf16_t*)(p.ws + WS_YSORT); const int* eid = (const int*)(p.ws + WS_EID); const float* gate = (const float*)(p.ws + WS_GATE); const int* relpos = (const int*)(p.ws + WS_RELPOS);
    const float* fg = p.in[I_FG]; const LAS int* tbase = (const LAS int*)(lds + TAB_BASE);
    const int gw = blockIdx.x * NWAVES + wave;
    f32x4 gv[4];
#pragma unroll
    for (int j = 0; j < 4; ++j) gv[j] = *(const f32x4*)(fg + 4 * lane + 256 * j);
    P12Meta m0, m1; P12Rows rc, rn;
    p12_meta(m0, eid, gate, relpos, gw); p12_meta(m1, eid, gate, relpos, gw + NGW);
    p12_rows(rc, m0, x1, ys, tbase, gw, lane);
    for (int tok = gw; tok < NTOK; tok += NGW) {
        m0 = m1;
        if (tok + 2 * NGW < NTOK) p12_meta(m1, eid, gate, relpos, tok + 2 * NGW);
        if (tok + NGW < NTOK) p12_rows(rn, m0, x1, ys, tbase, tok + NGW, lane);
        f32x4 v[4];
#pragma unroll
        for (int j = 0; j < 4; ++j) v[j] = rc.x[j];
#pragma unroll
        for (int k = 0; k < 4; ++k) { const float gt = rc.g[k];
#pragma unroll
            for (int j = 0; j < 4; ++j) { const u32x2 w = rc.y[k][j]; v[j][0] += gt * bflo(w.x); v[j][1] += gt * bfhi(w.x); v[j][2] += gt * bflo(w.y); v[j][3] += gt * bfhi(w.y); } }
        float ss = 0.f;
#pragma unroll
        for (int j = 0; j < 4; ++j) ss += (v[j][0] * v[j][0] + v[j][1] * v[j][1]) + (v[j][2] * v[j][2] + v[j][3] * v[j][3]);
        ss = wave_sum(ss); const float rs = 1.0f / sqrtf(ss * (1.0f / DM) + 1e-5f);
#pragma unroll
        for (int j = 0; j < 4; ++j) { f32x4 o = v[j] * rs * gv[j];
#ifdef SCRUB_NAN
#pragma unroll
            for (int q = 0; q < 4; ++q) o[q] = (o[q] == o[q] && fabsf(o[q]) < 1e30f) ? o[q] : 0.f;
#endif
            *(f32x4*)(x1 + (size_t)tok * DM + 4 * lane + 256 * j) = o; }
        rc = rn;
    }
}
#ifndef N_PHASES
#define N_PHASES 13
#endif
struct Args { Params p; int ph_lo, ph_hi, li, pad; };
__global__ void __launch_bounds__(NWAVES * 64, 2) hymba_fwd(Args a) {
    extern __shared__ __attribute__((aligned(16))) unsigned char lds_raw[];
    LAS unsigned char* lds = (LAS unsigned char*)lds_raw;
    const Params& p = a.p;
    const int wave = __builtin_amdgcn_readfirstlane((int)threadIdx.x >> 6);
    volatile LAS unsigned* misc = (volatile LAS unsigned*)(lds + MISC_OFF);
    if (threadIdx.x < 4) misc[threadIdx.x] = 0u;
    __syncthreads();
    unsigned* ctl = (unsigned*)(p.ws + WS_CTL);
    XcdBarrier bar = xcd_barrier_post(ctl + CW_BAR + a.li * XCD_BAR_WORDS, misc);
    const int lo = a.ph_lo, hi = a.ph_hi;
#ifndef PH_MASK
#define PH_MASK 0x1FFF
#endif
#define IN(k) ((((PH_MASK) >> (k)) & 1) && lo <= (k) && (k) < hi)
#define SEAM(k) do { if (IN(k) && IN((k) + 1)) xcd_barrier(bar, wave == 0 && lane_id() == 0); } while (0)
#define LN lane_id()
    unsigned char* ws = p.ws;
    if (IN(0)) { p0_prologue(p, lds, wave, LN); } SEAM(0);
    if (IN(1)) { pg8::Gemm g{(const bf16_t*)(ws + WS_XB), (const bf16_t*)(ws + WS_WINT), NTOK, DIN, DM}; pg8::StaticOrder S; S.init(NTOK, DIN, GRID, (int)blockIdx.x);
        EpiProj E{(bf16_t*)(ws + WS_PROJ), DIN, (const float*)(ws + WS_RSTD1)}; pg8::gemm_phase<EpiProj, pg8::StaticOrder, true, false>(lds, g, S, E, wave); } SEAM(1);
    if (IN(2)) { p2_lora_in(p, wave, LN); } SEAM(2);
    if (IN(3)) { pg8::Gemm g{(const bf16_t*)(ws + WS_LORAIN), (const bf16_t*)(ws + WS_LORAB), NTOK, 1536, 256}; pg8::StaticOrder S; S.init(NTOK, 1536, GRID, (int)blockIdx.x);
        EpiLora E{(float*)(ws + WS_LORAW), (float*)(ws + WS_LORAA), (float*)(ws + WS_LORAG)}; pg8::gemm_phase<EpiLora, pg8::StaticOrder, true, false>(lds, g, S, E, wave); } SEAM(3);
    if (IN(4)) { p4_chunks(p, lds, wave, LN); } SEAM(4);
    if (IN(5)) { if (blockIdx.x < 128) p5_seq(p, lds, wave, LN); else p5_s5(p, lds, wave, LN); } SEAM(5);
    if (IN(6)) { pg8::Gemm g{(const bf16_t*)(ws + WS_YGELU), (const bf16_t*)(ws + WS_WGLUT), NTOK, DSSM, DSSM}; pg8::StaticOrder S; S.init(NTOK, DSSM, GRID, (int)blockIdx.x);
        EpiGlu E{(const bf16_t*)(ws + WS_YGELU), (bf16_t*)(ws + WS_YGLU), p.in[I_BGLU], (float*)(ws + WS_SSQ)}; pg8::gemm_phase<EpiGlu, pg8::StaticOrder, false, false>(lds, g, S, E, wave); } SEAM(6);
    if (IN(7)) { p7_mix(p, wave, LN); } SEAM(7);
    if (IN(8)) { pg8::Gemm g{(const bf16_t*)(ws + WS_MIXED), (const bf16_t*)(ws + WS_WOUTT), NTOK, DM, DM}; pg8::StaticOrder S; S.init(NTOK, DM, GRID, (int)blockIdx.x);
        EpiOut E{p.in[I_X], p.out, (bf16_t*)(ws + WS_XB)}; pg8::gemm_phase<EpiOut, pg8::StaticOrder, true, false>(lds, g, S, E, wave); } SEAM(8);
    if (IN(9)) { p9_router(p, lds, wave, LN); } SEAM(9);
    if (IN(10) || IN(11) || IN(12)) moe_tables(p, lds, wave == 0 && lane_id() == 0);
    if (IN(10)) { MoeOrder S{GRID, (int)blockIdx.x, 8, ((const LAS int*)(lds + TAB_BASE))[NE], (const LAS int*)(lds + TAB_SRC), (const LAS int*)(lds + TAB_VAL), (const LAS int*)(lds + TAB_E), (const int*)(ws + WS_STOK)};
        pg8::Gemm g{(const bf16_t*)(ws + WS_XB), (const bf16_t*)(ws + WS_W1T), 0, 0, DM};
        EpiSwiglu E{(bf16_t*)(ws + WS_ACT), (const float*)(ws + WS_B1G), (const float*)(ws + WS_B1L), (const float*)(ws + WS_SRS), (const LAS int*)(lds + TAB_SRC), (const LAS int*)(lds + TAB_VAL)};
        pg8::gemm_phase<EpiSwiglu, MoeOrder, true, true>(lds, g, S, E, wave); } SEAM(10);
    if (IN(11)) { MoeOrder S{GRID, (int)blockIdx.x, 4, ((const LAS int*)(lds + TAB_BASE))[NE], (const LAS int*)(lds + TAB_SRC), (const LAS int*)(lds + TAB_VAL), (const LAS int*)(lds + TAB_E), (const int*)(ws + WS_STOK)};
        pg8::Gemm g{(const bf16_t*)(ws + WS_ACT), (const bf16_t*)(ws + WS_W2T), 0, 0, DFF};
        EpiMoe2 E{(bf16_t*)(ws + WS_YSORT), p.in[I_B2]}; pg8::gemm_phase<EpiMoe2, MoeOrder, true, false>(lds, g, S, E, wave); } SEAM(11);
    if (IN(12)) { p12_combine(p, lds, wave, LN); }
#undef IN
#undef SEAM
#undef LN
}
#ifndef MK_SPLIT
#define MK_SPLIT 0
#endif
extern "C" void kernel_launch(void* const* d_in, const int* in_sizes, int n_in, void* d_out, int out_size, void* d_ws, size_t ws_size, hipStream_t stream) {
    static int ready = 0;
    if (ready == 0) {
        if (n_in != 34 || out_size != NTOK * DM || ws_size < WS_END) { fprintf(stderr, "kernel_launch: unexpected shapes (n_in %d, out %d, ws %zu); nothing launched\n", n_in, out_size, ws_size); ready = -1; return; }
        if (hipFuncSetAttribute((const void*)hymba_fwd, hipFuncAttributeMaxDynamicSharedMemorySize, LDS_BYTES) != hipSuccess) { fprintf(stderr, "kernel_launch: hipFuncSetAttribute failed\n"); ready = -1; return; }
        int per_cu = 0; if (hipOccupancyMaxActiveBlocksPerMultiprocessor(&per_cu, (const void*)hymba_fwd, NWAVES * 64, LDS_BYTES) != hipSuccess || per_cu < 1) fprintf(stderr, "kernel_launch: occupancy query says %d\n", per_cu);
        (void)hipGetLastError();
        ready = 1;
    }
    if (ready < 0) return;
    (void)hipMemsetAsync((char*)d_ws + WS_CTL, 0, CTL_ZERO_BYTES, stream);
    Args a{};
    for (int i = 0; i < 34; ++i) a.p.in[i] = (const float*)d_in[i];
    a.p.out = (float*)d_out; a.p.ws = (unsigned char*)d_ws;
#if defined(PROBE_LO)
    a.ph_lo = 0; a.ph_hi = PROBE_HI + 1; a.li = 0; hipLaunchKernelGGL(hymba_fwd, dim3(GRID), dim3(NWAVES * 64), LDS_BYTES, stream, a);
    a.ph_lo = PROBE_LO; a.ph_hi = N_PHASES; a.li = 1; hipLaunchKernelGGL(hymba_fwd, dim3(GRID), dim3(NWAVES * 64), LDS_BYTES, stream, a);
#elif MK_SPLIT
    for (int ph = 0; ph < N_PHASES; ++ph) { a.ph_lo = ph; a.ph_hi = ph + 1; a.li = 0; hipLaunchKernelGGL(hymba_fwd, dim3(GRID), dim3(NWAVES * 64), LDS_BYTES, stream, a); }
#else
#ifndef RUN_HI
#define RUN_HI N_PHASES
#endif
    a.ph_lo = 0; a.ph_hi = RUN_HI; a.li = 0; hipLaunchKernelGGL(hymba_fwd, dim3(GRID), dim3(NWAVES * 64), LDS_BYTES, stream, a);
#endif
}
```

```cpp
#include <hip/hip_runtime.h>
#include <cstdio>
#include <cstdint>

#define LAS __attribute__((address_space(3)))
typedef unsigned short bf16_t;
typedef short bf16x8 __attribute__((ext_vector_type(8)));
typedef float f32x4 __attribute__((ext_vector_type(4)));
typedef float f32x2 __attribute__((ext_vector_type(2)));
typedef float f32x16 __attribute__((ext_vector_type(16)));
typedef unsigned u32x4 __attribute__((ext_vector_type(4)));
typedef unsigned u32x2 __attribute__((ext_vector_type(2)));

typedef __bf16 bf16x2_t __attribute__((ext_vector_type(2)));
__device__ __forceinline__ unsigned cvt_pk_bf16(float lo, float hi) { const bf16x2_t v = {(__bf16)lo, (__bf16)hi}; return __builtin_bit_cast(unsigned, v); }
__device__ __forceinline__ float bflo(unsigned w) { return __uint_as_float(w << 16); }
__device__ __forceinline__ float bfhi(unsigned w) { return __uint_as_float(w & 0xffff0000u); }
__device__ __forceinline__ float bf2f(bf16_t b) { return __uint_as_float(((unsigned)b) << 16); }
__device__ __forceinline__ bf16_t f2bf(float f) { return (bf16_t)(cvt_pk_bf16(f, 0.f) & 0xffffu); }
__device__ __forceinline__ float wave_sum(float v) {
#pragma unroll
    for (int o = 32; o >= 1; o >>= 1) v += __shfl_xor(v, o);
    return v;
}
__device__ __forceinline__ float sigmoidf_(float x) { return __builtin_amdgcn_rcpf(1.0f + __builtin_amdgcn_exp2f(-1.4426950408889634f * x)); }
__device__ __forceinline__ int lane_id() { int l; asm volatile("v_mbcnt_lo_u32_b32 %0, -1, 0\n\tv_mbcnt_hi_u32_b32 %0, -1, %0" : "=v"(l)); return l; }
#define LDS_WAIT() asm volatile("s_waitcnt lgkmcnt(0)" ::: "memory")
#define VM_WAIT() asm volatile("s_waitcnt vmcnt(0)" ::: "memory")

namespace pg8 {
constexpr int BM = 256, BK = 64, HALF = 128, HTB = HALF * BK * 2, STAGE_BYTES = 8 * HTB, NXCD = 8, WGM = 8;
__host__ __device__ __forceinline__ int lds_byte(int r, int c) { const int st = (r >> 4) * 2 + (c >> 5), rr = r & 15, cc = c & 31, ob = rr * 64 + cc * 2; return st * 1024 + (ob ^ (((ob >> 9) & 1) << 5)); }
__host__ __device__ __forceinline__ void stage_rc(int b, int& R, int& C) { const int st = b / 1024, sb = b % 1024, swz = sb ^ (((sb >> 9) & 1) << 5); R = (st >> 1) * 16 + swz / 64; C = (st & 1) * 32 + (swz % 64) / 2; }
__host__ __device__ __forceinline__ int perm32(int rho) { const int n = rho >> 4, i = rho & 15; return 8 * (i >> 2) + 4 * n + (i & 3); }

struct Unit { int pm, pn; };
struct Gemm { const bf16_t* A; const bf16_t* Bt; int M, N, K; };

struct StaticOrder {
    int nM, nN, nwg, G, c;
    __host__ __device__ void init(int M, int N, int G_, int c_) { nM = M / BM; nN = N / BM; nwg = nM * nN; G = G_; c = c_; }
    __host__ __device__ bool next(int i, Unit& u) const {
        const long L = (long)i * G + c; if (L >= nwg) return false;
        int wgid = (int)L; { const int q = nwg / NXCD, r = nwg % NXCD, xcd = wgid % NXCD, off = wgid / NXCD; wgid = (xcd < r ? xcd * (q + 1) : r * (q + 1) + (xcd - r) * q) + off; }
        const int nig = WGM * nN, gid = wgid / nig, fm = gid * WGM, gsz = (nM - fm) < WGM ? (nM - fm) : WGM;
        u.pm = fm + ((wgid % nig) % gsz); u.pn = (wgid % nig) / gsz; return true;
    }
    __device__ __forceinline__ int arow(const Unit& u, int r) const { return u.pm * BM + r; }
};

template <class Epi, class Sched, bool ALIGN_EPI, bool GATHER>
__device__ __forceinline__ void gemm_phase(LAS unsigned char* lds, const Gemm g, const Sched& S, const Epi& E, const int wid) {
    const int lane = lane_id(), tid = wid * 64 + lane, wr = wid >> 2, wc = wid & 3, fr = lane & 15, fq = lane >> 4;
    const int K = g.K, nt = K / BK;
    int Rst[2], Cst[2];
    unsigned voffB[2], vAc[2][2], vAn[2][2];
#pragma unroll
    for (int i = 0; i < 2; ++i) { int R, C; stage_rc(tid * 16 + i * 8192, R, C); const int Rb = Epi::PERM ? ((R & ~31) + perm32(R & 31)) : R;
        Rst[i] = R; Cst[i] = C; voffB[i] = (unsigned)(Rb * K + C) * 2u; }
    const size_t kstep = (size_t)(BK * 2);
    const size_t hstep = (size_t)HALF * K * 2;
    const size_t tstep = 2 * hstep;
    const unsigned ldsw = (unsigned)wid * 1024u;
    const int aoff = lds_byte(wr * 64 + fr, fq * 8), boff = lds_byte(wc * 32 + fr, fq * 8);
#define PG8_SA(b, h) (((b) * 2 + (h)) * HTB)
#define PG8_SB(b, h) ((4 + (b) * 2 + (h)) * HTB)
#define PG8_STAGE(bufoff, gbase, voff) do { _Pragma("unroll") for (int _i = 0; _i < 2; ++_i) \
        __builtin_amdgcn_global_load_lds((const unsigned*)((const char*)(gbase) + (voff)[_i]), (LAS unsigned*)(lds + (bufoff) + ldsw + _i * 8192), 16, 0, 0); } while (0)
#define PG8_STAGE_SEL(bufoff, gbase, va, vb, sel) do { _Pragma("unroll") for (int _i = 0; _i < 2; ++_i) \
        __builtin_amdgcn_global_load_lds((const unsigned*)((const char*)(gbase) + ((sel) ? (vb)[_i] : (va)[_i])), (LAS unsigned*)(lds + (bufoff) + ldsw + _i * 8192), 16, 0, 0); } while (0)
#define PG8_LDA(dst, b, h) do { _Pragma("unroll") for (int m = 0; m < 4; ++m) _Pragma("unroll") for (int k = 0; k < 2; ++k) dst[m][k] = *(const LAS bf16x8*)(lds + PG8_SA(b, h) + aoff + m * 2048 + k * 1024); } while (0)
#define PG8_LDB(dst, b, h) do { _Pragma("unroll") for (int n = 0; n < 2; ++n) _Pragma("unroll") for (int k = 0; k < 2; ++k) dst[n][k] = *(const LAS bf16x8*)(lds + PG8_SB(b, h) + boff + n * 2048 + k * 1024); } while (0)
#define PG8_MMA(ai, bj, At, Bt) do { __builtin_amdgcn_s_setprio(1); _Pragma("unroll") for (int m = 0; m < 4; ++m) _Pragma("unroll") for (int n = 0; n < 2; ++n) _Pragma("unroll") for (int k = 0; k < 2; ++k) \
        acc[ai][bj][m][n] = __builtin_amdgcn_mfma_f32_16x16x32_bf16(Bt[n][k], At[m][k], acc[ai][bj][m][n], 0, 0, 0); __builtin_amdgcn_s_setprio(0); } while (0)
#define PG8_WAIT_V(n) asm volatile("s_waitcnt vmcnt(" #n ")" ::: "memory")
#define PG8_WAIT_L(n) asm volatile("s_waitcnt lgkmcnt(" #n ")" ::: "memory")
#define PG8_BAR __builtin_amdgcn_s_barrier()
#define PG8_SCHED __builtin_amdgcn_sched_barrier(0)
#define PG8_LOADOFF(dst, unit) do { _Pragma("unroll") for (int _h = 0; _h < 2; ++_h) _Pragma("unroll") for (int _i = 0; _i < 2; ++_i) \
        dst[_h][_i] = GATHER ? ((unsigned)S.arow(unit, _h * HALF + Rst[_i]) * (unsigned)(K * 2) + (unsigned)(Cst[_i] * 2)) : ((unsigned)((_h * HALF + Rst[_i]) * K + Cst[_i]) * 2u); } while (0)
    Unit cur, nxt; int ui = 0;
    if (!S.next(0, cur)) return;
    f32x4 acc[2][2][4][2];
#pragma unroll
    for (int a = 0; a < 2; ++a)
#pragma unroll
        for (int b = 0; b < 2; ++b)
#pragma unroll
            for (int m = 0; m < 4; ++m)
#pragma unroll
                for (int n = 0; n < 2; ++n) acc[a][b][m][n] = (f32x4){0.f, 0.f, 0.f, 0.f};
    bf16x8 At[4][2], B0[2][2], B1[2][2];
    const char* cA = GATHER ? (const char*)g.A : (const char*)g.A + (size_t)cur.pm * tstep; const char* cB = (const char*)g.Bt + (size_t)cur.pn * tstep;
    PG8_LOADOFF(vAc, cur);
    if (GATHER) { Unit u1; if (S.next(1, u1)) PG8_LOADOFF(vAn, u1); else PG8_LOADOFF(vAn, cur); } else { PG8_LOADOFF(vAn, cur); }
    PG8_STAGE(PG8_SB(0, 0), cB, voffB); PG8_STAGE(PG8_SB(0, 1), cB + hstep, voffB); PG8_STAGE(PG8_SA(0, 0), cA, vAc[0]); PG8_STAGE(PG8_SA(0, 1), cA, vAc[1]);
    if (wr == 1) PG8_BAR;
    PG8_WAIT_V(2); PG8_BAR;
    PG8_STAGE(PG8_SB(1, 0), cB + kstep, voffB); PG8_STAGE(PG8_SA(1, 0), cA + kstep, vAc[0]); PG8_STAGE(PG8_SB(1, 1), cB + hstep + kstep, voffB);
    PG8_WAIT_V(6); PG8_BAR;
    for (;;) {
        const bool has_next = S.next(ui + 1, nxt);
        const char* nA = GATHER ? cA : (has_next ? (const char*)g.A + (size_t)nxt.pm * tstep : cA); const char* nB = has_next ? (const char*)g.Bt + (size_t)nxt.pn * tstep : cB;
        const bool usen = GATHER && has_next;
        for (int t = 0; t < nt; t += 2) {
            const bool last = (t == nt - 2);
            const char* a1 = cA + (size_t)(t + 1) * kstep;
            const char* a2 = last ? nA : cA + (size_t)(t + 2) * kstep; const char* b2 = last ? nB : cB + (size_t)(t + 2) * kstep;
            const char* a3 = a2 + kstep; const char* b3 = b2 + kstep;
            const bool sel = last && usen;
            PG8_LDB(B0, 0, 0); PG8_LDB(B1, 0, 1); PG8_SCHED; PG8_LDA(At, 0, 0); PG8_STAGE(PG8_SA(1, 1), a1, vAc[1]);
            PG8_WAIT_V(8); PG8_WAIT_L(0); PG8_BAR; PG8_MMA(0, 0, At, B0); PG8_MMA(0, 1, At, B1); PG8_BAR; PG8_SCHED;
            PG8_LDA(At, 0, 1); PG8_STAGE(PG8_SB(0, 0), b2, voffB); PG8_STAGE(PG8_SB(0, 1), b2 + hstep, voffB); PG8_STAGE_SEL(PG8_SA(0, 0), a2, vAc[0], vAn[0], sel);
            PG8_WAIT_V(8); PG8_WAIT_L(0); PG8_BAR; PG8_MMA(1, 0, At, B0); PG8_MMA(1, 1, At, B1); PG8_BAR; PG8_SCHED;
            PG8_LDB(B0, 1, 0); PG8_LDB(B1, 1, 1); PG8_SCHED; PG8_LDA(At, 1, 0); PG8_STAGE_SEL(PG8_SA(0, 1), a2, vAc[1], vAn[1], sel);
            PG8_WAIT_V(8); PG8_WAIT_L(0); PG8_BAR; PG8_MMA(0, 0, At, B0); PG8_MMA(0, 1, At, B1); PG8_BAR; PG8_SCHED;
            PG8_LDA(At, 1, 1); PG8_STAGE(PG8_SB(1, 0), b3, voffB); PG8_STAGE(PG8_SB(1, 1), b3 + hstep, voffB); PG8_STAGE_SEL(PG8_SA(1, 0), a3, vAc[0], vAn[0], sel);
            PG8_WAIT_V(8); PG8_WAIT_L(0); PG8_BAR; PG8_MMA(1, 0, At, B0); PG8_MMA(1, 1, At, B1); PG8_BAR; PG8_SCHED;
        }
        if constexpr (ALIGN_EPI) { if (wr == 0) PG8_BAR; }
        E(acc, cur, wr, wc, fr, fq);
        if (!has_next) break;
#pragma unroll
        for (int a = 0; a < 2; ++a)
#pragma unroll
            for (int b = 0; b < 2; ++b)
#pragma unroll
                for (int m = 0; m < 4; ++m)
#pragma unroll
                    for (int n = 0; n < 2; ++n) acc[a][b][m][n] = (f32x4){0.f, 0.f, 0.f, 0.f};
        cur = nxt; cA = nA; cB = nB; ++ui;
        if (GATHER) {
#pragma unroll
            for (int _h = 0; _h < 2; ++_h)
#pragma unroll
                for (int _i = 0; _i < 2; ++_i) vAc[_h][_i] = vAn[_h][_i];
            Unit u2; if (S.next(ui + 1, u2)) PG8_LOADOFF(vAn, u2);
        }
        if constexpr (ALIGN_EPI) { if (wr == 1) PG8_BAR; }
    }
    PG8_WAIT_V(0);
    if constexpr (!ALIGN_EPI) { if (wr == 0) PG8_BAR; }
    PG8_BAR;
#undef PG8_SA
#undef PG8_SB
#undef PG8_STAGE
#undef PG8_STAGE_SEL
#undef PG8_LDA
#undef PG8_LDB
#undef PG8_MMA
#undef PG8_WAIT_V
#undef PG8_WAIT_L
#undef PG8_BAR
#undef PG8_SCHED
#undef PG8_LOADOFF
}
}
#define XB_TMO      128
#define XB_XCNT(j)  (256  + 64 * (j))
#define XB_XSUB(j)  (1280 + 64 * (j))
#define XB_XGEN(j)  (2304 + 64 * (j))
#define XB_TOP      3328
#define XB_TOPGEN   3392
#define XCD_BAR_WORDS 3456
#define XB_SPIN_CAP (1u << 18)

__device__ __forceinline__ unsigned xb_ld(unsigned* p)              { return __hip_atomic_load(p, __ATOMIC_RELAXED, __HIP_MEMORY_SCOPE_AGENT); }
__device__ __forceinline__ unsigned xb_add(unsigned* p, unsigned v) { return __hip_atomic_fetch_add(p, v, __ATOMIC_RELAXED, __HIP_MEMORY_SCOPE_AGENT); }
__device__ __forceinline__ unsigned xb_xcc_id() { return (unsigned)__builtin_amdgcn_s_getreg((3 << 11) | 20) & 0xFu; }
#define XB_SPIN(cond, bar) do { unsigned _sp = 0; while (cond) { __builtin_amdgcn_s_sleep(1); \
    if ((++_sp & 255u) == 0u) { if (xb_ld(&(bar)[XB_TMO])) break; if (_sp > XB_SPIN_CAP) { atomicAdd(&(bar)[XB_TMO], 1u); break; } } } } while (0)

struct XcdBarrier {
    unsigned* bar; unsigned x;
    volatile LAS unsigned* st;
};

__device__ __forceinline__ XcdBarrier xcd_barrier_post(unsigned* bar, volatile LAS unsigned* st) {
    XcdBarrier b; b.bar = bar; b.x = xb_xcc_id(); b.st = st;
    if (threadIdx.x == 0) (void)xb_add(&bar[XB_XCNT(b.x)], 1u);
    return b;
}
__device__ __forceinline__ void xcd_barrier_complete(unsigned* bar, unsigned x, unsigned& nloc, unsigned& nx) {
    const unsigned G = gridDim.x * gridDim.y * gridDim.z;
    unsigned sum, cnt, mine, sp = 0u;
    for (;;) {
        sum = 0u; cnt = 0u; mine = 0u;
#pragma unroll
        for (unsigned j = 0; j < 16; ++j) { const unsigned c = xb_ld(&bar[XB_XCNT(j)]); sum += c; cnt += (c > 0u) ? 1u : 0u; mine = (j == x) ? c : mine; }
        if (sum == G) break;
        __builtin_amdgcn_s_sleep(1);
        if ((++sp & 255u) == 0u) { if (xb_ld(&bar[XB_TMO])) break; if (sp > XB_SPIN_CAP) { atomicAdd(&bar[XB_TMO], 1u); break; } }
    }
    nloc = mine > 0u ? mine : 1u; nx = cnt > 0u ? cnt : 1u;
}

__device__ __forceinline__ void xcd_barrier(const XcdBarrier& b, const bool t0) {
    asm volatile("s_waitcnt vmcnt(0)" ::: "memory");
    __syncthreads();
    if (t0) {
        unsigned* bar = b.bar;
        __builtin_amdgcn_s_waitcnt(0);
        unsigned nloc = b.st[0], nx = b.st[1];
        if (nloc == 0u) { xcd_barrier_complete(bar, b.x, nloc, nx); b.st[0] = nloc; b.st[1] = nx; }
        const unsigned old = xb_add(&bar[XB_XSUB(b.x)], 1u);
        const unsigned gen = old / nloc;
        if (old + 1u == (gen + 1u) * nloc) {
            __builtin_amdgcn_fence(__ATOMIC_RELEASE, "agent");
            asm volatile("s_waitcnt vmcnt(0)" ::: "memory");
            const unsigned og = xb_add(&bar[XB_TOP], 1u);
            const unsigned tg = og / nx;
            if (og + 1u == (tg + 1u) * nx) xb_add(&bar[XB_TOPGEN], 1u);
            else XB_SPIN(xb_ld(&bar[XB_TOPGEN]) == tg, bar);
            __builtin_amdgcn_fence(__ATOMIC_ACQUIRE, "agent");
            xb_add(&bar[XB_XGEN(b.x)], 1u);
            asm volatile("s_waitcnt vmcnt(0)" ::: "memory");
        } else {
            XB_SPIN(xb_ld(&bar[XB_XGEN(b.x)]) == gen, bar);
            __builtin_amdgcn_fence(__ATOMIC_ACQUIRE, "agent");
            asm volatile("s_waitcnt vmcnt(0)" ::: "memory");
        }
    }
    __syncthreads();
}

constexpr int DM = 1024, NBATCH = 8, SEQ = 4096, NTOK = NBATCH * SEQ;
constexpr int DIN = 2304, DR = 512, DSSM = 512, NH = 8, HD = 64;
constexpr int COL_K = 512, COL_V = 1024, COL_LORA = 1536, COL_U = 1792;
constexpr int NE = 32, DFF = 1024, CAP = 32768, MAXTILES = 544;
constexpr int OPS_STRIDE = 388;
constexpr int NWAVES = 8, GRID = 256, NGW = GRID * NWAVES;
constexpr size_t MiB = 1u << 20;
constexpr size_t WS_CTL = 0, CTL_ZERO_BYTES = 1 * MiB;
constexpr size_t WS_WINT = 1 * MiB, WS_LORAB = 6 * MiB, WS_WGLUT = 7 * MiB, WS_WOUTT = 8 * MiB;
constexpr size_t WS_B1G = 10 * MiB, WS_B1L = 10 * MiB + 128 * 1024, WS_RWP = 10 * MiB + 256 * 1024, WS_RSTD1 = 10 * MiB + 512 * 1024;
constexpr size_t WS_SSQ = 11 * MiB, WS_EID = 12 * MiB, WS_GATE = 12 * MiB + 512 * 1024, WS_RELPOS = 13 * MiB, WS_STOK = 14 * MiB;
constexpr size_t WS_W2T = 20 * MiB, WS_W1T = 84 * MiB, WS_XB = 212 * MiB;
constexpr size_t WS_PROJ = 276 * MiB, WS_LORAIN = 420 * MiB, WS_LORAW = 436 * MiB, WS_LORAA = 500 * MiB, WS_LORAG = 564 * MiB, WS_OPS = 628 * MiB, WS_SRS = 1016 * MiB, WS_END = 1020 * MiB;
constexpr size_t WS_YRAW = WS_LORAW, WS_YGELU = WS_LORAA, WS_YGLU = WS_LORAA + 32 * MiB, WS_MIXED = WS_OPS + 200 * MiB, WS_ACT = WS_OPS, WS_YSORT = WS_PROJ;
constexpr size_t WS_QP = WS_OPS, WS_YG = WS_OPS + 64 * MiB, WS_RKB = WS_OPS + 192 * MiB;
static_assert(WS_LORAA - WS_LORAW == (size_t)NTOK * 512 * 4 && WS_LORAG - WS_LORAA == (size_t)NTOK * 512 * 4, "lora buffers contiguous");
static_assert(WS_OPS + (size_t)64 * 4096 * OPS_STRIDE * 4 <= WS_SRS, "ops fits");
constexpr int CW_TMO = 0, CW_BAR = 4096, CW_GCOUNT = 16384;
constexpr int LDS_BYTES = 163840, TAB_OFF = 131072, MISC_OFF = 159744;
constexpr int TAB_SRC = TAB_OFF, TAB_VAL = TAB_OFF + MAXTILES * 4, TAB_E = TAB_OFF + 2 * MAXTILES * 4, TAB_BASE = TAB_OFF + 3 * MAXTILES * 4;

struct Params { const float* in[34]; float* out; unsigned char* ws; };
enum { I_X = 0, I_N1G, I_WIN, I_MU, I_W0, I_WUP, I_A0, I_AUP, I_GUP, I_KK, I_KA, I_RK, I_LNW, I_LNB, I_LRE, I_LIM, I_LSTEP, I_BRE, I_BIM, I_CRE, I_CIM, I_DSKIP, I_WGLU, I_BGLU, I_BETA, I_WOUT, I_N2G, I_RW, I_RB, I_W1, I_B1, I_W2, I_B2, I_FG };

using pg8::Unit; using pg8::HALF; using pg8::BM;
struct EpiProj {
    static constexpr bool PERM = true;
    bf16_t* O; int ldc; const float* rs;
    __device__ __forceinline__ void operator()(const f32x4 (&acc)[2][2][4][2], const Unit& u, int wr, int wc, int fr, int fq) const {
        const int row0 = u.pm * BM + wr * 64 + fr, col0 = u.pn * BM + wc * 32 + 8 * fq;
#pragma unroll
        for (int ai = 0; ai < 2; ++ai)
#pragma unroll
            for (int m = 0; m < 4; ++m) { const int row = row0 + ai * HALF + m * 16; const float s = rs[row]; bf16_t* rowp = O + (size_t)row * ldc + col0;
#pragma unroll
                for (int bj = 0; bj < 2; ++bj) { const f32x4 v0 = acc[ai][bj][m][0] * s, v1 = acc[ai][bj][m][1] * s;
                    u32x4 w; w.x = cvt_pk_bf16(v0[0], v0[1]); w.y = cvt_pk_bf16(v0[2], v0[3]); w.z = cvt_pk_bf16(v1[0], v1[1]); w.w = cvt_pk_bf16(v1[2], v1[3]);
                    *(u32x4*)(rowp + bj * HALF) = w; } }
    }
};
struct EpiLora {
    static constexpr bool PERM = false;
    float* bw; float* ba; float* bg;
    __device__ __forceinline__ void operator()(const f32x4 (&acc)[2][2][4][2], const Unit& u, int wr, int wc, int fr, int fq) const {
        const int kind = u.pn >> 1; const int row0 = u.pm * BM + wr * 64 + fr, cc0 = (u.pn & 1) * 256 + wc * 32 + 4 * fq;
        float* base = bw + (size_t)kind * ((size_t)NTOK * 512);
#pragma unroll
        for (int ai = 0; ai < 2; ++ai)
#pragma unroll
            for (int m = 0; m < 4; ++m) { float* rowp = base + (size_t)(row0 + ai * HALF + m * 16) * 512 + cc0;
#pragma unroll
                for (int bj = 0; bj < 2; ++bj)
#pragma unroll
                    for (int n = 0; n < 2; ++n) *(f32x4*)(rowp + bj * HALF + n * 16) = acc[ai][bj][m][n]; }
    }
};
struct EpiGlu {
    static constexpr bool PERM = true;
    const bf16_t* Y; bf16_t* O; const float* bias; float* ssq;
    __device__ __forceinline__ void operator()(const f32x4 (&acc)[2][2][4][2], const Unit& u, int wr, int wc, int fr, int fq) const {
        const int row0 = u.pm * BM + wr * 64 + fr, col0 = u.pn * BM + wc * 32 + 8 * fq;
        f32x4 bv[2][2];
#pragma unroll
        for (int bj = 0; bj < 2; ++bj)
#pragma unroll
            for (int n = 0; n < 2; ++n) bv[bj][n] = *(const f32x4*)(bias + col0 + bj * HALF + 4 * n);
#pragma unroll
        for (int ai = 0; ai < 2; ++ai)
#pragma unroll
            for (int m = 0; m < 4; ++m) { const int row = row0 + ai * HALF + m * 16; float sq = 0.f;
#pragma unroll
                for (int bj = 0; bj < 2; ++bj) { const size_t off = (size_t)row * 512 + col0 + bj * HALF; const u32x4 yv = *(const u32x4*)(Y + off);
                    const f32x4 z0 = acc[ai][bj][m][0] + bv[bj][0], z1 = acc[ai][bj][m][1] + bv[bj][1];
                    float o[8]; o[0] = bflo(yv.x) * sigmoidf_(z0[0]); o[1] = bfhi(yv.x) * sigmoidf_(z0[1]); o[2] = bflo(yv.y) * sigmoidf_(z0[2]); o[3] = bfhi(yv.y) * sigmoidf_(z0[3]);
                    o[4] = bflo(yv.z) * sigmoidf_(z1[0]); o[5] = bfhi(yv.z) * sigmoidf_(z1[1]); o[6] = bflo(yv.w) * sigmoidf_(z1[2]); o[7] = bfhi(yv.w) * sigmoidf_(z1[3]);
#pragma unroll
                    for (int j = 0; j < 8; ++j) sq += o[j] * o[j];
                    u32x4 w; w.x = cvt_pk_bf16(o[0], o[1]); w.y = cvt_pk_bf16(o[2], o[3]); w.z = cvt_pk_bf16(o[4], o[5]); w.w = cvt_pk_bf16(o[6], o[7]);
                    *(u32x4*)(O + off) = w; }
                sq += __shfl_xor(sq, 16); sq += __shfl_xor(sq, 32);
                if (fq == 0) ssq[(size_t)row * 8 + u.pn * 4 + wc] = sq; }
    }
};
struct EpiOut {
    static constexpr bool PERM = false;
    const float* X; float* X1; bf16_t* X1B;
    __device__ __forceinline__ void operator()(const f32x4 (&acc)[2][2][4][2], const Unit& u, int wr, int wc, int fr, int fq) const {
        const int row0 = u.pm * BM + wr * 64 + fr, col0 = u.pn * BM + wc * 32 + 4 * fq;
#pragma unroll
        for (int ai = 0; ai < 2; ++ai)
#pragma unroll
            for (int m = 0; m < 4; ++m) { const size_t off = (size_t)(row0 + ai * HALF + m * 16) * DM + col0;
#pragma unroll
                for (int bj = 0; bj < 2; ++bj)
#pragma unroll
                    for (int n = 0; n < 2; ++n) { const size_t o2 = off + bj * HALF + n * 16; const f32x4 v = *(const f32x4*)(X + o2) + acc[ai][bj][m][n];
                        *(f32x4*)(X1 + o2) = v; u32x2 w; w.x = cvt_pk_bf16(v[0], v[1]); w.y = cvt_pk_bf16(v[2], v[3]); *(u32x2*)(X1B + o2) = w; } }
    }
};
struct EpiSwiglu {
    static constexpr bool PERM = true;
    bf16_t* O; const float* b1g; const float* b1l; const float* srs; const LAS int* tsrc; const LAS int* tval;
    __device__ __forceinline__ void operator()(const f32x4 (&acc)[2][2][4][2], const Unit& u, int wr, int wc, int fr, int fq) const {
        const int e = u.pn >> 3, pnl = u.pn & 7; const int r0 = wr * 64 + fr, o0 = pnl * 128 + wc * 32 + 8 * fq;
        const int src = tsrc[u.pm], nval = tval[u.pm];
        f32x4 bg[2], bl[2];
#pragma unroll
        for (int n = 0; n < 2; ++n) { bg[n] = *(const f32x4*)(b1g + e * DFF + o0 + 4 * n); bl[n] = *(const f32x4*)(b1l + e * DFF + o0 + 4 * n); }
#pragma unroll
        for (int ai = 0; ai < 2; ++ai)
#pragma unroll
            for (int m = 0; m < 4; ++m) { const int r = r0 + ai * HALF + m * 16; const float s = r < nval ? srs[src + r] : 0.f;
                float o[8];
#pragma unroll
                for (int n = 0; n < 2; ++n)
#pragma unroll
                    for (int j = 0; j < 4; ++j) { const float gl = fminf(acc[ai][0][m][n][j] * s + bg[n][j], 7.0f); const float li = fminf(fmaxf(acc[ai][1][m][n][j] * s + bl[n][j], -7.0f), 7.0f);
                        o[4 * n + j] = gl * sigmoidf_(1.702f * gl) * (li + 1.0f); }
                u32x4 w; w.x = cvt_pk_bf16(o[0], o[1]); w.y = cvt_pk_bf16(o[2], o[3]); w.z = cvt_pk_bf16(o[4], o[5]); w.w = cvt_pk_bf16(o[6], o[7]);
                *(u32x4*)(O + (size_t)(u.pm * BM + r) * DFF + o0) = w; }
    }
};
struct EpiMoe2 {
    static constexpr bool PERM = true;
    bf16_t* O; const float* b2;
    __device__ __forceinline__ void operator()(const f32x4 (&acc)[2][2][4][2], const Unit& u, int wr, int wc, int fr, int fq) const {
        const int e = u.pn >> 2, pnl = u.pn & 3; const int row0 = u.pm * BM + wr * 64 + fr, col0 = pnl * BM + wc * 32 + 8 * fq;
        f32x4 bv[2][2];
#pragma unroll
        for (int bj = 0; bj < 2; ++bj)
#pragma unroll
            for (int n = 0; n < 2; ++n) bv[bj][n] = *(const f32x4*)(b2 + e * DM + col0 + bj * HALF + 4 * n);
#pragma unroll
        for (int ai = 0; ai < 2; ++ai)
#pragma unroll
            for (int m = 0; m < 4; ++m) { bf16_t* rowp = O + (size_t)(row0 + ai * HALF + m * 16) * DM + col0;
#pragma unroll
                for (int bj = 0; bj < 2; ++bj) { const f32x4 v0 = acc[ai][bj][m][0] + bv[bj][0], v1 = acc[ai][bj][m][1] + bv[bj][1];
                    u32x4 w; w.x = cvt_pk_bf16(v0[0], v0[1]); w.y = cvt_pk_bf16(v0[2], v0[3]); w.z = cvt_pk_bf16(v1[0], v1[1]); w.w = cvt_pk_bf16(v1[2], v1[3]);
                    *(u32x4*)(rowp + bj * HALF) = w; } }
    }
};
struct MoeOrder {
    int G, c, NT, ntiles; const LAS int* tsrc; const LAS int* tval; const LAS int* te; const int* stok;
    __device__ __forceinline__ bool next(int i, Unit& u) const {
        const int L = i * G + c, xcd = L & 7, j = L >> 3; const int mt = (j / NT) * 8 + xcd; if (mt >= ntiles) return false;
        u.pm = mt; u.pn = te[mt] * NT + (j % NT); return true; }
    __device__ __forceinline__ int arow(const Unit& u, int r) const { return r < tval[u.pm] ? stok[tsrc[u.pm] + r] : 0; }
};
struct KsOne { __device__ __forceinline__ float operator()(int) const { return 1.f; } };
struct KsVec { const float* g; __device__ __forceinline__ float operator()(int k) const { return g[k]; } };
struct KsOut { const float* beta; __device__ __forceinline__ float operator()(int k) const { return k < DR ? 1.f : beta[k - DR]; } };
struct RmId { int off; __device__ __forceinline__ int operator()(int c) const { return off + c; } };
struct RmW1 { int e; __device__ __forceinline__ int operator()(int c) const { const int o = c >> 1, bj = c & 1; return e * 2048 + (o >> 7) * 256 + bj * 128 + (o & 127); } };
template <class KS, class RM>
__device__ __forceinline__ void tr_item(const float* src, int N, int k0, int c0, bf16_t* dst, int ldk, const KS ks, const RM rm, LAS float* scr, int lane) {
#pragma unroll 4
    for (int it = 0; it < 16; ++it) { const int r = it * 4 + (lane >> 4); const f32x4 v = *(const f32x4*)(src + (size_t)(k0 + r) * N + c0 + 4 * (lane & 15)); const float s = ks(k0 + r);
        LAS float* d = scr + r * 65 + 4 * (lane & 15); d[0] = v[0] * s; d[1] = v[1] * s; d[2] = v[2] * s; d[3] = v[3] * s; }
    LDS_WAIT();
    const int c = lane & 7;
#pragma unroll
    for (int jj = 0; jj < 8; ++jj) { const int n = (lane >> 3) + 8 * jj; const LAS float* s = scr + (8 * c) * 65 + n;
        u32x4 o; o.x = cvt_pk_bf16(s[0 * 65], s[1 * 65]); o.y = cvt_pk_bf16(s[2 * 65], s[3 * 65]); o.z = cvt_pk_bf16(s[4 * 65], s[5 * 65]); o.w = cvt_pk_bf16(s[6 * 65], s[7 * 65]);
        *(u32x4*)(dst + (size_t)rm(c0 + n) * ldk + k0 + 8 * c) = o; }
    LDS_WAIT();
}
__device__ __forceinline__ void p0_prologue(const Params& p, LAS unsigned char* lds, int wave, int lane) {
    unsigned char* ws = p.ws;
    LAS float* scr = (LAS float*)(lds + wave * 16640);
    const int gw = blockIdx.x * NWAVES + wave;
    bf16_t* W1T = (bf16_t*)(ws + WS_W1T); bf16_t* W2T = (bf16_t*)(ws + WS_W2T); bf16_t* WinT = (bf16_t*)(ws + WS_WINT); bf16_t* WoutT = (bf16_t*)(ws + WS_WOUTT); bf16_t* WgluT = (bf16_t*)(ws + WS_WGLUT);
    constexpr int I_1 = NE * 16 * 32, I_2 = NE * 16 * 16, I_IN = 16 * 36, I_OUT = 16 * 16, I_GLU = 8 * 8, NITEMS = I_1 + I_2 + I_IN + I_OUT + I_GLU;
    for (int it = gw; it < NITEMS; it += NGW) {
        int r = it;
        if (r < I_1) { const int e = r >> 9, q = r & 511, kb = q >> 5, nb = q & 31; tr_item(p.in[I_W1] + (size_t)e * DM * 2048, 2048, kb * 64, nb * 64, W1T, DM, KsVec{p.in[I_N2G]}, RmW1{e}, scr, lane); continue; } r -= I_1;
        if (r < I_2) { const int e = r >> 8, q = r & 255, kb = q >> 4, nb = q & 15; tr_item(p.in[I_W2] + (size_t)e * DFF * DM, DM, kb * 64, nb * 64, W2T, DFF, KsOne{}, RmId{e * DM}, scr, lane); continue; } r -= I_2;
        if (r < I_IN) { const int kb = r / 36, nb = r % 36; tr_item(p.in[I_WIN], DIN, kb * 64, nb * 64, WinT, DM, KsVec{p.in[I_N1G]}, RmId{0}, scr, lane); continue; } r -= I_IN;
        if (r < I_OUT) { const int kb = r >> 4, nb = r & 15; tr_item(p.in[I_WOUT], DM, kb * 64, nb * 64, WoutT, DM, KsOut{p.in[I_BETA]}, RmId{0}, scr, lane); continue; } r -= I_OUT;
        { const int kb = r >> 3, nb = r & 7; tr_item(p.in[I_WGLU], DSSM, kb * 64, nb * 64, WgluT, DSSM, KsOne{}, RmId{0}, scr, lane); }
    }
    { const float* x = p.in[I_X]; bf16_t* xb = (bf16_t*)(ws + WS_XB); float* rs = (float*)(ws + WS_RSTD1);
      for (int m = gw; m < NTOK; m += NGW) { const f32x4* xr = (const f32x4*)(x + (size_t)m * DM) + lane; f32x4 v[4]; float s = 0.f;
#pragma unroll
          for (int j = 0; j < 4; ++j) { v[j] = xr[64 * j]; s += (v[j][0] * v[j][0] + v[j][1] * v[j][1]) + (v[j][2] * v[j][2] + v[j][3] * v[j][3]); }
          s = wave_sum(s); if (lane == 0) rs[m] = 1.0f / sqrtf(s * (1.0f / DM) + 1e-5f);
          u32x2* o8 = (u32x2*)(xb + (size_t)m * DM) + lane;
#pragma unroll
          for (int j = 0; j < 4; ++j) { u32x2 w; w.x = cvt_pk_bf16(v[j][0], v[j][1]); w.y = cvt_pk_bf16(v[j][2], v[j][3]); o8[64 * j] = w; } } }
    const int gt = blockIdx.x * (NWAVES * 64) + wave * 64 + lane, NT_ = GRID * NWAVES * 64;
    { float* b1g = (float*)(ws + WS_B1G); float* b1l = (float*)(ws + WS_B1L); const float* b1 = p.in[I_B1];
      for (int i = gt; i < NE * DFF; i += NT_) { const int e = i >> 10, o = i & 1023; b1g[i] = b1[e * 2048 + 2 * o]; b1l[i] = b1[e * 2048 + 2 * o + 1]; } }
    { float* rwp = (float*)(ws + WS_RWP); const float* rw = p.in[I_RW]; const float* g2 = p.in[I_N2G];
      for (int i = gt; i < DM * NE; i += NT_) rwp[i] = g2[i >> 5] * rw[i]; }
    { bf16_t* LB = (bf16_t*)(ws + WS_LORAB); const float* wup = p.in[I_WUP]; const float* aup = p.in[I_AUP]; const float* gup = p.in[I_GUP];
      for (int i = gt; i < 1536 * 256; i += NT_) { const int n = i >> 8, k = i & 255; float v = 0.f;
          if (n < 512) { if (k < 64) v = wup[k * 512 + n]; } else if (n < 1024) { if (k >= 64 && k < 128) v = aup[(k - 64) * 512 + (n - 512)]; } else { if (k >= 128) v = gup[(k - 128) * 512 + (n - 1024)]; }
          LB[i] = f2bf(v); } }
}
__device__ __forceinline__ void p2_lora_in(const Params& p, int wave, int lane) {
    const bf16_t* proj = (const bf16_t*)(p.ws + WS_PROJ); bf16_t* li = (bf16_t*)(p.ws + WS_LORAIN); const float* mu = p.in[I_MU] + COL_LORA;
    const int gt = blockIdx.x * (NWAVES * 64) + wave * 64 + lane, NT_ = GRID * NWAVES * 64;
    for (int idx = gt; idx < NTOK * 32; idx += NT_) { const int tok = idx >> 5, c = (idx & 31) * 8;
        const bf16_t* pr = proj + (size_t)tok * DIN + COL_LORA + c; const u32x4 cur = *(const u32x4*)pr; u32x4 prv = (u32x4){0u, 0u, 0u, 0u}; if (tok & (SEQ - 1)) prv = *(const u32x4*)(pr - DIN);
        float v[8], q[8];
        v[0] = bflo(cur.x); v[1] = bfhi(cur.x); v[2] = bflo(cur.y); v[3] = bfhi(cur.y); v[4] = bflo(cur.z); v[5] = bfhi(cur.z); v[6] = bflo(cur.w); v[7] = bfhi(cur.w);
        q[0] = bflo(prv.x); q[1] = bfhi(prv.x); q[2] = bflo(prv.y); q[3] = bfhi(prv.y); q[4] = bflo(prv.z); q[5] = bfhi(prv.z); q[6] = bflo(prv.w); q[7] = bfhi(prv.w);
#pragma unroll
        for (int j = 0; j < 8; ++j) { float s = v[j] + mu[c + j] * (q[j] - v[j]); if (c < 64) s = tanhf(s); else if (c >= 128) s = sigmoidf_(s); v[j] = s; }
        u32x4 w; w.x = cvt_pk_bf16(v[0], v[1]); w.y = cvt_pk_bf16(v[2], v[3]); w.z = cvt_pk_bf16(v[4], v[5]); w.w = cvt_pk_bf16(v[6], v[7]);
        *(u32x4*)(li + (size_t)tok * 256 + c) = w; }
}
template <int CTRL> __device__ __forceinline__ float dpp_mov(float x) { return __int_as_float(__builtin_amdgcn_update_dpp(0, __float_as_int(x), CTRL, 0xF, 0xF, true)); }
__device__ __forceinline__ float sum8(float x) { x += dpp_mov<0xB1>(x); x += dpp_mov<0x4E>(x); x += dpp_mov<0x141>(x); return x; }
__device__ __forceinline__ float rowsum16(float x) { x = sum8(x); x += dpp_mov<0x140>(x); return x; }
__device__ __forceinline__ void unpack8(const u32x4 w, float (&f)[8]) { f[0] = bflo(w.x); f[1] = bfhi(w.x); f[2] = bflo(w.y); f[3] = bfhi(w.y); f[4] = bflo(w.z); f[5] = bfhi(w.z); f[6] = bflo(w.w); f[7] = bfhi(w.w); }
__device__ __forceinline__ void ld8(const float* p_, float (&f)[8]) { const f32x4 a = *(const f32x4*)p_, b = *(const f32x4*)(p_ + 4); f[0] = a[0]; f[1] = a[1]; f[2] = a[2]; f[3] = a[3]; f[4] = b[0]; f[5] = b[1]; f[6] = b[2]; f[7] = b[3]; }
__device__ __forceinline__ float gelu_tanh(float y) { const float t = 0.7978845608028654f * (y + 0.044715f * y * y * y); const float th = 1.0f - 2.0f / (1.0f + __expf(2.0f * t)); return 0.5f * y * (1.0f + th); }
constexpr int S5_T = 32, S5_NT = SEQ / S5_T, S5_BU = S5_T * 64 * 8, S5_ST = S5_T * 272, S5_SEQB = 2 * S5_BU + 2 * S5_ST;
__device__ __forceinline__ void p5_s5(const Params& p, LAS unsigned char* lds, int wave, int lane) {
    const int sq = wave >> 2, wq = wave & 3, q = (blockIdx.x - 128) * 2 + sq, b = q >> 5, g = q & 31;
    LAS unsigned char* L = lds + sq * 51200;
    const float dt = expf(p.in[I_LSTEP][g]);
    const bf16_t* ubase = (const bf16_t*)(p.ws + WS_PROJ) + (size_t)b * SEQ * DIN + COL_U + g * 16;
    bf16_t* yg = (bf16_t*)(p.ws + WS_YGELU) + (size_t)b * SEQ * DSSM + g * 16;
    f32x2 l1 = (f32x2){0.f, 0.f}, l2 = (f32x2){0.f, 0.f}, sv = (f32x2){0.f, 0.f};
    bf16x8 Bop[2], Bout[4], Dop; bf16x8 An, Un[2];
    const u32x4 z4 = (u32x4){0u, 0u, 0u, 0u};
    Bop[0] = Bop[1] = Dop = An = Un[0] = Un[1] = __builtin_bit_cast(bf16x8, z4);
#pragma unroll
    for (int ks = 0; ks < 4; ++ks) Bout[ks] = __builtin_bit_cast(bf16x8, z4);
    if (wq == 0) { const float lre = fminf(p.in[I_LRE][g * 64 + lane], -1e-4f), lim = p.in[I_LIM][g * 64 + lane]; const float mag = expf(lre * dt), ang = lim * dt; const float lbr = mag * cosf(ang), lbi = mag * sinf(ang);
        l1 = (f32x2){lbr, lbr}; l2 = (f32x2){-lbi, lbi}; }
    else if (wq < 3) {
#pragma unroll
        for (int ct2 = 0; ct2 < 2; ++ct2) { const int c = 32 * (2 * (wq - 1) + ct2) + (lane & 31), pp = c & 63, isim = c >> 6; const float lre = fminf(p.in[I_LRE][g * 64 + pp], -1e-4f), lim = p.in[I_LIM][g * 64 + pp];
            const float mag = expf(lre * dt), ang = lim * dt, cr = mag * cosf(ang), ci = mag * sinf(ang), den = lre * lre + lim * lim, nre = cr - 1.0f;
            const float zre = (nre * lre + ci * lim) / den, zim = (ci * lre - nre * lim) / den;
            const float* bre = p.in[I_BRE] + (size_t)(g * 64 + pp) * 16 + 8 * (lane >> 5); const float* bim = p.in[I_BIM] + (size_t)(g * 64 + pp) * 16 + 8 * (lane >> 5);
            float t[8];
#pragma unroll
            for (int jj = 0; jj < 8; ++jj) t[jj] = isim ? (zre * bim[jj] + zim * bre[jj]) : (zre * bre[jj] - zim * bim[jj]);
            u32x4 w; w.x = cvt_pk_bf16(t[0], t[1]); w.y = cvt_pk_bf16(t[2], t[3]); w.z = cvt_pk_bf16(t[4], t[5]); w.w = cvt_pk_bf16(t[6], t[7]); Bop[ct2] = __builtin_bit_cast(bf16x8, w); }
        An = *(const bf16x8*)(ubase + (size_t)(lane & 31) * DIN + 8 * (lane >> 5)); }
    else { const int m = lane & 15;
#pragma unroll
        for (int ks = 0; ks < 4; ++ks) { float t[8];
#pragma unroll
            for (int jj = 0; jj < 8; ++jj) { const int k = 32 * ks + 8 * (lane >> 4) + jj, pp = k >> 1; t[jj] = (k & 1) ? -p.in[I_CIM][(size_t)(g * 16 + m) * 64 + pp] : p.in[I_CRE][(size_t)(g * 16 + m) * 64 + pp]; }
            u32x4 w; w.x = cvt_pk_bf16(t[0], t[1]); w.y = cvt_pk_bf16(t[2], t[3]); w.z = cvt_pk_bf16(t[4], t[5]); w.w = cvt_pk_bf16(t[6], t[7]); Bout[ks] = __builtin_bit_cast(bf16x8, w); }
        { const float dsk = p.in[I_DSKIP][g * 16 + m]; float t[8];
#pragma unroll
          for (int jj = 0; jj < 8; ++jj) t[jj] = (8 * (lane >> 4) + jj == m) ? dsk : 0.f;
          u32x4 w; w.x = cvt_pk_bf16(t[0], t[1]); w.y = cvt_pk_bf16(t[2], t[3]); w.z = cvt_pk_bf16(t[4], t[5]); w.w = cvt_pk_bf16(t[6], t[7]); Dop = __builtin_bit_cast(bf16x8, w); }
        if (lane < 32) { Un[0] = *(const bf16x8*)(ubase + (size_t)(lane & 15) * DIN + 8 * (lane >> 4)); Un[1] = *(const bf16x8*)(ubase + (size_t)(16 + (lane & 15)) * DIN + 8 * (lane >> 4)); } }
    const f32x16 z16 = {0.f, 0.f, 0.f, 0.f, 0.f, 0.f, 0.f, 0.f, 0.f, 0.f, 0.f, 0.f, 0.f, 0.f, 0.f, 0.f};
#define S5_STAGE1(tileidx) do { LAS float* bu_ = (LAS float*)(L + ((tileidx) & 1) * S5_BU); \
        _Pragma("unroll") for (int ct2 = 0; ct2 < 2; ++ct2) { const f32x16 d = __builtin_amdgcn_mfma_f32_32x32x16_bf16(An, Bop[ct2], z16, 0, 0, 0); const int c = 32 * (2 * (wq - 1) + ct2) + (lane & 31), pp = c & 63, isim = c >> 6; \
            _Pragma("unroll") for (int r = 0; r < 16; ++r) { const int rw = (r & 3) + 8 * (r >> 2) + 4 * (lane >> 5); bu_[(rw * 64 + pp) * 2 + isim] = d[r]; } } \
        if ((tileidx) + 1 < S5_NT) An = *(const bf16x8*)(ubase + (size_t)(((tileidx) + 1) * S5_T + (lane & 31)) * DIN + 8 * (lane >> 5)); } while (0)
#define S5_STAGE3(tileidx) do { const LAS unsigned char* st_ = L + 2 * S5_BU + ((tileidx) & 1) * S5_ST; const bf16x8 u0 = Un[0], u1 = Un[1]; \
        if ((tileidx) + 1 < S5_NT && lane < 32) { Un[0] = *(const bf16x8*)(ubase + (size_t)(((tileidx) + 1) * S5_T + (lane & 15)) * DIN + 8 * (lane >> 4)); Un[1] = *(const bf16x8*)(ubase + (size_t)(((tileidx) + 1) * S5_T + 16 + (lane & 15)) * DIN + 8 * (lane >> 4)); } \
        _Pragma("unroll") for (int rt = 0; rt < 2; ++rt) { f32x4 acc = __builtin_amdgcn_mfma_f32_16x16x32_bf16(rt ? u1 : u0, Dop, (f32x4){0.f, 0.f, 0.f, 0.f}, 0, 0, 0); \
            _Pragma("unroll") for (int ks = 0; ks < 4; ++ks) { const bf16x8 a = *(const LAS bf16x8*)(st_ + (16 * rt + (lane & 15)) * 272 + (32 * ks + 8 * (lane >> 4)) * 2); acc = __builtin_amdgcn_mfma_f32_16x16x32_bf16(a, Bout[ks], acc, 0, 0, 0); } \
            _Pragma("unroll") for (int r = 0; r < 4; ++r) { const int tok = (tileidx) * S5_T + 16 * rt + 4 * (lane >> 4) + r; yg[(size_t)tok * DSSM + (lane & 15)] = f2bf(gelu_tanh(acc[r])); } } } while (0)
    if (wq == 1 || wq == 2) S5_STAGE1(0);
    __syncthreads();
    for (int i = 0; i < S5_NT; ++i) {
        if (wq == 0) { const LAS float* bu_ = (const LAS float*)(L + (i & 1) * S5_BU); LAS unsigned char* st_ = L + 2 * S5_BU + (i & 1) * S5_ST;
            f32x2 x[S5_T];
#pragma unroll
            for (int t = 0; t < S5_T; ++t) x[t] = *(const LAS f32x2*)(bu_ + (t * 64 + lane) * 2);
#pragma unroll
            for (int t = 0; t < S5_T; ++t) { const f32x2 t1 = l1 * sv + x[t]; const f32x2 sw = __builtin_shufflevector(sv, sv, 1, 0); sv = l2 * sw + t1; *(LAS unsigned*)(st_ + t * 272 + lane * 4) = cvt_pk_bf16(sv.x, sv.y); } }
        else if (wq < 3) { if (i + 1 < S5_NT) S5_STAGE1(i + 1); }
        else { if (i >= 1) S5_STAGE3(i - 1); }
        __syncthreads();
    }
    if (wq == 3) S5_STAGE3(S5_NT - 1);
#undef S5_STAGE1
#undef S5_STAGE3
}
struct P7In { f32x4 y0, y1, g0, g1, s0, s1; float rk; u32x4 yg, cv, qv; };
__device__ __forceinline__ void p7_load(P7In& in, const float* yraw, const bf16_t* proj, const float* rkb, const float* lg, const bf16_t* yglu, const float* ssq, int tok, int lane) {
    const int c0 = lane * 8, h = lane >> 3;
    const float* py = yraw + (size_t)tok * DR + c0; in.y0 = *(const f32x4*)py; in.y1 = *(const f32x4*)(py + 4);
    { const bf16_t* pv = proj + (size_t)tok * DIN + COL_V + c0; in.cv = *(const u32x4*)pv; in.qv = (tok & (SEQ - 1)) ? *(const u32x4*)(pv - DIN) : (u32x4){0u, 0u, 0u, 0u}; in.rk = rkb[(size_t)tok * NH + h]; }
    const float* pg = lg + (size_t)tok * DR + c0; in.g0 = *(const f32x4*)pg; in.g1 = *(const f32x4*)(pg + 4);
    in.s0 = *(const f32x4*)(ssq + (size_t)tok * 8); in.s1 = *(const f32x4*)(ssq + (size_t)tok * 8 + 4);
    in.yg = *(const u32x4*)(yglu + (size_t)tok * DSSM + c0);
}
__device__ __forceinline__ void p7_mix(const Params& p, int wave, int lane) {
    const float* yraw = (const float*)(p.ws + WS_YRAW); const bf16_t* proj = (const bf16_t*)(p.ws + WS_PROJ); const float* rkb = (const float*)(p.ws + WS_RKB); const float* lg = (const float*)(p.ws + WS_LORAG); bf16_t* mixed = (bf16_t*)(p.ws + WS_MIXED);
    const bf16_t* yglu = (const bf16_t*)(p.ws + WS_YGLU); const float* ssq = (const float*)(p.ws + WS_SSQ);
    const int c0 = lane * 8;
    float lnw[8], lnb[8], muv[8]; ld8(p.in[I_LNW] + c0, lnw); ld8(p.in[I_LNB] + c0, lnb); ld8(p.in[I_MU] + COL_V + c0, muv);
    const int gw = blockIdx.x * NWAVES + wave;
    P7In cur, nxt; p7_load(cur, yraw, proj, rkb, lg, yglu, ssq, gw, lane);
    for (int tok = gw; tok < NTOK; tok += NGW) {
        if (tok + NGW < NTOK) p7_load(nxt, yraw, proj, rkb, lg, yglu, ssq, tok + NGW, lane);
        float y[8], v[8], g[8], o[8], cvv[8], qvv[8]; unpack8(cur.cv, cvv); unpack8(cur.qv, qvv);
#pragma unroll
        for (int j = 0; j < 4; ++j) { y[j] = cur.y0[j]; y[j + 4] = cur.y1[j]; g[j] = cur.g0[j]; g[j + 4] = cur.g1[j]; }
#pragma unroll
        for (int j = 0; j < 8; ++j) v[j] = cvv[j] + muv[j] * (qvv[j] - cvv[j]);
        float sm = 0.f;
#pragma unroll
        for (int j = 0; j < 8; ++j) sm += y[j];
        const float mu = sum8(sm) * (1.0f / 64.0f); float sq = 0.f;
#pragma unroll
        for (int j = 0; j < 8; ++j) { y[j] -= mu; sq += y[j] * y[j]; }
        const float rstd = 1.0f / sqrtf(sum8(sq) * (1.0f / 64.0f) + 64e-5f);
#pragma unroll
        for (int j = 0; j < 8; ++j) { o[j] = (y[j] * rstd * lnw[j] + lnb[j] + cur.rk * v[j]) * g[j];
#ifdef SCRUB7
            o[j] = (o[j] == o[j] && fabsf(o[j]) < 1e30f) ? o[j] : 0.f;
#endif
        }
        u32x4 w; w.x = cvt_pk_bf16(o[0], o[1]); w.y = cvt_pk_bf16(o[2], o[3]); w.z = cvt_pk_bf16(o[4], o[5]); w.w = cvt_pk_bf16(o[6], o[7]);
        *(u32x4*)(mixed + (size_t)tok * DM + c0) = w;
        const float ss = ((cur.s0[0] + cur.s0[1]) + (cur.s0[2] + cur.s0[3])) + ((cur.s1[0] + cur.s1[1]) + (cur.s1[2] + cur.s1[3])); const float rs = 1.0f / sqrtf(ss * (1.0f / DSSM) + 1e-5f);
        float yv[8]; unpack8(cur.yg, yv);
        u32x4 w2; w2.x = cvt_pk_bf16(yv[0] * rs, yv[1] * rs); w2.y = cvt_pk_bf16(yv[2] * rs, yv[3] * rs); w2.z = cvt_pk_bf16(yv[4] * rs, yv[5] * rs); w2.w = cvt_pk_bf16(yv[6] * rs, yv[7] * rs);
        *(u32x4*)(mixed + (size_t)tok * DM + DR + c0) = w2;
        cur = nxt;
    }
}
constexpr int CT = 72;
constexpr int SLOT = 64 * CT * 2;
constexpr int SL_AH = 0, SL_BH = 1, SL_KH = 2, SL_RH = 3, SL_AHT = 4, SL_BTT = 5, SL_KTT = 6, SL_VT = 7, SL_PA = 8, SL_PAT = 9, SL_TA = 10, SL_AAK = 11, SL_ARB = 12, SL_ARK = 13, SL_XT = 14, SL_UVT = 15;
constexpr int SL_PB = 0, SL_PBT = 1, SL_TB = 2, SL_WT = 11;
constexpr int LC_OFF = SL_PA * SLOT, TOT_OFF = LC_OFF + 64 * 64 * 4;
constexpr int GT_OFF = 16 * SLOT;
__device__ __forceinline__ LAS bf16_t* slot(LAS unsigned char* lds, int s) { return (LAS bf16_t*)(lds + s * SLOT); }
template <bool TR> __device__ __forceinline__ void mm2(const LAS bf16_t* X, const LAS bf16_t* YT, int mi, int ni0, int lane, f32x4 (&acc)[2]) {
    const int fr = lane & 15, fq = lane >> 4;
#pragma unroll
    for (int ks = 0; ks < 2; ++ks) { const bf16x8 a = *(const LAS bf16x8*)(X + (16 * mi + fr) * CT + 32 * ks + 8 * fq);
#pragma unroll
        for (int t = 0; t < 2; ++t) { const bf16x8 b = *(const LAS bf16x8*)(YT + (16 * (ni0 + t) + fr) * CT + 32 * ks + 8 * fq);
            acc[t] = TR ? __builtin_amdgcn_mfma_f32_16x16x32_bf16(a, b, acc[t], 0, 0, 0) : __builtin_amdgcn_mfma_f32_16x16x32_bf16(b, a, acc[t], 0, 0, 0); } }
}
__device__ __forceinline__ void st_rm(LAS bf16_t* Z, int mi, int ni, int lane, const f32x4 v) { u32x2 w; w.x = cvt_pk_bf16(v[0], v[1]); w.y = cvt_pk_bf16(v[2], v[3]); *(LAS u32x2*)(Z + (16 * mi + (lane & 15)) * CT + 16 * ni + 4 * (lane >> 4)) = w; }
__device__ __forceinline__ void st_tr(LAS bf16_t* ZT, int mi, int ni, int lane, const f32x4 v) {
#pragma unroll
    for (int r = 0; r < 4; ++r) ZT[(16 * ni + 4 * (lane >> 4) + r) * CT + 16 * mi + (lane & 15)] = f2bf(v[r]); }
__device__ __forceinline__ void st_trT(LAS bf16_t* ZT, int mi, int ni, int lane, const f32x4 v) { u32x2 w; w.x = cvt_pk_bf16(v[0], v[1]); w.y = cvt_pk_bf16(v[2], v[3]); *(LAS u32x2*)(ZT + (16 * ni + (lane & 15)) * CT + 16 * mi + 4 * (lane >> 4)) = w; }
struct PaIn { u32x4 cr, ck, cv, qr, qk, qv; f32x4 a0, a1, w0, w1; float lwr[8]; };
__device__ __forceinline__ void pa_load(PaIn& in, const bf16_t* proj, const float* la, const float* lw, int job, int wave, int lane) {
    const int bh = job >> 6, c = job & 63, b = bh >> 3, h = bh & 7; const int tok0 = b * SEQ + c * 64;
    { const int t = wave * 8 + (lane >> 3), cg = lane & 7, tok = tok0 + t; const bf16_t* row = proj + (size_t)tok * DIN + h * HD + cg * 8; const bool first = (c == 0 && t == 0); const u32x4 z = (u32x4){0u, 0u, 0u, 0u};
      in.cr = *(const u32x4*)row; in.ck = *(const u32x4*)(row + COL_K); in.cv = *(const u32x4*)(row + COL_V);
      in.qr = first ? z : *(const u32x4*)(row - DIN); in.qk = first ? z : *(const u32x4*)(row - DIN + COL_K); in.qv = first ? z : *(const u32x4*)(row - DIN + COL_V);
      const float* pa = la + (size_t)tok * DR + h * HD + cg * 8; const float* pw = lw + (size_t)tok * DR + h * HD + cg * 8;
      in.a0 = *(const f32x4*)pa; in.a1 = *(const f32x4*)(pa + 4); in.w0 = *(const f32x4*)pw; in.w1 = *(const f32x4*)(pw + 4); }
#pragma unroll
    for (int i = 0; i < 8; ++i) in.lwr[i] = lw[(size_t)(tok0 + wave * 8 + i) * DR + h * HD + lane];
}
__device__ __forceinline__ float logdecay(float x) { const float z = -x; const float sp = fmaxf(z, 0.f) + __logf(1.0f + __expf(-fabsf(z))); return -__expf(-sp - 0.5f); }
__device__ __forceinline__ void p4_chunks(const Params& p, LAS unsigned char* lds, int wave, int lane) {
    const bf16_t* proj = (const bf16_t*)(p.ws + WS_PROJ); const float* lwp = (const float*)(p.ws + WS_LORAW); const float* lap = (const float*)(p.ws + WS_LORAA);
    bf16_t* QP = (bf16_t*)(p.ws + WS_QP); float* YG = (float*)(p.ws + WS_YG); float* rkb = (float*)(p.ws + WS_RKB);
    LAS float* lct = (LAS float*)(lds + LC_OFF); LAS float* tot = (LAS float*)(lds + TOT_OFF); LAS float* gtab = (LAS float*)(lds + GT_OFF);
    const int mi = wave >> 1, ni0 = (wave & 1) * 2, fr = lane & 15, fq = lane >> 4;
    PaIn in; pa_load(in, proj, lap, lwp, blockIdx.x, wave, lane);
    for (int job = blockIdx.x; job < 64 * 64; job += GRID) {
        const int bh = job >> 6, c = job & 63, b = bh >> 3, h = bh & 7; const int tok0 = b * SEQ + c * 64;
        { const float w0k = p.in[I_W0][h * HD + lane]; float pre[8]; float run = 0.f;
#pragma unroll
          for (int i = 0; i < 8; ++i) { run += logdecay(w0k + in.lwr[i]); pre[i] = run; }
          tot[wave * 64 + lane] = run;
          __syncthreads();
          float off = 0.f;
#pragma unroll
          for (int w2 = 0; w2 < 7; ++w2) off += (w2 < wave) ? tot[w2 * 64 + lane] : 0.f;
#pragma unroll
          for (int i = 0; i < 8; ++i) lct[(wave * 8 + i) * 64 + lane] = off + pre[i]; }
        __syncthreads();
        { const int t = wave * 8 + (lane >> 3), cg = lane & 7, k0 = cg * 8, col = h * HD + k0;
          float cr[8], ck[8], cv[8], qr[8], qk[8], qv[8], lc[8], gc[8], mur[8], muk[8], muv[8], kkw[8], kaw[8], rkw[8], a0c[8], w0c[8];
          unpack8(in.cr, cr); unpack8(in.ck, ck); unpack8(in.cv, cv); unpack8(in.qr, qr); unpack8(in.qk, qk); unpack8(in.qv, qv);
          { const f32x4 x0 = *(const LAS f32x4*)(lct + t * 64 + k0), x1 = *(const LAS f32x4*)(lct + t * 64 + k0 + 4), g0 = *(const LAS f32x4*)(lct + 63 * 64 + k0), g1 = *(const LAS f32x4*)(lct + 63 * 64 + k0 + 4);
#pragma unroll
            for (int j = 0; j < 4; ++j) { lc[j] = x0[j]; lc[j + 4] = x1[j]; gc[j] = g0[j]; gc[j + 4] = g1[j]; } }
          ld8(p.in[I_MU] + col, mur); ld8(p.in[I_MU] + COL_K + col, muk); ld8(p.in[I_MU] + COL_V + col, muv); ld8(p.in[I_KK] + col, kkw); ld8(p.in[I_KA] + col, kaw); ld8(p.in[I_RK] + col, rkw); ld8(p.in[I_A0] + col, a0c); ld8(p.in[I_W0] + col, w0c);
          float ah[8], bh_[8], kh[8], rh[8], bt[8], kt[8], vv[8], kk[8]; float n2 = 0.f, rk = 0.f;
#pragma unroll
          for (int j = 0; j < 8; ++j) { const float r = cr[j] + mur[j] * (qr[j] - cr[j]), kraw = ck[j] + muk[j] * (qk[j] - ck[j]); vv[j] = cv[j] + muv[j] * (qv[j] - cv[j]);
              const float ap = j < 4 ? in.a0[j & 3] : in.a1[j & 3], wp = j < 4 ? in.w0[j & 3] : in.w1[j & 3];
              const float a = sigmoidf_(a0c[j] + ap), lw = logdecay(w0c[j] + wp);
              kk[j] = kraw * kkw[j]; n2 += kk[j] * kk[j]; const float km = kraw * (1.0f + (a - 1.0f) * kaw[j]); rk += r * km * rkw[j];
              const float e1 = __expf(lc[j]), e2 = __expf(-lc[j]), g = __expf(gc[j]);
              rh[j] = r * e1; kh[j] = km * e2; kt[j] = kh[j] * g; ah[j] = -__expf(lc[j] - lw); bh_[j] = a * e2; bt[j] = g; }
          n2 = sum8(n2); rk = sum8(rk);
#ifdef NO_INV
          const float inv = 0.125f;
#else
          const float inv = 1.0f / fmaxf(sqrtf(n2), 1e-12f);
#endif
#pragma unroll
          for (int j = 0; j < 8; ++j) { const float kn = kk[j] * inv; ah[j] *= kn; bh_[j] *= kn; bt[j] *= bh_[j]; }
          if (cg == 0) rkb[(size_t)(tok0 + t) * NH + h] = rk;
          if (t == 63) {
#pragma unroll
              for (int j = 0; j < 8; ++j) gtab[k0 + j] = __expf(gc[j]); }
          u32x4 w;
          w.x = cvt_pk_bf16(ah[0], ah[1]); w.y = cvt_pk_bf16(ah[2], ah[3]); w.z = cvt_pk_bf16(ah[4], ah[5]); w.w = cvt_pk_bf16(ah[6], ah[7]); *(LAS u32x4*)(slot(lds, SL_AH) + t * CT + k0) = w;
          w.x = cvt_pk_bf16(bh_[0], bh_[1]); w.y = cvt_pk_bf16(bh_[2], bh_[3]); w.z = cvt_pk_bf16(bh_[4], bh_[5]); w.w = cvt_pk_bf16(bh_[6], bh_[7]); *(LAS u32x4*)(slot(lds, SL_BH) + t * CT + k0) = w;
          w.x = cvt_pk_bf16(kh[0], kh[1]); w.y = cvt_pk_bf16(kh[2], kh[3]); w.z = cvt_pk_bf16(kh[4], kh[5]); w.w = cvt_pk_bf16(kh[6], kh[7]); *(LAS u32x4*)(slot(lds, SL_KH) + t * CT + k0) = w;
          w.x = cvt_pk_bf16(rh[0], rh[1]); w.y = cvt_pk_bf16(rh[2], rh[3]); w.z = cvt_pk_bf16(rh[4], rh[5]); w.w = cvt_pk_bf16(rh[6], rh[7]); *(LAS u32x4*)(slot(lds, SL_RH) + t * CT + k0) = w;
#pragma unroll
          for (int j = 0; j < 8; ++j) { slot(lds, SL_AHT)[(k0 + j) * CT + t] = f2bf(ah[j]); slot(lds, SL_BTT)[(k0 + j) * CT + t] = f2bf(bt[j]); slot(lds, SL_KTT)[(k0 + j) * CT + t] = f2bf(kt[j]); slot(lds, SL_VT)[(k0 + j) * CT + t] = f2bf(vv[j]); } }
        if (job + GRID < 64 * 64) pa_load(in, proj, lap, lwp, job + GRID, wave, lane);
        __syncthreads();
        f32x4 accT[2];
        { f32x4 acc[2];
          acc[0] = acc[1] = (f32x4){0.f, 0.f, 0.f, 0.f}; mm2<false>(slot(lds, SL_AH), slot(lds, SL_BH), mi, ni0, lane, acc);
#pragma unroll
          for (int t = 0; t < 2; ++t) { const int m = 16 * mi + fr, n = 16 * (ni0 + t) + 4 * fq;
#pragma unroll
              for (int r = 0; r < 4; ++r) acc[t][r] = (n + r < m) ? acc[t][r] : 0.f;
              st_rm(slot(lds, SL_PA), mi, ni0 + t, lane, acc[t]); st_tr(slot(lds, SL_PAT), mi, ni0 + t, lane, acc[t]);
#pragma unroll
              for (int r = 0; r < 4; ++r) accT[t][r] = acc[t][r] + ((n + r == m) ? 1.0f : 0.f);
              st_rm(slot(lds, SL_TA), mi, ni0 + t, lane, accT[t]);
#ifdef DBG_S0
              *(f32x4*)(YG + (size_t)job * 2 * 4096 + m * 64 + n) = acc[t];
#endif
              }
          acc[0] = acc[1] = (f32x4){0.f, 0.f, 0.f, 0.f}; mm2<false>(slot(lds, SL_AH), slot(lds, SL_KH), mi, ni0, lane, acc);
#pragma unroll
          for (int t = 0; t < 2; ++t) { const int m = 16 * mi + fr, n = 16 * (ni0 + t) + 4 * fq;
#pragma unroll
              for (int r = 0; r < 4; ++r) acc[t][r] = (n + r < m) ? acc[t][r] : 0.f;
              st_rm(slot(lds, SL_AAK), mi, ni0 + t, lane, acc[t]); }
          acc[0] = acc[1] = (f32x4){0.f, 0.f, 0.f, 0.f}; mm2<false>(slot(lds, SL_RH), slot(lds, SL_BH), mi, ni0, lane, acc);
#pragma unroll
          for (int t = 0; t < 2; ++t) { const int m = 16 * mi + fr, n = 16 * (ni0 + t) + 4 * fq;
#pragma unroll
              for (int r = 0; r < 4; ++r) acc[t][r] = (n + r <= m) ? acc[t][r] : 0.f;
              st_rm(slot(lds, SL_ARB), mi, ni0 + t, lane, acc[t]); }
          acc[0] = acc[1] = (f32x4){0.f, 0.f, 0.f, 0.f}; mm2<false>(slot(lds, SL_RH), slot(lds, SL_KH), mi, ni0, lane, acc);
#pragma unroll
          for (int t = 0; t < 2; ++t) { const int m = 16 * mi + fr, n = 16 * (ni0 + t) + 4 * fq;
#pragma unroll
              for (int r = 0; r < 4; ++r) acc[t][r] = (n + r <= m) ? acc[t][r] : 0.f;
              st_rm(slot(lds, SL_ARK), mi, ni0 + t, lane, acc[t]); } }
        __syncthreads();
        { f32x4 acc[2]; acc[0] = acc[1] = (f32x4){0.f, 0.f, 0.f, 0.f}; mm2<false>(slot(lds, SL_PA), slot(lds, SL_PAT), mi, ni0, lane, acc);
#pragma unroll
          for (int t = 0; t < 2; ++t) { st_rm(slot(lds, SL_PB), mi, ni0 + t, lane, acc[t]); st_tr(slot(lds, SL_PBT), mi, ni0 + t, lane, acc[t]); }
          acc[0] = acc[1] = (f32x4){0.f, 0.f, 0.f, 0.f}; mm2<true>(slot(lds, SL_AAK), slot(lds, SL_VT), mi, ni0, lane, acc);
#pragma unroll
          for (int t = 0; t < 2; ++t) st_trT(slot(lds, SL_XT), mi, ni0 + t, lane, acc[t]); }
        __syncthreads();
#pragma unroll
        for (int it = 1; it <= 5; ++it) { const bool odd = (it & 1) != 0;
            LAS bf16_t* Pr = slot(lds, odd ? SL_PB : SL_PA); LAS bf16_t* PrT = slot(lds, odd ? SL_PBT : SL_PAT); LAS bf16_t* Pw = slot(lds, odd ? SL_PA : SL_PB); LAS bf16_t* PwT = slot(lds, odd ? SL_PAT : SL_PBT);
            LAS bf16_t* Tr = slot(lds, odd ? SL_TA : SL_TB); LAS bf16_t* Tw = slot(lds, odd ? SL_TB : SL_TA);
            mm2<false>(Tr, PrT, mi, ni0, lane, accT);
#pragma unroll
            for (int t = 0; t < 2; ++t) st_rm(Tw, mi, ni0 + t, lane, accT[t]);
            if (it < 5) { f32x4 acc[2]; acc[0] = acc[1] = (f32x4){0.f, 0.f, 0.f, 0.f}; mm2<false>(Pr, PrT, mi, ni0, lane, acc);
#pragma unroll
                for (int t = 0; t < 2; ++t) { st_rm(Pw, mi, ni0 + t, lane, acc[t]); st_tr(PwT, mi, ni0 + t, lane, acc[t]); } }
            __syncthreads(); }
#ifdef DBG_EARLY
        { const int m = 16 * mi + fr;
#pragma unroll
          for (int t = 0; t < 2; ++t) { const u32x2 rr = *(const LAS u32x2*)(slot(lds, DBG_EARLY) + m * CT + 16 * (ni0 + t) + 4 * fq); *(f32x4*)(YG + (size_t)job * 2 * 4096 + m * 64 + 16 * (ni0 + t) + 4 * fq) = (f32x4){bflo(rr.x), bfhi(rr.x), bflo(rr.y), bfhi(rr.y)}; } }
#endif
#ifdef DBG_TM
        { const int m = 16 * mi + fr;
#pragma unroll
          for (int t = 0; t < 2; ++t) *(f32x4*)(YG + (size_t)job * 2 * 4096 + m * 64 + 16 * (ni0 + t) + 4 * fq) = accT[t]; }
#endif
        { f32x4 acc[2]; acc[0] = acc[1] = (f32x4){0.f, 0.f, 0.f, 0.f}; mm2<true>(slot(lds, SL_TB), slot(lds, SL_AHT), mi, ni0, lane, acc);
#pragma unroll
          for (int t = 0; t < 2; ++t) st_trT(slot(lds, SL_WT), mi, ni0 + t, lane, acc[t]);
          acc[0] = acc[1] = (f32x4){0.f, 0.f, 0.f, 0.f}; mm2<true>(slot(lds, SL_TB), slot(lds, SL_XT), mi, ni0, lane, acc);
#pragma unroll
          for (int t = 0; t < 2; ++t) st_trT(slot(lds, SL_UVT), mi, ni0 + t, lane, acc[t]); }
        __syncthreads();
        { bf16_t* qp = QP + (size_t)job * 2 * 4096; float* yg = YG + (size_t)job * 2 * 4096; const int m = 16 * mi + fr, qs = 2 * (fq & 1) + (fq >> 1);
          f32x4 acc[2];
          acc[0] = acc[1] = (f32x4){0.f, 0.f, 0.f, 0.f}; mm2<false>(slot(lds, SL_ARB), slot(lds, SL_WT), mi, ni0, lane, acc);
#pragma unroll
          for (int t = 0; t < 2; ++t) { const u32x2 rr = *(const LAS u32x2*)(slot(lds, SL_RH) + m * CT + 16 * (ni0 + t) + 4 * fq);
              u32x2 w; w.x = cvt_pk_bf16(acc[t][0] + bflo(rr.x), acc[t][1] + bfhi(rr.x)); w.y = cvt_pk_bf16(acc[t][2] + bflo(rr.y), acc[t][3] + bfhi(rr.y)); *(u32x2*)(qp + m * 64 + 16 * (ni0 + t) + 4 * qs) = w; }
          acc[0] = acc[1] = (f32x4){0.f, 0.f, 0.f, 0.f};
#if !defined(YL_V1)
#if defined(YL_V3)
          mm2<false>(slot(lds, SL_ARB), slot(lds, SL_XT), mi, ni0, lane, acc);
#elif defined(YL_V4)
          mm2<false>(slot(lds, SL_TB), slot(lds, SL_VT), mi, ni0, lane, acc);
#else
          mm2<false>(slot(lds, SL_ARB), slot(lds, SL_UVT), mi, ni0, lane, acc);
#endif
#endif
#if !defined(YL_V2)
          mm2<false>(slot(lds, SL_ARK), slot(lds, SL_VT), mi, ni0, lane, acc);
#endif

#ifdef YL_CONST
          acc[0] = acc[1] = (f32x4){1.f, 1.f, 1.f, 1.f};
#endif
#ifdef DBG_SLOT
#pragma unroll
          for (int t = 0; t < 2; ++t) { const u32x2 rr = *(const LAS u32x2*)(slot(lds, DBG_SLOT) + m * CT + 16 * (ni0 + t) + 4 * fq); acc[t] = (f32x4){bflo(rr.x), bfhi(rr.x), bflo(rr.y), bfhi(rr.y)}; }
#endif
#if !defined(DBG_S0) && !defined(DBG_TM) && !defined(DBG_EARLY)
#pragma unroll
          for (int t = 0; t < 2; ++t) *(f32x4*)(yg + m * 64 + 16 * (ni0 + t) + 4 * fq) = acc[t];
#endif
          acc[0] = acc[1] = (f32x4){0.f, 0.f, 0.f, 0.f}; mm2<false>(slot(lds, SL_BTT), slot(lds, SL_WT), mi, ni0, lane, acc);
#pragma unroll
          for (int t = 0; t < 2; ++t) { const int n = 16 * (ni0 + t) + 4 * fq; const float gm = gtab[m];
#pragma unroll
              for (int r = 0; r < 4; ++r) acc[t][r] += (n + r == m) ? gm : 0.f;
              u32x2 w; w.x = cvt_pk_bf16(acc[t][0], acc[t][1]); w.y = cvt_pk_bf16(acc[t][2], acc[t][3]); *(u32x2*)(qp + 4096 + m * 64 + 16 * (ni0 + t) + 4 * qs) = w; }
          acc[0] = acc[1] = (f32x4){0.f, 0.f, 0.f, 0.f}; mm2<false>(slot(lds, SL_BTT), slot(lds, SL_UVT), mi, ni0, lane, acc); mm2<false>(slot(lds, SL_KTT), slot(lds, SL_VT), mi, ni0, lane, acc);
#pragma unroll
          for (int t = 0; t < 2; ++t) *(f32x4*)(yg + 4096 + m * 64 + 16 * (ni0 + t) + 4 * fq) = acc[t]; }
        __syncthreads();
    }
}

constexpr int PB_BUF = 32768;
__device__ __forceinline__ void pb_dma(const bf16_t* qt, const float* yl, int jv, LAS unsigned char* dst, int wave, int lane) {
    const int rr = lane >> 3, cc = lane & 7;
#pragma unroll
    for (int q = 0; q < 2; ++q) { const int pc = wave + 8 * q;
        __builtin_amdgcn_global_load_lds((const unsigned*)((const char*)qt + pc * 1024 + rr * 128 + ((cc ^ rr) * 16)), (LAS unsigned*)(dst + pc * 1024), 16, 0, 0); }
#pragma unroll
    for (int q = 0; q < 2; ++q) { const float* base = yl + q * 4096;
        __builtin_amdgcn_global_load_lds((const unsigned*)((const char*)(base + (wave * 8 + rr) * 64 + jv * 32) + cc * 16), (LAS unsigned*)(dst + 16384 + q * 8192 + wave * 1024), 16, 0, 0); }
}
__device__ __forceinline__ void p5_seq(const Params& p, LAS unsigned char* lds, int wave, int lane) {
    const int bh = blockIdx.x >> 1, jv = blockIdx.x & 1, b = bh >> 3, h = bh & 7, r31 = lane & 31, hh = lane >> 5;
    const bf16_t* QP = (const bf16_t*)(p.ws + WS_QP) + (size_t)bh * 64 * 2 * 4096; const float* YG = (const float*)(p.ws + WS_YG) + (size_t)bh * 64 * 2 * 4096;
    float* yraw = (float*)(p.ws + WS_YRAW) + (size_t)b * SEQ * DR + h * HD + 32 * jv + r31;
    f32x16 H[2];
#pragma unroll
    for (int i = 0; i < 2; ++i)
#pragma unroll
        for (int r = 0; r < 16; ++r) H[i][r] = 0.f;
    pb_dma(QP, YG, jv, lds, wave, lane);
    VM_WAIT(); __syncthreads();
    for (int c = 0; c < 64; ++c) { const LAS unsigned char* bp = lds + (c & 1) * PB_BUF;
        if (c + 1 < 64) pb_dma(QP + (size_t)(c + 1) * 2 * 4096, YG + (size_t)(c + 1) * 2 * 4096, jv, lds + ((c + 1) & 1) * PB_BUF, wave, lane);
        if (wave == 0) {
            bf16x8 Bf[4];
#pragma unroll
            for (int i = 0; i < 2; ++i)
#pragma unroll
                for (int s2 = 0; s2 < 2; ++s2) { u32x4 w; w.x = cvt_pk_bf16(H[i][8 * s2 + 0], H[i][8 * s2 + 1]); w.y = cvt_pk_bf16(H[i][8 * s2 + 2], H[i][8 * s2 + 3]); w.z = cvt_pk_bf16(H[i][8 * s2 + 4], H[i][8 * s2 + 5]); w.w = cvt_pk_bf16(H[i][8 * s2 + 6], H[i][8 * s2 + 7]);
                    Bf[2 * i + s2] = __builtin_bit_cast(bf16x8, w); }
#pragma unroll
            for (int tt = 0; tt < 2; ++tt) { f32x16 acc; const int row = 32 * tt + r31;
#pragma unroll
                for (int r = 0; r < 16; ++r) acc[r] = *(const LAS float*)(bp + 16384 + ((32 * tt + (r & 3) + 8 * (r >> 2) + 4 * hh) * 32 + r31) * 4);
#ifndef PB_NOQ
#pragma unroll
                for (int kq = 0; kq < 4; ++kq) { const bf16x8 a = *(const LAS bf16x8*)(bp + row * 128 + (((2 * kq + hh) ^ (row & 7)) * 16)); acc = __builtin_amdgcn_mfma_f32_32x32x16_bf16(a, Bf[kq], acc, 0, 0, 0); }
#endif
#pragma unroll
                for (int r = 0; r < 16; ++r) yraw[(size_t)(c * 64 + 32 * tt + (r & 3) + 8 * (r >> 2) + 4 * hh) * DR] = acc[r]; }
            f32x16 Hn[2];
#pragma unroll
            for (int i = 0; i < 2; ++i) { const int row = 32 * i + r31;
#pragma unroll
                for (int r = 0; r < 16; ++r) Hn[i][r] = *(const LAS float*)(bp + 24576 + ((32 * i + (r & 3) + 8 * (r >> 2) + 4 * hh) * 32 + r31) * 4);
#pragma unroll
                for (int kq = 0; kq < 4; ++kq) { const bf16x8 a = *(const LAS bf16x8*)(bp + 8192 + row * 128 + (((2 * kq + hh) ^ (row & 7)) * 16)); Hn[i] = __builtin_amdgcn_mfma_f32_32x32x16_bf16(a, Bf[kq], Hn[i], 0, 0, 0); } }
#ifndef PB_NOH
            H[0] = Hn[0]; H[1] = Hn[1];
#else
            asm volatile("" :: "v"(Hn[0]), "v"(Hn[1]));
#endif
        }
        VM_WAIT(); __syncthreads();
    }
}
constexpr int RT_ROW = 36;
constexpr int RT_HIST = 147456, RT_BASE = RT_HIST + 128, RT_ETAB = RT_HIST + 256, RT_RS = RT_HIST + 256 + 2048;
__device__ __forceinline__ void p9_router(const Params& p, LAS unsigned char* lds, int wave, int lane) {
    const float* x1 = p.out; const float* rwp = (const float*)(p.ws + WS_RWP); const float* rb = p.in[I_RB];
    int* eid = (int*)(p.ws + WS_EID); float* gate = (float*)(p.ws + WS_GATE); int* relpos = (int*)(p.ws + WS_RELPOS); int* stok = (int*)(p.ws + WS_STOK); float* srs = (float*)(p.ws + WS_SRS);
    unsigned* gcount = (unsigned*)(p.ws + WS_CTL) + CW_GCOUNT;
    const int tid = wave * 64 + lane;
    LAS unsigned* hist = (LAS unsigned*)(lds + RT_HIST); LAS unsigned* base = (LAS unsigned*)(lds + RT_BASE); LAS unsigned* etab = (LAS unsigned*)(lds + RT_ETAB); LAS float* rsl = (LAS float*)(lds + RT_RS);
#pragma unroll
    for (int c = 0; c < 16; ++c) { const int i4 = tid + 512 * c, k = i4 >> 3, e4 = i4 & 7; *(LAS f32x4*)(lds + k * (RT_ROW * 4) + e4 * 16) = *(const f32x4*)(rwp + (size_t)i4 * 4); }
    if (tid < 32) hist[tid] = 0u;
    __syncthreads();
    const int e_own = lane >> 1; const float rbias = rb[e_own];
    float xn[16];
    { const float* xr = x1 + (size_t)(blockIdx.x * 128 + wave * 16) * DM;
#pragma unroll
      for (int c = 0; c < 16; ++c) xn[c] = xr[lane + 64 * c]; }
    for (int i = 0; i < 16; ++i) { const int tl = wave * 16 + i, tok = blockIdx.x * 128 + tl;
        float xv[16]; float ss = 0.f;
#pragma unroll
        for (int c = 0; c < 16; ++c) { xv[c] = xn[c]; ss += xv[c] * xv[c]; }
        if (i + 1 < 16) { const float* xr = x1 + (size_t)(tok + 1) * DM;
#pragma unroll
            for (int c = 0; c < 16; ++c) xn[c] = xr[lane + 64 * c]; }
        float pl[32];
#pragma unroll
        for (int e = 0; e < 32; ++e) pl[e] = 0.f;
#pragma unroll
        for (int c = 0; c < 16; ++c) { const LAS f32x4* wrow = (const LAS f32x4*)(lds + (lane + 64 * c) * (RT_ROW * 4));
#pragma unroll
            for (int e4 = 0; e4 < 8; ++e4) { const f32x4 w = wrow[e4]; pl[4 * e4 + 0] += xv[c] * w[0]; pl[4 * e4 + 1] += xv[c] * w[1]; pl[4 * e4 + 2] += xv[c] * w[2]; pl[4 * e4 + 3] += xv[c] * w[3]; } }
        ss = wave_sum(ss); const float rstd = 1.0f / sqrtf(ss * (1.0f / DM) + 1e-5f);
        const bool b5 = (lane & 32) != 0, b4 = (lane & 16) != 0, b3 = (lane & 8) != 0, b2 = (lane & 4) != 0, b1 = (lane & 2) != 0;
        float q16[16], q8[8], q4[4], q2[2];
#pragma unroll
        for (int k = 0; k < 16; ++k) { const float keep = b5 ? pl[k + 16] : pl[k], send = b5 ? pl[k] : pl[k + 16]; q16[k] = keep + __shfl_xor(send, 32); }
#pragma unroll
        for (int k = 0; k < 8; ++k) { const float keep = b4 ? q16[k + 8] : q16[k], send = b4 ? q16[k] : q16[k + 8]; q8[k] = keep + __shfl_xor(send, 16); }
#pragma unroll
        for (int k = 0; k < 4; ++k) { const float keep = b3 ? q8[k + 4] : q8[k], send = b3 ? q8[k] : q8[k + 4]; q4[k] = keep + __shfl_xor(send, 8); }
#pragma unroll
        for (int k = 0; k < 2; ++k) { const float keep = b2 ? q4[k + 2] : q4[k], send = b2 ? q4[k] : q4[k + 2]; q2[k] = keep + __shfl_xor(send, 4); }
        float q1; { const float keep = b1 ? q2[1] : q2[0], send = b1 ? q2[0] : q2[1]; q1 = keep + __shfl_xor(send, 2); }
        q1 += __shfl_xor(q1, 1);
        float logit = q1 * rstd + rbias; logit = (logit == logit) ? fminf(fmaxf(logit, -1.0e30f), 1.0e30f) : -1.0e30f;
        const bool even = (lane & 1) == 0;
        float cur = even ? logit : -3.0e38f; int rank = -1; float topv[4];
#pragma unroll
        for (int k = 0; k < 4; ++k) { float m = cur;
#pragma unroll
            for (int o = 32; o >= 1; o >>= 1) m = fmaxf(m, __shfl_xor(m, o));
            const unsigned long long bm = __ballot(cur == m); const int l0 = __ffsll((long long)bm) - 1;
            if (lane == l0) { rank = k; cur = -3.0e38f; }
            topv[k] = m; }
        const float sum = 1.0f + __expf(topv[1] - topv[0]) + __expf(topv[2] - topv[0]) + __expf(topv[3] - topv[0]);
        if (rank >= 0) { const unsigned lr = atomicAdd((unsigned*)&hist[e_own], 1u); eid[(size_t)tok * 4 + rank] = e_own; gate[(size_t)tok * 4 + rank] = __expf(logit - topv[0]) / sum; etab[tl * 4 + rank] = (lr << 5) | (unsigned)e_own; }
        if (lane == 0) rsl[tl] = rstd;
    }
    __syncthreads();
    if (tid < 32) { const unsigned hc = hist[tid]; base[tid] = hc ? atomicAdd(&gcount[tid], hc) : 0u; }
    __syncthreads();
    { const int tl = tid >> 2, k = tid & 3, tok = blockIdx.x * 128 + tl; const unsigned pk = etab[tid]; const int e = pk & 31; const unsigned rel = base[e] + (pk >> 5);
      relpos[(size_t)tok * 4 + k] = (int)rel; stok[(size_t)e * CAP + rel] = tok; srs[(size_t)e * CAP + rel] = rsl[tl]; }
}
__device__ __forceinline__ void moe_tables(const Params& p, LAS unsigned char* lds, const bool t0) {
    const unsigned* gcount = (const unsigned*)(p.ws + WS_CTL) + CW_GCOUNT;
    LAS int* tsrc = (LAS int*)(lds + TAB_SRC); LAS int* tval = (LAS int*)(lds + TAB_VAL); LAS int* te = (LAS int*)(lds + TAB_E); LAS int* tbase = (LAS int*)(lds + TAB_BASE);
    if (t0) { int tb = 0;
        for (int e = 0; e < NE; ++e) { const int c = (int)__hip_atomic_load(&gcount[e], __ATOMIC_RELAXED, __HIP_MEMORY_SCOPE_AGENT); const int nt = (c + 255) >> 8; tbase[e] = tb;
            for (int lt = 0; lt < nt; ++lt) { tsrc[tb + lt] = e * CAP + lt * 256; const int rem = c - lt * 256; tval[tb + lt] = rem < 256 ? rem : 256; te[tb + lt] = e; }
            tb += nt; }
        tbase[NE] = tb; }
    __syncthreads();
}
typedef int i32x4 __attribute__((ext_vector_type(4)));
struct P12Meta { i32x4 e, rp; f32x4 g; };
struct P12Rows { f32x4 x[4]; u32x2 y[4][4]; f32x4 g; };
__device__ __forceinline__ void p12_meta(P12Meta& m, const int* eid, const float* gate, const int* relpos, int tok) {
    m.e = *(const i32x4*)(eid + (size_t)tok * 4); m.g = *(const f32x4*)(gate + (size_t)tok * 4); m.rp = *(const i32x4*)(relpos + (size_t)tok * 4); }
__device__ __forceinline__ void p12_rows(P12Rows& r, const P12Meta& m, const float* x1, const bf16_t* ys, const LAS int* tbase, int tok, int lane) {
#pragma unroll
    for (int j = 0; j < 4; ++j) r.x[j] = *(const f32x4*)(x1 + (size_t)tok * DM + 4 * lane + 256 * j);
#pragma unroll
    for (int k = 0; k < 4; ++k) { const bf16_t* yr = ys + ((size_t)tbase[m.e[k]] * 256 + m.rp[k]) * DM + 4 * lane;
#pragma unroll
        for (int j = 0; j < 4; ++j) r.y[k][j] = *(const u32x2*)(yr + 256 * j); }
    r.g = m.g;
}
__device__ __forceinline__ void p12_combine(const Params& p, LAS unsigned char* lds, int wave, int lane) {
    float* x1 = p.out; const bf16_t* ys = (const bf16_t*)(p.ws + WS_YSORT); const int* eid = (const int*)(p.ws + WS_EID); const float* gate = (const float*)(p.ws + WS_GATE); const int* relpos = (const int*)(p.ws + WS_RELPOS);
    const float* fg = p.in[I_FG]; const LAS int* tbase = (const LAS int*)(lds + TAB_BASE);
    const int gw = blockIdx.x * NWAVES + wave;
    f32x4 gv[4];
#pragma unroll
    for (int j = 0; j < 4; ++j) gv[j] = *(const f32x4*)(fg + 4 * lane + 256 * j);
    P12Meta m0, m1; P12Rows rc, rn;
    p12_meta(m0, eid, gate, relpos, gw); p12_meta(m1, eid, gate, relpos, gw + NGW);
    p12_rows(rc, m0, x1, ys, tbase, gw, lane);
    for (int tok = gw; tok < NTOK; tok += NGW) {
        m0 = m1;
        if (tok + 2 * NGW < NTOK) p12_meta(m1, eid, gate, relpos, tok + 2 * NGW);
        if (tok + NGW < NTOK) p12_rows(rn, m0, x1, ys, tbase, tok + NGW, lane);
        f32x4 v[4];
#pragma unroll
        for (int j = 0; j < 4; ++j) v[j] = rc.x[j];
#pragma unroll
        for (int k = 0; k < 4; ++k) { const float gt = rc.g[k];
#pragma unroll
            for (int j = 0; j < 4; ++j) { const u32x2 w = rc.y[k][j]; v[j][0] += gt * bflo(w.x); v[j][1] += gt * bfhi(w.x); v[j][2] += gt * bflo(w.y); v[j][3] += gt * bfhi(w.y); } }
        float ss = 0.f;
#pragma unroll
        for (int j = 0; j < 4; ++j) ss += (v[j][0] * v[j][0] + v[j][1] * v[j][1]) + (v[j][2] * v[j][2] + v[j][3] * v[j][3]);
        ss = wave_sum(ss); const float rs = 1.0f / sqrtf(ss * (1.0f / DM) + 1e-5f);
#pragma unroll
        for (int j = 0; j < 4; ++j) { f32x4 o = v[j] * rs * gv[j];
#ifdef SCRUB_NAN
#pragma unroll
            for (int q = 0; q < 4; ++q) o[q] = (o[q] == o[q] && fabsf(o[q]) < 1e30f) ? o[q] : 0.f;
#endif
            *(f32x4*)(x1 + (size_t)tok * DM + 4 * lane + 256 * j) = o; }
        rc = rn;
    }
}
#ifndef N_PHASES
#define N_PHASES 13
#endif
struct Args { Params p; int ph_lo, ph_hi, li, pad; };
__global__ void __launch_bounds__(NWAVES * 64, 2) hymba_fwd(Args a) {
    extern __shared__ __attribute__((aligned(16))) unsigned char lds_raw[];
    LAS unsigned char* lds = (LAS unsigned char*)lds_raw;
    const Params& p = a.p;
    const int wave = __builtin_amdgcn_readfirstlane((int)threadIdx.x >> 6);
    volatile LAS unsigned* misc = (volatile LAS unsigned*)(lds + MISC_OFF);
    if (threadIdx.x < 4) misc[threadIdx.x] = 0u;
    __syncthreads();
    unsigned* ctl = (unsigned*)(p.ws + WS_CTL);
    XcdBarrier bar = xcd_barrier_post(ctl + CW_BAR + a.li * XCD_BAR_WORDS, misc);
    const int lo = a.ph_lo & 0xFF, hi = a.ph_hi, padf = a.ph_lo >> 8;
#ifndef PH_MASK
#define PH_MASK 0x1FFF
#endif
#define IN(k) ((((PH_MASK) >> (k)) & 1) && lo <= (k) && (k) < hi)
#define SEAM(k) do { if (IN(k) && IN((k) + 1)) xcd_barrier(bar, wave == 0 && lane_id() == 0); } while (0)
#define LN lane_id()
    unsigned char* ws = p.ws;
    if (IN(0)) { p0_prologue(p, lds, wave, LN); } SEAM(0);
    if (IN(1)) { pg8::Gemm g{(const bf16_t*)(ws + WS_XB), (const bf16_t*)(ws + WS_WINT), NTOK, DIN, DM}; pg8::StaticOrder S; S.init(NTOK, DIN, GRID, (int)blockIdx.x);
        EpiProj E{(bf16_t*)(ws + WS_PROJ), DIN, (const float*)(ws + WS_RSTD1)}; pg8::gemm_phase<EpiProj, pg8::StaticOrder, true, false>(lds, g, S, E, wave); } SEAM(1);
    if (IN(2)) { p2_lora_in(p, wave, LN); } SEAM(2);
    if (IN(3)) { pg8::Gemm g{(const bf16_t*)(ws + WS_LORAIN), (const bf16_t*)(ws + WS_LORAB), NTOK, 1536, 256}; pg8::StaticOrder S; S.init(NTOK, 1536, GRID, (int)blockIdx.x);
        EpiLora E{(float*)(ws + WS_LORAW), (float*)(ws + WS_LORAA), (float*)(ws + WS_LORAG)}; pg8::gemm_phase<EpiLora, pg8::StaticOrder, true, false>(lds, g, S, E, wave); } SEAM(3);
    if (IN(4)) { p4_chunks(p, lds, wave, LN); } SEAM(4);
    if (IN(5)) {
#ifdef PROBE_PAD
        if (blockIdx.x < 128) { if (!(padf & 2)) p5_seq(p, lds, wave, LN); } else { if (!(padf & 1)) p5_s5(p, lds, wave, LN); }
#else
        if (blockIdx.x < 128) p5_seq(p, lds, wave, LN); else p5_s5(p, lds, wave, LN);
#endif
 } SEAM(5);
    if (IN(6)) { pg8::Gemm g{(const bf16_t*)(ws + WS_YGELU), (const bf16_t*)(ws + WS_WGLUT), NTOK, DSSM, DSSM}; pg8::StaticOrder S; S.init(NTOK, DSSM, GRID, (int)blockIdx.x);
        EpiGlu E{(const bf16_t*)(ws + WS_YGELU), (bf16_t*)(ws + WS_YGLU), p.in[I_BGLU], (float*)(ws + WS_SSQ)}; pg8::gemm_phase<EpiGlu, pg8::StaticOrder, false, false>(lds, g, S, E, wave); } SEAM(6);
    if (IN(7)) { p7_mix(p, wave, LN); } SEAM(7);
    if (IN(8)) { pg8::Gemm g{(const bf16_t*)(ws + WS_MIXED), (const bf16_t*)(ws + WS_WOUTT), NTOK, DM, DM}; pg8::StaticOrder S; S.init(NTOK, DM, GRID, (int)blockIdx.x);
        EpiOut E{p.in[I_X], p.out, (bf16_t*)(ws + WS_XB)}; pg8::gemm_phase<EpiOut, pg8::StaticOrder, true, false>(lds, g, S, E, wave); } SEAM(8);
    if (IN(9)) { p9_router(p, lds, wave, LN); } SEAM(9);
    if (IN(10) || IN(11) || IN(12)) moe_tables(p, lds, wave == 0 && lane_id() == 0);
    if (IN(10)) { MoeOrder S{GRID, (int)blockIdx.x, 8, ((const LAS int*)(lds + TAB_BASE))[NE], (const LAS int*)(lds + TAB_SRC), (const LAS int*)(lds + TAB_VAL), (const LAS int*)(lds + TAB_E), (const int*)(ws + WS_STOK)};
        pg8::Gemm g{(const bf16_t*)(ws + WS_XB), (const bf16_t*)(ws + WS_W1T), 0, 0, DM};
        EpiSwiglu E{(bf16_t*)(ws + WS_ACT), (const float*)(ws + WS_B1G), (const float*)(ws + WS_B1L), (const float*)(ws + WS_SRS), (const LAS int*)(lds + TAB_SRC), (const LAS int*)(lds + TAB_VAL)};
        pg8::gemm_phase<EpiSwiglu, MoeOrder, true, true>(lds, g, S, E, wave); } SEAM(10);
    if (IN(11)) { MoeOrder S{GRID, (int)blockIdx.x, 4, ((const LAS int*)(lds + TAB_BASE))[NE], (const LAS int*)(lds + TAB_SRC), (const LAS int*)(lds + TAB_VAL), (const LAS int*)(lds + TAB_E), (const int*)(ws + WS_STOK)};
        pg8::Gemm g{(const bf16_t*)(ws + WS_ACT), (const bf16_t*)(ws + WS_W2T), 0, 0, DFF};
        EpiMoe2 E{(bf16_t*)(ws + WS_YSORT), p.in[I_B2]}; pg8::gemm_phase<EpiMoe2, MoeOrder, true, false>(lds, g, S, E, wave); } SEAM(11);
    if (IN(12)) { p12_combine(p, lds, wave, LN); }
#undef IN
#undef SEAM
#undef LN
}
#ifndef MK_SPLIT
#define MK_SPLIT 0
#endif
extern "C" void kernel_launch(void* const* d_in, const int* in_sizes, int n_in, void* d_out, int out_size, void* d_ws, size_t ws_size, hipStream_t stream) {
    static int ready = 0;
    if (ready == 0) {
        if (n_in != 34 || out_size != NTOK * DM || ws_size < WS_END) { fprintf(stderr, "kernel_launch: unexpected shapes (n_in %d, out %d, ws %zu); nothing launched\n", n_in, out_size, ws_size); ready = -1; return; }
        if (hipFuncSetAttribute((const void*)hymba_fwd, hipFuncAttributeMaxDynamicSharedMemorySize, LDS_BYTES) != hipSuccess) { fprintf(stderr, "kernel_launch: hipFuncSetAttribute failed\n"); ready = -1; return; }
        int per_cu = 0; if (hipOccupancyMaxActiveBlocksPerMultiprocessor(&per_cu, (const void*)hymba_fwd, NWAVES * 64, LDS_BYTES) != hipSuccess || per_cu < 1) fprintf(stderr, "kernel_launch: occupancy query says %d\n", per_cu);
        (void)hipGetLastError();
        ready = 1;
    }
    if (ready < 0) return;
    (void)hipMemsetAsync((char*)d_ws + WS_CTL, 0, CTL_ZERO_BYTES, stream);
    Args a{};
    for (int i = 0; i < 34; ++i) a.p.in[i] = (const float*)d_in[i];
    a.p.out = (float*)d_out; a.p.ws = (unsigned char*)d_ws;
#if defined(PROBE_LO)
    a.ph_lo = 0; a.ph_hi = PROBE_HI + 1; a.li = 0; hipLaunchKernelGGL(hymba_fwd, dim3(GRID), dim3(NWAVES * 64), LDS_BYTES, stream, a);
#ifndef PROBE_PAD
#define PROBE_PAD 0
#endif
    a.ph_lo = PROBE_LO | (PROBE_PAD << 8); a.ph_hi = PROBE_LO + 1; a.li = 1; hipLaunchKernelGGL(hymba_fwd, dim3(GRID), dim3(NWAVES * 64), LDS_BYTES, stream, a);
    a.ph_lo = PROBE_LO + 1; a.ph_hi = N_PHASES; a.li = 2; hipLaunchKernelGGL(hymba_fwd, dim3(GRID), dim3(NWAVES * 64), LDS_BYTES, stream, a);
#elif MK_SPLIT
    for (int ph = 0; ph < N_PHASES; ++ph) { a.ph_lo = ph; a.ph_hi = ph + 1; a.li = 0; hipLaunchKernelGGL(hymba_fwd, dim3(GRID), dim3(NWAVES * 64), LDS_BYTES, stream, a); }
#else
#ifndef RUN_HI
#define RUN_HI N_PHASES
#endif
    a.ph_lo = 0; a.ph_hi = RUN_HI; a.li = 0; hipLaunchKernelGGL(hymba_fwd, dim3(GRID), dim3(NWAVES * 64), LDS_BYTES, stream, a);
#endif
}
```

```cpp
#include <hip/hip_runtime.h>
#include <cstdio>
#include <cstdint>

#define LAS __attribute__((address_space(3)))
typedef unsigned short bf16_t;
typedef short bf16x8 __attribute__((ext_vector_type(8)));
typedef float f32x4 __attribute__((ext_vector_type(4)));
typedef float f32x2 __attribute__((ext_vector_type(2)));
typedef float f32x16 __attribute__((ext_vector_type(16)));
typedef unsigned u32x4 __attribute__((ext_vector_type(4)));
typedef unsigned u32x2 __attribute__((ext_vector_type(2)));

typedef __bf16 bf16x2_t __attribute__((ext_vector_type(2)));
__device__ __forceinline__ unsigned cvt_pk_bf16(float lo, float hi) { const bf16x2_t v = {(__bf16)lo, (__bf16)hi}; return __builtin_bit_cast(unsigned, v); }
__device__ __forceinline__ float bflo(unsigned w) { return __uint_as_float(w << 16); }
__device__ __forceinline__ float bfhi(unsigned w) { return __uint_as_float(w & 0xffff0000u); }
__device__ __forceinline__ float bf2f(bf16_t b) { return __uint_as_float(((unsigned)b) << 16); }
__device__ __forceinline__ bf16_t f2bf(float f) { return (bf16_t)(cvt_pk_bf16(f, 0.f) & 0xffffu); }
__device__ __forceinline__ float wave_sum(float v) {
#pragma unroll
    for (int o = 32; o >= 1; o >>= 1) v += __shfl_xor(v, o);
    return v;
}
__device__ __forceinline__ float sigmoidf_(float x) { return __builtin_amdgcn_rcpf(1.0f + __builtin_amdgcn_exp2f(-1.4426950408889634f * x)); }
__device__ __forceinline__ int lane_id() { int l; asm volatile("v_mbcnt_lo_u32_b32 %0, -1, 0\n\tv_mbcnt_hi_u32_b32 %0, -1, %0" : "=v"(l)); return l; }
__device__ __forceinline__ void lds_barrier() { asm volatile("s_waitcnt lgkmcnt(0)" ::: "memory"); __builtin_amdgcn_s_barrier(); asm volatile("" ::: "memory"); }
#define LDS_WAIT() asm volatile("s_waitcnt lgkmcnt(0)" ::: "memory")
#define VM_WAIT() asm volatile("s_waitcnt vmcnt(0)" ::: "memory")

namespace pg8 {
constexpr int BM = 256, BK = 64, HALF = 128, HTB = HALF * BK * 2, STAGE_BYTES = 8 * HTB, NXCD = 8, WGM = 8;
__host__ __device__ __forceinline__ int lds_byte(int r, int c) { const int st = (r >> 4) * 2 + (c >> 5), rr = r & 15, cc = c & 31, ob = rr * 64 + cc * 2; return st * 1024 + (ob ^ (((ob >> 9) & 1) << 5)); }
__host__ __device__ __forceinline__ void stage_rc(int b, int& R, int& C) { const int st = b / 1024, sb = b % 1024, swz = sb ^ (((sb >> 9) & 1) << 5); R = (st >> 1) * 16 + swz / 64; C = (st & 1) * 32 + (swz % 64) / 2; }
__host__ __device__ __forceinline__ int perm32(int rho) { const int n = rho >> 4, i = rho & 15; return 8 * (i >> 2) + 4 * n + (i & 3); }

struct Unit { int pm, pn; };
struct Gemm { const bf16_t* A; const bf16_t* Bt; int M, N, K; };

struct StaticOrder {
    int nM, nN, nwg, G, c;
    __host__ __device__ void init(int M, int N, int G_, int c_) { nM = M / BM; nN = N / BM; nwg = nM * nN; G = G_; c = c_; }
    __host__ __device__ bool next(int i, Unit& u) const {
        const long L = (long)i * G + c; if (L >= nwg) return false;
        int wgid = (int)L; { const int q = nwg / NXCD, r = nwg % NXCD, xcd = wgid % NXCD, off = wgid / NXCD; wgid = (xcd < r ? xcd * (q + 1) : r * (q + 1) + (xcd - r) * q) + off; }
        const int nig = WGM * nN, gid = wgid / nig, fm = gid * WGM, gsz = (nM - fm) < WGM ? (nM - fm) : WGM;
        u.pm = fm + ((wgid % nig) % gsz); u.pn = (wgid % nig) / gsz; return true;
    }
    __device__ __forceinline__ int arow(const Unit& u, int r) const { return u.pm * BM + r; }
};

template <class Epi, class Sched, bool ALIGN_EPI, bool GATHER>
__device__ __forceinline__ void gemm_phase(LAS unsigned char* lds, const Gemm g, const Sched& S, const Epi& E, const int wid) {
    const int lane = lane_id(), tid = wid * 64 + lane, wr = wid >> 2, wc = wid & 3, fr = lane & 15, fq = lane >> 4;
    const int K = g.K, nt = K / BK;
    int Rst[2], Cst[2];
    unsigned voffB[2], vAc[2][2], vAn[2][2];
#pragma unroll
    for (int i = 0; i < 2; ++i) { int R, C; stage_rc(tid * 16 + i * 8192, R, C); const int Rb = Epi::PERM ? ((R & ~31) + perm32(R & 31)) : R;
        Rst[i] = R; Cst[i] = C; voffB[i] = (unsigned)(Rb * K + C) * 2u; }
    const size_t kstep = (size_t)(BK * 2);
    const size_t hstep = (size_t)HALF * K * 2;
    const size_t tstep = 2 * hstep;
    const unsigned ldsw = (unsigned)wid * 1024u;
    const int aoff = lds_byte(wr * 64 + fr, fq * 8), boff = lds_byte(wc * 32 + fr, fq * 8);
#define PG8_SA(b, h) (((b) * 2 + (h)) * HTB)
#define PG8_SB(b, h) ((4 + (b) * 2 + (h)) * HTB)
#define PG8_STAGE(bufoff, gbase, voff) do { _Pragma("unroll") for (int _i = 0; _i < 2; ++_i) \
        __builtin_amdgcn_global_load_lds((const unsigned*)((const char*)(gbase) + (voff)[_i]), (LAS unsigned*)(lds + (bufoff) + ldsw + _i * 8192), 16, 0, 0); } while (0)
#define PG8_STAGE_SEL(bufoff, gbase, va, vb, sel) do { _Pragma("unroll") for (int _i = 0; _i < 2; ++_i) \
        __builtin_amdgcn_global_load_lds((const unsigned*)((const char*)(gbase) + ((sel) ? (vb)[_i] : (va)[_i])), (LAS unsigned*)(lds + (bufoff) + ldsw + _i * 8192), 16, 0, 0); } while (0)
#define PG8_LDA(dst, b, h) do { _Pragma("unroll") for (int m = 0; m < 4; ++m) _Pragma("unroll") for (int k = 0; k < 2; ++k) dst[m][k] = *(const LAS bf16x8*)(lds + PG8_SA(b, h) + aoff + m * 2048 + k * 1024); } while (0)
#define PG8_LDB(dst, b, h) do { _Pragma("unroll") for (int n = 0; n < 2; ++n) _Pragma("unroll") for (int k = 0; k < 2; ++k) dst[n][k] = *(const LAS bf16x8*)(lds + PG8_SB(b, h) + boff + n * 2048 + k * 1024); } while (0)
#define PG8_MMA(ai, bj, At, Bt) do { __builtin_amdgcn_s_setprio(1); _Pragma("unroll") for (int m = 0; m < 4; ++m) _Pragma("unroll") for (int n = 0; n < 2; ++n) _Pragma("unroll") for (int k = 0; k < 2; ++k) \
        acc[ai][bj][m][n] = __builtin_amdgcn_mfma_f32_16x16x32_bf16(Bt[n][k], At[m][k], acc[ai][bj][m][n], 0, 0, 0); __builtin_amdgcn_s_setprio(0); } while (0)
#define PG8_WAIT_V(n) asm volatile("s_waitcnt vmcnt(" #n ")" ::: "memory")
#define PG8_WAIT_L(n) asm volatile("s_waitcnt lgkmcnt(" #n ")" ::: "memory")
#define PG8_BAR __builtin_amdgcn_s_barrier()
#define PG8_SCHED __builtin_amdgcn_sched_barrier(0)
#define PG8_LOADOFF(dst, unit) do { _Pragma("unroll") for (int _h = 0; _h < 2; ++_h) _Pragma("unroll") for (int _i = 0; _i < 2; ++_i) \
        dst[_h][_i] = GATHER ? ((unsigned)S.arow(unit, _h * HALF + Rst[_i]) * (unsigned)(K * 2) + (unsigned)(Cst[_i] * 2)) : ((unsigned)((_h * HALF + Rst[_i]) * K + Cst[_i]) * 2u); } while (0)
    Unit cur, nxt; int ui = 0;
    if (!S.next(0, cur)) return;
    f32x4 acc[2][2][4][2];
#pragma unroll
    for (int a = 0; a < 2; ++a)
#pragma unroll
        for (int b = 0; b < 2; ++b)
#pragma unroll
            for (int m = 0; m < 4; ++m)
#pragma unroll
                for (int n = 0; n < 2; ++n) acc[a][b][m][n] = (f32x4){0.f, 0.f, 0.f, 0.f};
    bf16x8 At[4][2], B0[2][2], B1[2][2];
    const char* cA = GATHER ? (const char*)g.A : (const char*)g.A + (size_t)cur.pm * tstep; const char* cB = (const char*)g.Bt + (size_t)cur.pn * tstep;
    PG8_LOADOFF(vAc, cur);
    if constexpr (Epi::PREFETCH) E.prefetch(cur, 0, wid, lane);
    if (GATHER) { Unit u1; if (S.next(1, u1)) PG8_LOADOFF(vAn, u1); else PG8_LOADOFF(vAn, cur); } else { PG8_LOADOFF(vAn, cur); }
    PG8_STAGE(PG8_SB(0, 0), cB, voffB); PG8_STAGE(PG8_SB(0, 1), cB + hstep, voffB); PG8_STAGE(PG8_SA(0, 0), cA, vAc[0]); PG8_STAGE(PG8_SA(0, 1), cA, vAc[1]);
    if (wr == 1) PG8_BAR;
    PG8_WAIT_V(2); PG8_BAR;
    PG8_STAGE(PG8_SB(1, 0), cB + kstep, voffB); PG8_STAGE(PG8_SA(1, 0), cA + kstep, vAc[0]); PG8_STAGE(PG8_SB(1, 1), cB + hstep + kstep, voffB);
    PG8_WAIT_V(6); PG8_BAR;
    for (;;) {
        const bool has_next = S.next(ui + 1, nxt);
        const char* nA = GATHER ? cA : (has_next ? (const char*)g.A + (size_t)nxt.pm * tstep : cA); const char* nB = has_next ? (const char*)g.Bt + (size_t)nxt.pn * tstep : cB;
        const bool usen = GATHER && has_next;
        for (int t = 0; t < nt; t += 2) {
            const bool last = (t == nt - 2);
            const char* a1 = cA + (size_t)(t + 1) * kstep;
            const char* a2 = last ? nA : cA + (size_t)(t + 2) * kstep; const char* b2 = last ? nB : cB + (size_t)(t + 2) * kstep;
            const char* a3 = a2 + kstep; const char* b3 = b2 + kstep;
            const bool sel = last && usen;
            PG8_LDB(B0, 0, 0); PG8_LDB(B1, 0, 1); PG8_SCHED; PG8_LDA(At, 0, 0); PG8_STAGE(PG8_SA(1, 1), a1, vAc[1]);
            PG8_WAIT_V(8); PG8_WAIT_L(0); PG8_BAR; PG8_MMA(0, 0, At, B0); PG8_MMA(0, 1, At, B1); PG8_BAR; PG8_SCHED;
            PG8_LDA(At, 0, 1); PG8_STAGE(PG8_SB(0, 0), b2, voffB); PG8_STAGE(PG8_SB(0, 1), b2 + hstep, voffB); PG8_STAGE_SEL(PG8_SA(0, 0), a2, vAc[0], vAn[0], sel);
            PG8_WAIT_V(8); PG8_WAIT_L(0); PG8_BAR; PG8_MMA(1, 0, At, B0); PG8_MMA(1, 1, At, B1); PG8_BAR; PG8_SCHED;
            PG8_LDB(B0, 1, 0); PG8_LDB(B1, 1, 1); PG8_SCHED; PG8_LDA(At, 1, 0); PG8_STAGE_SEL(PG8_SA(0, 1), a2, vAc[1], vAn[1], sel);
            PG8_WAIT_V(8); PG8_WAIT_L(0); PG8_BAR; PG8_MMA(0, 0, At, B0); PG8_MMA(0, 1, At, B1); PG8_BAR; PG8_SCHED;
            PG8_LDA(At, 1, 1); PG8_STAGE(PG8_SB(1, 0), b3, voffB); PG8_STAGE(PG8_SB(1, 1), b3 + hstep, voffB); PG8_STAGE_SEL(PG8_SA(1, 0), a3, vAc[0], vAn[0], sel);
            PG8_WAIT_V(8); PG8_WAIT_L(0); PG8_BAR; PG8_MMA(1, 0, At, B0); PG8_MMA(1, 1, At, B1); PG8_BAR; PG8_SCHED;
        }
        if constexpr (ALIGN_EPI) { if (wr == 0) PG8_BAR; }
        if (GATHER && has_next) {
#pragma unroll
            for (int _h = 0; _h < 2; ++_h)
#pragma unroll
                for (int _i = 0; _i < 2; ++_i) vAc[_h][_i] = vAn[_h][_i];
            Unit u2; if (S.next(ui + 2, u2)) PG8_LOADOFF(vAn, u2);
        }
        if constexpr (Epi::PREFETCH) { if (has_next) E.prefetch(nxt, (ui + 1) & 1, wid, lane); E(acc, cur, wr, wc, fr, fq, ui & 1); } else E(acc, cur, wr, wc, fr, fq);
        if (!has_next) break;
#pragma unroll
        for (int a = 0; a < 2; ++a)
#pragma unroll
            for (int b = 0; b < 2; ++b)
#pragma unroll
                for (int m = 0; m < 4; ++m)
#pragma unroll
                    for (int n = 0; n < 2; ++n) acc[a][b][m][n] = (f32x4){0.f, 0.f, 0.f, 0.f};
        cur = nxt; cA = nA; cB = nB; ++ui;
        if constexpr (ALIGN_EPI) { if (wr == 1) PG8_BAR; }
    }
    PG8_WAIT_V(0);
    if constexpr (!ALIGN_EPI) { if (wr == 0) PG8_BAR; }
    PG8_BAR;
#undef PG8_SA
#undef PG8_SB
#undef PG8_STAGE
#undef PG8_STAGE_SEL
#undef PG8_LDA
#undef PG8_LDB
#undef PG8_MMA
#undef PG8_WAIT_V
#undef PG8_WAIT_L
#undef PG8_BAR
#undef PG8_SCHED
#undef PG8_LOADOFF
}
}
#define XB_TMO      128
#define XB_XCNT(j)  (256  + 64 * (j))
#define XB_XSUB(j)  (1280 + 64 * (j))
#define XB_XGEN(j)  (2304 + 64 * (j))
#define XB_TOP      3328
#define XB_TOPGEN   3392
#define XCD_BAR_WORDS 3456
#define XB_SPIN_CAP (1u << 18)

__device__ __forceinline__ unsigned xb_ld(unsigned* p)              { return __hip_atomic_load(p, __ATOMIC_RELAXED, __HIP_MEMORY_SCOPE_AGENT); }
__device__ __forceinline__ unsigned xb_add(unsigned* p, unsigned v) { return __hip_atomic_fetch_add(p, v, __ATOMIC_RELAXED, __HIP_MEMORY_SCOPE_AGENT); }
__device__ __forceinline__ unsigned xb_xcc_id() { return (unsigned)__builtin_amdgcn_s_getreg((3 << 11) | 20) & 0xFu; }
#define XB_SPIN(cond, bar) do { unsigned _sp = 0; while (cond) { __builtin_amdgcn_s_sleep(1); \
    if ((++_sp & 255u) == 0u) { if (xb_ld(&(bar)[XB_TMO])) break; if (_sp > XB_SPIN_CAP) { atomicAdd(&(bar)[XB_TMO], 1u); break; } } } } while (0)

struct XcdBarrier {
    unsigned* bar; unsigned x;
    volatile LAS unsigned* st;
};

__device__ __forceinline__ XcdBarrier xcd_barrier_post(unsigned* bar, volatile LAS unsigned* st) {
    XcdBarrier b; b.bar = bar; b.x = xb_xcc_id(); b.st = st;
    if (threadIdx.x == 0) (void)xb_add(&bar[XB_XCNT(b.x)], 1u);
    return b;
}
__device__ __forceinline__ void xcd_barrier_complete(unsigned* bar, unsigned x, unsigned& nloc, unsigned& nx) {
    const unsigned G = gridDim.x * gridDim.y * gridDim.z;
    unsigned sum, cnt, mine, sp = 0u;
    for (;;) {
        sum = 0u; cnt = 0u; mine = 0u;
#pragma unroll
        for (unsigned j = 0; j < 16; ++j) { const unsigned c = xb_ld(&bar[XB_XCNT(j)]); sum += c; cnt += (c > 0u) ? 1u : 0u; mine = (j == x) ? c : mine; }
        if (sum == G) break;
        __builtin_amdgcn_s_sleep(1);
        if ((++sp & 255u) == 0u) { if (xb_ld(&bar[XB_TMO])) break; if (sp > XB_SPIN_CAP) { atomicAdd(&bar[XB_TMO], 1u); break; } }
    }
    nloc = mine > 0u ? mine : 1u; nx = cnt > 0u ? cnt : 1u;
}

__device__ __forceinline__ void xcd_barrier(const XcdBarrier& b, const bool t0) {
    asm volatile("s_waitcnt vmcnt(0)" ::: "memory");
    __syncthreads();
    if (t0) {
        unsigned* bar = b.bar;
        __builtin_amdgcn_s_waitcnt(0);
        unsigned nloc = b.st[0], nx = b.st[1];
        if (nloc == 0u) { xcd_barrier_complete(bar, b.x, nloc, nx); b.st[0] = nloc; b.st[1] = nx; }
        const unsigned old = xb_add(&bar[XB_XSUB(b.x)], 1u);
        const unsigned gen = old / nloc;
        if (old + 1u == (gen + 1u) * nloc) {
            __builtin_amdgcn_fence(__ATOMIC_RELEASE, "agent");
            asm volatile("s_waitcnt vmcnt(0)" ::: "memory");
            const unsigned og = xb_add(&bar[XB_TOP], 1u);
            const unsigned tg = og / nx;
            if (og + 1u == (tg + 1u) * nx) xb_add(&bar[XB_TOPGEN], 1u);
            else XB_SPIN(xb_ld(&bar[XB_TOPGEN]) == tg, bar);
            __builtin_amdgcn_fence(__ATOMIC_ACQUIRE, "agent");
            xb_add(&bar[XB_XGEN(b.x)], 1u);
            asm volatile("s_waitcnt vmcnt(0)" ::: "memory");
        } else {
            XB_SPIN(xb_ld(&bar[XB_XGEN(b.x)]) == gen, bar);
            __builtin_amdgcn_fence(__ATOMIC_ACQUIRE, "agent");
            asm volatile("s_waitcnt vmcnt(0)" ::: "memory");
        }
    }
    __syncthreads();
}

constexpr int DM = 1024, NBATCH = 8, SEQ = 4096, NTOK = NBATCH * SEQ;
constexpr int DIN = 2304, DR = 512, DSSM = 512, NH = 8, HD = 64;
constexpr int COL_K = 512, COL_V = 1024, COL_LORA = 1536, COL_U = 1792;
constexpr int NE = 32, DFF = 1024, CAP = 32768, MAXTILES = 544;
constexpr int OPS_STRIDE = 388;
constexpr int NWAVES = 8, GRID = 256, NGW = GRID * NWAVES;
constexpr size_t MiB = 1u << 20;
constexpr size_t WS_CTL = 0, CTL_ZERO_BYTES = 1 * MiB;
constexpr size_t WS_WINT = 1 * MiB, WS_LORAB = 6 * MiB, WS_WGLUT = 7 * MiB, WS_WOUTT = 8 * MiB;
constexpr size_t WS_B1G = 10 * MiB, WS_B1L = 10 * MiB + 128 * 1024, WS_RWP = 10 * MiB + 256 * 1024, WS_RSTD1 = 10 * MiB + 512 * 1024;
constexpr size_t WS_SSQ = 11 * MiB, WS_EID = 12 * MiB, WS_GATE = 12 * MiB + 512 * 1024, WS_RELPOS = 13 * MiB, WS_STOK = 14 * MiB;
constexpr size_t WS_W2T = 20 * MiB, WS_W1T = 84 * MiB, WS_XB = 212 * MiB;
constexpr size_t WS_PROJ = 276 * MiB, WS_LORAIN = 420 * MiB, WS_LORAW = 436 * MiB, WS_LORAA = 500 * MiB, WS_LORAG = 564 * MiB, WS_OPS = 628 * MiB, WS_SRS = 1016 * MiB, WS_END = 1020 * MiB;
constexpr size_t WS_YRAW = WS_LORAW, WS_YGELU = WS_LORAA, WS_YGLU = WS_LORAA + 32 * MiB, WS_MIXED = WS_OPS + 200 * MiB, WS_ACT = WS_OPS, WS_YSORT = WS_PROJ;
constexpr size_t WS_QP = WS_OPS, WS_YG = WS_OPS + 64 * MiB, WS_RKB = WS_OPS + 192 * MiB;
static_assert(WS_OPS + (size_t)64 * 4096 * OPS_STRIDE * 4 <= WS_SRS, "ops fits");
constexpr int CW_TMO = 0, CW_BAR = 4096, CW_GCOUNT = 16384, CW_CVCTR = 16384 + 64, CW_CVT1 = 16512, CW_CVT2 = 16768;
constexpr int LDS_BYTES = 163840, TAB_OFF = 131072, MISC_OFF = 159744;
constexpr int TAB_SRC = TAB_OFF, TAB_VAL = TAB_OFF + MAXTILES * 4, TAB_E = TAB_OFF + 2 * MAXTILES * 4, TAB_BASE = TAB_OFF + 3 * MAXTILES * 4;

struct Params { const float* in[34]; float* out; unsigned char* ws; };
enum { I_X = 0, I_N1G, I_WIN, I_MU, I_W0, I_WUP, I_A0, I_AUP, I_GUP, I_KK, I_KA, I_RK, I_LNW, I_LNB, I_LRE, I_LIM, I_LSTEP, I_BRE, I_BIM, I_CRE, I_CIM, I_DSKIP, I_WGLU, I_BGLU, I_BETA, I_WOUT, I_N2G, I_RW, I_RB, I_W1, I_B1, I_W2, I_B2, I_FG };

using pg8::Unit; using pg8::HALF; using pg8::BM;
constexpr int EPB_OFF = 139264, EPB_BYTES = 2048;
struct EpiProj {
    static constexpr bool PERM = true, PREFETCH = true;
    bf16_t* O; int ldc; const float* rs; LAS unsigned char* lds;
    __device__ __forceinline__ void prefetch(const Unit& u, int buf, int wid, int lane) const {
        if (wid != 0) return;
        __builtin_amdgcn_global_load_lds((const unsigned*)(rs + u.pm * BM + 4 * lane), (LAS unsigned*)(lds + EPB_OFF + buf * EPB_BYTES), 16, 0, 0);
    }
    __device__ __forceinline__ void operator()(const f32x4 (&acc)[2][2][4][2], const Unit& u, int wr, int wc, int fr, int fq, int buf) const {
        const int row0 = u.pm * BM + wr * 64 + fr, col0 = u.pn * BM + wc * 32 + 8 * fq;
        const LAS float* pb = (const LAS float*)(lds + EPB_OFF + buf * EPB_BYTES) + wr * 64 + fr;
#pragma unroll
        for (int ai = 0; ai < 2; ++ai)
#pragma unroll
            for (int m = 0; m < 4; ++m) { const int row = row0 + ai * HALF + m * 16; const float s = pb[ai * HALF + m * 16]; bf16_t* rowp = O + (size_t)row * ldc + col0;
#pragma unroll
                for (int bj = 0; bj < 2; ++bj) { const f32x4 v0 = acc[ai][bj][m][0] * s, v1 = acc[ai][bj][m][1] * s;
                    u32x4 w; w.x = cvt_pk_bf16(v0[0], v0[1]); w.y = cvt_pk_bf16(v0[2], v0[3]); w.z = cvt_pk_bf16(v1[0], v1[1]); w.w = cvt_pk_bf16(v1[2], v1[3]);
                    *(u32x4*)(rowp + bj * HALF) = w; } }
    }
};
struct EpiLora {
    static constexpr bool PERM = false, PREFETCH = false;
    float* bw; bf16_t* ba; bf16_t* bg;
    __device__ __forceinline__ void operator()(const f32x4 (&acc)[2][2][4][2], const Unit& u, int wr, int wc, int fr, int fq) const {
        const int kind = u.pn >> 1; const int row0 = u.pm * BM + wr * 64 + fr, cc0 = (u.pn & 1) * 256 + wc * 32 + 4 * fq;
        bf16_t* hb = kind == 1 ? ba : bg;
#pragma unroll
        for (int ai = 0; ai < 2; ++ai)
#pragma unroll
            for (int m = 0; m < 4; ++m) { const size_t off = (size_t)(row0 + ai * HALF + m * 16) * 512 + cc0;
#pragma unroll
                for (int bj = 0; bj < 2; ++bj)
#pragma unroll
                    for (int n = 0; n < 2; ++n) { const f32x4 v = acc[ai][bj][m][n];
                        if (kind == 0) *(f32x4*)(bw + off + bj * HALF + n * 16) = v;
                        else { u32x2 w; w.x = cvt_pk_bf16(v[0], v[1]); w.y = cvt_pk_bf16(v[2], v[3]); *(u32x2*)(hb + off + bj * HALF + n * 16) = w; } } }
    }
};
struct EpiGlu {
    static constexpr bool PERM = true, PREFETCH = false;
    const bf16_t* Y; bf16_t* O; const float* bias; float* ssq;
    __device__ __forceinline__ void operator()(const f32x4 (&acc)[2][2][4][2], const Unit& u, int wr, int wc, int fr, int fq) const {
        const int row0 = u.pm * BM + wr * 64 + fr, col0 = u.pn * BM + wc * 32 + 8 * fq;
        f32x4 bv[2][2];
#pragma unroll
        for (int bj = 0; bj < 2; ++bj)
#pragma unroll
            for (int n = 0; n < 2; ++n) bv[bj][n] = *(const f32x4*)(bias + col0 + bj * HALF + 4 * n);
#pragma unroll
        for (int ai = 0; ai < 2; ++ai)
#pragma unroll
            for (int m = 0; m < 4; ++m) { const int row = row0 + ai * HALF + m * 16; float sq = 0.f;
#pragma unroll
                for (int bj = 0; bj < 2; ++bj) { const size_t off = (size_t)row * 512 + col0 + bj * HALF; const u32x4 yv = *(const u32x4*)(Y + off);
                    const f32x4 z0 = acc[ai][bj][m][0] + bv[bj][0], z1 = acc[ai][bj][m][1] + bv[bj][1];
                    float o[8]; o[0] = bflo(yv.x) * sigmoidf_(z0[0]); o[1] = bfhi(yv.x) * sigmoidf_(z0[1]); o[2] = bflo(yv.y) * sigmoidf_(z0[2]); o[3] = bfhi(yv.y) * sigmoidf_(z0[3]);
                    o[4] = bflo(yv.z) * sigmoidf_(z1[0]); o[5] = bfhi(yv.z) * sigmoidf_(z1[1]); o[6] = bflo(yv.w) * sigmoidf_(z1[2]); o[7] = bfhi(yv.w) * sigmoidf_(z1[3]);
#pragma unroll
                    for (int j = 0; j < 8; ++j) sq += o[j] * o[j];
                    u32x4 w; w.x = cvt_pk_bf16(o[0], o[1]); w.y = cvt_pk_bf16(o[2], o[3]); w.z = cvt_pk_bf16(o[4], o[5]); w.w = cvt_pk_bf16(o[6], o[7]);
                    *(u32x4*)(O + off) = w; }
                sq += __shfl_xor(sq, 16); sq += __shfl_xor(sq, 32);
                if (fq == 0) ssq[(size_t)row * 8 + u.pn * 4 + wc] = sq; }
    }
};
struct EpiOut {
    static constexpr bool PERM = true, PREFETCH = false;
    bf16_t* X1B;
    __device__ __forceinline__ void operator()(const f32x4 (&acc)[2][2][4][2], const Unit& u, int wr, int wc, int fr, int fq) const {
        const int row0 = u.pm * BM + wr * 64 + fr, col0 = u.pn * BM + wc * 32 + 8 * fq;
        u32x4 xin[2][4][2];
#pragma unroll
        for (int ai = 0; ai < 2; ++ai)
#pragma unroll
            for (int m = 0; m < 4; ++m)
#pragma unroll
                for (int bj = 0; bj < 2; ++bj) xin[ai][m][bj] = *(const u32x4*)(X1B + (size_t)(row0 + ai * HALF + m * 16) * DM + col0 + bj * HALF);
#pragma unroll
        for (int ai = 0; ai < 2; ++ai)
#pragma unroll
            for (int m = 0; m < 4; ++m) { const size_t off = (size_t)(row0 + ai * HALF + m * 16) * DM + col0;
#pragma unroll
                for (int bj = 0; bj < 2; ++bj) { const u32x4 xi = xin[ai][m][bj]; const f32x4 a0 = acc[ai][bj][m][0], a1 = acc[ai][bj][m][1];
                    u32x4 w; w.x = cvt_pk_bf16(bflo(xi.x) + a0[0], bfhi(xi.x) + a0[1]); w.y = cvt_pk_bf16(bflo(xi.y) + a0[2], bfhi(xi.y) + a0[3]);
                    w.z = cvt_pk_bf16(bflo(xi.z) + a1[0], bfhi(xi.z) + a1[1]); w.w = cvt_pk_bf16(bflo(xi.w) + a1[2], bfhi(xi.w) + a1[3]); *(u32x4*)(X1B + off + bj * HALF) = w; } }
    }
};
struct EpiSwiglu {
    static constexpr bool PERM = true, PREFETCH = true;
    bf16_t* O; const float* b1g; const float* b1l; const float* srs; const LAS int* tsrc; const LAS int* tval; int flags; LAS unsigned char* lds;
    __device__ __forceinline__ void prefetch(const Unit& u, int buf, int wid, int lane) const {
        if (wid != 0) return;
        const int e = u.pn >> 3, pnl = u.pn & 7, src = tsrc[u.pm];
        LAS unsigned char* d = lds + EPB_OFF + buf * EPB_BYTES;
        __builtin_amdgcn_global_load_lds((const unsigned*)(srs + src + 4 * lane), (LAS unsigned*)d, 16, 0, 0);
        const float* bsrc = (lane < 32 ? b1g : b1l) + e * DFF + pnl * 128 + 4 * (lane & 31);
        __builtin_amdgcn_global_load_lds((const unsigned*)bsrc, (LAS unsigned*)(d + 1024), 16, 0, 0);
    }
    __device__ __forceinline__ void operator()(const f32x4 (&acc)[2][2][4][2], const Unit& u, int wr, int wc, int fr, int fq, int buf) const {
#ifdef PROBE_VARIANT
        if (flags & 16) return;
#endif
        const int pnl = u.pn & 7; const int r0 = wr * 64 + fr, ol = wc * 32 + 8 * fq, o0 = pnl * 128 + ol;
        const int nval = tval[u.pm];
        const LAS float* pb = (const LAS float*)(lds + EPB_OFF + buf * EPB_BYTES);
        f32x4 bg[2], bl[2];
#pragma unroll
        for (int n = 0; n < 2; ++n) { bg[n] = *(const LAS f32x4*)(pb + 256 + ol + 4 * n); bl[n] = *(const LAS f32x4*)(pb + 384 + ol + 4 * n); }
#pragma unroll
        for (int ai = 0; ai < 2; ++ai)
#pragma unroll
            for (int m = 0; m < 4; ++m) { const int r = r0 + ai * HALF + m * 16; const float s = r < nval ? pb[r] : 0.f;
                float o[8];
#pragma unroll
                for (int n = 0; n < 2; ++n)
#pragma unroll
                    for (int j = 0; j < 4; ++j) { const float gl = fminf(acc[ai][0][m][n][j] * s + bg[n][j], 7.0f); const float li = fminf(fmaxf(acc[ai][1][m][n][j] * s + bl[n][j], -7.0f), 7.0f);
                        o[4 * n + j] = gl * sigmoidf_(1.702f * gl) * (li + 1.0f); }
                u32x4 w; w.x = cvt_pk_bf16(o[0], o[1]); w.y = cvt_pk_bf16(o[2], o[3]); w.z = cvt_pk_bf16(o[4], o[5]); w.w = cvt_pk_bf16(o[6], o[7]);
                *(u32x4*)(O + (size_t)(u.pm * BM + r) * DFF + o0) = w; }
    }
};
struct EpiMoe2 {
    static constexpr bool PERM = true, PREFETCH = true;
    bf16_t* O; const float* b2; LAS unsigned char* lds;
    __device__ __forceinline__ void prefetch(const Unit& u, int buf, int wid, int lane) const {
        if (wid != 0) return;
        const int e = u.pn >> 2, pnl = u.pn & 3;
        __builtin_amdgcn_global_load_lds((const unsigned*)(b2 + e * DM + pnl * BM + 4 * lane), (LAS unsigned*)(lds + EPB_OFF + buf * EPB_BYTES), 16, 0, 0);
    }
    __device__ __forceinline__ void operator()(const f32x4 (&acc)[2][2][4][2], const Unit& u, int wr, int wc, int fr, int fq, int buf) const {
        const int pnl = u.pn & 3; const int row0 = u.pm * BM + wr * 64 + fr, col0 = pnl * BM + wc * 32 + 8 * fq;
        const LAS float* pb = (const LAS float*)(lds + EPB_OFF + buf * EPB_BYTES) + wc * 32 + 8 * fq;
        f32x4 bv[2][2];
#pragma unroll
        for (int bj = 0; bj < 2; ++bj)
#pragma unroll
            for (int n = 0; n < 2; ++n) bv[bj][n] = *(const LAS f32x4*)(pb + bj * HALF + 4 * n);
#pragma unroll
        for (int ai = 0; ai < 2; ++ai)
#pragma unroll
            for (int m = 0; m < 4; ++m) { bf16_t* rowp = O + (size_t)(row0 + ai * HALF + m * 16) * DM + col0;
#pragma unroll
                for (int bj = 0; bj < 2; ++bj) { const f32x4 v0 = acc[ai][bj][m][0] + bv[bj][0], v1 = acc[ai][bj][m][1] + bv[bj][1];
                    u32x4 w; w.x = cvt_pk_bf16(v0[0], v0[1]); w.y = cvt_pk_bf16(v0[2], v0[3]); w.z = cvt_pk_bf16(v1[0], v1[1]); w.w = cvt_pk_bf16(v1[2], v1[3]);
                    *(u32x4*)(rowp + bj * HALF) = w; } }
    }
};
struct MoeOrder {
    int G, c, NT, ntiles; const LAS int* tsrc; const LAS int* tval; const LAS int* te; const int* stok; const LAS int* tbase; int flags;
    __device__ __forceinline__ bool next(int i, Unit& u) const {
#if defined(MOE_STATIC)
        const int nwg = ntiles * NT; const int L0 = i * G + c; if (L0 >= nwg) return false;
        int wgid = L0; { const int q = nwg / 8, r = nwg % 8, xcd = wgid % 8, off = wgid / 8; wgid = (xcd < r ? xcd * (q + 1) : r * (q + 1) + (xcd - r) * q) + off; }
        const int nig = 8 * NT, gid = wgid / nig, fm = gid * 8, gsz = (ntiles - fm) < 8 ? (ntiles - fm) : 8;
        u.pm = fm + ((wgid % nig) % gsz); u.pn = te[u.pm] * NT + (wgid % nig) / gsz; return true; }
#elif defined(MOE_PLAIN)
        const int L = i * G + c; const int mt = L / NT; if (mt >= ntiles) return false;
        u.pm = mt; u.pn = te[mt] * NT + (L % NT); return true; }
#else
        const int L = i * G + c, xcd = L & 7, j = L >> 3; const int mt = (j / NT) * 8 + xcd; if (mt >= ntiles) return false;
        u.pm = mt; u.pn = te[mt] * NT + (j % NT); return true; }
#endif
    __device__ __forceinline__ int arow(const Unit& u, int r) const {
#ifdef PROBE_VARIANT
        if (flags & 4) return (u.pm * 256 + r) & (NTOK - 1);
#endif
        return r < tval[u.pm] ? stok[tsrc[u.pm] + r] : 0; }
};
struct KsOne { __device__ __forceinline__ float operator()(int) const { return 1.f; } };
struct KsVec { const float* g; __device__ __forceinline__ float operator()(int k) const { return g[k]; } };
struct KsOut { const float* beta; __device__ __forceinline__ float operator()(int k) const { return k < DR ? 1.f : beta[k - DR]; } };
struct RmId { int off; __device__ __forceinline__ int operator()(int c) const { return off + c; } };
struct RmW1 { int e; __device__ __forceinline__ int operator()(int c) const { const int o = c >> 1, bj = c & 1; return e * 2048 + (o >> 7) * 256 + bj * 128 + (o & 127); } };
template <class KS, class RM>
__device__ __forceinline__ void tr_item(const float* src, int N, int k0, int c0, bf16_t* dst, int ldk, const KS ks, const RM rm, LAS float* scr, int lane) {
#pragma unroll 4
    for (int it = 0; it < 16; ++it) { const int r = it * 4 + (lane >> 4); const f32x4 v = *(const f32x4*)(src + (size_t)(k0 + r) * N + c0 + 4 * (lane & 15)); const float s = ks(k0 + r);
        LAS float* d = scr + r * 65 + 4 * (lane & 15); d[0] = v[0] * s; d[1] = v[1] * s; d[2] = v[2] * s; d[3] = v[3] * s; }
    LDS_WAIT();
    const int c = lane & 7;
#pragma unroll
    for (int jj = 0; jj < 8; ++jj) { const int n = (lane >> 3) + 8 * jj; const LAS float* s = scr + (8 * c) * 65 + n;
        u32x4 o; o.x = cvt_pk_bf16(s[0 * 65], s[1 * 65]); o.y = cvt_pk_bf16(s[2 * 65], s[3 * 65]); o.z = cvt_pk_bf16(s[4 * 65], s[5 * 65]); o.w = cvt_pk_bf16(s[6 * 65], s[7 * 65]);
        *(u32x4*)(dst + (size_t)rm(c0 + n) * ldk + k0 + 8 * c) = o; }
    LDS_WAIT();
}
struct CvItem { const float* src; int N, k0, c0; bf16_t* dst; int e; const float* ks; };
__device__ __forceinline__ void cv_item(const Params& p, int it, CvItem& c) {
    constexpr int I_1 = NE * 16 * 64;
    if (it < I_1) { const int e = it >> 10, q = it & 1023, kb = q >> 6, nb = q & 63; c.src = p.in[I_W1] + (size_t)e * DM * 2048; c.N = 2048; c.k0 = kb * 64; c.c0 = nb * 32; c.dst = (bf16_t*)(p.ws + WS_W1T); c.e = e; c.ks = p.in[I_N2G]; }
    else { const int r = it - I_1, e = r >> 9, q = r & 511, kb = q >> 5, nb = q & 31; c.src = p.in[I_W2] + (size_t)e * DFF * DM; c.N = DM; c.k0 = kb * 64; c.c0 = nb * 32; c.dst = (bf16_t*)(p.ws + WS_W2T); c.e = -(e * DM) - 1; c.ks = nullptr; }
}
__device__ __forceinline__ void cv_load(const CvItem& c, f32x4 (&v)[8], float (&s)[8], int lane) {
#pragma unroll
    for (int i = 0; i < 8; ++i) v[i] = __builtin_nontemporal_load((const f32x4*)(c.src + (size_t)(c.k0 + 8 * (lane >> 3) + i) * c.N + c.c0 + 4 * (lane & 7)));
    if (c.ks) { const f32x4 a = *(const f32x4*)(c.ks + c.k0 + 8 * (lane >> 3)), b = *(const f32x4*)(c.ks + c.k0 + 8 * (lane >> 3) + 4);
        s[0] = a[0]; s[1] = a[1]; s[2] = a[2]; s[3] = a[3]; s[4] = b[0]; s[5] = b[1]; s[6] = b[2]; s[7] = b[3]; }
    else {
#pragma unroll
        for (int i = 0; i < 8; ++i) s[i] = 1.0f; }
}
__device__ __forceinline__ void cv_emit(const CvItem& c0, const f32x4 (&v0)[8], const float (&s0)[8], LAS float*, int lane) {
#pragma unroll
    for (int j = 0; j < 4; ++j) { const int c = c0.c0 + 4 * (lane & 7) + j;
        u32x4 o; o.x = cvt_pk_bf16(v0[0][j] * s0[0], v0[1][j] * s0[1]); o.y = cvt_pk_bf16(v0[2][j] * s0[2], v0[3][j] * s0[3]); o.z = cvt_pk_bf16(v0[4][j] * s0[4], v0[5][j] * s0[5]); o.w = cvt_pk_bf16(v0[6][j] * s0[6], v0[7][j] * s0[7]);
        int row; if (c0.e >= 0) { const int oo = c >> 1, bj = c & 1; row = c0.e * 2048 + (oo >> 7) * 256 + bj * 128 + (oo & 127); } else row = -(c0.e + 1) + c;
        *(u32x4*)(c0.dst + (size_t)row * DM + c0.k0 + 8 * (lane >> 3)) = o; }
}
constexpr int CV_NIT = NE * 16 * 64 + NE * 16 * 32;
constexpr int CV_A = 0, CV_B = 8192, CV_C = 40960;
__device__ __forceinline__ int cv_ticket(unsigned* ctr, int lane) { unsigned t = 0; if (lane == 0) t = __hip_atomic_fetch_add(ctr, 1u, __ATOMIC_RELAXED, __HIP_MEMORY_SCOPE_AGENT); return (int)__builtin_amdgcn_readfirstlane(t); }
template <int BATCH>
__device__ __forceinline__ void cv_queue(const Params& p, LAS float* scr, int lane, unsigned* ctr, const int lo, const int hi) {
    CvItem c0, c1, c2; f32x4 v0[8], v1[8], v2[8]; float s0[8], s1[8], s2[8];
    int tb = 0, tp = BATCH;
#define CV_NEXT() (tp == BATCH ? (tb = lo + cv_ticket(ctr, lane) * BATCH, tp = 1, tb) : tb + tp++)
    int i0 = CV_NEXT(), i1 = CV_NEXT();
    if (i0 >= hi) return;
    cv_item(p, i0, c0); cv_load(c0, v0, s0, lane);
    if (i1 < hi) { cv_item(p, i1, c1); cv_load(c1, v1, s1, lane); }
    for (;;) {
        const int i2 = CV_NEXT();
        if (i2 < hi) { cv_item(p, i2, c2); cv_load(c2, v2, s2, lane); }
        cv_emit(c0, v0, s0, scr, lane);
        if (i1 >= hi) break;
        c0 = c1; c1 = c2; i1 = i2;
#pragma unroll
        for (int i = 0; i < 8; ++i) { v0[i] = v1[i]; v1[i] = v2[i]; s0[i] = s1[i]; s1[i] = s2[i]; }
    }
}
__device__ __forceinline__ void p5_convert(const Params& p, LAS float* scr, int lane) { cv_queue<16>(p, scr, lane, (unsigned*)(p.ws + WS_CTL) + CW_CVCTR, CV_B, CV_C); }
__device__ __forceinline__ void cv_tail(const Params& p, LAS unsigned char* lds, int wave, int lane, int cw, int lo, int n) {
    const int x = (int)blockIdx.x & 7, per = n >> 3; cv_queue<8>(p, (LAS float*)lds, lane, (unsigned*)(p.ws + WS_CTL) + cw + x * 32, lo + x * per, lo + (x + 1) * per); }
#undef CV_NEXT
__device__ __forceinline__ void p0_prologue(const Params& p, LAS unsigned char* lds, int wave, int lane) {
    unsigned char* ws = p.ws;
    LAS float* scr = (LAS float*)(lds + wave * 16640);
    const int gw = blockIdx.x * NWAVES + wave;
    bf16_t* WinT = (bf16_t*)(ws + WS_WINT); bf16_t* WoutT = (bf16_t*)(ws + WS_WOUTT); bf16_t* WgluT = (bf16_t*)(ws + WS_WGLUT);
    constexpr int I_IN = 16 * 36, I_OUT = 16 * 16, I_GLU = 8 * 8, NITEMS = I_IN + I_OUT + I_GLU;
    for (int it = gw; it < NITEMS; it += NGW) {
        int r = it;
        if (r < I_IN) { const int kb = r / 36, nb = r % 36; tr_item(p.in[I_WIN], DIN, kb * 64, nb * 64, WinT, DM, KsVec{p.in[I_N1G]}, RmId{0}, scr, lane); continue; } r -= I_IN;
        if (r < I_OUT) { const int kb = r >> 4, nb = r & 15; tr_item(p.in[I_WOUT], DM, kb * 64, nb * 64, WoutT, DM, KsOut{p.in[I_BETA]}, RmId{0}, scr, lane); continue; } r -= I_OUT;
        { const int kb = r >> 3, nb = r & 7; tr_item(p.in[I_WGLU], DSSM, kb * 64, nb * 64, WgluT, DSSM, KsOne{}, RmId{0}, scr, lane); }
    }
    { const float* x = p.in[I_X]; bf16_t* xb = (bf16_t*)(ws + WS_XB); float* rs = (float*)(ws + WS_RSTD1);
      for (int m = gw; m < NTOK; m += NGW) { const f32x4* xr = (const f32x4*)(x + (size_t)m * DM) + lane; f32x4 v[4]; float s = 0.f;
#pragma unroll
          for (int j = 0; j < 4; ++j) { v[j] = xr[64 * j]; s += (v[j][0] * v[j][0] + v[j][1] * v[j][1]) + (v[j][2] * v[j][2] + v[j][3] * v[j][3]); }
          s = wave_sum(s); if (lane == 0) rs[m] = 1.0f / sqrtf(s * (1.0f / DM) + 1e-5f);
          u32x2* o8 = (u32x2*)(xb + (size_t)m * DM) + lane;
#pragma unroll
          for (int j = 0; j < 4; ++j) { u32x2 w; w.x = cvt_pk_bf16(v[j][0], v[j][1]); w.y = cvt_pk_bf16(v[j][2], v[j][3]); o8[64 * j] = w; } } }
    const int gt = blockIdx.x * (NWAVES * 64) + wave * 64 + lane, NT_ = GRID * NWAVES * 64;
    { float* b1g = (float*)(ws + WS_B1G); float* b1l = (float*)(ws + WS_B1L); const float* b1 = p.in[I_B1];
      for (int i = gt; i < NE * DFF; i += NT_) { const int e = i >> 10, o = i & 1023; b1g[i] = b1[e * 2048 + 2 * o]; b1l[i] = b1[e * 2048 + 2 * o + 1]; } }
    { bf16_t* rwh = (bf16_t*)(ws + WS_RWP); bf16_t* rwl = rwh + NE * DM; const float* rw = p.in[I_RW]; const float* g2 = p.in[I_N2G];
      for (int i = gt; i < DM * NE; i += NT_) { const int e = i >> 10, k = i & 1023; const float v = g2[k] * rw[k * NE + e]; const bf16_t h = f2bf(v); rwh[i] = h; rwl[i] = f2bf(v - bf2f(h)); } }
    { bf16_t* LB = (bf16_t*)(ws + WS_LORAB); const float* wup = p.in[I_WUP]; const float* aup = p.in[I_AUP]; const float* gup = p.in[I_GUP];
      for (int i = gt; i < 1536 * 256; i += NT_) { const int n = i >> 8, k = i & 255; float v = 0.f;
          if (n < 512) { if (k < 64) v = wup[k * 512 + n]; } else if (n < 1024) { if (k >= 64 && k < 128) v = aup[(k - 64) * 512 + (n - 512)]; } else { if (k >= 128) v = gup[(k - 128) * 512 + (n - 1024)]; }
          LB[i] = f2bf(v); } }
}
__device__ __forceinline__ void p2_lora_in(const Params& p, int wave, int lane) {
    const bf16_t* proj = (const bf16_t*)(p.ws + WS_PROJ); bf16_t* li = (bf16_t*)(p.ws + WS_LORAIN); const float* mu = p.in[I_MU] + COL_LORA;
    const int gt = blockIdx.x * (NWAVES * 64) + wave * 64 + lane, NT_ = GRID * NWAVES * 64;
    for (int idx = gt; idx < NTOK * 32; idx += NT_) { const int tok = idx >> 5, c = (idx & 31) * 8;
        const bf16_t* pr = proj + (size_t)tok * DIN + COL_LORA + c; const u32x4 cur = *(const u32x4*)pr; u32x4 prv = (u32x4){0u, 0u, 0u, 0u}; if (tok & (SEQ - 1)) prv = *(const u32x4*)(pr - DIN);
        float v[8], q[8];
        v[0] = bflo(cur.x); v[1] = bfhi(cur.x); v[2] = bflo(cur.y); v[3] = bfhi(cur.y); v[4] = bflo(cur.z); v[5] = bfhi(cur.z); v[6] = bflo(cur.w); v[7] = bfhi(cur.w);
        q[0] = bflo(prv.x); q[1] = bfhi(prv.x); q[2] = bflo(prv.y); q[3] = bfhi(prv.y); q[4] = bflo(prv.z); q[5] = bfhi(prv.z); q[6] = bflo(prv.w); q[7] = bfhi(prv.w);
#pragma unroll
        for (int j = 0; j < 8; ++j) { float s = v[j] + mu[c + j] * (q[j] - v[j]); if (c < 64) s = tanhf(s); else if (c >= 128) s = sigmoidf_(s); v[j] = s; }
        u32x4 w; w.x = cvt_pk_bf16(v[0], v[1]); w.y = cvt_pk_bf16(v[2], v[3]); w.z = cvt_pk_bf16(v[4], v[5]); w.w = cvt_pk_bf16(v[6], v[7]);
        *(u32x4*)(li + (size_t)tok * 256 + c) = w; }
}
template <int CTRL> __device__ __forceinline__ float dpp_mov(float x) { return __int_as_float(__builtin_amdgcn_update_dpp(0, __float_as_int(x), CTRL, 0xF, 0xF, true)); }
__device__ __forceinline__ float sum8(float x) { x += dpp_mov<0xB1>(x); x += dpp_mov<0x4E>(x); x += dpp_mov<0x141>(x); return x; }
__device__ __forceinline__ float rowsum16(float x) { x = sum8(x); x += dpp_mov<0x140>(x); return x; }
__device__ __forceinline__ void unpack8(const u32x4 w, float (&f)[8]) { f[0] = bflo(w.x); f[1] = bfhi(w.x); f[2] = bflo(w.y); f[3] = bfhi(w.y); f[4] = bflo(w.z); f[5] = bfhi(w.z); f[6] = bflo(w.w); f[7] = bfhi(w.w); }
__device__ __forceinline__ void ld8(const float* p_, float (&f)[8]) { const f32x4 a = *(const f32x4*)p_, b = *(const f32x4*)(p_ + 4); f[0] = a[0]; f[1] = a[1]; f[2] = a[2]; f[3] = a[3]; f[4] = b[0]; f[5] = b[1]; f[6] = b[2]; f[7] = b[3]; }
__device__ __forceinline__ float gelu_tanh(float y) { const float t = 0.7978845608028654f * (y + 0.044715f * y * y * y); return y * sigmoidf_(2.0f * t); }
#define S5_ROLE(w, s) ((w) & 3)
#if !defined(S5_MAP)
#define S5_MAP 0
#endif
#if S5_MAP == 0
#define S5_SQ(w) ((w) >> 2)
#define S5_WQ(w) ((w) & 3)
#elif S5_MAP == 1
#define S5_SQ(w) (1 - ((w) >> 2))
#define S5_WQ(w) ((w) & 3)
#elif S5_MAP == 4
#define S5_SQ(w) ((w) >> 2)
#define S5_WQ(w) (((w) & 3) ^ ((w) >> 2))
#elif S5_MAP == 2
#define S5_SQ(w) ((w) >> 2)
#define S5_WQ(w) (3 - ((w) & 3))
#else
#define S5_SQ(w) ((w) & 1)
#define S5_WQ(w) ((w) >> 1)
#endif
#ifdef S5_DELAY_ROLE
#define S5_DELAY(w) do { if ((w) == S5_DELAY_ROLE) __builtin_amdgcn_s_sleep(4); } while (0)
#else
#define S5_DELAY(w) do { } while (0)
#endif
#ifdef S5_SYNC
#define S5_BARRIER() __syncthreads()
#else
#define S5_BARRIER() lds_barrier()
#endif
constexpr int S5_T = 32, S5_NT = SEQ / S5_T, S5_BU = S5_T * 64 * 8, S5_ST = S5_T * 272, S5_SEQB = 2 * S5_BU + 2 * S5_ST;
__device__ __forceinline__ void p5_s5(const Params& p, LAS unsigned char* lds, int wave, int lane, const int vf = 0) {
    const int sq = S5_SQ(wave), wq = S5_WQ(wave), q = (blockIdx.x - 128) * 2 + sq, b = q >> 5, g = q & 31;
    LAS unsigned char* L = lds + sq * 51200;
    const float dt = expf(p.in[I_LSTEP][g]);
    const bf16_t* ubase = (const bf16_t*)(p.ws + WS_PROJ) + (size_t)b * SEQ * DIN + COL_U + g * 16;
    bf16_t* yg = (bf16_t*)(p.ws + WS_YGELU) + (size_t)b * SEQ * DSSM + g * 16;
    f32x2 l1 = (f32x2){0.f, 0.f}, l2 = (f32x2){0.f, 0.f}, sv = (f32x2){0.f, 0.f};
    bf16x8 Bop[4], Bout[4], Dop; bf16x8 An[8], Un[8];
    const u32x4 z4 = (u32x4){0u, 0u, 0u, 0u};
    Dop = __builtin_bit_cast(bf16x8, z4);
#pragma unroll
    for (int k = 0; k < 4; ++k) Bop[k] = Bout[k] = __builtin_bit_cast(bf16x8, z4);
#pragma unroll
    for (int k = 0; k < 8; ++k) An[k] = Un[k] = __builtin_bit_cast(bf16x8, z4);
    const int rt3 = wq - 1;
    if (wq == 0) { const float lre = fminf(p.in[I_LRE][g * 64 + lane], -1e-4f), lim = p.in[I_LIM][g * 64 + lane]; const float mag = expf(lre * dt), ang = lim * dt; const float lbr = mag * cosf(ang), lbi = mag * sinf(ang);
        l1 = (f32x2){lbr, lbr}; l2 = (f32x2){-lbi, lbi}; }
    else if (wq == 3) {
#pragma unroll
        for (int ct = 0; ct < 4; ++ct) { const int c = 32 * ct + (lane & 31), pp = c & 63, isim = c >> 6; const float lre = fminf(p.in[I_LRE][g * 64 + pp], -1e-4f), lim = p.in[I_LIM][g * 64 + pp];
            const float mag = expf(lre * dt), ang = lim * dt, cr = mag * cosf(ang), ci = mag * sinf(ang), den = lre * lre + lim * lim, nre = cr - 1.0f;
            const float zre = (nre * lre + ci * lim) / den, zim = (ci * lre - nre * lim) / den;
            const float* bre = p.in[I_BRE] + (size_t)(g * 64 + pp) * 16 + 8 * (lane >> 5); const float* bim = p.in[I_BIM] + (size_t)(g * 64 + pp) * 16 + 8 * (lane >> 5);
            float t[8];
#pragma unroll
            for (int jj = 0; jj < 8; ++jj) t[jj] = isim ? (zre * bim[jj] + zim * bre[jj]) : (zre * bre[jj] - zim * bim[jj]);
            u32x4 w; w.x = cvt_pk_bf16(t[0], t[1]); w.y = cvt_pk_bf16(t[2], t[3]); w.z = cvt_pk_bf16(t[4], t[5]); w.w = cvt_pk_bf16(t[6], t[7]); Bop[ct] = __builtin_bit_cast(bf16x8, w); }
#pragma unroll
        for (int k = 0; k < 8; ++k) An[k] = *(const bf16x8*)(ubase + (size_t)(k * S5_T + (lane & 31)) * DIN + 8 * (lane >> 5)); }
    else { const int m = lane & 15;
#pragma unroll
        for (int ks = 0; ks < 4; ++ks) { float t[8];
#pragma unroll
            for (int jj = 0; jj < 8; ++jj) { const int k = 32 * ks + 8 * (lane >> 4) + jj, pp = k >> 1; t[jj] = (k & 1) ? -p.in[I_CIM][(size_t)(g * 16 + m) * 64 + pp] : p.in[I_CRE][(size_t)(g * 16 + m) * 64 + pp]; }
            u32x4 w; w.x = cvt_pk_bf16(t[0], t[1]); w.y = cvt_pk_bf16(t[2], t[3]); w.z = cvt_pk_bf16(t[4], t[5]); w.w = cvt_pk_bf16(t[6], t[7]); Bout[ks] = __builtin_bit_cast(bf16x8, w); }
        { const float dsk = p.in[I_DSKIP][g * 16 + m]; float t[8];
#pragma unroll
          for (int jj = 0; jj < 8; ++jj) t[jj] = (8 * (lane >> 4) + jj == m) ? dsk : 0.f;
          u32x4 w; w.x = cvt_pk_bf16(t[0], t[1]); w.y = cvt_pk_bf16(t[2], t[3]); w.z = cvt_pk_bf16(t[4], t[5]); w.w = cvt_pk_bf16(t[6], t[7]); Dop = __builtin_bit_cast(bf16x8, w); }
        if (lane < 32) {
#pragma unroll
            for (int k = 0; k < 8; ++k) Un[k] = *(const bf16x8*)(ubase + (size_t)(k * S5_T + 16 * rt3 + (lane & 15)) * DIN + 8 * (lane >> 4)); } }
    const f32x16 z16 = {0.f, 0.f, 0.f, 0.f, 0.f, 0.f, 0.f, 0.f, 0.f, 0.f, 0.f, 0.f, 0.f, 0.f, 0.f, 0.f};
#ifdef PROBE_S5
#define S5_SKIP(b) if (vf & (b)) break;
#else
#define S5_SKIP(b)
#endif
#define S5_STAGE1(tileidx, sl) do { S5_SKIP(4) LAS float* bu_ = (LAS float*)(L + ((tileidx) & 1) * S5_BU); \
        _Pragma("unroll") for (int hh = 0; hh < 2; ++hh) { const f32x16 dre = __builtin_amdgcn_mfma_f32_32x32x16_bf16(An[sl], Bop[hh], z16, 0, 0, 0), dim = __builtin_amdgcn_mfma_f32_32x32x16_bf16(An[sl], Bop[hh + 2], z16, 0, 0, 0); const int pp = 32 * hh + (lane & 31); \
            _Pragma("unroll") for (int r = 0; r < 16; ++r) { const int rw = (r & 3) + 8 * (r >> 2) + 4 * (lane >> 5); *(LAS f32x2*)(bu_ + (rw * 64 + pp) * 2) = (f32x2){dre[r], dim[r]}; } }     \
        } while (0)
#define S5_LD1(sl, t) do { const int tn_ = (t) < S5_NT ? (t) : S5_NT - 1; An[sl] = *(const bf16x8*)(ubase + (size_t)(tn_ * S5_T + (lane & 31)) * DIN + 8 * (lane >> 5)); } while (0)
#define S5_STAGE3(tileidx, sl) do { S5_SKIP(8) const LAS unsigned char* st_ = L + 2 * S5_BU + ((tileidx) & 1) * S5_ST; \
        f32x4 acc = __builtin_amdgcn_mfma_f32_16x16x32_bf16(Un[sl], Dop, (f32x4){0.f, 0.f, 0.f, 0.f}, 0, 0, 0); \
        _Pragma("unroll") for (int ks = 0; ks < 4; ++ks) { const bf16x8 a = *(const LAS bf16x8*)(st_ + (16 * rt3 + (lane & 15)) * 272 + (32 * ks + 8 * (lane >> 4)) * 2); acc = __builtin_amdgcn_mfma_f32_16x16x32_bf16(a, Bout[ks], acc, 0, 0, 0); } \
        _Pragma("unroll") for (int r = 0; r < 4; ++r) { const int tok = (tileidx) * S5_T + 16 * rt3 + 4 * (lane >> 4) + r; yg[(size_t)tok * DSSM + (lane & 15)] = f2bf(gelu_tanh(acc[r])); } } while (0)
#define S5_LD3(sl, t) do { const int tn_ = (t) < S5_NT ? (t) : S5_NT - 1; if (lane < 32) Un[sl] = *(const bf16x8*)(ubase + (size_t)(tn_ * S5_T + 16 * rt3 + (lane & 15)) * DIN + 8 * (lane >> 4)); } while (0)
#define S5_SCAN(ii) do { S5_SKIP(16) const LAS float* bu_ = (const LAS float*)(L + ((ii) & 1) * S5_BU); LAS unsigned char* st_ = L + 2 * S5_BU + ((ii) & 1) * S5_ST; \
            f32x2 xa[16], xb[16];     \
            _Pragma("unroll") for (int t = 0; t < 16; ++t) xa[t] = *(const LAS f32x2*)(bu_ + (t * 64 + lane) * 2); \
            __builtin_amdgcn_sched_barrier(0); \
            _Pragma("unroll") for (int t = 0; t < 8; ++t) { const f32x2 t1 = l1 * sv + xa[t]; const f32x2 sw = __builtin_shufflevector(sv, sv, 1, 0); sv = l2 * sw + t1; *(LAS unsigned*)(st_ + t * 272 + lane * 4) = cvt_pk_bf16(sv.x, sv.y); } \
            __builtin_amdgcn_sched_barrier(0); \
            _Pragma("unroll") for (int t = 0; t < 16; ++t) xb[t] = *(const LAS f32x2*)(bu_ + ((16 + t) * 64 + lane) * 2); \
            __builtin_amdgcn_sched_barrier(0); \
            _Pragma("unroll") for (int t = 8; t < 16; ++t) { const f32x2 t1 = l1 * sv + xa[t]; const f32x2 sw = __builtin_shufflevector(sv, sv, 1, 0); sv = l2 * sw + t1; *(LAS unsigned*)(st_ + t * 272 + lane * 4) = cvt_pk_bf16(sv.x, sv.y); } \
            _Pragma("unroll") for (int t = 0; t < 16; ++t) { const f32x2 t1 = l1 * sv + xb[t]; const f32x2 sw = __builtin_shufflevector(sv, sv, 1, 0); sv = l2 * sw + t1; *(LAS unsigned*)(st_ + (16 + t) * 272 + lane * 4) = cvt_pk_bf16(sv.x, sv.y); } } while (0)
    if (wq == 3) S5_STAGE1(0, 0);
    S5_BARRIER();
#define BAR_ S5_BARRIER()
    if (wq == 0) { for (int i = 0; i < S5_NT; ++i) { S5_SCAN(i); BAR_; } }
    else if (wq == 3) {
        for (int t0 = 0; t0 < S5_NT - 8; t0 += 8) {
            S5_STAGE1(t0 + 1, 1); BAR_; S5_STAGE1(t0 + 2, 2); BAR_;
            S5_LD1(6, t0 + 6); S5_LD1(7, t0 + 7); S5_LD1(0, t0 + 8); S5_LD1(1, t0 + 9); S5_LD1(2, t0 + 10);
            S5_STAGE1(t0 + 3, 3); BAR_; S5_STAGE1(t0 + 4, 4); BAR_; S5_STAGE1(t0 + 5, 5); BAR_;
            S5_LD1(3, t0 + 11); S5_LD1(4, t0 + 12); S5_LD1(5, t0 + 13);
            S5_STAGE1(t0 + 6, 6); BAR_; S5_STAGE1(t0 + 7, 7); BAR_; S5_STAGE1(t0 + 8, 0); BAR_; }
        { constexpr int t0 = S5_NT - 8;
            S5_STAGE1(t0 + 1, 1); BAR_; S5_STAGE1(t0 + 2, 2); BAR_; S5_LD1(6, t0 + 6); S5_LD1(7, t0 + 7);
            S5_STAGE1(t0 + 3, 3); BAR_; S5_STAGE1(t0 + 4, 4); BAR_; S5_STAGE1(t0 + 5, 5); BAR_; S5_STAGE1(t0 + 6, 6); BAR_; S5_STAGE1(t0 + 7, 7); BAR_; BAR_; } }
    else {
        BAR_;
        for (int t0 = 0; t0 < S5_NT - 8; t0 += 8) {
            S5_STAGE3(t0, 0); BAR_; S5_STAGE3(t0 + 1, 1); BAR_;
            S5_LD3(5, t0 + 5); S5_LD3(6, t0 + 6); S5_LD3(7, t0 + 7); S5_LD3(0, t0 + 8); S5_LD3(1, t0 + 9);
            S5_STAGE3(t0 + 2, 2); BAR_; S5_STAGE3(t0 + 3, 3); BAR_; S5_STAGE3(t0 + 4, 4); BAR_;
            S5_LD3(2, t0 + 10); S5_LD3(3, t0 + 11); S5_LD3(4, t0 + 12);
            S5_STAGE3(t0 + 5, 5); BAR_; S5_STAGE3(t0 + 6, 6); BAR_; S5_STAGE3(t0 + 7, 7); BAR_; }
        { constexpr int t0 = S5_NT - 8;
            S5_STAGE3(t0, 0); BAR_; S5_STAGE3(t0 + 1, 1); BAR_; S5_LD3(5, t0 + 5); S5_LD3(6, t0 + 6); S5_LD3(7, t0 + 7);
            S5_STAGE3(t0 + 2, 2); BAR_; S5_STAGE3(t0 + 3, 3); BAR_; S5_STAGE3(t0 + 4, 4); BAR_; S5_STAGE3(t0 + 5, 5); BAR_; S5_STAGE3(t0 + 6, 6); BAR_; S5_STAGE3(t0 + 7, 7); } }
#undef BAR_
#undef S5_LD1
#undef S5_LD3
#undef S5_SCAN
#undef S5_ITER
#undef S5_STAGE1
#undef S5_STAGE3
}
struct P7In { f32x4 s0, s1; float rk; u32x4 yr, yg, cv, qv, gg; };
__device__ __forceinline__ void p7_load(P7In& in, const bf16_t* yraw, const bf16_t* proj, const float* rkb, const bf16_t* lg, const bf16_t* yglu, const float* ssq, int tok, int lane) {
    const int c0 = lane * 8, h = lane >> 3;
    in.yr = *(const u32x4*)(yraw + (size_t)tok * DR + c0);
    { const bf16_t* pv = proj + (size_t)tok * DIN + COL_V + c0; in.cv = *(const u32x4*)pv; in.qv = (tok & (SEQ - 1)) ? *(const u32x4*)(pv - DIN) : (u32x4){0u, 0u, 0u, 0u}; in.rk = rkb[(size_t)tok * NH + h]; }
    in.gg = *(const u32x4*)(lg + (size_t)tok * DR + c0);
    in.s0 = *(const f32x4*)(ssq + (size_t)tok * 8); in.s1 = *(const f32x4*)(ssq + (size_t)tok * 8 + 4);
    in.yg = *(const u32x4*)(yglu + (size_t)tok * DSSM + c0);
}
__device__ __forceinline__ void p7_mix(const Params& p, int wave, int lane) {
    const bf16_t* yraw = (const bf16_t*)(p.ws + WS_YRAW); const bf16_t* proj = (const bf16_t*)(p.ws + WS_PROJ); const float* rkb = (const float*)(p.ws + WS_RKB); const bf16_t* lg = (const bf16_t*)(p.ws + WS_LORAG); bf16_t* mixed = (bf16_t*)(p.ws + WS_MIXED);
    const bf16_t* yglu = (const bf16_t*)(p.ws + WS_YGLU); const float* ssq = (const float*)(p.ws + WS_SSQ);
    const int c0 = lane * 8;
    float lnw[8], lnb[8], muv[8]; ld8(p.in[I_LNW] + c0, lnw); ld8(p.in[I_LNB] + c0, lnb); ld8(p.in[I_MU] + COL_V + c0, muv);
    const int gw = blockIdx.x * NWAVES + wave;
    P7In cur, nxt; p7_load(cur, yraw, proj, rkb, lg, yglu, ssq, gw, lane);
    for (int tok = gw; tok < NTOK; tok += NGW) {
        if (tok + NGW < NTOK) p7_load(nxt, yraw, proj, rkb, lg, yglu, ssq, tok + NGW, lane);
        float y[8], v[8], g[8], o[8], cvv[8], qvv[8]; unpack8(cur.cv, cvv); unpack8(cur.qv, qvv); unpack8(cur.gg, g); unpack8(cur.yr, y);
#pragma unroll
        for (int j = 0; j < 8; ++j) v[j] = cvv[j] + muv[j] * (qvv[j] - cvv[j]);
        float sm = 0.f;
#pragma unroll
        for (int j = 0; j < 8; ++j) sm += y[j];
        const float mu = sum8(sm) * (1.0f / 64.0f); float sq = 0.f;
#pragma unroll
        for (int j = 0; j < 8; ++j) { y[j] -= mu; sq += y[j] * y[j]; }
        const float rstd = 1.0f / sqrtf(sum8(sq) * (1.0f / 64.0f) + 64e-5f);
#pragma unroll
        for (int j = 0; j < 8; ++j) { o[j] = (y[j] * rstd * lnw[j] + lnb[j] + cur.rk * v[j]) * g[j];
#ifdef SCRUB7
            o[j] = (o[j] == o[j] && fabsf(o[j]) < 1e30f) ? o[j] : 0.f;
#endif
        }
        u32x4 w; w.x = cvt_pk_bf16(o[0], o[1]); w.y = cvt_pk_bf16(o[2], o[3]); w.z = cvt_pk_bf16(o[4], o[5]); w.w = cvt_pk_bf16(o[6], o[7]);
        *(u32x4*)(mixed + (size_t)tok * DM + c0) = w;
        const float ss = ((cur.s0[0] + cur.s0[1]) + (cur.s0[2] + cur.s0[3])) + ((cur.s1[0] + cur.s1[1]) + (cur.s1[2] + cur.s1[3])); const float rs = 1.0f / sqrtf(ss * (1.0f / DSSM) + 1e-5f);
        float yv[8]; unpack8(cur.yg, yv);
        u32x4 w2; w2.x = cvt_pk_bf16(yv[0] * rs, yv[1] * rs); w2.y = cvt_pk_bf16(yv[2] * rs, yv[3] * rs); w2.z = cvt_pk_bf16(yv[4] * rs, yv[5] * rs); w2.w = cvt_pk_bf16(yv[6] * rs, yv[7] * rs);
        *(u32x4*)(mixed + (size_t)tok * DM + DR + c0) = w2;
        cur = nxt;
    }
}
constexpr int CT = 72;
constexpr int SLOT = 64 * CT * 2;
constexpr int SL_AH = 0, SL_BH = 1, SL_KH = 2, SL_RH = 3, SL_AHT = 4, SL_BTT = 5, SL_KTT = 6, SL_VT = 7, SL_PA = 8, SL_PAT = 9, SL_TA = 10, SL_AAK = 11, SL_ARB = 12, SL_ARK = 13, SL_XT = 14, SL_UVT = 15;
constexpr int SL_PB = 0, SL_PBT = 1, SL_TB = 2, SL_WT = 11;
constexpr int LC_OFF = SL_PA * SLOT, TOT_OFF = LC_OFF + 64 * 64 * 4;
constexpr int GT_OFF = 16 * SLOT;
constexpr int PC_OFF = GT_OFF + 256;
__device__ __forceinline__ LAS bf16_t* slot(LAS unsigned char* lds, int s) { return (LAS bf16_t*)(lds + s * SLOT); }
template <bool TR> __device__ __forceinline__ void mm2(const LAS bf16_t* X, const LAS bf16_t* YT, int mi, int ni0, int lane, f32x4 (&acc)[2]) {
    const int fr = lane & 15, fq = lane >> 4;
#pragma unroll
    for (int ks = 0; ks < 2; ++ks) { const bf16x8 a = *(const LAS bf16x8*)(X + (16 * mi + fr) * CT + 32 * ks + 8 * fq);
#pragma unroll
        for (int t = 0; t < 2; ++t) { const bf16x8 b = *(const LAS bf16x8*)(YT + (16 * (ni0 + t) + fr) * CT + 32 * ks + 8 * fq);
            acc[t] = TR ? __builtin_amdgcn_mfma_f32_16x16x32_bf16(a, b, acc[t], 0, 0, 0) : __builtin_amdgcn_mfma_f32_16x16x32_bf16(b, a, acc[t], 0, 0, 0); } }
}
__device__ __forceinline__ void ldA(const LAS bf16_t* X, int mi, int lane, bf16x8 (&a)[2]) {
#pragma unroll
    for (int ks = 0; ks < 2; ++ks) a[ks] = *(const LAS bf16x8*)(X + (16 * mi + (lane & 15)) * CT + 32 * ks + 8 * (lane >> 4)); }
__device__ __forceinline__ void ldB(const LAS bf16_t* YT, int ni0, int lane, bf16x8 (&b)[2][2]) {
#pragma unroll
    for (int t = 0; t < 2; ++t)
#pragma unroll
        for (int ks = 0; ks < 2; ++ks) b[t][ks] = *(const LAS bf16x8*)(YT + (16 * (ni0 + t) + (lane & 15)) * CT + 32 * ks + 8 * (lane >> 4)); }
template <bool TR> __device__ __forceinline__ void mma(const bf16x8 (&a)[2], const bf16x8 (&b)[2][2], f32x4 (&acc)[2]) {
#pragma unroll
    for (int ks = 0; ks < 2; ++ks)
#pragma unroll
        for (int t = 0; t < 2; ++t) acc[t] = TR ? __builtin_amdgcn_mfma_f32_16x16x32_bf16(a[ks], b[t][ks], acc[t], 0, 0, 0) : __builtin_amdgcn_mfma_f32_16x16x32_bf16(b[t][ks], a[ks], acc[t], 0, 0, 0); }
#define ZACC(x) x[0] = x[1] = (f32x4){0.f, 0.f, 0.f, 0.f}
__device__ __forceinline__ void st_rm(LAS bf16_t* Z, int mi, int ni, int lane, const f32x4 v) { u32x2 w; w.x = cvt_pk_bf16(v[0], v[1]); w.y = cvt_pk_bf16(v[2], v[3]); *(LAS u32x2*)(Z + (16 * mi + (lane & 15)) * CT + 16 * ni + 4 * (lane >> 4)) = w; }
__device__ __forceinline__ void st_tr(LAS bf16_t* ZT, int mi, int ni, int lane, const f32x4 v) {
#pragma unroll
    for (int r = 0; r < 4; ++r) ZT[(16 * ni + 4 * (lane >> 4) + r) * CT + 16 * mi + (lane & 15)] = f2bf(v[r]); }
__device__ __forceinline__ void st_trT(LAS bf16_t* ZT, int mi, int ni, int lane, const f32x4 v) { u32x2 w; w.x = cvt_pk_bf16(v[0], v[1]); w.y = cvt_pk_bf16(v[2], v[3]); *(LAS u32x2*)(ZT + (16 * ni + (lane & 15)) * CT + 16 * mi + 4 * (lane >> 4)) = w; }
__device__ __forceinline__ void ld8l(const LAS float* s, float (&d)[8]) { const f32x4 a = *(const LAS f32x4*)s, b = *(const LAS f32x4*)(s + 4); d[0] = a[0]; d[1] = a[1]; d[2] = a[2]; d[3] = a[3]; d[4] = b[0]; d[5] = b[1]; d[6] = b[2]; d[7] = b[3]; }
struct PaIn { u32x4 cr, ck, cv, qr, qk, qv, ap; float lwr[8]; };
__device__ __forceinline__ void pa_load(PaIn& in, const bf16_t* proj, const bf16_t* la, const float* lw, int job, int wave, int lane) {
    const int bh = job >> 6, c = job & 63, b = bh >> 3, h = bh & 7; const int tok0 = b * SEQ + c * 64;
    { const int t = wave * 8 + (lane >> 3), cg = lane & 7, tok = tok0 + t; const bf16_t* row = proj + (size_t)tok * DIN + h * HD + cg * 8; const bool first = (c == 0 && t == 0); const u32x4 z = (u32x4){0u, 0u, 0u, 0u};
      in.cr = *(const u32x4*)row; in.ck = *(const u32x4*)(row + COL_K); in.cv = *(const u32x4*)(row + COL_V);
      in.qr = first ? z : *(const u32x4*)(row - DIN); in.qk = first ? z : *(const u32x4*)(row - DIN + COL_K); in.qv = first ? z : *(const u32x4*)(row - DIN + COL_V);
      in.ap = *(const u32x4*)(la + (size_t)tok * DR + h * HD + cg * 8); }
#pragma unroll
    for (int i = 0; i < 8; ++i) in.lwr[i] = lw[(size_t)(tok0 + wave * 8 + i) * DR + h * HD + lane];
}
__device__ __forceinline__ float logdecay(float x) { const float z = -x; const float sp = fmaxf(z, 0.f) + __logf(1.0f + __expf(-fabsf(z))); return -__expf(-sp - 0.5f); }
__device__ __forceinline__ void p4_chunks(const Params& p, LAS unsigned char* lds, int wave, int lane, const int vflags) {
    const bf16_t* proj = (const bf16_t*)(p.ws + WS_PROJ); const float* lwp = (const float*)(p.ws + WS_LORAW); const bf16_t* lap = (const bf16_t*)(p.ws + WS_LORAA);
    bf16_t* QP = (bf16_t*)(p.ws + WS_QP); bf16_t* YG = (bf16_t*)(p.ws + WS_YG); float* rkb = (float*)(p.ws + WS_RKB);
    LAS float* lct = (LAS float*)(lds + LC_OFF); LAS float* tot = (LAS float*)(lds + TOT_OFF); LAS float* gtab = (LAS float*)(lds + GT_OFF); LAS bf16_t* ewt = slot(lds, SL_TA);
    const int mi = wave >> 1, ni0 = (wave & 1) * 2, fr = lane & 15, fq = lane >> 4;
    PaIn in; pa_load(in, proj, lap, lwp, blockIdx.x, wave, lane);
    bf16x8 aI[2];
    { const int m = 16 * (wave >> 1) + (lane & 15);
#pragma unroll
      for (int ks = 0; ks < 2; ++ks) { u32x4 w = (u32x4){0u, 0u, 0u, 0u}; const int e = m - 32 * ks - 8 * (lane >> 4);
          if (e >= 0 && e < 8) { const unsigned one = (e & 1) ? 0x3F800000u : 0x00003F80u; if ((e >> 1) == 0) w.x = one; else if ((e >> 1) == 1) w.y = one; else if ((e >> 1) == 2) w.z = one; else w.w = one; }
          aI[ks] = __builtin_bit_cast(bf16x8, w); } }
    LAS float* pcs = (LAS float*)(lds + PC_OFF);
    { const int tid = wave * 64 + lane;
#pragma unroll
      for (int q = 0; q < 2; ++q) { const int e = tid + q * 512, hs = e >> 9, ar = (e >> 6) & 7, k = e & 63, hh = (int)(blockIdx.x >> 6) + 4 * hs, col = hh * HD + k;
          const float* src = ar == 0 ? p.in[I_W0] + col : ar == 1 ? p.in[I_MU] + col : ar == 2 ? p.in[I_MU] + COL_K + col : ar == 3 ? p.in[I_MU] + COL_V + col : ar == 4 ? p.in[I_KK] + col : ar == 5 ? p.in[I_KA] + col : ar == 6 ? p.in[I_RK] + col : p.in[I_A0] + col;
          pcs[e] = *src; } }
    lds_barrier();
    for (int job = blockIdx.x; job < 64 * 64; job += GRID) {
        const int bh = job >> 6, c = job & 63, b = bh >> 3, h = bh & 7; const int tok0 = b * SEQ + c * 64;
        const LAS float* pch = pcs + (h >> 2) * 512;
        { const float w0k = pch[lane]; float pre[8]; float run = 0.f;
#pragma unroll
          for (int i = 0; i < 8; ++i) { const float lw_ = logdecay(w0k + in.lwr[i]); run += lw_; pre[i] = run; ewt[(wave * 8 + i) * 64 + lane] = f2bf(__expf(-lw_)); }
          tot[wave * 64 + lane] = run;
          lds_barrier();
          float off = 0.f;
#pragma unroll
          for (int w2 = 0; w2 < 7; ++w2) off += (w2 < wave) ? tot[w2 * 64 + lane] : 0.f;
#pragma unroll
          for (int i = 0; i < 8; ++i) lct[(wave * 8 + i) * 64 + lane] = off + pre[i];
          if (wave == 7) gtab[lane] = __expf(off + pre[7]); }
        lds_barrier();
        { const int t = wave * 8 + (lane >> 3), cg = lane & 7, k0 = cg * 8, col = h * HD + k0;
          float cr[8], ck[8], cv[8], qr[8], qk[8], qv[8], lc[8], gc[8], mur[8], muk[8], muv[8], kkw[8], kaw[8], rkw[8], a0c[8];
          unpack8(in.cr, cr); unpack8(in.ck, ck); unpack8(in.cv, cv); unpack8(in.qr, qr); unpack8(in.qk, qk); unpack8(in.qv, qv);
          { const f32x4 x0 = *(const LAS f32x4*)(lct + t * 64 + k0), x1 = *(const LAS f32x4*)(lct + t * 64 + k0 + 4), g0 = *(const LAS f32x4*)(gtab + k0), g1 = *(const LAS f32x4*)(gtab + k0 + 4);
#pragma unroll
            for (int j = 0; j < 4; ++j) { lc[j] = x0[j]; lc[j + 4] = x1[j]; gc[j] = g0[j]; gc[j + 4] = g1[j]; } }
          ld8l(pch + 64 + k0, mur); ld8l(pch + 128 + k0, muk); ld8l(pch + 192 + k0, muv); ld8l(pch + 256 + k0, kkw); ld8l(pch + 320 + k0, kaw); ld8l(pch + 384 + k0, rkw); ld8l(pch + 448 + k0, a0c);
          float ah[8], bh_[8], kh[8], rh[8], bt[8], kt[8], vv[8], kk[8], ew[8], apv[8]; float n2 = 0.f, rk = 0.f; unpack8(in.ap, apv);
          unpack8(*(const LAS u32x4*)(ewt + t * 64 + k0), ew);
#pragma unroll
          for (int j = 0; j < 8; ++j) { const float r = cr[j] + mur[j] * (qr[j] - cr[j]), kraw = ck[j] + muk[j] * (qk[j] - ck[j]); vv[j] = cv[j] + muv[j] * (qv[j] - cv[j]);
              const float ap = apv[j];
              const float a = sigmoidf_(a0c[j] + ap);
              kk[j] = kraw * kkw[j]; n2 += kk[j] * kk[j]; const float km = kraw * (1.0f + (a - 1.0f) * kaw[j]); rk += r * km * rkw[j];
              const float e1 = __expf(lc[j]), e2 = __builtin_amdgcn_rcpf(e1), g = gc[j];
              rh[j] = r * e1; kh[j] = km * e2; kt[j] = kh[j] * g; ah[j] = -e1 * ew[j]; bh_[j] = a * e2; bt[j] = g; }
          n2 = sum8(n2); rk = sum8(rk);
          const float inv = 1.0f / fmaxf(sqrtf(n2), 1e-12f);
#pragma unroll
          for (int j = 0; j < 8; ++j) { const float kn = kk[j] * inv; ah[j] *= kn; bh_[j] *= kn; bt[j] *= bh_[j]; }
          if (cg == 0) rkb[(size_t)(tok0 + t) * NH + h] = rk;
          u32x4 w;
          w.x = cvt_pk_bf16(ah[0], ah[1]); w.y = cvt_pk_bf16(ah[2], ah[3]); w.z = cvt_pk_bf16(ah[4], ah[5]); w.w = cvt_pk_bf16(ah[6], ah[7]); *(LAS u32x4*)(slot(lds, SL_AH) + t * CT + k0) = w;
          w.x = cvt_pk_bf16(bh_[0], bh_[1]); w.y = cvt_pk_bf16(bh_[2], bh_[3]); w.z = cvt_pk_bf16(bh_[4], bh_[5]); w.w = cvt_pk_bf16(bh_[6], bh_[7]); *(LAS u32x4*)(slot(lds, SL_BH) + t * CT + k0) = w;
          w.x = cvt_pk_bf16(kh[0], kh[1]); w.y = cvt_pk_bf16(kh[2], kh[3]); w.z = cvt_pk_bf16(kh[4], kh[5]); w.w = cvt_pk_bf16(kh[6], kh[7]); *(LAS u32x4*)(slot(lds, SL_KH) + t * CT + k0) = w;
          w.x = cvt_pk_bf16(rh[0], rh[1]); w.y = cvt_pk_bf16(rh[2], rh[3]); w.z = cvt_pk_bf16(rh[4], rh[5]); w.w = cvt_pk_bf16(rh[6], rh[7]); *(LAS u32x4*)(slot(lds, SL_RH) + t * CT + k0) = w;
          w.x = cvt_pk_bf16(bt[0], bt[1]); w.y = cvt_pk_bf16(bt[2], bt[3]); w.z = cvt_pk_bf16(bt[4], bt[5]); w.w = cvt_pk_bf16(bt[6], bt[7]); *(LAS u32x4*)(slot(lds, SL_BTT) + t * CT + k0) = w;
          w.x = cvt_pk_bf16(kt[0], kt[1]); w.y = cvt_pk_bf16(kt[2], kt[3]); w.z = cvt_pk_bf16(kt[4], kt[5]); w.w = cvt_pk_bf16(kt[6], kt[7]); *(LAS u32x4*)(slot(lds, SL_KTT) + t * CT + k0) = w;
          w.x = cvt_pk_bf16(vv[0], vv[1]); w.y = cvt_pk_bf16(vv[2], vv[3]); w.z = cvt_pk_bf16(vv[4], vv[5]); w.w = cvt_pk_bf16(vv[6], vv[7]); *(LAS u32x4*)(slot(lds, SL_XT) + t * CT + k0) = w; }
        if (job + GRID < 64 * 64) pa_load(in, proj, lap, lwp, job + GRID, wave, lane);
        lds_barrier();
#ifdef PROBE_VPHASE
        if (vflags & 4) { lds_barrier(); continue; }
#endif
        f32x4 accT[2];
        { bf16x8 aA[2], aR[2], bB[2][2], bK[2][2]; ldA(slot(lds, SL_AH), mi, lane, aA); ldA(slot(lds, SL_RH), mi, lane, aR); ldB(slot(lds, SL_BH), ni0, lane, bB); ldB(slot(lds, SL_KH), ni0, lane, bK);
          f32x4 c1[2], c2[2], c3[2], c4[2]; ZACC(c1); ZACC(c2); ZACC(c3); ZACC(c4);
          mma<false>(aA, bB, c1); mma<false>(aA, bK, c2); mma<false>(aR, bB, c3); mma<false>(aR, bK, c4);
          { bf16x8 bA2[2][2], bV2[2][2]; ldB(slot(lds, SL_AH), ni0, lane, bA2); ldB(slot(lds, SL_XT), ni0, lane, bV2); f32x4 t1[2], t2[2]; ZACC(t1); ZACC(t2); mma<false>(aI, bA2, t1); mma<false>(aI, bV2, t2);
#pragma unroll
            for (int t = 0; t < 2; ++t) { st_rm(slot(lds, SL_AHT), mi, ni0 + t, lane, t1[t]); st_rm(slot(lds, SL_VT), mi, ni0 + t, lane, t2[t]); } }
#pragma unroll
          for (int t = 0; t < 2; ++t) { const int m = 16 * mi + fr, n = 16 * (ni0 + t) + 4 * fq;
#pragma unroll
              for (int r = 0; r < 4; ++r) { c1[t][r] = (n + r < m) ? c1[t][r] : 0.f; c2[t][r] = (n + r < m) ? c2[t][r] : 0.f; c3[t][r] = (n + r <= m) ? c3[t][r] : 0.f; c4[t][r] = (n + r <= m) ? c4[t][r] : 0.f;
                  accT[t][r] = c1[t][r] + ((n + r == m) ? 1.0f : 0.f); }
              st_rm(slot(lds, SL_PA), mi, ni0 + t, lane, c1[t]); st_tr(slot(lds, SL_PAT), mi, ni0 + t, lane, c1[t]); st_rm(slot(lds, SL_TA), mi, ni0 + t, lane, accT[t]);
              st_rm(slot(lds, SL_AAK), mi, ni0 + t, lane, c2[t]); st_rm(slot(lds, SL_ARB), mi, ni0 + t, lane, c3[t]); st_rm(slot(lds, SL_ARK), mi, ni0 + t, lane, c4[t]); } }
        lds_barrier();
        { bf16x8 aP[2], aK[2], bP[2][2], bV[2][2]; ldA(slot(lds, SL_PA), mi, lane, aP); ldA(slot(lds, SL_AAK), mi, lane, aK); ldB(slot(lds, SL_PAT), ni0, lane, bP); ldB(slot(lds, SL_VT), ni0, lane, bV);
          f32x4 c1[2], c2[2]; ZACC(c1); ZACC(c2); mma<false>(aP, bP, c1); mma<true>(aK, bV, c2);
#pragma unroll
          for (int t = 0; t < 2; ++t) { st_rm(slot(lds, SL_PB), mi, ni0 + t, lane, c1[t]); st_tr(slot(lds, SL_PBT), mi, ni0 + t, lane, c1[t]); st_trT(slot(lds, SL_XT), mi, ni0 + t, lane, c2[t]); } }
        lds_barrier();
#pragma unroll
        for (int it = 1; it <= 5; ++it) { const bool odd = (it & 1) != 0;
#ifdef PROBE_VPHASE
            if (vflags & 1) continue;
#endif
            LAS bf16_t* Pr = slot(lds, odd ? SL_PB : SL_PA); LAS bf16_t* PrT = slot(lds, odd ? SL_PBT : SL_PAT); LAS bf16_t* Pw = slot(lds, odd ? SL_PA : SL_PB); LAS bf16_t* PwT = slot(lds, odd ? SL_PAT : SL_PBT);
            LAS bf16_t* Tr = slot(lds, odd ? SL_TA : SL_TB); LAS bf16_t* Tw = slot(lds, odd ? SL_TB : SL_TA);
            bf16x8 aT[2], aP[2], bP[2][2]; ldA(Tr, mi, lane, aT); ldB(PrT, ni0, lane, bP); if (it < 5) ldA(Pr, mi, lane, aP);
            f32x4 c1[2]; ZACC(c1);
            mma<false>(aT, bP, accT); if (it < 5) mma<false>(aP, bP, c1);
#pragma unroll
            for (int t = 0; t < 2; ++t) { st_rm(Tw, mi, ni0 + t, lane, accT[t]); if (it < 5) { st_rm(Pw, mi, ni0 + t, lane, c1[t]); st_tr(PwT, mi, ni0 + t, lane, c1[t]); } }
            lds_barrier(); }
        { bf16x8 aT[2], bA[2][2], bX[2][2]; ldA(slot(lds, SL_TB), mi, lane, aT); ldB(slot(lds, SL_AHT), ni0, lane, bA); ldB(slot(lds, SL_XT), ni0, lane, bX);
          f32x4 c1[2], c2[2]; ZACC(c1); ZACC(c2); mma<true>(aT, bA, c1); mma<true>(aT, bX, c2);
          { bf16x8 bB2[2][2], bK2[2][2]; ldB(slot(lds, SL_BTT), ni0, lane, bB2); ldB(slot(lds, SL_KTT), ni0, lane, bK2); f32x4 t1[2], t2[2]; ZACC(t1); ZACC(t2); mma<false>(aI, bB2, t1); mma<false>(aI, bK2, t2);
#pragma unroll
            for (int t = 0; t < 2; ++t) { st_rm(slot(lds, SL_PA), mi, ni0 + t, lane, t1[t]); st_rm(slot(lds, SL_PAT), mi, ni0 + t, lane, t2[t]); } }
#pragma unroll
          for (int t = 0; t < 2; ++t) { st_trT(slot(lds, SL_WT), mi, ni0 + t, lane, c1[t]); st_trT(slot(lds, SL_UVT), mi, ni0 + t, lane, c2[t]); } }
        lds_barrier();
        { bf16_t* qp = QP + (size_t)job * 2 * 4096; bf16_t* yg = YG + (size_t)job * 2 * 4096; const int m = 16 * mi + fr, qs = 2 * (fq & 1) + (fq >> 1);
          bf16x8 aRB[2], aRK[2], aBT[2], aKT[2], bW[2][2], bU[2][2], bV[2][2];
          ldA(slot(lds, SL_ARB), mi, lane, aRB); ldA(slot(lds, SL_ARK), mi, lane, aRK); ldA(slot(lds, SL_PA), mi, lane, aBT); ldA(slot(lds, SL_PAT), mi, lane, aKT);
          ldB(slot(lds, SL_WT), ni0, lane, bW); ldB(slot(lds, SL_UVT), ni0, lane, bU); ldB(slot(lds, SL_VT), ni0, lane, bV);
          u32x2 rr[2];
#pragma unroll
          for (int t = 0; t < 2; ++t) rr[t] = *(const LAS u32x2*)(slot(lds, SL_RH) + m * CT + 16 * (ni0 + t) + 4 * fq);
          const float gm = gtab[m];
          f32x4 cq[2], cy[2], cp[2], cg[2]; ZACC(cq); ZACC(cy); ZACC(cp); ZACC(cg);
          mma<false>(aRB, bW, cq); mma<false>(aRB, bU, cy); mma<false>(aBT, bW, cp); mma<false>(aBT, bU, cg); mma<false>(aRK, bV, cy); mma<false>(aKT, bV, cg);
#pragma unroll
          for (int t = 0; t < 2; ++t) { const int n = 16 * (ni0 + t) + 4 * fq; u32x2 w;
              w.x = cvt_pk_bf16(cq[t][0] + bflo(rr[t].x), cq[t][1] + bfhi(rr[t].x)); w.y = cvt_pk_bf16(cq[t][2] + bflo(rr[t].y), cq[t][3] + bfhi(rr[t].y)); *(u32x2*)(qp + m * 64 + 16 * (ni0 + t) + 4 * qs) = w;
              w.x = cvt_pk_bf16(cy[t][0], cy[t][1]); w.y = cvt_pk_bf16(cy[t][2], cy[t][3]); *(u32x2*)(yg + m * 64 + n) = w;
#pragma unroll
              for (int r = 0; r < 4; ++r) cp[t][r] += (n + r == m) ? gm : 0.f;
              w.x = cvt_pk_bf16(cp[t][0], cp[t][1]); w.y = cvt_pk_bf16(cp[t][2], cp[t][3]); *(u32x2*)(qp + 4096 + m * 64 + 16 * (ni0 + t) + 4 * qs) = w;
              w.x = cvt_pk_bf16(cg[t][0], cg[t][1]); w.y = cvt_pk_bf16(cg[t][2], cg[t][3]); *(u32x2*)(yg + 4096 + m * 64 + n) = w; } }
        lds_barrier();
    }
}
#undef ZACC

constexpr int PB_BUF = 32768;
__device__ __forceinline__ void pb_dma(const bf16_t* qt, const bf16_t* yl, int jv, LAS unsigned char* dst, int lane) {
    const int rr = lane >> 3, cc = lane & 7;
#pragma unroll
    for (int pc = 0; pc < 16; ++pc)
        __builtin_amdgcn_global_load_lds((const unsigned*)((const char*)qt + pc * 1024 + rr * 128 + ((cc ^ rr) * 16)), (LAS unsigned*)(dst + pc * 1024), 16, 0, 0);
#pragma unroll
    for (int q = 0; q < 2; ++q)
#pragma unroll
        for (int pc = 0; pc < 4; ++pc) { const bf16_t* base = yl + q * 4096;
            __builtin_amdgcn_global_load_lds((const unsigned*)((const char*)(base + (pc * 16 + (lane >> 2)) * 64 + jv * 32) + (lane & 3) * 16), (LAS unsigned*)(dst + 16384 + q * 4096 + pc * 1024), 16, 0, 0); }
}
__device__ __forceinline__ void p5_seq(const Params& p, LAS unsigned char* lds, int lane) {
    const int bh = blockIdx.x >> 1, jv = blockIdx.x & 1, b = bh >> 3, h = bh & 7, r31 = lane & 31, hh = lane >> 5;
    const bf16_t* QP = (const bf16_t*)(p.ws + WS_QP) + (size_t)bh * 64 * 2 * 4096; const bf16_t* YG = (const bf16_t*)(p.ws + WS_YG) + (size_t)bh * 64 * 2 * 4096;
    bf16_t* yraw = (bf16_t*)(p.ws + WS_YRAW) + (size_t)b * SEQ * DR + h * HD + 32 * jv + r31;
    f32x16 H[2];
#pragma unroll
    for (int i = 0; i < 2; ++i)
#pragma unroll
        for (int r = 0; r < 16; ++r) H[i][r] = 0.f;
    pb_dma(QP, YG, jv, lds, lane);
    VM_WAIT();
    for (int c = 0; c < 64; ++c) { const LAS unsigned char* bp = lds + (c & 1) * PB_BUF;
        if (c + 1 < 64) pb_dma(QP + (size_t)(c + 1) * 2 * 4096, YG + (size_t)(c + 1) * 2 * 4096, jv, lds + ((c + 1) & 1) * PB_BUF, lane);
        {
            bf16x8 Bf[4];
#pragma unroll
            for (int i = 0; i < 2; ++i)
#pragma unroll
                for (int s2 = 0; s2 < 2; ++s2) { u32x4 w; w.x = cvt_pk_bf16(H[i][8 * s2 + 0], H[i][8 * s2 + 1]); w.y = cvt_pk_bf16(H[i][8 * s2 + 2], H[i][8 * s2 + 3]); w.z = cvt_pk_bf16(H[i][8 * s2 + 4], H[i][8 * s2 + 5]); w.w = cvt_pk_bf16(H[i][8 * s2 + 6], H[i][8 * s2 + 7]);
                    Bf[2 * i + s2] = __builtin_bit_cast(bf16x8, w); }
#pragma unroll
            for (int tt = 0; tt < 2; ++tt) { f32x16 acc; const int row = 32 * tt + r31;
#pragma unroll
                for (int r = 0; r < 16; ++r) acc[r] = bf2f(*(const LAS bf16_t*)(bp + 16384 + ((32 * tt + (r & 3) + 8 * (r >> 2) + 4 * hh) * 32 + r31) * 2));
#pragma unroll
                for (int kq = 0; kq < 4; ++kq) { const bf16x8 a = *(const LAS bf16x8*)(bp + row * 128 + (((2 * kq + hh) ^ (row & 7)) * 16)); acc = __builtin_amdgcn_mfma_f32_32x32x16_bf16(a, Bf[kq], acc, 0, 0, 0); }
#pragma unroll
                for (int r = 0; r < 16; ++r) yraw[(size_t)(c * 64 + 32 * tt + (r & 3) + 8 * (r >> 2) + 4 * hh) * DR] = f2bf(acc[r]); }
            f32x16 Hn[2];
#pragma unroll
            for (int i = 0; i < 2; ++i) { const int row = 32 * i + r31;
#pragma unroll
                for (int r = 0; r < 16; ++r) Hn[i][r] = bf2f(*(const LAS bf16_t*)(bp + 20480 + ((32 * i + (r & 3) + 8 * (r >> 2) + 4 * hh) * 32 + r31) * 2));
#pragma unroll
                for (int kq = 0; kq < 4; ++kq) { const bf16x8 a = *(const LAS bf16x8*)(bp + 8192 + row * 128 + (((2 * kq + hh) ^ (row & 7)) * 16)); Hn[i] = __builtin_amdgcn_mfma_f32_32x32x16_bf16(a, Bf[kq], Hn[i], 0, 0, 0); } }
            H[0] = Hn[0]; H[1] = Hn[1];
        }
        VM_WAIT();
    }
}
constexpr int RT_BROW = 2064, RT_LO = 32 * RT_BROW;
constexpr int RT_HIST = 147456, RT_BASE = RT_HIST + 128, RT_ETAB = RT_HIST + 256, RT_RS = RT_HIST + 256 + 2048;
__device__ __forceinline__ float rowmax16(float x) { x = fmaxf(x, dpp_mov<0xB1>(x)); x = fmaxf(x, dpp_mov<0x4E>(x)); x = fmaxf(x, dpp_mov<0x141>(x)); x = fmaxf(x, dpp_mov<0x140>(x)); return x; }
__device__ __forceinline__ float rt_key(float v, int e) { v = (v == v) ? fminf(fmaxf(v, -1.0e30f), 1.0e30f) : -1.0e30f; return __uint_as_float((__float_as_uint(v) & ~31u) | (unsigned)(31 - e)); }
__device__ __forceinline__ void p9_router(const Params& p, LAS unsigned char* lds, int wave, int lane) {
    const bf16_t* x1 = (const bf16_t*)(p.ws + WS_XB); const unsigned char* rwp = (const unsigned char*)(p.ws + WS_RWP); const float* rb = p.in[I_RB];
    int* eid = (int*)(p.ws + WS_EID); float* gate = (float*)(p.ws + WS_GATE); int* relpos = (int*)(p.ws + WS_RELPOS); int* stok = (int*)(p.ws + WS_STOK); float* srs = (float*)(p.ws + WS_SRS);
    unsigned* gcount = (unsigned*)(p.ws + WS_CTL) + CW_GCOUNT;
    const int tid = wave * 64 + lane, fr = lane & 15, q = lane >> 4;
    LAS unsigned* hist = (LAS unsigned*)(lds + RT_HIST); LAS unsigned* base = (LAS unsigned*)(lds + RT_BASE); LAS unsigned* etab = (LAS unsigned*)(lds + RT_ETAB); LAS float* rsl = (LAS float*)(lds + RT_RS);
#pragma unroll
    for (int i = 0; i < 16; ++i) { const int c = tid + 512 * i, which = c >> 12, cc = c & 4095, e = cc >> 7, kc = cc & 127; *(LAS u32x4*)(lds + which * RT_LO + e * RT_BROW + kc * 16) = *(const u32x4*)(rwp + (size_t)c * 16); }
    if (tid < 32) hist[tid] = 0u;
    const int tok0 = blockIdx.x * 128 + wave * 16;
    const bf16_t* arow = x1 + (size_t)(tok0 + fr) * DM + 8 * q;
    bf16x8 a_n[4];
#pragma unroll
    for (int k = 0; k < 4; ++k) a_n[k] = *(const bf16x8*)(arow + 32 * k);
    __syncthreads();
    f32x4 acc[2], accs; acc[0] = acc[1] = accs = (f32x4){0.f, 0.f, 0.f, 0.f};
#pragma unroll
    for (int ks = 0; ks < 32; ++ks) { const bf16x8 a = a_n[ks & 3];
        if (ks + 4 < 32) a_n[ks & 3] = *(const bf16x8*)(arow + 32 * (ks + 4));
        accs = __builtin_amdgcn_mfma_f32_16x16x32_bf16(a, a, accs, 0, 0, 0);
#pragma unroll
        for (int h2 = 0; h2 < 2; ++h2) { const LAS unsigned char* bp = lds + (16 * h2 + fr) * RT_BROW + (32 * ks + 8 * q) * 2;
            acc[h2] = __builtin_amdgcn_mfma_f32_16x16x32_bf16(a, *(const LAS bf16x8*)bp, acc[h2], 0, 0, 0);
            acc[h2] = __builtin_amdgcn_mfma_f32_16x16x32_bf16(a, *(const LAS bf16x8*)(bp + RT_LO), acc[h2], 0, 0, 0); } }
    const float rb0 = rb[fr], rb1 = rb[16 + fr];
#pragma unroll
    for (int r = 0; r < 4; ++r) { const int tl = wave * 16 + 4 * q + r, tok = blockIdx.x * 128 + tl;
        const float ss = __shfl(accs[r], 20 * q + r); const float rstd = 1.0f / sqrtf(ss * (1.0f / DM) + 1e-5f);
        float k0 = rt_key(acc[0][r] * rstd + rb0, fr), k1 = rt_key(acc[1][r] * rstd + rb1, 16 + fr);
        float tv[4]; int te[4];
#pragma unroll
        for (int rd = 0; rd < 4; ++rd) { const float m = rowmax16(fmaxf(k0, k1)); tv[rd] = m; te[rd] = 31 - (int)(__float_as_uint(m) & 31u); k0 = (k0 == m) ? -3.0e38f : k0; k1 = (k1 == m) ? -3.0e38f : k1; }
        const float ex1 = __expf(tv[1] - tv[0]), ex2 = __expf(tv[2] - tv[0]), ex3 = __expf(tv[3] - tv[0]); const float inv = 1.0f / (1.0f + ex1 + ex2 + ex3);
        if (fr < 4) { const int e = fr == 0 ? te[0] : (fr == 1 ? te[1] : (fr == 2 ? te[2] : te[3])); const float g = (fr == 0 ? 1.0f : (fr == 1 ? ex1 : (fr == 2 ? ex2 : ex3))) * inv;
            const unsigned lr = atomicAdd((unsigned*)&hist[e], 1u); eid[(size_t)tok * 4 + fr] = e; gate[(size_t)tok * 4 + fr] = g; etab[tl * 4 + fr] = (lr << 5) | (unsigned)e; }
        if (fr == 0) rsl[tl] = rstd; }
    __syncthreads();
    if (tid < 32) { const unsigned hc = hist[tid]; base[tid] = hc ? atomicAdd(&gcount[tid], hc) : 0u; }
    __syncthreads();
    { const int tl = tid >> 2, k = tid & 3, tok = blockIdx.x * 128 + tl; const unsigned pk = etab[tid]; const int e = pk & 31; const unsigned rel = base[e] + (pk >> 5);
      relpos[(size_t)tok * 4 + k] = (int)rel; stok[(size_t)e * CAP + rel] = tok; srs[(size_t)e * CAP + rel] = rsl[tl]; }
}
__device__ __forceinline__ void moe_tables(const Params& p, LAS unsigned char* lds, int wave, int lane) {
    const unsigned* gcount = (const unsigned*)(p.ws + WS_CTL) + CW_GCOUNT;
    LAS int* tsrc = (LAS int*)(lds + TAB_SRC); LAS int* tval = (LAS int*)(lds + TAB_VAL); LAS int* te = (LAS int*)(lds + TAB_E); LAS int* tbase = (LAS int*)(lds + TAB_BASE);
    if (wave == 0) {
        const int c = lane < NE ? (int)__hip_atomic_load(&gcount[lane & 31], __ATOMIC_RELAXED, __HIP_MEMORY_SCOPE_AGENT) : 0; const int nt = (c + 255) >> 8;
        int inc = nt;
#pragma unroll
        for (int o = 1; o < 32; o <<= 1) { const int v = __shfl_up(inc, o); inc += (lane & 31) >= o ? v : 0; }
        const int tb = inc - nt;
        if (lane < NE) { tbase[lane] = tb; if (lane == NE - 1) tbase[NE] = inc;
            for (int lt = 0; lt < nt; ++lt) { tsrc[tb + lt] = lane * CAP + lt * 256; const int rem = c - lt * 256; tval[tb + lt] = rem < 256 ? rem : 256; te[tb + lt] = lane; } } }
    __syncthreads();
}
typedef int i32x4 __attribute__((ext_vector_type(4)));
struct P12Meta { i32x4 e, rp; f32x4 g; };
struct P12Rows { u32x2 x[4]; u32x2 y[4][4]; f32x4 g; };
__device__ __forceinline__ void p12_meta(P12Meta& m, const int* eid, const float* gate, const int* relpos, int tok) {
    m.e = *(const i32x4*)(eid + (size_t)tok * 4); m.g = *(const f32x4*)(gate + (size_t)tok * 4); m.rp = *(const i32x4*)(relpos + (size_t)tok * 4); }
__device__ __forceinline__ void p12_rows(P12Rows& r, const P12Meta& m, const bf16_t* x1, const bf16_t* ys, const LAS int* tbase, int tok, int lane) {
#pragma unroll
    for (int j = 0; j < 4; ++j) r.x[j] = *(const u32x2*)(x1 + (size_t)tok * DM + 4 * lane + 256 * j);
#pragma unroll
    for (int k = 0; k < 4; ++k) { const bf16_t* yr = ys + ((size_t)tbase[m.e[k]] * 256 + m.rp[k]) * DM + 4 * lane;
#pragma unroll
        for (int j = 0; j < 4; ++j) r.y[k][j] = *(const u32x2*)(yr + 256 * j); }
    r.g = m.g;
}
__device__ __forceinline__ void p12_combine(const Params& p, LAS unsigned char* lds, int wave, int lane) {
    const bf16_t* x1 = (const bf16_t*)(p.ws + WS_XB); float* outp = p.out; const bf16_t* ys = (const bf16_t*)(p.ws + WS_YSORT); const int* eid = (const int*)(p.ws + WS_EID); const float* gate = (const float*)(p.ws + WS_GATE); const int* relpos = (const int*)(p.ws + WS_RELPOS);
    const float* fg = p.in[I_FG]; const LAS int* tbase = (const LAS int*)(lds + TAB_BASE);
    const int gw = blockIdx.x * NWAVES + wave;
    f32x4 gv[4];
#pragma unroll
    for (int j = 0; j < 4; ++j) gv[j] = *(const f32x4*)(fg + 4 * lane + 256 * j);
    P12Meta m0, m1; P12Rows rc, rn;
    p12_meta(m0, eid, gate, relpos, gw); p12_meta(m1, eid, gate, relpos, gw + NGW);
    p12_rows(rc, m0, x1, ys, tbase, gw, lane);
    for (int tok = gw; tok < NTOK; tok += NGW) {
        m0 = m1;
        if (tok + 2 * NGW < NTOK) p12_meta(m1, eid, gate, relpos, tok + 2 * NGW);
        if (tok + NGW < NTOK) p12_rows(rn, m0, x1, ys, tbase, tok + NGW, lane);
        f32x4 v[4];
#pragma unroll
        for (int j = 0; j < 4; ++j) v[j] = (f32x4){bflo(rc.x[j].x), bfhi(rc.x[j].x), bflo(rc.x[j].y), bfhi(rc.x[j].y)};
#pragma unroll
        for (int k = 0; k < 4; ++k) { const float gt = rc.g[k];
#pragma unroll
            for (int j = 0; j < 4; ++j) { const u32x2 w = rc.y[k][j]; v[j][0] += gt * bflo(w.x); v[j][1] += gt * bfhi(w.x); v[j][2] += gt * bflo(w.y); v[j][3] += gt * bfhi(w.y); } }
        float ss = 0.f;
#pragma unroll
        for (int j = 0; j < 4; ++j) ss += (v[j][0] * v[j][0] + v[j][1] * v[j][1]) + (v[j][2] * v[j][2] + v[j][3] * v[j][3]);
        ss = wave_sum(ss); const float rs = 1.0f / sqrtf(ss * (1.0f / DM) + 1e-5f);
#pragma unroll
        for (int j = 0; j < 4; ++j) { f32x4 o = v[j] * rs * gv[j];
#ifdef SCRUB_NAN
#pragma unroll
            for (int q = 0; q < 4; ++q) o[q] = (o[q] == o[q] && fabsf(o[q]) < 1e30f) ? o[q] : 0.f;
#endif
            *(f32x4*)(outp + (size_t)tok * DM + 4 * lane + 256 * j) = o; }
        rc = rn;
    }
}
#ifndef MOE_ALIGN
#define MOE_ALIGN true
#endif
#ifndef N_PHASES
#define N_PHASES 13
#endif
struct Args { Params p; int ph_lo, ph_hi, li, pad; };
__global__ void __launch_bounds__(NWAVES * 64, 2) hymba_fwd(Args a) {
    extern __shared__ __attribute__((aligned(16))) unsigned char lds_raw[];
    LAS unsigned char* lds = (LAS unsigned char*)lds_raw;
    const Params& p = a.p;
    const int wave = __builtin_amdgcn_readfirstlane((int)threadIdx.x >> 6);
    volatile LAS unsigned* misc = (volatile LAS unsigned*)(lds + MISC_OFF);
    if (threadIdx.x < 4) misc[threadIdx.x] = 0u;
    __syncthreads();
    unsigned* ctl = (unsigned*)(p.ws + WS_CTL);
    XcdBarrier bar = xcd_barrier_post(ctl + CW_BAR + a.li * XCD_BAR_WORDS, misc);
    const int lo = a.ph_lo & 0xFF, hi = a.ph_hi, padf = a.ph_lo >> 8;
#ifdef DIAG_A
    volatile LAS unsigned long long* tsl = (volatile LAS unsigned long long*)(lds + MISC_OFF + 64);
#define STAMP(k) do { if (blockIdx.x == 0 && wave == 0 && lane_id() == 0) tsl[k] = __builtin_amdgcn_s_memrealtime(); } while (0)
#else
#define STAMP(k) do { } while (0)
#endif
#ifndef PH_MASK
#define PH_MASK 0x1FFF
#endif
#ifdef STAGGER_US
#define STAGGER() do { const unsigned long long t0_ = __builtin_amdgcn_s_memrealtime(); const unsigned long long dl_ = (unsigned long long)(((blockIdx.x >> 3) & 3) * STAGGER_US * 100); \
        while (__builtin_amdgcn_s_memrealtime() - t0_ < dl_) __builtin_amdgcn_s_sleep(32); } while (0)
#else
#define STAGGER() do {} while (0)
#endif
#ifdef STAGGER_P1
#define STAGGER1() STAGGER()
#else
#define STAGGER1() do {} while (0)
#endif
#ifdef STAGGER_P11
#define STAGGER2() STAGGER()
#else
#define STAGGER2() do {} while (0)
#endif
#define IN(k) ((((PH_MASK) >> (k)) & 1) && lo <= (k) && (k) < hi)
#define SEAM(k) do { if (IN(k) && IN((k) + 1)) xcd_barrier(bar, wave == 0 && lane_id() == 0); } while (0)
#define LN lane_id()
    unsigned char* ws = p.ws;
    STAMP(0); if (IN(0)) { p0_prologue(p, lds, wave, LN); } SEAM(0);
    STAMP(1); if (IN(1)) { pg8::Gemm g{(const bf16_t*)(ws + WS_XB), (const bf16_t*)(ws + WS_WINT), NTOK, DIN, DM}; pg8::StaticOrder S; S.init(NTOK, DIN, GRID, (int)blockIdx.x);
        EpiProj E{(bf16_t*)(ws + WS_PROJ), DIN, (const float*)(ws + WS_RSTD1), lds}; STAGGER1(); pg8::gemm_phase<EpiProj, pg8::StaticOrder, true, false>(lds, g, S, E, wave); cv_tail(p, lds, wave, LN, CW_CVT1, CV_A, CV_B - CV_A); } SEAM(1);
    STAMP(2); if (IN(2)) { p2_lora_in(p, wave, LN); } SEAM(2);
    STAMP(3); if (IN(3)) { pg8::Gemm g{(const bf16_t*)(ws + WS_LORAIN), (const bf16_t*)(ws + WS_LORAB), NTOK, 1536, 256}; pg8::StaticOrder S; S.init(NTOK, 1536, GRID, (int)blockIdx.x);
        EpiLora E{(float*)(ws + WS_LORAW), (bf16_t*)(ws + WS_LORAA), (bf16_t*)(ws + WS_LORAG)}; pg8::gemm_phase<EpiLora, pg8::StaticOrder, true, false>(lds, g, S, E, wave); } SEAM(3);
    STAMP(4); if (IN(4)) { p4_chunks(p, lds, wave, LN, padf); } SEAM(4);
    STAMP(5); if (IN(5)) {
#ifdef PROBE_PAD
        if (blockIdx.x < 128) { if (!(padf & 2)) { if (wave == 0) p5_seq(p, lds, LN); else p5_convert(p, (LAS float*)(lds + 65536 + (wave - 1) * 8448), LN); } } else { if (!(padf & 1)) { p5_s5(p, lds, wave, LN, padf); __syncthreads(); if (!(padf & 32)) p5_convert(p, (LAS float*)(lds + wave * 8448), LN); } }
#else
        if (blockIdx.x < 128) { if (wave == 0) p5_seq(p, lds, LN); else p5_convert(p, (LAS float*)(lds + 65536 + (wave - 1) * 8448), LN); } else { p5_s5(p, lds, wave, LN); __syncthreads(); p5_convert(p, (LAS float*)(lds + wave * 8448), LN); }
#endif
 } SEAM(5);
    STAMP(6); if (IN(6)) { pg8::Gemm g{(const bf16_t*)(ws + WS_YGELU), (const bf16_t*)(ws + WS_WGLUT), NTOK, DSSM, DSSM}; pg8::StaticOrder S; S.init(NTOK, DSSM, GRID, (int)blockIdx.x);
        EpiGlu E{(const bf16_t*)(ws + WS_YGELU), (bf16_t*)(ws + WS_YGLU), p.in[I_BGLU], (float*)(ws + WS_SSQ)}; pg8::gemm_phase<EpiGlu, pg8::StaticOrder, false, false>(lds, g, S, E, wave); } SEAM(6);
    STAMP(7); if (IN(7)) { p7_mix(p, wave, LN); } SEAM(7);
    STAMP(8); if (IN(8)) { pg8::Gemm g{(const bf16_t*)(ws + WS_MIXED), (const bf16_t*)(ws + WS_WOUTT), NTOK, DM, DM}; pg8::StaticOrder S; S.init(NTOK, DM, GRID, (int)blockIdx.x);
        EpiOut E{(bf16_t*)(ws + WS_XB)}; pg8::gemm_phase<EpiOut, pg8::StaticOrder, true, false>(lds, g, S, E, wave); } SEAM(8);
    STAMP(9); if (IN(9)) { p9_router(p, lds, wave, LN); } SEAM(9);
    STAMP(13); if (IN(10) || IN(11) || IN(12)) moe_tables(p, lds, wave, lane_id());
    STAMP(10); if (IN(10)) { MoeOrder S{GRID, (int)blockIdx.x, 8, ((const LAS int*)(lds + TAB_BASE))[NE], (const LAS int*)(lds + TAB_SRC), (const LAS int*)(lds + TAB_VAL), (const LAS int*)(lds + TAB_E), (const int*)(ws + WS_STOK), (const LAS int*)(lds + TAB_BASE), padf};
        pg8::Gemm g{(const bf16_t*)(ws + WS_XB), (const bf16_t*)(ws + WS_W1T), 0, 0, DM};
        EpiSwiglu E{(bf16_t*)(ws + WS_ACT), (const float*)(ws + WS_B1G), (const float*)(ws + WS_B1L), (const float*)(ws + WS_SRS), (const LAS int*)(lds + TAB_SRC), (const LAS int*)(lds + TAB_VAL), padf, lds};
        STAGGER();
        pg8::gemm_phase<EpiSwiglu, MoeOrder, MOE_ALIGN, true>(lds, g, S, E, wave); cv_tail(p, lds, wave, LN, CW_CVT2, CV_C, CV_NIT - CV_C); } SEAM(10);
    STAMP(11); if (IN(11)) { MoeOrder S{GRID, (int)blockIdx.x, 4, ((const LAS int*)(lds + TAB_BASE))[NE], (const LAS int*)(lds + TAB_SRC), (const LAS int*)(lds + TAB_VAL), (const LAS int*)(lds + TAB_E), (const int*)(ws + WS_STOK), (const LAS int*)(lds + TAB_BASE), padf};
        pg8::Gemm g{(const bf16_t*)(ws + WS_ACT), (const bf16_t*)(ws + WS_W2T), 0, 0, DFF};
        EpiMoe2 E{(bf16_t*)(ws + WS_YSORT), p.in[I_B2], lds}; STAGGER2(); pg8::gemm_phase<EpiMoe2, MoeOrder, MOE_ALIGN, false>(lds, g, S, E, wave); } SEAM(11);
    STAMP(12); if (IN(12)) { p12_combine(p, lds, wave, LN); }
#ifdef DIAG_A
    STAMP(14);
    xcd_barrier(bar, wave == 0 && lane_id() == 0);
    if (blockIdx.x == 0) { const int l = lane_id();
        auto dur = [&](int k) -> float { const int e = (k == 9) ? 13 : (k == 12 ? 14 : k + 1); const int b0 = (k == 10) ? 13 : k; return (float)(tsl[e] - tsl[b0]) * 0.01f; };
        const float ta = dur(DIAG_A), tb = dur(DIAG_B);
        float* o = p.out;
        for (int i = wave * 64 + l; i < (1 << 22); i += NWAVES * 64) o[i] = (i == 0) ? ta * 1.0e5f : tb * 1.0e3f; }
#endif
#undef IN
#undef SEAM
#undef LN
#undef STAMP
}
#ifndef MK_SPLIT
#define MK_SPLIT 0
#endif
extern "C" void kernel_launch(void* const* d_in, const int* in_sizes, int n_in, void* d_out, int out_size, void* d_ws, size_t ws_size, hipStream_t stream) {
    static int ready = 0;
    if (ready == 0) {
        if (n_in != 34 || out_size != NTOK * DM || ws_size < WS_END) { fprintf(stderr, "kernel_launch: unexpected shapes (n_in %d, out %d, ws %zu); nothing launched\n", n_in, out_size, ws_size); ready = -1; return; }
        if (hipFuncSetAttribute((const void*)hymba_fwd, hipFuncAttributeMaxDynamicSharedMemorySize, LDS_BYTES) != hipSuccess) { fprintf(stderr, "kernel_launch: hipFuncSetAttribute failed\n"); ready = -1; return; }
        int per_cu = 0; if (hipOccupancyMaxActiveBlocksPerMultiprocessor(&per_cu, (const void*)hymba_fwd, NWAVES * 64, LDS_BYTES) != hipSuccess || per_cu < 1) fprintf(stderr, "kernel_launch: occupancy query says %d\n", per_cu);
        (void)hipGetLastError();
        ready = 1;
    }
    if (ready < 0) return;
    (void)hipMemsetAsync((char*)d_ws + WS_CTL, 0, CTL_ZERO_BYTES, stream);
    Args a{};
    for (int i = 0; i < 34; ++i) a.p.in[i] = (const float*)d_in[i];
    a.p.out = (float*)d_out; a.p.ws = (unsigned char*)d_ws;
#if defined(PROBE_VPHASE)
    a.ph_lo = 0; a.ph_hi = PROBE_VPHASE; a.li = 0; hipLaunchKernelGGL(hymba_fwd, dim3(GRID), dim3(NWAVES * 64), LDS_BYTES, stream, a);
    a.ph_lo = PROBE_VPHASE | (PROBE_VFLAGS << 8); a.ph_hi = PROBE_VPHASE + 1; a.li = 1; hipLaunchKernelGGL(hymba_fwd, dim3(GRID), dim3(NWAVES * 64), LDS_BYTES, stream, a);
    a.ph_lo = PROBE_VPHASE; a.ph_hi = N_PHASES; a.li = 2; hipLaunchKernelGGL(hymba_fwd, dim3(GRID), dim3(NWAVES * 64), LDS_BYTES, stream, a);
#elif defined(PROBE_VARIANT)
    a.ph_lo = 0; a.ph_hi = 10; a.li = 0; hipLaunchKernelGGL(hymba_fwd, dim3(GRID), dim3(NWAVES * 64), LDS_BYTES, stream, a);
    a.ph_lo = 10 | (PROBE_VARIANT << 8); a.ph_hi = 11; a.li = 1; hipLaunchKernelGGL(hymba_fwd, dim3(GRID), dim3(NWAVES * 64), LDS_BYTES, stream, a);
    a.ph_lo = 10; a.ph_hi = N_PHASES; a.li = 2; hipLaunchKernelGGL(hymba_fwd, dim3(GRID), dim3(NWAVES * 64), LDS_BYTES, stream, a);
#elif defined(PROBE_LO)
    a.ph_lo = 0; a.ph_hi = PROBE_HI + 1; a.li = 0; hipLaunchKernelGGL(hymba_fwd, dim3(GRID), dim3(NWAVES * 64), LDS_BYTES, stream, a);
#ifndef PROBE_PAD
#define PROBE_PAD 0
#endif
    a.ph_lo = PROBE_LO | (PROBE_PAD << 8); a.ph_hi = PROBE_LO + 1; a.li = 1; hipLaunchKernelGGL(hymba_fwd, dim3(GRID), dim3(NWAVES * 64), LDS_BYTES, stream, a);
    a.ph_lo = PROBE_LO + 1; a.ph_hi = N_PHASES; a.li = 2; hipLaunchKernelGGL(hymba_fwd, dim3(GRID), dim3(NWAVES * 64), LDS_BYTES, stream, a);
#elif MK_SPLIT
    for (int ph = 0; ph < N_PHASES; ++ph) { a.ph_lo = ph; a.ph_hi = ph + 1; a.li = 0; hipLaunchKernelGGL(hymba_fwd, dim3(GRID), dim3(NWAVES * 64), LDS_BYTES, stream, a); }
#else
#ifndef RUN_HI
#define RUN_HI N_PHASES
#endif
    a.ph_lo = 0; a.ph_hi = RUN_HI; a.li = 0; hipLaunchKernelGGL(hymba_fwd, dim3(GRID), dim3(NWAVES * 64), LDS_BYTES, stream, a);
#endif
}
```

```cpp
#include <hip/hip_runtime.h>
#include <cstdio>
#include <cstdint>

#define LAS __attribute__((address_space(3)))
typedef unsigned short bf16_t;
typedef short bf16x8 __attribute__((ext_vector_type(8)));
typedef float f32x4 __attribute__((ext_vector_type(4)));
typedef float f32x2 __attribute__((ext_vector_type(2)));
typedef float f32x16 __attribute__((ext_vector_type(16)));
typedef unsigned u32x4 __attribute__((ext_vector_type(4)));
typedef unsigned u32x2 __attribute__((ext_vector_type(2)));

typedef __bf16 bf16x2_t __attribute__((ext_vector_type(2)));
__device__ __forceinline__ unsigned cvt_pk_bf16(float lo, float hi) { const bf16x2_t v = {(__bf16)lo, (__bf16)hi}; return __builtin_bit_cast(unsigned, v); }
__device__ __forceinline__ float bflo(unsigned w) { return __uint_as_float(w << 16); }
__device__ __forceinline__ float bfhi(unsigned w) { return __uint_as_float(w & 0xffff0000u); }
__device__ __forceinline__ float bf2f(bf16_t b) { return __uint_as_float(((unsigned)b) << 16); }
__device__ __forceinline__ bf16_t f2bf(float f) { return (bf16_t)(cvt_pk_bf16(f, 0.f) & 0xffffu); }
__device__ __forceinline__ float wave_sum(float v) {
#pragma unroll
    for (int o = 32; o >= 1; o >>= 1) v += __shfl_xor(v, o);
    return v;
}
__device__ __forceinline__ float sigmoidf_(float x) { return __builtin_amdgcn_rcpf(1.0f + __builtin_amdgcn_exp2f(-1.4426950408889634f * x)); }
__device__ __forceinline__ int lane_id() { int l; asm volatile("v_mbcnt_lo_u32_b32 %0, -1, 0\n\tv_mbcnt_hi_u32_b32 %0, -1, %0" : "=v"(l)); return l; }
__device__ __forceinline__ void lds_barrier() { asm volatile("s_waitcnt lgkmcnt(0)" ::: "memory"); __builtin_amdgcn_s_barrier(); asm volatile("" ::: "memory"); }
#define LDS_WAIT() asm volatile("s_waitcnt lgkmcnt(0)" ::: "memory")
#define VM_WAIT() asm volatile("s_waitcnt vmcnt(0)" ::: "memory")

namespace pg8 {
constexpr int BM = 256, BK = 64, HALF = 128, HTB = HALF * BK * 2, STAGE_BYTES = 8 * HTB, NXCD = 8, WGM = 8;
__host__ __device__ __forceinline__ int lds_byte(int r, int c) { const int st = (r >> 4) * 2 + (c >> 5), rr = r & 15, cc = c & 31, ob = rr * 64 + cc * 2; return st * 1024 + (ob ^ (((ob >> 9) & 1) << 5)); }
__host__ __device__ __forceinline__ void stage_rc(int b, int& R, int& C) { const int st = b / 1024, sb = b % 1024, swz = sb ^ (((sb >> 9) & 1) << 5); R = (st >> 1) * 16 + swz / 64; C = (st & 1) * 32 + (swz % 64) / 2; }
__host__ __device__ __forceinline__ int perm32(int rho) { const int n = rho >> 4, i = rho & 15; return 8 * (i >> 2) + 4 * n + (i & 3); }

struct Unit { int pm, pn; };
struct Gemm { const bf16_t* A; const bf16_t* Bt; int M, N, K; };

struct StaticOrder {
    int nM, nN, nwg, G, c;
    __host__ __device__ void init(int M, int N, int G_, int c_) { nM = M / BM; nN = N / BM; nwg = nM * nN; G = G_; c = c_; }
    __host__ __device__ bool next(int i, Unit& u) const {
        const long L = (long)i * G + c; if (L >= nwg) return false;
        int wgid = (int)L; { const int q = nwg / NXCD, r = nwg % NXCD, xcd = wgid % NXCD, off = wgid / NXCD; wgid = (xcd < r ? xcd * (q + 1) : r * (q + 1) + (xcd - r) * q) + off; }
        const int nig = WGM * nN, gid = wgid / nig, fm = gid * WGM, gsz = (nM - fm) < WGM ? (nM - fm) : WGM;
        u.pm = fm + ((wgid % nig) % gsz); u.pn = (wgid % nig) / gsz; return true;
    }
    __device__ __forceinline__ int arow(const Unit& u, int r) const { return u.pm * BM + r; }
};

template <class Epi, class Sched, bool ALIGN_EPI, bool GATHER>
__device__ __forceinline__ void gemm_phase(LAS unsigned char* lds, const Gemm g, const Sched& S, const Epi& E, const int wid) {
    const int lane = lane_id(), tid = wid * 64 + lane, wr = wid >> 2, wc = wid & 3, fr = lane & 15, fq = lane >> 4;
    const int K = g.K, nt = K / BK;
    int Rst[2], Cst[2];
    unsigned voffB[2], vAc[2][2], vAn[2][2];
#pragma unroll
    for (int i = 0; i < 2; ++i) { int R, C; stage_rc(tid * 16 + i * 8192, R, C); const int Rb = Epi::PERM ? ((R & ~31) + perm32(R & 31)) : R;
        Rst[i] = R; Cst[i] = C; voffB[i] = (unsigned)(Rb * K + C) * 2u; }
    const size_t kstep = (size_t)(BK * 2);
    const size_t hstep = (size_t)HALF * K * 2;
    const size_t tstep = 2 * hstep;
    const unsigned ldsw = (unsigned)wid * 1024u;
    const int aoff = lds_byte(wr * 64 + fr, fq * 8), boff = lds_byte(wc * 32 + fr, fq * 8);
#define PG8_SA(b, h) (((b) * 2 + (h)) * HTB)
#define PG8_SB(b, h) ((4 + (b) * 2 + (h)) * HTB)
#define PG8_STAGE(bufoff, gbase, voff) do { _Pragma("unroll") for (int _i = 0; _i < 2; ++_i) \
        __builtin_amdgcn_global_load_lds((const unsigned*)((const char*)(gbase) + (voff)[_i]), (LAS unsigned*)(lds + (bufoff) + ldsw + _i * 8192), 16, 0, 0); } while (0)
#define PG8_STAGE_SEL(bufoff, gbase, va, vb, sel) do { _Pragma("unroll") for (int _i = 0; _i < 2; ++_i) \
        __builtin_amdgcn_global_load_lds((const unsigned*)((const char*)(gbase) + ((sel) ? (vb)[_i] : (va)[_i])), (LAS unsigned*)(lds + (bufoff) + ldsw + _i * 8192), 16, 0, 0); } while (0)
#define PG8_LDA(dst, b, h) do { _Pragma("unroll") for (int m = 0; m < 4; ++m) _Pragma("unroll") for (int k = 0; k < 2; ++k) dst[m][k] = *(const LAS bf16x8*)(lds + PG8_SA(b, h) + aoff + m * 2048 + k * 1024); } while (0)
#define PG8_LDB(dst, b, h) do { _Pragma("unroll") for (int n = 0; n < 2; ++n) _Pragma("unroll") for (int k = 0; k < 2; ++k) dst[n][k] = *(const LAS bf16x8*)(lds + PG8_SB(b, h) + boff + n * 2048 + k * 1024); } while (0)
#define PG8_MMA(ai, bj, At, Bt) do { __builtin_amdgcn_s_setprio(1); _Pragma("unroll") for (int m = 0; m < 4; ++m) _Pragma("unroll") for (int n = 0; n < 2; ++n) _Pragma("unroll") for (int k = 0; k < 2; ++k) \
        acc[ai][bj][m][n] = __builtin_amdgcn_mfma_f32_16x16x32_bf16(Bt[n][k], At[m][k], acc[ai][bj][m][n], 0, 0, 0); __builtin_amdgcn_s_setprio(0); } while (0)
#define PG8_WAIT_V(n) asm volatile("s_waitcnt vmcnt(" #n ")" ::: "memory")
#define PG8_WAIT_L(n) asm volatile("s_waitcnt lgkmcnt(" #n ")" ::: "memory")
#define PG8_BAR __builtin_amdgcn_s_barrier()
#define PG8_SCHED __builtin_amdgcn_sched_barrier(0)
#define PG8_LOADOFF(dst, unit) do { _Pragma("unroll") for (int _h = 0; _h < 2; ++_h) _Pragma("unroll") for (int _i = 0; _i < 2; ++_i) \
        dst[_h][_i] = GATHER ? ((unsigned)S.arow(unit, _h * HALF + Rst[_i]) * (unsigned)(K * 2) + (unsigned)(Cst[_i] * 2)) : ((unsigned)((_h * HALF + Rst[_i]) * K + Cst[_i]) * 2u); } while (0)
    Unit cur, nxt; int ui = 0;
    if (!S.next(0, cur)) return;
    f32x4 acc[2][2][4][2];
#pragma unroll
    for (int a = 0; a < 2; ++a)
#pragma unroll
        for (int b = 0; b < 2; ++b)
#pragma unroll
            for (int m = 0; m < 4; ++m)
#pragma unroll
                for (int n = 0; n < 2; ++n) acc[a][b][m][n] = (f32x4){0.f, 0.f, 0.f, 0.f};
    bf16x8 At[4][2], B0[2][2], B1[2][2];
    const char* cA = GATHER ? (const char*)g.A : (const char*)g.A + (size_t)cur.pm * tstep; const char* cB = (const char*)g.Bt + (size_t)cur.pn * tstep;
    PG8_LOADOFF(vAc, cur);
    if constexpr (Epi::PREFETCH) E.prefetch(cur, 0, wid, lane);
    if (GATHER) { Unit u1; if (S.next(1, u1)) PG8_LOADOFF(vAn, u1); else PG8_LOADOFF(vAn, cur); } else { PG8_LOADOFF(vAn, cur); }
    PG8_STAGE(PG8_SB(0, 0), cB, voffB); PG8_STAGE(PG8_SB(0, 1), cB + hstep, voffB); PG8_STAGE(PG8_SA(0, 0), cA, vAc[0]); PG8_STAGE(PG8_SA(0, 1), cA, vAc[1]);
    if (wr == 1) PG8_BAR;
    PG8_WAIT_V(2); PG8_BAR;
    PG8_STAGE(PG8_SB(1, 0), cB + kstep, voffB); PG8_STAGE(PG8_SA(1, 0), cA + kstep, vAc[0]); PG8_STAGE(PG8_SB(1, 1), cB + hstep + kstep, voffB);
    PG8_WAIT_V(6); PG8_BAR;
    for (;;) {
        const bool has_next = S.next(ui + 1, nxt);
        const char* nA = GATHER ? cA : (has_next ? (const char*)g.A + (size_t)nxt.pm * tstep : cA); const char* nB = has_next ? (const char*)g.Bt + (size_t)nxt.pn * tstep : cB;
        const bool usen = GATHER && has_next;
        for (int t = 0; t < nt; t += 2) {
            const bool last = (t == nt - 2);
            const char* a1 = cA + (size_t)(t + 1) * kstep;
            const char* a2 = last ? nA : cA + (size_t)(t + 2) * kstep; const char* b2 = last ? nB : cB + (size_t)(t + 2) * kstep;
            const char* a3 = a2 + kstep; const char* b3 = b2 + kstep;
            const bool sel = last && usen;
            PG8_LDB(B0, 0, 0); PG8_LDB(B1, 0, 1); PG8_SCHED; PG8_LDA(At, 0, 0); PG8_STAGE(PG8_SA(1, 1), a1, vAc[1]);
            PG8_WAIT_V(8); PG8_WAIT_L(0); PG8_BAR; PG8_MMA(0, 0, At, B0); PG8_MMA(0, 1, At, B1); PG8_BAR; PG8_SCHED;
            PG8_LDA(At, 0, 1); PG8_STAGE(PG8_SB(0, 0), b2, voffB); PG8_STAGE(PG8_SB(0, 1), b2 + hstep, voffB); PG8_STAGE_SEL(PG8_SA(0, 0), a2, vAc[0], vAn[0], sel);
            PG8_WAIT_V(8); PG8_WAIT_L(0); PG8_BAR; PG8_MMA(1, 0, At, B0); PG8_MMA(1, 1, At, B1); PG8_BAR; PG8_SCHED;
            PG8_LDB(B0, 1, 0); PG8_LDB(B1, 1, 1); PG8_SCHED; PG8_LDA(At, 1, 0); PG8_STAGE_SEL(PG8_SA(0, 1), a2, vAc[1], vAn[1], sel);
            PG8_WAIT_V(8); PG8_WAIT_L(0); PG8_BAR; PG8_MMA(0, 0, At, B0); PG8_MMA(0, 1, At, B1); PG8_BAR; PG8_SCHED;
            PG8_LDA(At, 1, 1); PG8_STAGE(PG8_SB(1, 0), b3, voffB); PG8_STAGE(PG8_SB(1, 1), b3 + hstep, voffB); PG8_STAGE_SEL(PG8_SA(1, 0), a3, vAc[0], vAn[0], sel);
            PG8_WAIT_V(8); PG8_WAIT_L(0); PG8_BAR; PG8_MMA(1, 0, At, B0); PG8_MMA(1, 1, At, B1); PG8_BAR; PG8_SCHED;
        }
        if constexpr (ALIGN_EPI) { if (wr == 0) PG8_BAR; }
        if (GATHER && has_next) {
#pragma unroll
            for (int _h = 0; _h < 2; ++_h)
#pragma unroll
                for (int _i = 0; _i < 2; ++_i) vAc[_h][_i] = vAn[_h][_i];
            Unit u2; if (S.next(ui + 2, u2)) PG8_LOADOFF(vAn, u2);
        }
        if constexpr (Epi::PREFETCH) { if (has_next) E.prefetch(nxt, (ui + 1) & 1, wid, lane); E(acc, cur, wr, wc, fr, fq, ui & 1); } else E(acc, cur, wr, wc, fr, fq);
        if (!has_next) break;
#pragma unroll
        for (int a = 0; a < 2; ++a)
#pragma unroll
            for (int b = 0; b < 2; ++b)
#pragma unroll
                for (int m = 0; m < 4; ++m)
#pragma unroll
                    for (int n = 0; n < 2; ++n) acc[a][b][m][n] = (f32x4){0.f, 0.f, 0.f, 0.f};
        cur = nxt; cA = nA; cB = nB; ++ui;
        if constexpr (ALIGN_EPI) { if (wr == 1) PG8_BAR; }
    }
    PG8_WAIT_V(0);
    if constexpr (!ALIGN_EPI) { if (wr == 0) PG8_BAR; }
    PG8_BAR;
#undef PG8_SA
#undef PG8_SB
#undef PG8_STAGE
#undef PG8_STAGE_SEL
#undef PG8_LDA
#undef PG8_LDB
#undef PG8_MMA
#undef PG8_WAIT_V
#undef PG8_WAIT_L
#undef PG8_BAR
#undef PG8_SCHED
#undef PG8_LOADOFF
}
}
#define XB_TMO      128
#define XB_XCNT(j)  (256  + 64 * (j))
#define XB_XSUB(j)  (1280 + 64 * (j))
#define XB_XGEN(j)  (2304 + 64 * (j))
#define XB_TOP      3328
#define XB_TOPGEN   3392
#define XCD_BAR_WORDS 3456
#define XB_SPIN_CAP (1u << 18)

__device__ __forceinline__ unsigned xb_ld(unsigned* p)              { return __hip_atomic_load(p, __ATOMIC_RELAXED, __HIP_MEMORY_SCOPE_AGENT); }
__device__ __forceinline__ unsigned xb_add(unsigned* p, unsigned v) { return __hip_atomic_fetch_add(p, v, __ATOMIC_RELAXED, __HIP_MEMORY_SCOPE_AGENT); }
__device__ __forceinline__ unsigned xb_xcc_id() { return (unsigned)__builtin_amdgcn_s_getreg((3 << 11) | 20) & 0xFu; }
#define XB_SPIN(cond, bar) do { unsigned _sp = 0; while (cond) { __builtin_amdgcn_s_sleep(1); \
    if ((++_sp & 255u) == 0u) { if (xb_ld(&(bar)[XB_TMO])) break; if (_sp > XB_SPIN_CAP) { atomicAdd(&(bar)[XB_TMO], 1u); break; } } } } while (0)

struct XcdBarrier {
    unsigned* bar; unsigned x;
    volatile LAS unsigned* st;
};

__device__ __forceinline__ XcdBarrier xcd_barrier_post(unsigned* bar, volatile LAS unsigned* st) {
    XcdBarrier b; b.bar = bar; b.x = xb_xcc_id(); b.st = st;
    if (threadIdx.x == 0) (void)xb_add(&bar[XB_XCNT(b.x)], 1u);
    return b;
}
__device__ __forceinline__ void xcd_barrier_complete(unsigned* bar, unsigned x, unsigned& nloc, unsigned& nx) {
    const unsigned G = gridDim.x * gridDim.y * gridDim.z;
    unsigned sum, cnt, mine, sp = 0u;
    for (;;) {
        sum = 0u; cnt = 0u; mine = 0u;
#pragma unroll
        for (unsigned j = 0; j < 16; ++j) { const unsigned c = xb_ld(&bar[XB_XCNT(j)]); sum += c; cnt += (c > 0u) ? 1u : 0u; mine = (j == x) ? c : mine; }
        if (sum == G) break;
        __builtin_amdgcn_s_sleep(1);
        if ((++sp & 255u) == 0u) { if (xb_ld(&bar[XB_TMO])) break; if (sp > XB_SPIN_CAP) { atomicAdd(&bar[XB_TMO], 1u); break; } }
    }
    nloc = mine > 0u ? mine : 1u; nx = cnt > 0u ? cnt : 1u;
}

__device__ __forceinline__ void xcd_barrier(const XcdBarrier& b, const bool t0) {
    asm volatile("s_waitcnt vmcnt(0)" ::: "memory");
    __syncthreads();
    if (t0) {
        unsigned* bar = b.bar;
        __builtin_amdgcn_s_waitcnt(0);
        unsigned nloc = b.st[0], nx = b.st[1];
        if (nloc == 0u) { xcd_barrier_complete(bar, b.x, nloc, nx); b.st[0] = nloc; b.st[1] = nx; }
        const unsigned old = xb_add(&bar[XB_XSUB(b.x)], 1u);
        const unsigned gen = old / nloc;
        if (old + 1u == (gen + 1u) * nloc) {
            __builtin_amdgcn_fence(__ATOMIC_RELEASE, "agent");
            asm volatile("s_waitcnt vmcnt(0)" ::: "memory");
            const unsigned og = xb_add(&bar[XB_TOP], 1u);
            const unsigned tg = og / nx;
            if (og + 1u == (tg + 1u) * nx) xb_add(&bar[XB_TOPGEN], 1u);
            else XB_SPIN(xb_ld(&bar[XB_TOPGEN]) == tg, bar);
            __builtin_amdgcn_fence(__ATOMIC_ACQUIRE, "agent");
            xb_add(&bar[XB_XGEN(b.x)], 1u);
            asm volatile("s_waitcnt vmcnt(0)" ::: "memory");
        } else {
            XB_SPIN(xb_ld(&bar[XB_XGEN(b.x)]) == gen, bar);
            __builtin_amdgcn_fence(__ATOMIC_ACQUIRE, "agent");
            asm volatile("s_waitcnt vmcnt(0)" ::: "memory");
        }
    }
    __syncthreads();
}

constexpr int DM = 1024, NBATCH = 8, SEQ = 4096, NTOK = NBATCH * SEQ;
constexpr int DIN = 2304, DR = 512, DSSM = 512, NH = 8, HD = 64;
constexpr int COL_K = 512, COL_V = 1024, COL_LORA = 1536, COL_U = 1792;
constexpr int NE = 32, DFF = 1024, CAP = 32768, MAXTILES = 544;
constexpr int OPS_STRIDE = 388;
constexpr int NWAVES = 8, GRID = 256, NGW = GRID * NWAVES;
constexpr size_t MiB = 1u << 20;
constexpr size_t WS_CTL = 0, CTL_ZERO_BYTES = 1 * MiB;
constexpr size_t WS_WINT = 1 * MiB, WS_LORAB = 6 * MiB, WS_WGLUT = 7 * MiB, WS_WOUTT = 8 * MiB;
constexpr size_t WS_B1G = 10 * MiB, WS_B1L = 10 * MiB + 128 * 1024, WS_RWP = 10 * MiB + 256 * 1024, WS_RSTD1 = 10 * MiB + 512 * 1024;
constexpr size_t WS_SSQ = 11 * MiB, WS_EID = 12 * MiB, WS_GATE = 12 * MiB + 512 * 1024, WS_RELPOS = 13 * MiB, WS_STOK = 14 * MiB;
constexpr size_t WS_W2T = 20 * MiB, WS_W1T = 84 * MiB, WS_XB = 212 * MiB;
constexpr size_t WS_PROJ = 276 * MiB, WS_LORAIN = 420 * MiB, WS_LORAW = 436 * MiB, WS_LORAA = 500 * MiB, WS_LORAG = 564 * MiB, WS_OPS = 628 * MiB, WS_SRS = 1016 * MiB, WS_END = 1020 * MiB;
constexpr size_t WS_YRAW = WS_LORAW, WS_YGELU = WS_LORAA, WS_YGLU = WS_LORAA + 32 * MiB, WS_MIXED = WS_OPS + 200 * MiB, WS_ACT = WS_OPS, WS_YSORT = WS_PROJ;
constexpr size_t WS_QP = WS_OPS, WS_YG = WS_OPS + 64 * MiB, WS_RKB = WS_OPS + 192 * MiB;
static_assert(WS_OPS + (size_t)64 * 4096 * OPS_STRIDE * 4 <= WS_SRS, "ops fits");
constexpr int CW_TMO = 0, CW_BAR = 4096, CW_GCOUNT = 16384, CW_CVCTR = 16384 + 64, CW_CVT1 = 16512, CW_CVT2 = 16768;
constexpr int LDS_BYTES = 163840, TAB_OFF = 131072, MISC_OFF = 159744;
constexpr int TAB_SRC = TAB_OFF, TAB_VAL = TAB_OFF + MAXTILES * 4, TAB_E = TAB_OFF + 2 * MAXTILES * 4, TAB_BASE = TAB_OFF + 3 * MAXTILES * 4;

struct Params { const float* in[34]; float* out; unsigned char* ws; };
enum { I_X = 0, I_N1G, I_WIN, I_MU, I_W0, I_WUP, I_A0, I_AUP, I_GUP, I_KK, I_KA, I_RK, I_LNW, I_LNB, I_LRE, I_LIM, I_LSTEP, I_BRE, I_BIM, I_CRE, I_CIM, I_DSKIP, I_WGLU, I_BGLU, I_BETA, I_WOUT, I_N2G, I_RW, I_RB, I_W1, I_B1, I_W2, I_B2, I_FG };

using pg8::Unit; using pg8::HALF; using pg8::BM;
constexpr int EPB_OFF = 139264, EPB_BYTES = 2048;
struct EpiProj {
    static constexpr bool PERM = true, PREFETCH = true;
    bf16_t* O; int ldc; const float* rs; LAS unsigned char* lds;
    __device__ __forceinline__ void prefetch(const Unit& u, int buf, int wid, int lane) const {
        if (wid != 0) return;
        __builtin_amdgcn_global_load_lds((const unsigned*)(rs + u.pm * BM + 4 * lane), (LAS unsigned*)(lds + EPB_OFF + buf * EPB_BYTES), 16, 0, 0);
    }
    __device__ __forceinline__ void operator()(const f32x4 (&acc)[2][2][4][2], const Unit& u, int wr, int wc, int fr, int fq, int buf) const {
        const int row0 = u.pm * BM + wr * 64 + fr, col0 = u.pn * BM + wc * 32 + 8 * fq;
        const LAS float* pb = (const LAS float*)(lds + EPB_OFF + buf * EPB_BYTES) + wr * 64 + fr;
#pragma unroll
        for (int ai = 0; ai < 2; ++ai)
#pragma unroll
            for (int m = 0; m < 4; ++m) { const int row = row0 + ai * HALF + m * 16; const float s = pb[ai * HALF + m * 16]; bf16_t* rowp = O + (size_t)row * ldc + col0;
#pragma unroll
                for (int bj = 0; bj < 2; ++bj) { const f32x4 v0 = acc[ai][bj][m][0] * s, v1 = acc[ai][bj][m][1] * s;
                    u32x4 w; w.x = cvt_pk_bf16(v0[0], v0[1]); w.y = cvt_pk_bf16(v0[2], v0[3]); w.z = cvt_pk_bf16(v1[0], v1[1]); w.w = cvt_pk_bf16(v1[2], v1[3]);
                    *(u32x4*)(rowp + bj * HALF) = w; } }
    }
};
struct EpiLora {
    static constexpr bool PERM = false, PREFETCH = false;
    float* bw; bf16_t* ba; bf16_t* bg;
    __device__ __forceinline__ void operator()(const f32x4 (&acc)[2][2][4][2], const Unit& u, int wr, int wc, int fr, int fq) const {
        const int kind = u.pn >> 1; const int row0 = u.pm * BM + wr * 64 + fr, cc0 = (u.pn & 1) * 256 + wc * 32 + 4 * fq;
        bf16_t* hb = kind == 1 ? ba : bg;
#pragma unroll
        for (int ai = 0; ai < 2; ++ai)
#pragma unroll
            for (int m = 0; m < 4; ++m) { const size_t off = (size_t)(row0 + ai * HALF + m * 16) * 512 + cc0;
#pragma unroll
                for (int bj = 0; bj < 2; ++bj)
#pragma unroll
                    for (int n = 0; n < 2; ++n) { const f32x4 v = acc[ai][bj][m][n];
                        if (kind == 0) *(f32x4*)(bw + off + bj * HALF + n * 16) = v;
                        else { u32x2 w; w.x = cvt_pk_bf16(v[0], v[1]); w.y = cvt_pk_bf16(v[2], v[3]); *(u32x2*)(hb + off + bj * HALF + n * 16) = w; } } }
    }
};
struct EpiGlu {
    static constexpr bool PERM = true, PREFETCH = false;
    const bf16_t* Y; bf16_t* O; const float* bias; float* ssq;
    __device__ __forceinline__ void operator()(const f32x4 (&acc)[2][2][4][2], const Unit& u, int wr, int wc, int fr, int fq) const {
        const int row0 = u.pm * BM + wr * 64 + fr, col0 = u.pn * BM + wc * 32 + 8 * fq;
        f32x4 bv[2][2];
#pragma unroll
        for (int bj = 0; bj < 2; ++bj)
#pragma unroll
            for (int n = 0; n < 2; ++n) bv[bj][n] = *(const f32x4*)(bias + col0 + bj * HALF + 4 * n);
#pragma unroll
        for (int ai = 0; ai < 2; ++ai)
#pragma unroll
            for (int m = 0; m < 4; ++m) { const int row = row0 + ai * HALF + m * 16; float sq = 0.f;
#pragma unroll
                for (int bj = 0; bj < 2; ++bj) { const size_t off = (size_t)row * 512 + col0 + bj * HALF; const u32x4 yv = *(const u32x4*)(Y + off);
                    const f32x4 z0 = acc[ai][bj][m][0] + bv[bj][0], z1 = acc[ai][bj][m][1] + bv[bj][1];
                    float o[8]; o[0] = bflo(yv.x) * sigmoidf_(z0[0]); o[1] = bfhi(yv.x) * sigmoidf_(z0[1]); o[2] = bflo(yv.y) * sigmoidf_(z0[2]); o[3] = bfhi(yv.y) * sigmoidf_(z0[3]);
                    o[4] = bflo(yv.z) * sigmoidf_(z1[0]); o[5] = bfhi(yv.z) * sigmoidf_(z1[1]); o[6] = bflo(yv.w) * sigmoidf_(z1[2]); o[7] = bfhi(yv.w) * sigmoidf_(z1[3]);
#pragma unroll
                    for (int j = 0; j < 8; ++j) sq += o[j] * o[j];
                    u32x4 w; w.x = cvt_pk_bf16(o[0], o[1]); w.y = cvt_pk_bf16(o[2], o[3]); w.z = cvt_pk_bf16(o[4], o[5]); w.w = cvt_pk_bf16(o[6], o[7]);
                    *(u32x4*)(O + off) = w; }
                sq += __shfl_xor(sq, 16); sq += __shfl_xor(sq, 32);
                if (fq == 0) ssq[(size_t)row * 8 + u.pn * 4 + wc] = sq; }
    }
};
struct EpiOut {
    static constexpr bool PERM = true, PREFETCH = false;
    bf16_t* X1B;
    __device__ __forceinline__ void operator()(const f32x4 (&acc)[2][2][4][2], const Unit& u, int wr, int wc, int fr, int fq) const {
        const int row0 = u.pm * BM + wr * 64 + fr, col0 = u.pn * BM + wc * 32 + 8 * fq;
        u32x4 xin[2][4][2];
#pragma unroll
        for (int ai = 0; ai < 2; ++ai)
#pragma unroll
            for (int m = 0; m < 4; ++m)
#pragma unroll
                for (int bj = 0; bj < 2; ++bj) xin[ai][m][bj] = *(const u32x4*)(X1B + (size_t)(row0 + ai * HALF + m * 16) * DM + col0 + bj * HALF);
#pragma unroll
        for (int ai = 0; ai < 2; ++ai)
#pragma unroll
            for (int m = 0; m < 4; ++m) { const size_t off = (size_t)(row0 + ai * HALF + m * 16) * DM + col0;
#pragma unroll
                for (int bj = 0; bj < 2; ++bj) { const u32x4 xi = xin[ai][m][bj]; const f32x4 a0 = acc[ai][bj][m][0], a1 = acc[ai][bj][m][1];
                    u32x4 w; w.x = cvt_pk_bf16(bflo(xi.x) + a0[0], bfhi(xi.x) + a0[1]); w.y = cvt_pk_bf16(bflo(xi.y) + a0[2], bfhi(xi.y) + a0[3]);
                    w.z = cvt_pk_bf16(bflo(xi.z) + a1[0], bfhi(xi.z) + a1[1]); w.w = cvt_pk_bf16(bflo(xi.w) + a1[2], bfhi(xi.w) + a1[3]); *(u32x4*)(X1B + off + bj * HALF) = w; } }
    }
};
struct EpiSwiglu {
    static constexpr bool PERM = true, PREFETCH = true;
    bf16_t* O; const float* b1g; const float* b1l; const float* srs; const LAS int* tsrc; const LAS int* tval; int flags; LAS unsigned char* lds;
    __device__ __forceinline__ void prefetch(const Unit& u, int buf, int wid, int lane) const {
        if (wid != 0) return;
        const int e = u.pn >> 3, pnl = u.pn & 7, src = tsrc[u.pm];
        LAS unsigned char* d = lds + EPB_OFF + buf * EPB_BYTES;
        __builtin_amdgcn_global_load_lds((const unsigned*)(srs + src + 4 * lane), (LAS unsigned*)d, 16, 0, 0);
        const float* bsrc = (lane < 32 ? b1g : b1l) + e * DFF + pnl * 128 + 4 * (lane & 31);
        __builtin_amdgcn_global_load_lds((const unsigned*)bsrc, (LAS unsigned*)(d + 1024), 16, 0, 0);
    }
    __device__ __forceinline__ void operator()(const f32x4 (&acc)[2][2][4][2], const Unit& u, int wr, int wc, int fr, int fq, int buf) const {
#ifdef PROBE_VARIANT
        if (flags & 16) return;
#endif
        const int pnl = u.pn & 7; const int r0 = wr * 64 + fr, ol = wc * 32 + 8 * fq, o0 = pnl * 128 + ol;
        const int nval = tval[u.pm];
        const LAS float* pb = (const LAS float*)(lds + EPB_OFF + buf * EPB_BYTES);
        f32x4 bg[2], bl[2];
#pragma unroll
        for (int n = 0; n < 2; ++n) { bg[n] = *(const LAS f32x4*)(pb + 256 + ol + 4 * n); bl[n] = *(const LAS f32x4*)(pb + 384 + ol + 4 * n); }
#pragma unroll
        for (int ai = 0; ai < 2; ++ai)
#pragma unroll
            for (int m = 0; m < 4; ++m) { const int r = r0 + ai * HALF + m * 16; const float s = r < nval ? pb[r] : 0.f;
                float o[8];
#pragma unroll
                for (int n = 0; n < 2; ++n)
#pragma unroll
                    for (int j = 0; j < 4; ++j) { const float gl = fminf(acc[ai][0][m][n][j] * s + bg[n][j], 7.0f); const float li = fminf(fmaxf(acc[ai][1][m][n][j] * s + bl[n][j], -7.0f), 7.0f);
                        o[4 * n + j] = gl * sigmoidf_(1.702f * gl) * (li + 1.0f); }
                u32x4 w; w.x = cvt_pk_bf16(o[0], o[1]); w.y = cvt_pk_bf16(o[2], o[3]); w.z = cvt_pk_bf16(o[4], o[5]); w.w = cvt_pk_bf16(o[6], o[7]);
                *(u32x4*)(O + (size_t)(u.pm * BM + r) * DFF + o0) = w; }
    }
};
struct EpiMoe2 {
    static constexpr bool PERM = true, PREFETCH = false;
    bf16_t* O; const float* b2;
    __device__ __forceinline__ void operator()(const f32x4 (&acc)[2][2][4][2], const Unit& u, int wr, int wc, int fr, int fq) const {
        const int e = u.pn >> 2, pnl = u.pn & 3; const int row0 = u.pm * BM + wr * 64 + fr, col0 = pnl * BM + wc * 32 + 8 * fq;
        f32x4 bv[2][2];
#pragma unroll
        for (int bj = 0; bj < 2; ++bj)
#pragma unroll
            for (int n = 0; n < 2; ++n) bv[bj][n] = *(const f32x4*)(b2 + e * DM + col0 + bj * HALF + 4 * n);
#pragma unroll
        for (int ai = 0; ai < 2; ++ai)
#pragma unroll
            for (int m = 0; m < 4; ++m) { bf16_t* rowp = O + (size_t)(row0 + ai * HALF + m * 16) * DM + col0;
#pragma unroll
                for (int bj = 0; bj < 2; ++bj) { const f32x4 v0 = acc[ai][bj][m][0] + bv[bj][0], v1 = acc[ai][bj][m][1] + bv[bj][1];
                    u32x4 w; w.x = cvt_pk_bf16(v0[0], v0[1]); w.y = cvt_pk_bf16(v0[2], v0[3]); w.z = cvt_pk_bf16(v1[0], v1[1]); w.w = cvt_pk_bf16(v1[2], v1[3]);
                    *(u32x4*)(rowp + bj * HALF) = w; } }
    }
};
struct MoeOrder {
    int G, c, NT, ntiles; const LAS int* tsrc; const LAS int* tval; const LAS int* te; const int* stok; const LAS int* tbase; int flags;
    __device__ __forceinline__ bool next(int i, Unit& u) const {
#if defined(MOE_STATIC)
        const int nwg = ntiles * NT; const int L0 = i * G + c; if (L0 >= nwg) return false;
        int wgid = L0; { const int q = nwg / 8, r = nwg % 8, xcd = wgid % 8, off = wgid / 8; wgid = (xcd < r ? xcd * (q + 1) : r * (q + 1) + (xcd - r) * q) + off; }
        const int nig = 8 * NT, gid = wgid / nig, fm = gid * 8, gsz = (ntiles - fm) < 8 ? (ntiles - fm) : 8;
        u.pm = fm + ((wgid % nig) % gsz); u.pn = te[u.pm] * NT + (wgid % nig) / gsz; return true; }
#elif defined(MOE_PLAIN)
        const int L = i * G + c; const int mt = L / NT; if (mt >= ntiles) return false;
        u.pm = mt; u.pn = te[mt] * NT + (L % NT); return true; }
#else
        const int L = i * G + c, xcd = L & 7, j = L >> 3; const int mt = (j / NT) * 8 + xcd; if (mt >= ntiles) return false;
        u.pm = mt; u.pn = te[mt] * NT + (j % NT); return true; }
#endif
    __device__ __forceinline__ int arow(const Unit& u, int r) const {
#ifdef PROBE_VARIANT
        if (flags & 4) return (u.pm * 256 + r) & (NTOK - 1);
#endif
        return r < tval[u.pm] ? stok[tsrc[u.pm] + r] : 0; }
};
struct KsOne { __device__ __forceinline__ float operator()(int) const { return 1.f; } };
struct KsVec { const float* g; __device__ __forceinline__ float operator()(int k) const { return g[k]; } };
struct KsOut { const float* beta; __device__ __forceinline__ float operator()(int k) const { return k < DR ? 1.f : beta[k - DR]; } };
struct RmId { int off; __device__ __forceinline__ int operator()(int c) const { return off + c; } };
struct RmW1 { int e; __device__ __forceinline__ int operator()(int c) const { const int o = c >> 1, bj = c & 1; return e * 2048 + (o >> 7) * 256 + bj * 128 + (o & 127); } };
template <class KS, class RM>
__device__ __forceinline__ void tr_item(const float* src, int N, int k0, int c0, bf16_t* dst, int ldk, const KS ks, const RM rm, LAS float* scr, int lane) {
#pragma unroll 4
    for (int it = 0; it < 16; ++it) { const int r = it * 4 + (lane >> 4); const f32x4 v = *(const f32x4*)(src + (size_t)(k0 + r) * N + c0 + 4 * (lane & 15)); const float s = ks(k0 + r);
        LAS float* d = scr + r * 65 + 4 * (lane & 15); d[0] = v[0] * s; d[1] = v[1] * s; d[2] = v[2] * s; d[3] = v[3] * s; }
    LDS_WAIT();
    const int c = lane & 7;
#pragma unroll
    for (int jj = 0; jj < 8; ++jj) { const int n = (lane >> 3) + 8 * jj; const LAS float* s = scr + (8 * c) * 65 + n;
        u32x4 o; o.x = cvt_pk_bf16(s[0 * 65], s[1 * 65]); o.y = cvt_pk_bf16(s[2 * 65], s[3 * 65]); o.z = cvt_pk_bf16(s[4 * 65], s[5 * 65]); o.w = cvt_pk_bf16(s[6 * 65], s[7 * 65]);
        *(u32x4*)(dst + (size_t)rm(c0 + n) * ldk + k0 + 8 * c) = o; }
    LDS_WAIT();
}
struct CvItem { const float* src; int N, k0, c0; bf16_t* dst; int e; const float* ks; };
__device__ __forceinline__ void cv_item(const Params& p, int it, CvItem& c) {
    constexpr int I_1 = NE * 16 * 64;
    if (it < I_1) { const int e = it >> 10, q = it & 1023, kb = q >> 6, nb = q & 63; c.src = p.in[I_W1] + (size_t)e * DM * 2048; c.N = 2048; c.k0 = kb * 64; c.c0 = nb * 32; c.dst = (bf16_t*)(p.ws + WS_W1T); c.e = e; c.ks = p.in[I_N2G]; }
    else { const int r = it - I_1, e = r >> 9, q = r & 511, kb = q >> 5, nb = q & 31; c.src = p.in[I_W2] + (size_t)e * DFF * DM; c.N = DM; c.k0 = kb * 64; c.c0 = nb * 32; c.dst = (bf16_t*)(p.ws + WS_W2T); c.e = -(e * DM) - 1; c.ks = nullptr; }
}
__device__ __forceinline__ void cv_load(const CvItem& c, f32x4 (&v)[8], float (&s)[8], int lane) {
#pragma unroll
    for (int i = 0; i < 8; ++i) v[i] = __builtin_nontemporal_load((const f32x4*)(c.src + (size_t)(c.k0 + 8 * (lane >> 3) + i) * c.N + c.c0 + 4 * (lane & 7)));
    if (c.ks) { const f32x4 a = *(const f32x4*)(c.ks + c.k0 + 8 * (lane >> 3)), b = *(const f32x4*)(c.ks + c.k0 + 8 * (lane >> 3) + 4);
        s[0] = a[0]; s[1] = a[1]; s[2] = a[2]; s[3] = a[3]; s[4] = b[0]; s[5] = b[1]; s[6] = b[2]; s[7] = b[3]; }
    else {
#pragma unroll
        for (int i = 0; i < 8; ++i) s[i] = 1.0f; }
}
__device__ __forceinline__ void cv_emit(const CvItem& c0, const f32x4 (&v0)[8], const float (&s0)[8], LAS float*, int lane) {
#pragma unroll
    for (int j = 0; j < 4; ++j) { const int c = c0.c0 + 4 * (lane & 7) + j;
        u32x4 o; o.x = cvt_pk_bf16(v0[0][j] * s0[0], v0[1][j] * s0[1]); o.y = cvt_pk_bf16(v0[2][j] * s0[2], v0[3][j] * s0[3]); o.z = cvt_pk_bf16(v0[4][j] * s0[4], v0[5][j] * s0[5]); o.w = cvt_pk_bf16(v0[6][j] * s0[6], v0[7][j] * s0[7]);
        int row; if (c0.e >= 0) { const int oo = c >> 1, bj = c & 1; row = c0.e * 2048 + (oo >> 7) * 256 + bj * 128 + (oo & 127); } else row = -(c0.e + 1) + c;
        *(u32x4*)(c0.dst + (size_t)row * DM + c0.k0 + 8 * (lane >> 3)) = o; }
}
constexpr int CV_NIT = NE * 16 * 64 + NE * 16 * 32;
constexpr int CV_A = 0, CV_B = 8192, CV_C = 40960;
__device__ __forceinline__ int cv_ticket(unsigned* ctr, int lane) { unsigned t = 0; if (lane == 0) t = __hip_atomic_fetch_add(ctr, 1u, __ATOMIC_RELAXED, __HIP_MEMORY_SCOPE_AGENT); return (int)__builtin_amdgcn_readfirstlane(t); }
template <int BATCH>
__device__ __forceinline__ void cv_queue(const Params& p, LAS float* scr, int lane, unsigned* ctr, const int lo, const int hi) {
    CvItem c0, c1, c2; f32x4 v0[8], v1[8], v2[8]; float s0[8], s1[8], s2[8];
    int tb = 0, tp = BATCH;
#define CV_NEXT() (tp == BATCH ? (tb = lo + cv_ticket(ctr, lane) * BATCH, tp = 1, tb) : tb + tp++)
    int i0 = CV_NEXT(), i1 = CV_NEXT();
    if (i0 >= hi) return;
    cv_item(p, i0, c0); cv_load(c0, v0, s0, lane);
    if (i1 < hi) { cv_item(p, i1, c1); cv_load(c1, v1, s1, lane); }
    for (;;) {
        const int i2 = CV_NEXT();
        if (i2 < hi) { cv_item(p, i2, c2); cv_load(c2, v2, s2, lane); }
        cv_emit(c0, v0, s0, scr, lane);
        if (i1 >= hi) break;
        c0 = c1; c1 = c2; i1 = i2;
#pragma unroll
        for (int i = 0; i < 8; ++i) { v0[i] = v1[i]; v1[i] = v2[i]; s0[i] = s1[i]; s1[i] = s2[i]; }
    }
}
__device__ __forceinline__ void p5_convert(const Params& p, LAS float* scr, int lane) { cv_queue<16>(p, scr, lane, (unsigned*)(p.ws + WS_CTL) + CW_CVCTR, CV_B, CV_C); }
__device__ __forceinline__ void cv_tail(const Params& p, LAS unsigned char* lds, int wave, int lane, int cw, int lo, int n) {
    const int x = (int)blockIdx.x & 7, per = n >> 3; cv_queue<8>(p, (LAS float*)lds, lane, (unsigned*)(p.ws + WS_CTL) + cw + x * 32, lo + x * per, lo + (x + 1) * per); }
#undef CV_NEXT
__device__ __forceinline__ void p0_prologue(const Params& p, LAS unsigned char* lds, int wave, int lane) {
    unsigned char* ws = p.ws;
    LAS float* scr = (LAS float*)(lds + wave * 16640);
    const int gw = blockIdx.x * NWAVES + wave;
    bf16_t* WinT = (bf16_t*)(ws + WS_WINT); bf16_t* WoutT = (bf16_t*)(ws + WS_WOUTT); bf16_t* WgluT = (bf16_t*)(ws + WS_WGLUT);
    constexpr int I_IN = 16 * 36, I_OUT = 16 * 16, I_GLU = 8 * 8, NITEMS = I_IN + I_OUT + I_GLU;
    for (int it = gw; it < NITEMS; it += NGW) {
        int r = it;
        if (r < I_IN) { const int kb = r / 36, nb = r % 36; tr_item(p.in[I_WIN], DIN, kb * 64, nb * 64, WinT, DM, KsVec{p.in[I_N1G]}, RmId{0}, scr, lane); continue; } r -= I_IN;
        if (r < I_OUT) { const int kb = r >> 4, nb = r & 15; tr_item(p.in[I_WOUT], DM, kb * 64, nb * 64, WoutT, DM, KsOut{p.in[I_BETA]}, RmId{0}, scr, lane); continue; } r -= I_OUT;
        { const int kb = r >> 3, nb = r & 7; tr_item(p.in[I_WGLU], DSSM, kb * 64, nb * 64, WgluT, DSSM, KsOne{}, RmId{0}, scr, lane); }
    }
    { const float* x = p.in[I_X]; bf16_t* xb = (bf16_t*)(ws + WS_XB); float* rs = (float*)(ws + WS_RSTD1);
      for (int m = gw; m < NTOK; m += NGW) { const f32x4* xr = (const f32x4*)(x + (size_t)m * DM) + lane; f32x4 v[4]; float s = 0.f;
#pragma unroll
          for (int j = 0; j < 4; ++j) { v[j] = xr[64 * j]; s += (v[j][0] * v[j][0] + v[j][1] * v[j][1]) + (v[j][2] * v[j][2] + v[j][3] * v[j][3]); }
          s = wave_sum(s); if (lane == 0) rs[m] = 1.0f / sqrtf(s * (1.0f / DM) + 1e-5f);
          u32x2* o8 = (u32x2*)(xb + (size_t)m * DM) + lane;
#pragma unroll
          for (int j = 0; j < 4; ++j) { u32x2 w; w.x = cvt_pk_bf16(v[j][0], v[j][1]); w.y = cvt_pk_bf16(v[j][2], v[j][3]); o8[64 * j] = w; } } }
    const int gt = blockIdx.x * (NWAVES * 64) + wave * 64 + lane, NT_ = GRID * NWAVES * 64;
    { float* b1g = (float*)(ws + WS_B1G); float* b1l = (float*)(ws + WS_B1L); const float* b1 = p.in[I_B1];
      for (int i = gt; i < NE * DFF; i += NT_) { const int e = i >> 10, o = i & 1023; b1g[i] = b1[e * 2048 + 2 * o]; b1l[i] = b1[e * 2048 + 2 * o + 1]; } }
    { bf16_t* rwh = (bf16_t*)(ws + WS_RWP); bf16_t* rwl = rwh + NE * DM; const float* rw = p.in[I_RW]; const float* g2 = p.in[I_N2G];
      for (int i = gt; i < DM * NE; i += NT_) { const int e = i >> 10, k = i & 1023; const float v = g2[k] * rw[k * NE + e]; const bf16_t h = f2bf(v); rwh[i] = h; rwl[i] = f2bf(v - bf2f(h)); } }
    { bf16_t* LB = (bf16_t*)(ws + WS_LORAB); const float* wup = p.in[I_WUP]; const float* aup = p.in[I_AUP]; const float* gup = p.in[I_GUP];
      for (int i = gt; i < 1536 * 256; i += NT_) { const int n = i >> 8, k = i & 255; float v = 0.f;
          if (n < 512) { if (k < 64) v = wup[k * 512 + n]; } else if (n < 1024) { if (k >= 64 && k < 128) v = aup[(k - 64) * 512 + (n - 512)]; } else { if (k >= 128) v = gup[(k - 128) * 512 + (n - 1024)]; }
          LB[i] = f2bf(v); } }
}
__device__ __forceinline__ void p2_lora_in(const Params& p, int wave, int lane) {
    const bf16_t* proj = (const bf16_t*)(p.ws + WS_PROJ); bf16_t* li = (bf16_t*)(p.ws + WS_LORAIN); const float* mu = p.in[I_MU] + COL_LORA;
    const int gt = blockIdx.x * (NWAVES * 64) + wave * 64 + lane, NT_ = GRID * NWAVES * 64;
    for (int idx = gt; idx < NTOK * 32; idx += NT_) { const int tok = idx >> 5, c = (idx & 31) * 8;
        const bf16_t* pr = proj + (size_t)tok * DIN + COL_LORA + c; const u32x4 cur = *(const u32x4*)pr; u32x4 prv = (u32x4){0u, 0u, 0u, 0u}; if (tok & (SEQ - 1)) prv = *(const u32x4*)(pr - DIN);
        float v[8], q[8];
        v[0] = bflo(cur.x); v[1] = bfhi(cur.x); v[2] = bflo(cur.y); v[3] = bfhi(cur.y); v[4] = bflo(cur.z); v[5] = bfhi(cur.z); v[6] = bflo(cur.w); v[7] = bfhi(cur.w);
        q[0] = bflo(prv.x); q[1] = bfhi(prv.x); q[2] = bflo(prv.y); q[3] = bfhi(prv.y); q[4] = bflo(prv.z); q[5] = bfhi(prv.z); q[6] = bflo(prv.w); q[7] = bfhi(prv.w);
#pragma unroll
        for (int j = 0; j < 8; ++j) { float s = v[j] + mu[c + j] * (q[j] - v[j]); if (c < 64) s = tanhf(s); else if (c >= 128) s = sigmoidf_(s); v[j] = s; }
        u32x4 w; w.x = cvt_pk_bf16(v[0], v[1]); w.y = cvt_pk_bf16(v[2], v[3]); w.z = cvt_pk_bf16(v[4], v[5]); w.w = cvt_pk_bf16(v[6], v[7]);
        *(u32x4*)(li + (size_t)tok * 256 + c) = w; }
}
template <int CTRL> __device__ __forceinline__ float dpp_mov(float x) { return __int_as_float(__builtin_amdgcn_update_dpp(0, __float_as_int(x), CTRL, 0xF, 0xF, true)); }
__device__ __forceinline__ float sum8(float x) { x += dpp_mov<0xB1>(x); x += dpp_mov<0x4E>(x); x += dpp_mov<0x141>(x); return x; }
__device__ __forceinline__ float rowsum16(float x) { x = sum8(x); x += dpp_mov<0x140>(x); return x; }
__device__ __forceinline__ void unpack8(const u32x4 w, float (&f)[8]) { f[0] = bflo(w.x); f[1] = bfhi(w.x); f[2] = bflo(w.y); f[3] = bfhi(w.y); f[4] = bflo(w.z); f[5] = bfhi(w.z); f[6] = bflo(w.w); f[7] = bfhi(w.w); }
__device__ __forceinline__ void ld8(const float* p_, float (&f)[8]) { const f32x4 a = *(const f32x4*)p_, b = *(const f32x4*)(p_ + 4); f[0] = a[0]; f[1] = a[1]; f[2] = a[2]; f[3] = a[3]; f[4] = b[0]; f[5] = b[1]; f[6] = b[2]; f[7] = b[3]; }
__device__ __forceinline__ float gelu_tanh(float y) { const float t = 0.7978845608028654f * (y + 0.044715f * y * y * y); return y * sigmoidf_(2.0f * t); }
#define S5_ROLE(w, s) ((w) & 3)
#if !defined(S5_MAP)
#define S5_MAP 0
#endif
#if S5_MAP == 0
#define S5_SQ(w) ((w) >> 2)
#define S5_WQ(w) ((w) & 3)
#elif S5_MAP == 1
#define S5_SQ(w) (1 - ((w) >> 2))
#define S5_WQ(w) ((w) & 3)
#elif S5_MAP == 4
#define S5_SQ(w) ((w) >> 2)
#define S5_WQ(w) (((w) & 3) ^ ((w) >> 2))
#elif S5_MAP == 2
#define S5_SQ(w) ((w) >> 2)
#define S5_WQ(w) (3 - ((w) & 3))
#else
#define S5_SQ(w) ((w) & 1)
#define S5_WQ(w) ((w) >> 1)
#endif
#ifdef S5_DELAY_ROLE
#define S5_DELAY(w) do { if ((w) == S5_DELAY_ROLE) __builtin_amdgcn_s_sleep(4); } while (0)
#else
#define S5_DELAY(w) do { } while (0)
#endif
#ifdef S5_SYNC
#define S5_BARRIER() __syncthreads()
#else
#define S5_BARRIER() lds_barrier()
#endif
constexpr int S5_T = 32, S5_NT = SEQ / S5_T, S5_BU = S5_T * 64 * 8, S5_ST = S5_T * 272, S5_SEQB = 2 * S5_BU + 2 * S5_ST;
__device__ __forceinline__ void p5_s5(const Params& p, LAS unsigned char* lds, int wave, int lane, const int vf = 0) {
    const int sq = S5_SQ(wave), wq = S5_WQ(wave), q = (blockIdx.x - 128) * 2 + sq, b = q >> 5, g = q & 31;
    LAS unsigned char* L = lds + sq * 51200;
    const float dt = expf(p.in[I_LSTEP][g]);
    const bf16_t* ubase = (const bf16_t*)(p.ws + WS_PROJ) + (size_t)b * SEQ * DIN + COL_U + g * 16;
    bf16_t* yg = (bf16_t*)(p.ws + WS_YGELU) + (size_t)b * SEQ * DSSM + g * 16;
    f32x2 l1 = (f32x2){0.f, 0.f}, l2 = (f32x2){0.f, 0.f}, sv = (f32x2){0.f, 0.f};
    bf16x8 Bop[4], Bout[4], Dop; bf16x8 An[8], Un[8];
    const u32x4 z4 = (u32x4){0u, 0u, 0u, 0u};
    Dop = __builtin_bit_cast(bf16x8, z4);
#pragma unroll
    for (int k = 0; k < 4; ++k) Bop[k] = Bout[k] = __builtin_bit_cast(bf16x8, z4);
#pragma unroll
    for (int k = 0; k < 8; ++k) An[k] = Un[k] = __builtin_bit_cast(bf16x8, z4);
    const int rt3 = wq - 1;
    if (wq == 0) { const float lre = fminf(p.in[I_LRE][g * 64 + lane], -1e-4f), lim = p.in[I_LIM][g * 64 + lane]; const float mag = expf(lre * dt), ang = lim * dt; const float lbr = mag * cosf(ang), lbi = mag * sinf(ang);
        l1 = (f32x2){lbr, lbr}; l2 = (f32x2){-lbi, lbi}; }
    else if (wq == 3) {
#pragma unroll
        for (int ct = 0; ct < 4; ++ct) { const int c = 32 * ct + (lane & 31), pp = c & 63, isim = c >> 6; const float lre = fminf(p.in[I_LRE][g * 64 + pp], -1e-4f), lim = p.in[I_LIM][g * 64 + pp];
            const float mag = expf(lre * dt), ang = lim * dt, cr = mag * cosf(ang), ci = mag * sinf(ang), den = lre * lre + lim * lim, nre = cr - 1.0f;
            const float zre = (nre * lre + ci * lim) / den, zim = (ci * lre - nre * lim) / den;
            const float* bre = p.in[I_BRE] + (size_t)(g * 64 + pp) * 16 + 8 * (lane >> 5); const float* bim = p.in[I_BIM] + (size_t)(g * 64 + pp) * 16 + 8 * (lane >> 5);
            float t[8];
#pragma unroll
            for (int jj = 0; jj < 8; ++jj) t[jj] = isim ? (zre * bim[jj] + zim * bre[jj]) : (zre * bre[jj] - zim * bim[jj]);
            u32x4 w; w.x = cvt_pk_bf16(t[0], t[1]); w.y = cvt_pk_bf16(t[2], t[3]); w.z = cvt_pk_bf16(t[4], t[5]); w.w = cvt_pk_bf16(t[6], t[7]); Bop[ct] = __builtin_bit_cast(bf16x8, w); }
#pragma unroll
        for (int k = 0; k < 8; ++k) An[k] = *(const bf16x8*)(ubase + (size_t)(k * S5_T + (lane & 31)) * DIN + 8 * (lane >> 5)); }
    else { const int m = lane & 15;
#pragma unroll
        for (int ks = 0; ks < 4; ++ks) { float t[8];
#pragma unroll
            for (int jj = 0; jj < 8; ++jj) { const int k = 32 * ks + 8 * (lane >> 4) + jj, pp = k >> 1; t[jj] = (k & 1) ? -p.in[I_CIM][(size_t)(g * 16 + m) * 64 + pp] : p.in[I_CRE][(size_t)(g * 16 + m) * 64 + pp]; }
            u32x4 w; w.x = cvt_pk_bf16(t[0], t[1]); w.y = cvt_pk_bf16(t[2], t[3]); w.z = cvt_pk_bf16(t[4], t[5]); w.w = cvt_pk_bf16(t[6], t[7]); Bout[ks] = __builtin_bit_cast(bf16x8, w); }
        { const float dsk = p.in[I_DSKIP][g * 16 + m]; float t[8];
#pragma unroll
          for (int jj = 0; jj < 8; ++jj) t[jj] = (8 * (lane >> 4) + jj == m) ? dsk : 0.f;
          u32x4 w; w.x = cvt_pk_bf16(t[0], t[1]); w.y = cvt_pk_bf16(t[2], t[3]); w.z = cvt_pk_bf16(t[4], t[5]); w.w = cvt_pk_bf16(t[6], t[7]); Dop = __builtin_bit_cast(bf16x8, w); }
        if (lane < 32) {
#pragma unroll
            for (int k = 0; k < 8; ++k) Un[k] = *(const bf16x8*)(ubase + (size_t)(k * S5_T + 16 * rt3 + (lane & 15)) * DIN + 8 * (lane >> 4)); } }
    const f32x16 z16 = {0.f, 0.f, 0.f, 0.f, 0.f, 0.f, 0.f, 0.f, 0.f, 0.f, 0.f, 0.f, 0.f, 0.f, 0.f, 0.f};
#ifdef PROBE_S5
#define S5_SKIP(b) if (vf & (b)) break;
#else
#define S5_SKIP(b)
#endif
#define S5_STAGE1(tileidx, sl) do { S5_SKIP(4) LAS float* bu_ = (LAS float*)(L + ((tileidx) & 1) * S5_BU); \
        _Pragma("unroll") for (int hh = 0; hh < 2; ++hh) { const f32x16 dre = __builtin_amdgcn_mfma_f32_32x32x16_bf16(An[sl], Bop[hh], z16, 0, 0, 0), dim = __builtin_amdgcn_mfma_f32_32x32x16_bf16(An[sl], Bop[hh + 2], z16, 0, 0, 0); const int pp = 32 * hh + (lane & 31); \
            _Pragma("unroll") for (int r = 0; r < 16; ++r) { const int rw = (r & 3) + 8 * (r >> 2) + 4 * (lane >> 5); *(LAS f32x2*)(bu_ + (rw * 64 + pp) * 2) = (f32x2){dre[r], dim[r]}; } }     \
        } while (0)
#define S5_LD1(sl, t) do { const int tn_ = (t) < S5_NT ? (t) : S5_NT - 1; An[sl] = *(const bf16x8*)(ubase + (size_t)(tn_ * S5_T + (lane & 31)) * DIN + 8 * (lane >> 5)); } while (0)
#define S5_STAGE3(tileidx, sl) do { S5_SKIP(8) const LAS unsigned char* st_ = L + 2 * S5_BU + ((tileidx) & 1) * S5_ST; \
        f32x4 acc = __builtin_amdgcn_mfma_f32_16x16x32_bf16(Un[sl], Dop, (f32x4){0.f, 0.f, 0.f, 0.f}, 0, 0, 0); \
        _Pragma("unroll") for (int ks = 0; ks < 4; ++ks) { const bf16x8 a = *(const LAS bf16x8*)(st_ + (16 * rt3 + (lane & 15)) * 272 + (32 * ks + 8 * (lane >> 4)) * 2); acc = __builtin_amdgcn_mfma_f32_16x16x32_bf16(a, Bout[ks], acc, 0, 0, 0); } \
        _Pragma("unroll") for (int r = 0; r < 4; ++r) { const int tok = (tileidx) * S5_T + 16 * rt3 + 4 * (lane >> 4) + r; yg[(size_t)tok * DSSM + (lane & 15)] = f2bf(gelu_tanh(acc[r])); } } while (0)
#define S5_LD3(sl, t) do { const int tn_ = (t) < S5_NT ? (t) : S5_NT - 1; if (lane < 32) Un[sl] = *(const bf16x8*)(ubase + (size_t)(tn_ * S5_T + 16 * rt3 + (lane & 15)) * DIN + 8 * (lane >> 4)); } while (0)
#define S5_SCAN(ii) do { S5_SKIP(16) const LAS float* bu_ = (const LAS float*)(L + ((ii) & 1) * S5_BU); LAS unsigned char* st_ = L + 2 * S5_BU + ((ii) & 1) * S5_ST; \
            f32x2 xa[16], xb[16];     \
            _Pragma("unroll") for (int t = 0; t < 16; ++t) xa[t] = *(const LAS f32x2*)(bu_ + (t * 64 + lane) * 2); \
            __builtin_amdgcn_sched_barrier(0); \
            _Pragma("unroll") for (int t = 0; t < 8; ++t) { const f32x2 t1 = l1 * sv + xa[t]; const f32x2 sw = __builtin_shufflevector(sv, sv, 1, 0); sv = l2 * sw + t1; *(LAS unsigned*)(st_ + t * 272 + lane * 4) = cvt_pk_bf16(sv.x, sv.y); } \
            __builtin_amdgcn_sched_barrier(0); \
            _Pragma("unroll") for (int t = 0; t < 16; ++t) xb[t] = *(const LAS f32x2*)(bu_ + ((16 + t) * 64 + lane) * 2); \
            __builtin_amdgcn_sched_barrier(0); \
            _Pragma("unroll") for (int t = 8; t < 16; ++t) { const f32x2 t1 = l1 * sv + xa[t]; const f32x2 sw = __builtin_shufflevector(sv, sv, 1, 0); sv = l2 * sw + t1; *(LAS unsigned*)(st_ + t * 272 + lane * 4) = cvt_pk_bf16(sv.x, sv.y); } \
            _Pragma("unroll") for (int t = 0; t < 16; ++t) { const f32x2 t1 = l1 * sv + xb[t]; const f32x2 sw = __builtin_shufflevector(sv, sv, 1, 0); sv = l2 * sw + t1; *(LAS unsigned*)(st_ + (16 + t) * 272 + lane * 4) = cvt_pk_bf16(sv.x, sv.y); } } while (0)
    if (wq == 3) S5_STAGE1(0, 0);
    S5_BARRIER();
#define BAR_ S5_BARRIER()
    if (wq == 0) { for (int i = 0; i < S5_NT; ++i) { S5_SCAN(i); BAR_; } }
    else if (wq == 3) {
        for (int t0 = 0; t0 < S5_NT - 8; t0 += 8) {
            S5_STAGE1(t0 + 1, 1); BAR_; S5_STAGE1(t0 + 2, 2); BAR_;
            S5_LD1(6, t0 + 6); S5_LD1(7, t0 + 7); S5_LD1(0, t0 + 8); S5_LD1(1, t0 + 9); S5_LD1(2, t0 + 10);
            S5_STAGE1(t0 + 3, 3); BAR_; S5_STAGE1(t0 + 4, 4); BAR_; S5_STAGE1(t0 + 5, 5); BAR_;
            S5_LD1(3, t0 + 11); S5_LD1(4, t0 + 12); S5_LD1(5, t0 + 13);
            S5_STAGE1(t0 + 6, 6); BAR_; S5_STAGE1(t0 + 7, 7); BAR_; S5_STAGE1(t0 + 8, 0); BAR_; }
        { constexpr int t0 = S5_NT - 8;
            S5_STAGE1(t0 + 1, 1); BAR_; S5_STAGE1(t0 + 2, 2); BAR_; S5_LD1(6, t0 + 6); S5_LD1(7, t0 + 7);
            S5_STAGE1(t0 + 3, 3); BAR_; S5_STAGE1(t0 + 4, 4); BAR_; S5_STAGE1(t0 + 5, 5); BAR_; S5_STAGE1(t0 + 6, 6); BAR_; S5_STAGE1(t0 + 7, 7); BAR_; BAR_; } }
    else {
        BAR_;
        for (int t0 = 0; t0 < S5_NT - 8; t0 += 8) {
            S5_STAGE3(t0, 0); BAR_; S5_STAGE3(t0 + 1, 1); BAR_;
            S5_LD3(5, t0 + 5); S5_LD3(6, t0 + 6); S5_LD3(7, t0 + 7); S5_LD3(0, t0 + 8); S5_LD3(1, t0 + 9);
            S5_STAGE3(t0 + 2, 2); BAR_; S5_STAGE3(t0 + 3, 3); BAR_; S5_STAGE3(t0 + 4, 4); BAR_;
            S5_LD3(2, t0 + 10); S5_LD3(3, t0 + 11); S5_LD3(4, t0 + 12);
            S5_STAGE3(t0 + 5, 5); BAR_; S5_STAGE3(t0 + 6, 6); BAR_; S5_STAGE3(t0 + 7, 7); BAR_; }
        { constexpr int t0 = S5_NT - 8;
            S5_STAGE3(t0, 0); BAR_; S5_STAGE3(t0 + 1, 1); BAR_; S5_LD3(5, t0 + 5); S5_LD3(6, t0 + 6); S5_LD3(7, t0 + 7);
            S5_STAGE3(t0 + 2, 2); BAR_; S5_STAGE3(t0 + 3, 3); BAR_; S5_STAGE3(t0 + 4, 4); BAR_; S5_STAGE3(t0 + 5, 5); BAR_; S5_STAGE3(t0 + 6, 6); BAR_; S5_STAGE3(t0 + 7, 7); } }
#undef BAR_
#undef S5_LD1
#undef S5_LD3
#undef S5_SCAN
#undef S5_ITER
#undef S5_STAGE1
#undef S5_STAGE3
}
struct P7In { f32x4 s0, s1; float rk; u32x4 yr, yg, cv, qv, gg; };
__device__ __forceinline__ void p7_load(P7In& in, const bf16_t* yraw, const bf16_t* proj, const float* rkb, const bf16_t* lg, const bf16_t* yglu, const float* ssq, int tok, int lane) {
    const int c0 = lane * 8, h = lane >> 3;
    in.yr = *(const u32x4*)(yraw + (size_t)tok * DR + c0);
    { const bf16_t* pv = proj + (size_t)tok * DIN + COL_V + c0; in.cv = *(const u32x4*)pv; in.qv = (tok & (SEQ - 1)) ? *(const u32x4*)(pv - DIN) : (u32x4){0u, 0u, 0u, 0u}; in.rk = rkb[(size_t)tok * NH + h]; }
    in.gg = *(const u32x4*)(lg + (size_t)tok * DR + c0);
    in.s0 = *(const f32x4*)(ssq + (size_t)tok * 8); in.s1 = *(const f32x4*)(ssq + (size_t)tok * 8 + 4);
    in.yg = *(const u32x4*)(yglu + (size_t)tok * DSSM + c0);
}
__device__ __forceinline__ void p7_mix(const Params& p, int wave, int lane) {
    const bf16_t* yraw = (const bf16_t*)(p.ws + WS_YRAW); const bf16_t* proj = (const bf16_t*)(p.ws + WS_PROJ); const float* rkb = (const float*)(p.ws + WS_RKB); const bf16_t* lg = (const bf16_t*)(p.ws + WS_LORAG); bf16_t* mixed = (bf16_t*)(p.ws + WS_MIXED);
    const bf16_t* yglu = (const bf16_t*)(p.ws + WS_YGLU); const float* ssq = (const float*)(p.ws + WS_SSQ);
    const int c0 = lane * 8;
    float lnw[8], lnb[8], muv[8]; ld8(p.in[I_LNW] + c0, lnw); ld8(p.in[I_LNB] + c0, lnb); ld8(p.in[I_MU] + COL_V + c0, muv);
    const int gw = blockIdx.x * NWAVES + wave;
    P7In cur, nxt; p7_load(cur, yraw, proj, rkb, lg, yglu, ssq, gw, lane);
    for (int tok = gw; tok < NTOK; tok += NGW) {
        if (tok + NGW < NTOK) p7_load(nxt, yraw, proj, rkb, lg, yglu, ssq, tok + NGW, lane);
        float y[8], v[8], g[8], o[8], cvv[8], qvv[8]; unpack8(cur.cv, cvv); unpack8(cur.qv, qvv); unpack8(cur.gg, g); unpack8(cur.yr, y);
#pragma unroll
        for (int j = 0; j < 8; ++j) v[j] = cvv[j] + muv[j] * (qvv[j] - cvv[j]);
        float sm = 0.f;
#pragma unroll
        for (int j = 0; j < 8; ++j) sm += y[j];
        const float mu = sum8(sm) * (1.0f / 64.0f); float sq = 0.f;
#pragma unroll
        for (int j = 0; j < 8; ++j) { y[j] -= mu; sq += y[j] * y[j]; }
        const float rstd = 1.0f / sqrtf(sum8(sq) * (1.0f / 64.0f) + 64e-5f);
#pragma unroll
        for (int j = 0; j < 8; ++j) { o[j] = (y[j] * rstd * lnw[j] + lnb[j] + cur.rk * v[j]) * g[j];
#ifdef SCRUB7
            o[j] = (o[j] == o[j] && fabsf(o[j]) < 1e30f) ? o[j] : 0.f;
#endif
        }
        u32x4 w; w.x = cvt_pk_bf16(o[0], o[1]); w.y = cvt_pk_bf16(o[2], o[3]); w.z = cvt_pk_bf16(o[4], o[5]); w.w = cvt_pk_bf16(o[6], o[7]);
        *(u32x4*)(mixed + (size_t)tok * DM + c0) = w;
        const float ss = ((cur.s0[0] + cur.s0[1]) + (cur.s0[2] + cur.s0[3])) + ((cur.s1[0] + cur.s1[1]) + (cur.s1[2] + cur.s1[3])); const float rs = 1.0f / sqrtf(ss * (1.0f / DSSM) + 1e-5f);
        float yv[8]; unpack8(cur.yg, yv);
        u32x4 w2; w2.x = cvt_pk_bf16(yv[0] * rs, yv[1] * rs); w2.y = cvt_pk_bf16(yv[2] * rs, yv[3] * rs); w2.z = cvt_pk_bf16(yv[4] * rs, yv[5] * rs); w2.w = cvt_pk_bf16(yv[6] * rs, yv[7] * rs);
        *(u32x4*)(mixed + (size_t)tok * DM + DR + c0) = w2;
        cur = nxt;
    }
}
constexpr int CT = 72;
constexpr int SLOT = 64 * CT * 2;
constexpr int SL_AH = 0, SL_BH = 1, SL_KH = 2, SL_RH = 3, SL_AHT = 4, SL_BTT = 5, SL_KTT = 6, SL_VT = 7, SL_PA = 8, SL_PAT = 9, SL_TA = 10, SL_AAK = 11, SL_ARB = 12, SL_ARK = 13, SL_XT = 14, SL_UVT = 15;
constexpr int SL_PB = 0, SL_PBT = 1, SL_TB = 2, SL_WT = 11;
constexpr int LC_OFF = SL_PA * SLOT, TOT_OFF = LC_OFF + 64 * 64 * 4;
constexpr int GT_OFF = 16 * SLOT;
constexpr int PC_OFF = GT_OFF + 256;
__device__ __forceinline__ LAS bf16_t* slot(LAS unsigned char* lds, int s) { return (LAS bf16_t*)(lds + s * SLOT); }
template <bool TR> __device__ __forceinline__ void mm2(const LAS bf16_t* X, const LAS bf16_t* YT, int mi, int ni0, int lane, f32x4 (&acc)[2]) {
    const int fr = lane & 15, fq = lane >> 4;
#pragma unroll
    for (int ks = 0; ks < 2; ++ks) { const bf16x8 a = *(const LAS bf16x8*)(X + (16 * mi + fr) * CT + 32 * ks + 8 * fq);
#pragma unroll
        for (int t = 0; t < 2; ++t) { const bf16x8 b = *(const LAS bf16x8*)(YT + (16 * (ni0 + t) + fr) * CT + 32 * ks + 8 * fq);
            acc[t] = TR ? __builtin_amdgcn_mfma_f32_16x16x32_bf16(a, b, acc[t], 0, 0, 0) : __builtin_amdgcn_mfma_f32_16x16x32_bf16(b, a, acc[t], 0, 0, 0); } }
}
__device__ __forceinline__ void ldA(const LAS bf16_t* X, int mi, int lane, bf16x8 (&a)[2]) {
#pragma unroll
    for (int ks = 0; ks < 2; ++ks) a[ks] = *(const LAS bf16x8*)(X + (16 * mi + (lane & 15)) * CT + 32 * ks + 8 * (lane >> 4)); }
__device__ __forceinline__ void ldB(const LAS bf16_t* YT, int ni0, int lane, bf16x8 (&b)[2][2]) {
#pragma unroll
    for (int t = 0; t < 2; ++t)
#pragma unroll
        for (int ks = 0; ks < 2; ++ks) b[t][ks] = *(const LAS bf16x8*)(YT + (16 * (ni0 + t) + (lane & 15)) * CT + 32 * ks + 8 * (lane >> 4)); }
template <bool TR> __device__ __forceinline__ void mma(const bf16x8 (&a)[2], const bf16x8 (&b)[2][2], f32x4 (&acc)[2]) {
#pragma unroll
    for (int ks = 0; ks < 2; ++ks)
#pragma unroll
        for (int t = 0; t < 2; ++t) acc[t] = TR ? __builtin_amdgcn_mfma_f32_16x16x32_bf16(a[ks], b[t][ks], acc[t], 0, 0, 0) : __builtin_amdgcn_mfma_f32_16x16x32_bf16(b[t][ks], a[ks], acc[t], 0, 0, 0); }
#define ZACC(x) x[0] = x[1] = (f32x4){0.f, 0.f, 0.f, 0.f}
__device__ __forceinline__ void st_rm(LAS bf16_t* Z, int mi, int ni, int lane, const f32x4 v) { u32x2 w; w.x = cvt_pk_bf16(v[0], v[1]); w.y = cvt_pk_bf16(v[2], v[3]); *(LAS u32x2*)(Z + (16 * mi + (lane & 15)) * CT + 16 * ni + 4 * (lane >> 4)) = w; }
__device__ __forceinline__ void st_tr(LAS bf16_t* ZT, int mi, int ni, int lane, const f32x4 v) {
#pragma unroll
    for (int r = 0; r < 4; ++r) ZT[(16 * ni + 4 * (lane >> 4) + r) * CT + 16 * mi + (lane & 15)] = f2bf(v[r]); }
__device__ __forceinline__ void st_trT(LAS bf16_t* ZT, int mi, int ni, int lane, const f32x4 v) { u32x2 w; w.x = cvt_pk_bf16(v[0], v[1]); w.y = cvt_pk_bf16(v[2], v[3]); *(LAS u32x2*)(ZT + (16 * ni + (lane & 15)) * CT + 16 * mi + 4 * (lane >> 4)) = w; }
__device__ __forceinline__ void ld8l(const LAS float* s, float (&d)[8]) { const f32x4 a = *(const LAS f32x4*)s, b = *(const LAS f32x4*)(s + 4); d[0] = a[0]; d[1] = a[1]; d[2] = a[2]; d[3] = a[3]; d[4] = b[0]; d[5] = b[1]; d[6] = b[2]; d[7] = b[3]; }
struct PaIn { u32x4 cr, ck, cv, qr, qk, qv, ap; float lwr[8]; };
__device__ __forceinline__ void pa_load(PaIn& in, const bf16_t* proj, const bf16_t* la, const float* lw, int job, int wave, int lane) {
    const int bh = job >> 6, c = job & 63, b = bh >> 3, h = bh & 7; const int tok0 = b * SEQ + c * 64;
    { const int t = wave * 8 + (lane >> 3), cg = lane & 7, tok = tok0 + t; const bf16_t* row = proj + (size_t)tok * DIN + h * HD + cg * 8; const bool first = (c == 0 && t == 0); const u32x4 z = (u32x4){0u, 0u, 0u, 0u};
      in.cr = *(const u32x4*)row; in.ck = *(const u32x4*)(row + COL_K); in.cv = *(const u32x4*)(row + COL_V);
      in.qr = first ? z : *(const u32x4*)(row - DIN); in.qk = first ? z : *(const u32x4*)(row - DIN + COL_K); in.qv = first ? z : *(const u32x4*)(row - DIN + COL_V);
      in.ap = *(const u32x4*)(la + (size_t)tok * DR + h * HD + cg * 8); }
#pragma unroll
    for (int i = 0; i < 8; ++i) in.lwr[i] = lw[(size_t)(tok0 + wave * 8 + i) * DR + h * HD + lane];
}
__device__ __forceinline__ float logdecay(float x) { const float z = -x; const float sp = fmaxf(z, 0.f) + __logf(1.0f + __expf(-fabsf(z))); return -__expf(-sp - 0.5f); }
__device__ __forceinline__ void p4_chunks(const Params& p, LAS unsigned char* lds, int wave, int lane, const int vflags) {
    const bf16_t* proj = (const bf16_t*)(p.ws + WS_PROJ); const float* lwp = (const float*)(p.ws + WS_LORAW); const bf16_t* lap = (const bf16_t*)(p.ws + WS_LORAA);
    bf16_t* QP = (bf16_t*)(p.ws + WS_QP); bf16_t* YG = (bf16_t*)(p.ws + WS_YG); float* rkb = (float*)(p.ws + WS_RKB);
    LAS float* lct = (LAS float*)(lds + LC_OFF); LAS float* tot = (LAS float*)(lds + TOT_OFF); LAS float* gtab = (LAS float*)(lds + GT_OFF); LAS bf16_t* ewt = slot(lds, SL_TA);
    const int mi = wave >> 1, ni0 = (wave & 1) * 2, fr = lane & 15, fq = lane >> 4;
    PaIn in; pa_load(in, proj, lap, lwp, blockIdx.x, wave, lane);
    bf16x8 aI[2];
    { const int m = 16 * (wave >> 1) + (lane & 15);
#pragma unroll
      for (int ks = 0; ks < 2; ++ks) { u32x4 w = (u32x4){0u, 0u, 0u, 0u}; const int e = m - 32 * ks - 8 * (lane >> 4);
          if (e >= 0 && e < 8) { const unsigned one = (e & 1) ? 0x3F800000u : 0x00003F80u; if ((e >> 1) == 0) w.x = one; else if ((e >> 1) == 1) w.y = one; else if ((e >> 1) == 2) w.z = one; else w.w = one; }
          aI[ks] = __builtin_bit_cast(bf16x8, w); } }
    LAS float* pcs = (LAS float*)(lds + PC_OFF);
    { const int tid = wave * 64 + lane;
#pragma unroll
      for (int q = 0; q < 2; ++q) { const int e = tid + q * 512, hs = e >> 9, ar = (e >> 6) & 7, k = e & 63, hh = (int)(blockIdx.x >> 6) + 4 * hs, col = hh * HD + k;
          const float* src = ar == 0 ? p.in[I_W0] + col : ar == 1 ? p.in[I_MU] + col : ar == 2 ? p.in[I_MU] + COL_K + col : ar == 3 ? p.in[I_MU] + COL_V + col : ar == 4 ? p.in[I_KK] + col : ar == 5 ? p.in[I_KA] + col : ar == 6 ? p.in[I_RK] + col : p.in[I_A0] + col;
          pcs[e] = *src; } }
    lds_barrier();
    for (int job = blockIdx.x; job < 64 * 64; job += GRID) {
        const int bh = job >> 6, c = job & 63, b = bh >> 3, h = bh & 7; const int tok0 = b * SEQ + c * 64;
        const LAS float* pch = pcs + (h >> 2) * 512;
        { const float w0k = pch[lane]; float pre[8]; float run = 0.f;
#pragma unroll
          for (int i = 0; i < 8; ++i) { const float lw_ = logdecay(w0k + in.lwr[i]); run += lw_; pre[i] = run; ewt[(wave * 8 + i) * 64 + lane] = f2bf(__expf(-lw_)); }
          tot[wave * 64 + lane] = run;
          lds_barrier();
          float off = 0.f;
#pragma unroll
          for (int w2 = 0; w2 < 7; ++w2) off += (w2 < wave) ? tot[w2 * 64 + lane] : 0.f;
#pragma unroll
          for (int i = 0; i < 8; ++i) lct[(wave * 8 + i) * 64 + lane] = off + pre[i];
          if (wave == 7) gtab[lane] = __expf(off + pre[7]); }
        lds_barrier();
        { const int t = wave * 8 + (lane >> 3), cg = lane & 7, k0 = cg * 8, col = h * HD + k0;
          float cr[8], ck[8], cv[8], qr[8], qk[8], qv[8], lc[8], gc[8], mur[8], muk[8], muv[8], kkw[8], kaw[8], rkw[8], a0c[8];
          unpack8(in.cr, cr); unpack8(in.ck, ck); unpack8(in.cv, cv); unpack8(in.qr, qr); unpack8(in.qk, qk); unpack8(in.qv, qv);
          { const f32x4 x0 = *(const LAS f32x4*)(lct + t * 64 + k0), x1 = *(const LAS f32x4*)(lct + t * 64 + k0 + 4), g0 = *(const LAS f32x4*)(gtab + k0), g1 = *(const LAS f32x4*)(gtab + k0 + 4);
#pragma unroll
            for (int j = 0; j < 4; ++j) { lc[j] = x0[j]; lc[j + 4] = x1[j]; gc[j] = g0[j]; gc[j + 4] = g1[j]; } }
          ld8l(pch + 64 + k0, mur); ld8l(pch + 128 + k0, muk); ld8l(pch + 192 + k0, muv); ld8l(pch + 256 + k0, kkw); ld8l(pch + 320 + k0, kaw); ld8l(pch + 384 + k0, rkw); ld8l(pch + 448 + k0, a0c);
          float ah[8], bh_[8], kh[8], rh[8], bt[8], kt[8], vv[8], kk[8], ew[8], apv[8]; float n2 = 0.f, rk = 0.f; unpack8(in.ap, apv);
          unpack8(*(const LAS u32x4*)(ewt + t * 64 + k0), ew);
#pragma unroll
          for (int j = 0; j < 8; ++j) { const float r = cr[j] + mur[j] * (qr[j] - cr[j]), kraw = ck[j] + muk[j] * (qk[j] - ck[j]); vv[j] = cv[j] + muv[j] * (qv[j] - cv[j]);
              const float ap = apv[j];
              const float a = sigmoidf_(a0c[j] + ap);
              kk[j] = kraw * kkw[j]; n2 += kk[j] * kk[j]; const float km = kraw * (1.0f + (a - 1.0f) * kaw[j]); rk += r * km * rkw[j];
              const float e1 = __expf(lc[j]), e2 = __builtin_amdgcn_rcpf(e1), g = gc[j];
              rh[j] = r * e1; kh[j] = km * e2; kt[j] = kh[j] * g; ah[j] = -e1 * ew[j]; bh_[j] = a * e2; bt[j] = g; }
          n2 = sum8(n2); rk = sum8(rk);
          const float inv = 1.0f / fmaxf(sqrtf(n2), 1e-12f);
#pragma unroll
          for (int j = 0; j < 8; ++j) { const float kn = kk[j] * inv; ah[j] *= kn; bh_[j] *= kn; bt[j] *= bh_[j]; }
          if (cg == 0) rkb[(size_t)(tok0 + t) * NH + h] = rk;
          u32x4 w;
          w.x = cvt_pk_bf16(ah[0], ah[1]); w.y = cvt_pk_bf16(ah[2], ah[3]); w.z = cvt_pk_bf16(ah[4], ah[5]); w.w = cvt_pk_bf16(ah[6], ah[7]); *(LAS u32x4*)(slot(lds, SL_AH) + t * CT + k0) = w;
          w.x = cvt_pk_bf16(bh_[0], bh_[1]); w.y = cvt_pk_bf16(bh_[2], bh_[3]); w.z = cvt_pk_bf16(bh_[4], bh_[5]); w.w = cvt_pk_bf16(bh_[6], bh_[7]); *(LAS u32x4*)(slot(lds, SL_BH) + t * CT + k0) = w;
          w.x = cvt_pk_bf16(kh[0], kh[1]); w.y = cvt_pk_bf16(kh[2], kh[3]); w.z = cvt_pk_bf16(kh[4], kh[5]); w.w = cvt_pk_bf16(kh[6], kh[7]); *(LAS u32x4*)(slot(lds, SL_KH) + t * CT + k0) = w;
          w.x = cvt_pk_bf16(rh[0], rh[1]); w.y = cvt_pk_bf16(rh[2], rh[3]); w.z = cvt_pk_bf16(rh[4], rh[5]); w.w = cvt_pk_bf16(rh[6], rh[7]); *(LAS u32x4*)(slot(lds, SL_RH) + t * CT + k0) = w;
          w.x = cvt_pk_bf16(bt[0], bt[1]); w.y = cvt_pk_bf16(bt[2], bt[3]); w.z = cvt_pk_bf16(bt[4], bt[5]); w.w = cvt_pk_bf16(bt[6], bt[7]); *(LAS u32x4*)(slot(lds, SL_BTT) + t * CT + k0) = w;
          w.x = cvt_pk_bf16(kt[0], kt[1]); w.y = cvt_pk_bf16(kt[2], kt[3]); w.z = cvt_pk_bf16(kt[4], kt[5]); w.w = cvt_pk_bf16(kt[6], kt[7]); *(LAS u32x4*)(slot(lds, SL_KTT) + t * CT + k0) = w;
          w.x = cvt_pk_bf16(vv[0], vv[1]); w.y = cvt_pk_bf16(vv[2], vv[3]); w.z = cvt_pk_bf16(vv[4], vv[5]); w.w = cvt_pk_bf16(vv[6], vv[7]); *(LAS u32x4*)(slot(lds, SL_XT) + t * CT + k0) = w; }
        if (job + GRID < 64 * 64) pa_load(in, proj, lap, lwp, job + GRID, wave, lane);
        lds_barrier();
#ifdef PROBE_VPHASE
        if (vflags & 4) { lds_barrier(); continue; }
#endif
        f32x4 accT[2];
        { bf16x8 aA[2], aR[2], bB[2][2], bK[2][2]; ldA(slot(lds, SL_AH), mi, lane, aA); ldA(slot(lds, SL_RH), mi, lane, aR); ldB(slot(lds, SL_BH), ni0, lane, bB); ldB(slot(lds, SL_KH), ni0, lane, bK);
          f32x4 c1[2], c2[2], c3[2], c4[2]; ZACC(c1); ZACC(c2); ZACC(c3); ZACC(c4);
          mma<false>(aA, bB, c1); mma<false>(aA, bK, c2); mma<false>(aR, bB, c3); mma<false>(aR, bK, c4);
          { bf16x8 bA2[2][2], bV2[2][2]; ldB(slot(lds, SL_AH), ni0, lane, bA2); ldB(slot(lds, SL_XT), ni0, lane, bV2); f32x4 t1[2], t2[2]; ZACC(t1); ZACC(t2); mma<false>(aI, bA2, t1); mma<false>(aI, bV2, t2);
#pragma unroll
            for (int t = 0; t < 2; ++t) { st_rm(slot(lds, SL_AHT), mi, ni0 + t, lane, t1[t]); st_rm(slot(lds, SL_VT), mi, ni0 + t, lane, t2[t]); } }
#pragma unroll
          for (int t = 0; t < 2; ++t) { const int m = 16 * mi + fr, n = 16 * (ni0 + t) + 4 * fq;
#pragma unroll
              for (int r = 0; r < 4; ++r) { c1[t][r] = (n + r < m) ? c1[t][r] : 0.f; c2[t][r] = (n + r < m) ? c2[t][r] : 0.f; c3[t][r] = (n + r <= m) ? c3[t][r] : 0.f; c4[t][r] = (n + r <= m) ? c4[t][r] : 0.f;
                  accT[t][r] = c1[t][r] + ((n + r == m) ? 1.0f : 0.f); }
              st_rm(slot(lds, SL_PA), mi, ni0 + t, lane, c1[t]); st_tr(slot(lds, SL_PAT), mi, ni0 + t, lane, c1[t]); st_rm(slot(lds, SL_TA), mi, ni0 + t, lane, accT[t]);
              st_rm(slot(lds, SL_AAK), mi, ni0 + t, lane, c2[t]); st_rm(slot(lds, SL_ARB), mi, ni0 + t, lane, c3[t]); st_rm(slot(lds, SL_ARK), mi, ni0 + t, lane, c4[t]); } }
        lds_barrier();
        { bf16x8 aP[2], aK[2], bP[2][2], bV[2][2]; ldA(slot(lds, SL_PA), mi, lane, aP); ldA(slot(lds, SL_AAK), mi, lane, aK); ldB(slot(lds, SL_PAT), ni0, lane, bP); ldB(slot(lds, SL_VT), ni0, lane, bV);
          f32x4 c1[2], c2[2]; ZACC(c1); ZACC(c2); mma<false>(aP, bP, c1); mma<true>(aK, bV, c2);
#pragma unroll
          for (int t = 0; t < 2; ++t) { st_rm(slot(lds, SL_PB), mi, ni0 + t, lane, c1[t]); st_tr(slot(lds, SL_PBT), mi, ni0 + t, lane, c1[t]); st_trT(slot(lds, SL_XT), mi, ni0 + t, lane, c2[t]); } }
        lds_barrier();
#pragma unroll
        for (int it = 1; it <= 5; ++it) { const bool odd = (it & 1) != 0;
#ifdef PROBE_VPHASE
            if (vflags & 1) continue;
#endif
            LAS bf16_t* Pr = slot(lds, odd ? SL_PB : SL_PA); LAS bf16_t* PrT = slot(lds, odd ? SL_PBT : SL_PAT); LAS bf16_t* Pw = slot(lds, odd ? SL_PA : SL_PB); LAS bf16_t* PwT = slot(lds, odd ? SL_PAT : SL_PBT);
            LAS bf16_t* Tr = slot(lds, odd ? SL_TA : SL_TB); LAS bf16_t* Tw = slot(lds, odd ? SL_TB : SL_TA);
            bf16x8 aT[2], aP[2], bP[2][2]; ldA(Tr, mi, lane, aT); ldB(PrT, ni0, lane, bP); if (it < 5) ldA(Pr, mi, lane, aP);
            f32x4 c1[2]; ZACC(c1);
            mma<false>(aT, bP, accT); if (it < 5) mma<false>(aP, bP, c1);
#pragma unroll
            for (int t = 0; t < 2; ++t) { st_rm(Tw, mi, ni0 + t, lane, accT[t]); if (it < 5) { st_rm(Pw, mi, ni0 + t, lane, c1[t]); st_tr(PwT, mi, ni0 + t, lane, c1[t]); } }
            lds_barrier(); }
        { bf16x8 aT[2], bA[2][2], bX[2][2]; ldA(slot(lds, SL_TB), mi, lane, aT); ldB(slot(lds, SL_AHT), ni0, lane, bA); ldB(slot(lds, SL_XT), ni0, lane, bX);
          f32x4 c1[2], c2[2]; ZACC(c1); ZACC(c2); mma<true>(aT, bA, c1); mma<true>(aT, bX, c2);
          { bf16x8 bB2[2][2], bK2[2][2]; ldB(slot(lds, SL_BTT), ni0, lane, bB2); ldB(slot(lds, SL_KTT), ni0, lane, bK2); f32x4 t1[2], t2[2]; ZACC(t1); ZACC(t2); mma<false>(aI, bB2, t1); mma<false>(aI, bK2, t2);
#pragma unroll
            for (int t = 0; t < 2; ++t) { st_rm(slot(lds, SL_PA), mi, ni0 + t, lane, t1[t]); st_rm(slot(lds, SL_PAT), mi, ni0 + t, lane, t2[t]); } }
#pragma unroll
          for (int t = 0; t < 2; ++t) { st_trT(slot(lds, SL_WT), mi, ni0 + t, lane, c1[t]); st_trT(slot(lds, SL_UVT), mi, ni0 + t, lane, c2[t]); } }
        lds_barrier();
        { bf16_t* qp = QP + (size_t)job * 2 * 4096; bf16_t* yg = YG + (size_t)job * 2 * 4096; const int m = 16 * mi + fr, qs = 2 * (fq & 1) + (fq >> 1);
          bf16x8 aRB[2], aRK[2], aBT[2], aKT[2], bW[2][2], bU[2][2], bV[2][2];
          ldA(slot(lds, SL_ARB), mi, lane, aRB); ldA(slot(lds, SL_ARK), mi, lane, aRK); ldA(slot(lds, SL_PA), mi, lane, aBT); ldA(slot(lds, SL_PAT), mi, lane, aKT);
          ldB(slot(lds, SL_WT), ni0, lane, bW); ldB(slot(lds, SL_UVT), ni0, lane, bU); ldB(slot(lds, SL_VT), ni0, lane, bV);
          u32x2 rr[2];
#pragma unroll
          for (int t = 0; t < 2; ++t) rr[t] = *(const LAS u32x2*)(slot(lds, SL_RH) + m * CT + 16 * (ni0 + t) + 4 * fq);
          const float gm = gtab[m];
          f32x4 cq[2], cy[2], cp[2], cg[2]; ZACC(cq); ZACC(cy); ZACC(cp); ZACC(cg);
          mma<false>(aRB, bW, cq); mma<false>(aRB, bU, cy); mma<false>(aBT, bW, cp); mma<false>(aBT, bU, cg); mma<false>(aRK, bV, cy); mma<false>(aKT, bV, cg);
#pragma unroll
          for (int t = 0; t < 2; ++t) { const int n = 16 * (ni0 + t) + 4 * fq; u32x2 w;
              w.x = cvt_pk_bf16(cq[t][0] + bflo(rr[t].x), cq[t][1] + bfhi(rr[t].x)); w.y = cvt_pk_bf16(cq[t][2] + bflo(rr[t].y), cq[t][3] + bfhi(rr[t].y)); *(u32x2*)(qp + m * 64 + 16 * (ni0 + t) + 4 * qs) = w;
              w.x = cvt_pk_bf16(cy[t][0], cy[t][1]); w.y = cvt_pk_bf16(cy[t][2], cy[t][3]); *(u32x2*)(yg + m * 64 + n) = w;
#pragma unroll
              for (int r = 0; r < 4; ++r) cp[t][r] += (n + r == m) ? gm : 0.f;
              w.x = cvt_pk_bf16(cp[t][0], cp[t][1]); w.y = cvt_pk_bf16(cp[t][2], cp[t][3]); *(u32x2*)(qp + 4096 + m * 64 + 16 * (ni0 + t) + 4 * qs) = w;
              w.x = cvt_pk_bf16(cg[t][0], cg[t][1]); w.y = cvt_pk_bf16(cg[t][2], cg[t][3]); *(u32x2*)(yg + 4096 + m * 64 + n) = w; } }
        lds_barrier();
    }
}
#undef ZACC

constexpr int PB_BUF = 32768;
__device__ __forceinline__ void pb_dma(const bf16_t* qt, const bf16_t* yl, int jv, LAS unsigned char* dst, int lane) {
    const int rr = lane >> 3, cc = lane & 7;
#pragma unroll
    for (int pc = 0; pc < 16; ++pc)
        __builtin_amdgcn_global_load_lds((const unsigned*)((const char*)qt + pc * 1024 + rr * 128 + ((cc ^ rr) * 16)), (LAS unsigned*)(dst + pc * 1024), 16, 0, 0);
#pragma unroll
    for (int q = 0; q < 2; ++q)
#pragma unroll
        for (int pc = 0; pc < 4; ++pc) { const bf16_t* base = yl + q * 4096;
            __builtin_amdgcn_global_load_lds((const unsigned*)((const char*)(base + (pc * 16 + (lane >> 2)) * 64 + jv * 32) + (lane & 3) * 16), (LAS unsigned*)(dst + 16384 + q * 4096 + pc * 1024), 16, 0, 0); }
}
__device__ __forceinline__ void p5_seq(const Params& p, LAS unsigned char* lds, int lane) {
    const int bh = blockIdx.x >> 1, jv = blockIdx.x & 1, b = bh >> 3, h = bh & 7, r31 = lane & 31, hh = lane >> 5;
    const bf16_t* QP = (const bf16_t*)(p.ws + WS_QP) + (size_t)bh * 64 * 2 * 4096; const bf16_t* YG = (const bf16_t*)(p.ws + WS_YG) + (size_t)bh * 64 * 2 * 4096;
    bf16_t* yraw = (bf16_t*)(p.ws + WS_YRAW) + (size_t)b * SEQ * DR + h * HD + 32 * jv + r31;
    f32x16 H[2];
#pragma unroll
    for (int i = 0; i < 2; ++i)
#pragma unroll
        for (int r = 0; r < 16; ++r) H[i][r] = 0.f;
    pb_dma(QP, YG, jv, lds, lane);
    VM_WAIT();
    for (int c = 0; c < 64; ++c) { const LAS unsigned char* bp = lds + (c & 1) * PB_BUF;
        if (c + 1 < 64) pb_dma(QP + (size_t)(c + 1) * 2 * 4096, YG + (size_t)(c + 1) * 2 * 4096, jv, lds + ((c + 1) & 1) * PB_BUF, lane);
        {
            bf16x8 Bf[4];
#pragma unroll
            for (int i = 0; i < 2; ++i)
#pragma unroll
                for (int s2 = 0; s2 < 2; ++s2) { u32x4 w; w.x = cvt_pk_bf16(H[i][8 * s2 + 0], H[i][8 * s2 + 1]); w.y = cvt_pk_bf16(H[i][8 * s2 + 2], H[i][8 * s2 + 3]); w.z = cvt_pk_bf16(H[i][8 * s2 + 4], H[i][8 * s2 + 5]); w.w = cvt_pk_bf16(H[i][8 * s2 + 6], H[i][8 * s2 + 7]);
                    Bf[2 * i + s2] = __builtin_bit_cast(bf16x8, w); }
#pragma unroll
            for (int tt = 0; tt < 2; ++tt) { f32x16 acc; const int row = 32 * tt + r31;
#pragma unroll
                for (int r = 0; r < 16; ++r) acc[r] = bf2f(*(const LAS bf16_t*)(bp + 16384 + ((32 * tt + (r & 3) + 8 * (r >> 2) + 4 * hh) * 32 + r31) * 2));
#pragma unroll
                for (int kq = 0; kq < 4; ++kq) { const bf16x8 a = *(const LAS bf16x8*)(bp + row * 128 + (((2 * kq + hh) ^ (row & 7)) * 16)); acc = __builtin_amdgcn_mfma_f32_32x32x16_bf16(a, Bf[kq], acc, 0, 0, 0); }
#pragma unroll
                for (int r = 0; r < 16; ++r) yraw[(size_t)(c * 64 + 32 * tt + (r & 3) + 8 * (r >> 2) + 4 * hh) * DR] = f2bf(acc[r]); }
            f32x16 Hn[2];
#pragma unroll
            for (int i = 0; i < 2; ++i) { const int row = 32 * i + r31;
#pragma unroll
                for (int r = 0; r < 16; ++r) Hn[i][r] = bf2f(*(const LAS bf16_t*)(bp + 20480 + ((32 * i + (r & 3) + 8 * (r >> 2) + 4 * hh) * 32 + r31) * 2));
#pragma unroll
                for (int kq = 0; kq < 4; ++kq) { const bf16x8 a = *(const LAS bf16x8*)(bp + 8192 + row * 128 + (((2 * kq + hh) ^ (row & 7)) * 16)); Hn[i] = __builtin_amdgcn_mfma_f32_32x32x16_bf16(a, Bf[kq], Hn[i], 0, 0, 0); } }
            H[0] = Hn[0]; H[1] = Hn[1];
        }
        VM_WAIT();
    }
}
constexpr int RT_BROW = 2064, RT_LO = 32 * RT_BROW;
constexpr int RT_HIST = 147456, RT_BASE = RT_HIST + 128, RT_ETAB = RT_HIST + 256, RT_RS = RT_HIST + 256 + 2048;
__device__ __forceinline__ float rowmax16(float x) { x = fmaxf(x, dpp_mov<0xB1>(x)); x = fmaxf(x, dpp_mov<0x4E>(x)); x = fmaxf(x, dpp_mov<0x141>(x)); x = fmaxf(x, dpp_mov<0x140>(x)); return x; }
__device__ __forceinline__ float rt_key(float v, int e) { v = (v == v) ? fminf(fmaxf(v, -1.0e30f), 1.0e30f) : -1.0e30f; return __uint_as_float((__float_as_uint(v) & ~31u) | (unsigned)(31 - e)); }
__device__ __forceinline__ void p9_router(const Params& p, LAS unsigned char* lds, int wave, int lane) {
    const bf16_t* x1 = (const bf16_t*)(p.ws + WS_XB); const unsigned char* rwp = (const unsigned char*)(p.ws + WS_RWP); const float* rb = p.in[I_RB];
    int* eid = (int*)(p.ws + WS_EID); float* gate = (float*)(p.ws + WS_GATE); int* relpos = (int*)(p.ws + WS_RELPOS); int* stok = (int*)(p.ws + WS_STOK); float* srs = (float*)(p.ws + WS_SRS);
    unsigned* gcount = (unsigned*)(p.ws + WS_CTL) + CW_GCOUNT;
    const int tid = wave * 64 + lane, fr = lane & 15, q = lane >> 4;
    LAS unsigned* hist = (LAS unsigned*)(lds + RT_HIST); LAS unsigned* base = (LAS unsigned*)(lds + RT_BASE); LAS unsigned* etab = (LAS unsigned*)(lds + RT_ETAB); LAS float* rsl = (LAS float*)(lds + RT_RS);
#pragma unroll
    for (int i = 0; i < 16; ++i) { const int c = tid + 512 * i, which = c >> 12, cc = c & 4095, e = cc >> 7, kc = cc & 127; *(LAS u32x4*)(lds + which * RT_LO + e * RT_BROW + kc * 16) = *(const u32x4*)(rwp + (size_t)c * 16); }
    if (tid < 32) hist[tid] = 0u;
    const int tok0 = blockIdx.x * 128 + wave * 16;
    const bf16_t* arow = x1 + (size_t)(tok0 + fr) * DM + 8 * q;
    bf16x8 a_n[4];
#pragma unroll
    for (int k = 0; k < 4; ++k) a_n[k] = *(const bf16x8*)(arow + 32 * k);
    __syncthreads();
    f32x4 acc[2], accs; acc[0] = acc[1] = accs = (f32x4){0.f, 0.f, 0.f, 0.f};
#pragma unroll
    for (int ks = 0; ks < 32; ++ks) { const bf16x8 a = a_n[ks & 3];
        if (ks + 4 < 32) a_n[ks & 3] = *(const bf16x8*)(arow + 32 * (ks + 4));
        accs = __builtin_amdgcn_mfma_f32_16x16x32_bf16(a, a, accs, 0, 0, 0);
#pragma unroll
        for (int h2 = 0; h2 < 2; ++h2) { const LAS unsigned char* bp = lds + (16 * h2 + fr) * RT_BROW + (32 * ks + 8 * q) * 2;
            acc[h2] = __builtin_amdgcn_mfma_f32_16x16x32_bf16(a, *(const LAS bf16x8*)bp, acc[h2], 0, 0, 0);
            acc[h2] = __builtin_amdgcn_mfma_f32_16x16x32_bf16(a, *(const LAS bf16x8*)(bp + RT_LO), acc[h2], 0, 0, 0); } }
    const float rb0 = rb[fr], rb1 = rb[16 + fr];
#pragma unroll
    for (int r = 0; r < 4; ++r) { const int tl = wave * 16 + 4 * q + r, tok = blockIdx.x * 128 + tl;
        const float ss = __shfl(accs[r], 20 * q + r); const float rstd = 1.0f / sqrtf(ss * (1.0f / DM) + 1e-5f);
        float k0 = rt_key(acc[0][r] * rstd + rb0, fr), k1 = rt_key(acc[1][r] * rstd + rb1, 16 + fr);
        float tv[4]; int te[4];
#pragma unroll
        for (int rd = 0; rd < 4; ++rd) { const float m = rowmax16(fmaxf(k0, k1)); tv[rd] = m; te[rd] = 31 - (int)(__float_as_uint(m) & 31u); k0 = (k0 == m) ? -3.0e38f : k0; k1 = (k1 == m) ? -3.0e38f : k1; }
        const float ex1 = __expf(tv[1] - tv[0]), ex2 = __expf(tv[2] - tv[0]), ex3 = __expf(tv[3] - tv[0]); const float inv = 1.0f / (1.0f + ex1 + ex2 + ex3);
        if (fr < 4) { const int e = fr == 0 ? te[0] : (fr == 1 ? te[1] : (fr == 2 ? te[2] : te[3])); const float g = (fr == 0 ? 1.0f : (fr == 1 ? ex1 : (fr == 2 ? ex2 : ex3))) * inv;
            const unsigned lr = atomicAdd((unsigned*)&hist[e], 1u); eid[(size_t)tok * 4 + fr] = e; gate[(size_t)tok * 4 + fr] = g; etab[tl * 4 + fr] = (lr << 5) | (unsigned)e; }
        if (fr == 0) rsl[tl] = rstd; }
    __syncthreads();
    if (tid < 32) { const unsigned hc = hist[tid]; base[tid] = hc ? atomicAdd(&gcount[tid], hc) : 0u; }
    __syncthreads();
    { const int tl = tid >> 2, k = tid & 3, tok = blockIdx.x * 128 + tl; const unsigned pk = etab[tid]; const int e = pk & 31; const unsigned rel = base[e] + (pk >> 5);
      relpos[(size_t)tok * 4 + k] = (int)rel; stok[(size_t)e * CAP + rel] = tok; srs[(size_t)e * CAP + rel] = rsl[tl]; }
}
__device__ __forceinline__ void moe_tables(const Params& p, LAS unsigned char* lds, int wave, int lane) {
    const unsigned* gcount = (const unsigned*)(p.ws + WS_CTL) + CW_GCOUNT;
    LAS int* tsrc = (LAS int*)(lds + TAB_SRC); LAS int* tval = (LAS int*)(lds + TAB_VAL); LAS int* te = (LAS int*)(lds + TAB_E); LAS int* tbase = (LAS int*)(lds + TAB_BASE);
    if (wave == 0) {
        const int c = lane < NE ? (int)__hip_atomic_load(&gcount[lane & 31], __ATOMIC_RELAXED, __HIP_MEMORY_SCOPE_AGENT) : 0; const int nt = (c + 255) >> 8;
        int inc = nt;
#pragma unroll
        for (int o = 1; o < 32; o <<= 1) { const int v = __shfl_up(inc, o); inc += (lane & 31) >= o ? v : 0; }
        const int tb = inc - nt;
        if (lane < NE) { tbase[lane] = tb; if (lane == NE - 1) tbase[NE] = inc;
            for (int lt = 0; lt < nt; ++lt) { tsrc[tb + lt] = lane * CAP + lt * 256; const int rem = c - lt * 256; tval[tb + lt] = rem < 256 ? rem : 256; te[tb + lt] = lane; } } }
    __syncthreads();
}
typedef int i32x4 __attribute__((ext_vector_type(4)));
struct P12Meta { i32x4 e, rp; f32x4 g; };
struct P12Rows { u32x2 x[4]; u32x2 y[4][4]; f32x4 g; };
__device__ __forceinline__ void p12_meta(P12Meta& m, const int* eid, const float* gate, const int* relpos, int tok) {
    m.e = *(const i32x4*)(eid + (size_t)tok * 4); m.g = *(const f32x4*)(gate + (size_t)tok * 4); m.rp = *(const i32x4*)(relpos + (size_t)tok * 4); }
__device__ __forceinline__ void p12_rows(P12Rows& r, const P12Meta& m, const bf16_t* x1, const bf16_t* ys, const LAS int* tbase, int tok, int lane) {
#pragma unroll
    for (int j = 0; j < 4; ++j) r.x[j] = *(const u32x2*)(x1 + (size_t)tok * DM + 4 * lane + 256 * j);
#pragma unroll
    for (int k = 0; k < 4; ++k) { const bf16_t* yr = ys + ((size_t)tbase[m.e[k]] * 256 + m.rp[k]) * DM + 4 * lane;
#pragma unroll
        for (int j = 0; j < 4; ++j) r.y[k][j] = *(const u32x2*)(yr + 256 * j); }
    r.g = m.g;
}
__device__ __forceinline__ void p12_combine(const Params& p, LAS unsigned char* lds, int wave, int lane) {
    const bf16_t* x1 = (const bf16_t*)(p.ws + WS_XB); float* outp = p.out; const bf16_t* ys = (const bf16_t*)(p.ws + WS_YSORT); const int* eid = (const int*)(p.ws + WS_EID); const float* gate = (const float*)(p.ws + WS_GATE); const int* relpos = (const int*)(p.ws + WS_RELPOS);
    const float* fg = p.in[I_FG]; const LAS int* tbase = (const LAS int*)(lds + TAB_BASE);
    const int gw = blockIdx.x * NWAVES + wave;
    f32x4 gv[4];
#pragma unroll
    for (int j = 0; j < 4; ++j) gv[j] = *(const f32x4*)(fg + 4 * lane + 256 * j);
    P12Meta m0, m1; P12Rows rc, rn;
    p12_meta(m0, eid, gate, relpos, gw); p12_meta(m1, eid, gate, relpos, gw + NGW);
    p12_rows(rc, m0, x1, ys, tbase, gw, lane);
    for (int tok = gw; tok < NTOK; tok += NGW) {
        m0 = m1;
        if (tok + 2 * NGW < NTOK) p12_meta(m1, eid, gate, relpos, tok + 2 * NGW);
        if (tok + NGW < NTOK) p12_rows(rn, m0, x1, ys, tbase, tok + NGW, lane);
        f32x4 v[4];
#pragma unroll
        for (int j = 0; j < 4; ++j) v[j] = (f32x4){bflo(rc.x[j].x), bfhi(rc.x[j].x), bflo(rc.x[j].y), bfhi(rc.x[j].y)};
#pragma unroll
        for (int k = 0; k < 4; ++k) { const float gt = rc.g[k];
#pragma unroll
            for (int j = 0; j < 4; ++j) { const u32x2 w = rc.y[k][j]; v[j][0] += gt * bflo(w.x); v[j][1] += gt * bfhi(w.x); v[j][2] += gt * bflo(w.y); v[j][3] += gt * bfhi(w.y); } }
        float ss = 0.f;
#pragma unroll
        for (int j = 0; j < 4; ++j) ss += (v[j][0] * v[j][0] + v[j][1] * v[j][1]) + (v[j][2] * v[j][2] + v[j][3] * v[j][3]);
        ss = wave_sum(ss); const float rs = 1.0f / sqrtf(ss * (1.0f / DM) + 1e-5f);
#pragma unroll
        for (int j = 0; j < 4; ++j) { f32x4 o = v[j] * rs * gv[j];
#ifdef SCRUB_NAN
#pragma unroll
            for (int q = 0; q < 4; ++q) o[q] = (o[q] == o[q] && fabsf(o[q]) < 1e30f) ? o[q] : 0.f;
#endif
            *(f32x4*)(outp + (size_t)tok * DM + 4 * lane + 256 * j) = o; }
        rc = rn;
    }
}
#ifndef MOE_ALIGN
#define MOE_ALIGN true
#endif
#ifndef N_PHASES
#define N_PHASES 13
#endif
struct Args { Params p; int ph_lo, ph_hi, li, pad; };
__global__ void __launch_bounds__(NWAVES * 64, 2) hymba_fwd(Args a) {
    extern __shared__ __attribute__((aligned(16))) unsigned char lds_raw[];
    LAS unsigned char* lds = (LAS unsigned char*)lds_raw;
    const Params& p = a.p;
    const int wave = __builtin_amdgcn_readfirstlane((int)threadIdx.x >> 6);
    volatile LAS unsigned* misc = (volatile LAS unsigned*)(lds + MISC_OFF);
    if (threadIdx.x < 4) misc[threadIdx.x] = 0u;
    __syncthreads();
    unsigned* ctl = (unsigned*)(p.ws + WS_CTL);
    XcdBarrier bar = xcd_barrier_post(ctl + CW_BAR + a.li * XCD_BAR_WORDS, misc);
    const int lo = a.ph_lo & 0xFF, hi = a.ph_hi, padf = a.ph_lo >> 8;
#ifdef DIAG_A
    volatile LAS unsigned long long* tsl = (volatile LAS unsigned long long*)(lds + MISC_OFF + 64);
#define STAMP(k) do { if (blockIdx.x == 0 && wave == 0 && lane_id() == 0) tsl[k] = __builtin_amdgcn_s_memrealtime(); } while (0)
#else
#define STAMP(k) do { } while (0)
#endif
#ifndef PH_MASK
#define PH_MASK 0x1FFF
#endif
#ifdef STAGGER_US
#define STAGGER() do { const unsigned long long t0_ = __builtin_amdgcn_s_memrealtime(); const unsigned long long dl_ = (unsigned long long)(((blockIdx.x >> 3) & 3) * STAGGER_US * 100); \
        while (__builtin_amdgcn_s_memrealtime() - t0_ < dl_) __builtin_amdgcn_s_sleep(32); } while (0)
#else
#define STAGGER() do {} while (0)
#endif
#ifdef STAGGER_P1
#define STAGGER1() STAGGER()
#else
#define STAGGER1() do {} while (0)
#endif
#ifdef STAGGER_P11
#define STAGGER2() STAGGER()
#else
#define STAGGER2() do {} while (0)
#endif
#define IN(k) ((((PH_MASK) >> (k)) & 1) && lo <= (k) && (k) < hi)
#define SEAM(k) do { if (IN(k) && IN((k) + 1)) xcd_barrier(bar, wave == 0 && lane_id() == 0); } while (0)
#define LN lane_id()
    unsigned char* ws = p.ws;
    STAMP(0); if (IN(0)) { p0_prologue(p, lds, wave, LN); } SEAM(0);
    STAMP(1); if (IN(1)) { pg8::Gemm g{(const bf16_t*)(ws + WS_XB), (const bf16_t*)(ws + WS_WINT), NTOK, DIN, DM}; pg8::StaticOrder S; S.init(NTOK, DIN, GRID, (int)blockIdx.x);
        EpiProj E{(bf16_t*)(ws + WS_PROJ), DIN, (const float*)(ws + WS_RSTD1), lds}; STAGGER1(); pg8::gemm_phase<EpiProj, pg8::StaticOrder, true, false>(lds, g, S, E, wave); cv_tail(p, lds, wave, LN, CW_CVT1, CV_A, CV_B - CV_A); } SEAM(1);
    STAMP(2); if (IN(2)) { p2_lora_in(p, wave, LN); } SEAM(2);
    STAMP(3); if (IN(3)) { pg8::Gemm g{(const bf16_t*)(ws + WS_LORAIN), (const bf16_t*)(ws + WS_LORAB), NTOK, 1536, 256}; pg8::StaticOrder S; S.init(NTOK, 1536, GRID, (int)blockIdx.x);
        EpiLora E{(float*)(ws + WS_LORAW), (bf16_t*)(ws + WS_LORAA), (bf16_t*)(ws + WS_LORAG)}; pg8::gemm_phase<EpiLora, pg8::StaticOrder, true, false>(lds, g, S, E, wave); } SEAM(3);
    STAMP(4); if (IN(4)) { p4_chunks(p, lds, wave, LN, padf); } SEAM(4);
    STAMP(5); if (IN(5)) {
#ifdef PROBE_PAD
        if (blockIdx.x < 128) { if (!(padf & 2)) { if (wave == 0) p5_seq(p, lds, LN); else p5_convert(p, (LAS float*)(lds + 65536 + (wave - 1) * 8448), LN); } } else { if (!(padf & 1)) { p5_s5(p, lds, wave, LN, padf); __syncthreads(); if (!(padf & 32)) p5_convert(p, (LAS float*)(lds + wave * 8448), LN); } }
#else
        if (blockIdx.x < 128) { if (wave == 0) p5_seq(p, lds, LN); else p5_convert(p, (LAS float*)(lds + 65536 + (wave - 1) * 8448), LN); } else { p5_s5(p, lds, wave, LN); __syncthreads(); p5_convert(p, (LAS float*)(lds + wave * 8448), LN); }
#endif
 } SEAM(5);
    STAMP(6); if (IN(6)) { pg8::Gemm g{(const bf16_t*)(ws + WS_YGELU), (const bf16_t*)(ws + WS_WGLUT), NTOK, DSSM, DSSM}; pg8::StaticOrder S; S.init(NTOK, DSSM, GRID, (int)blockIdx.x);
        EpiGlu E{(const bf16_t*)(ws + WS_YGELU), (bf16_t*)(ws + WS_YGLU), p.in[I_BGLU], (float*)(ws + WS_SSQ)}; pg8::gemm_phase<EpiGlu, pg8::StaticOrder, false, false>(lds, g, S, E, wave); } SEAM(6);
    STAMP(7); if (IN(7)) { p7_mix(p, wave, LN); } SEAM(7);
    STAMP(8); if (IN(8)) { pg8::Gemm g{(const bf16_t*)(ws + WS_MIXED), (const bf16_t*)(ws + WS_WOUTT), NTOK, DM, DM}; pg8::StaticOrder S; S.init(NTOK, DM, GRID, (int)blockIdx.x);
        EpiOut E{(bf16_t*)(ws + WS_XB)}; pg8::gemm_phase<EpiOut, pg8::StaticOrder, true, false>(lds, g, S, E, wave); } SEAM(8);
    STAMP(9); if (IN(9)) { p9_router(p, lds, wave, LN); } SEAM(9);
    STAMP(13); if (IN(10) || IN(11) || IN(12)) moe_tables(p, lds, wave, lane_id());
    STAMP(10); if (IN(10)) { MoeOrder S{GRID, (int)blockIdx.x, 8, ((const LAS int*)(lds + TAB_BASE))[NE], (const LAS int*)(lds + TAB_SRC), (const LAS int*)(lds + TAB_VAL), (const LAS int*)(lds + TAB_E), (const int*)(ws + WS_STOK), (const LAS int*)(lds + TAB_BASE), padf};
        pg8::Gemm g{(const bf16_t*)(ws + WS_XB), (const bf16_t*)(ws + WS_W1T), 0, 0, DM};
        EpiSwiglu E{(bf16_t*)(ws + WS_ACT), (const float*)(ws + WS_B1G), (const float*)(ws + WS_B1L), (const float*)(ws + WS_SRS), (const LAS int*)(lds + TAB_SRC), (const LAS int*)(lds + TAB_VAL), padf, lds};
        STAGGER();
        pg8::gemm_phase<EpiSwiglu, MoeOrder, MOE_ALIGN, true>(lds, g, S, E, wave); cv_tail(p, lds, wave, LN, CW_CVT2, CV_C, CV_NIT - CV_C); } SEAM(10);
    STAMP(11); if (IN(11)) { MoeOrder S{GRID, (int)blockIdx.x, 4, ((const LAS int*)(lds + TAB_BASE))[NE], (const LAS int*)(lds + TAB_SRC), (const LAS int*)(lds + TAB_VAL), (const LAS int*)(lds + TAB_E), (const int*)(ws + WS_STOK), (const LAS int*)(lds + TAB_BASE), padf};
        pg8::Gemm g{(const bf16_t*)(ws + WS_ACT), (const bf16_t*)(ws + WS_W2T), 0, 0, DFF};
        EpiMoe2 E{(bf16_t*)(ws + WS_YSORT), p.in[I_B2]}; STAGGER2(); pg8::gemm_phase<EpiMoe2, MoeOrder, MOE_ALIGN, false>(lds, g, S, E, wave); } SEAM(11);
    STAMP(12); if (IN(12)) { p12_combine(p, lds, wave, LN); }
#ifdef DIAG_A
    STAMP(14);
    xcd_barrier(bar, wave == 0 && lane_id() == 0);
    if (blockIdx.x == 0) { const int l = lane_id();
        auto dur = [&](int k) -> float { const int e = (k == 9) ? 13 : (k == 12 ? 14 : k + 1); const int b0 = (k == 10) ? 13 : k; return (float)(tsl[e] - tsl[b0]) * 0.01f; };
        const float ta = dur(DIAG_A), tb = dur(DIAG_B);
        float* o = p.out;
        for (int i = wave * 64 + l; i < (1 << 22); i += NWAVES * 64) o[i] = (i == 0) ? ta * 1.0e5f : tb * 1.0e3f; }
#endif
#undef IN
#undef SEAM
#undef LN
#undef STAMP
}
#ifndef MK_SPLIT
#define MK_SPLIT 0
#endif
extern "C" void kernel_launch(void* const* d_in, const int* in_sizes, int n_in, void* d_out, int out_size, void* d_ws, size_t ws_size, hipStream_t stream) {
    static int ready = 0;
    if (ready == 0) {
        if (n_in != 34 || out_size != NTOK * DM || ws_size < WS_END) { fprintf(stderr, "kernel_launch: unexpected shapes (n_in %d, out %d, ws %zu); nothing launched\n", n_in, out_size, ws_size); ready = -1; return; }
        if (hipFuncSetAttribute((const void*)hymba_fwd, hipFuncAttributeMaxDynamicSharedMemorySize, LDS_BYTES) != hipSuccess) { fprintf(stderr, "kernel_launch: hipFuncSetAttribute failed\n"); ready = -1; return; }
        int per_cu = 0; if (hipOccupancyMaxActiveBlocksPerMultiprocessor(&per_cu, (const void*)hymba_fwd, NWAVES * 64, LDS_BYTES) != hipSuccess || per_cu < 1) fprintf(stderr, "kernel_launch: occupancy query says %d\n", per_cu);
        (void)hipGetLastError();
        ready = 1;
    }
    if (ready < 0) return;
    (void)hipMemsetAsync((char*)d_ws + WS_CTL, 0, CTL_ZERO_BYTES, stream);
    Args a{};
    for (int i = 0; i < 34; ++i) a.p.in[i] = (const float*)d_in[i];
    a.p.out = (float*)d_out; a.p.ws = (unsigned char*)d_ws;
#if defined(PROBE_VPHASE)
    a.ph_lo = 0; a.ph_hi = PROBE_VPHASE; a.li = 0; hipLaunchKernelGGL(hymba_fwd, dim3(GRID), dim3(NWAVES * 64), LDS_BYTES, stream, a);
    a.ph_lo = PROBE_VPHASE | (PROBE_VFLAGS << 8); a.ph_hi = PROBE_VPHASE + 1; a.li = 1; hipLaunchKernelGGL(hymba_fwd, dim3(GRID), dim3(NWAVES * 64), LDS_BYTES, stream, a);
    a.ph_lo = PROBE_VPHASE; a.ph_hi = N_PHASES; a.li = 2; hipLaunchKernelGGL(hymba_fwd, dim3(GRID), dim3(NWAVES * 64), LDS_BYTES, stream, a);
#elif defined(PROBE_VARIANT)
    a.ph_lo = 0; a.ph_hi = 10; a.li = 0; hipLaunchKernelGGL(hymba_fwd, dim3(GRID), dim3(NWAVES * 64), LDS_BYTES, stream, a);
    a.ph_lo = 10 | (PROBE_VARIANT << 8); a.ph_hi = 11; a.li = 1; hipLaunchKernelGGL(hymba_fwd, dim3(GRID), dim3(NWAVES * 64), LDS_BYTES, stream, a);
    a.ph_lo = 10; a.ph_hi = N_PHASES; a.li = 2; hipLaunchKernelGGL(hymba_fwd, dim3(GRID), dim3(NWAVES * 64), LDS_BYTES, stream, a);
#elif defined(PROBE_LO)
    a.ph_lo = 0; a.ph_hi = PROBE_HI + 1; a.li = 0; hipLaunchKernelGGL(hymba_fwd, dim3(GRID), dim3(NWAVES * 64), LDS_BYTES, stream, a);
#ifndef PROBE_PAD
#define PROBE_PAD 0
#endif
    a.ph_lo = PROBE_LO | (PROBE_PAD << 8); a.ph_hi = PROBE_LO + 1; a.li = 1; hipLaunchKernelGGL(hymba_fwd, dim3(GRID), dim3(NWAVES * 64), LDS_BYTES, stream, a);
    a.ph_lo = PROBE_LO + 1; a.ph_hi = N_PHASES; a.li = 2; hipLaunchKernelGGL(hymba_fwd, dim3(GRID), dim3(NWAVES * 64), LDS_BYTES, stream, a);
#elif MK_SPLIT
    for (int ph = 0; ph < N_PHASES; ++ph) { a.ph_lo = ph; a.ph_hi = ph + 1; a.li = 0; hipLaunchKernelGGL(hymba_fwd, dim3(GRID), dim3(NWAVES * 64), LDS_BYTES, stream, a); }
#else
#ifndef RUN_HI
#define RUN_HI N_PHASES
#endif
    a.ph_lo = 0; a.ph_hi = RUN_HI; a.li = 0; hipLaunchKernelGGL(hymba_fwd, dim3(GRID), dim3(NWAVES * 64), LDS_BYTES, stream, a);
#endif
}
```

```cpp
#include <hip/hip_runtime.h>
#include <cstdio>
#include <cstdint>

#define LAS __attribute__((address_space(3)))
typedef unsigned short bf16_t;
typedef short bf16x8 __attribute__((ext_vector_type(8)));
typedef float f32x4 __attribute__((ext_vector_type(4)));
typedef float f32x2 __attribute__((ext_vector_type(2)));
typedef float f32x16 __attribute__((ext_vector_type(16)));
typedef unsigned u32x4 __attribute__((ext_vector_type(4)));
typedef unsigned u32x2 __attribute__((ext_vector_type(2)));

typedef __bf16 bf16x2_t __attribute__((ext_vector_type(2)));
__device__ __forceinline__ unsigned cvt_pk_bf16(float lo, float hi) { const bf16x2_t v = {(__bf16)lo, (__bf16)hi}; return __builtin_bit_cast(unsigned, v); }
__device__ __forceinline__ float bflo(unsigned w) { return __uint_as_float(w << 16); }
__device__ __forceinline__ float bfhi(unsigned w) { return __uint_as_float(w & 0xffff0000u); }
__device__ __forceinline__ float bf2f(bf16_t b) { return __uint_as_float(((unsigned)b) << 16); }
__device__ __forceinline__ bf16_t f2bf(float f) { return (bf16_t)(cvt_pk_bf16(f, 0.f) & 0xffffu); }
__device__ __forceinline__ float wave_sum(float v) {
#pragma unroll
    for (int o = 32; o >= 1; o >>= 1) v += __shfl_xor(v, o);
    return v;
}
__device__ __forceinline__ float sigmoidf_(float x) { return __builtin_amdgcn_rcpf(1.0f + __builtin_amdgcn_exp2f(-1.4426950408889634f * x)); }
__device__ __forceinline__ int lane_id() { int l; asm volatile("v_mbcnt_lo_u32_b32 %0, -1, 0\n\tv_mbcnt_hi_u32_b32 %0, -1, %0" : "=v"(l)); return l; }
__device__ __forceinline__ void lds_barrier() { asm volatile("s_waitcnt lgkmcnt(0)" ::: "memory"); __builtin_amdgcn_s_barrier(); asm volatile("" ::: "memory"); }
#define LDS_WAIT() asm volatile("s_waitcnt lgkmcnt(0)" ::: "memory")
#define VM_WAIT() asm volatile("s_waitcnt vmcnt(0)" ::: "memory")

namespace pg8 {
constexpr int BM = 256, BK = 64, HALF = 128, HTB = HALF * BK * 2, STAGE_BYTES = 8 * HTB, NXCD = 8, WGM = 8;
__host__ __device__ __forceinline__ int lds_byte(int r, int c) { const int st = (r >> 4) * 2 + (c >> 5), rr = r & 15, cc = c & 31, ob = rr * 64 + cc * 2; return st * 1024 + (ob ^ (((ob >> 9) & 1) << 5)); }
__host__ __device__ __forceinline__ void stage_rc(int b, int& R, int& C) { const int st = b / 1024, sb = b % 1024, swz = sb ^ (((sb >> 9) & 1) << 5); R = (st >> 1) * 16 + swz / 64; C = (st & 1) * 32 + (swz % 64) / 2; }
__host__ __device__ __forceinline__ int perm32(int rho) { const int n = rho >> 4, i = rho & 15; return 8 * (i >> 2) + 4 * n + (i & 3); }

struct Unit { int pm, pn; };
struct Gemm { const bf16_t* A; const bf16_t* Bt; int M, N, K; };

struct StaticOrder {
    int nM, nN, nwg, G, c;
    __host__ __device__ void init(int M, int N, int G_, int c_) { nM = M / BM; nN = N / BM; nwg = nM * nN; G = G_; c = c_; }
    __host__ __device__ bool next(int i, Unit& u) const {
        const long L = (long)i * G + c; if (L >= nwg) return false;
        int wgid = (int)L; { const int q = nwg / NXCD, r = nwg % NXCD, xcd = wgid % NXCD, off = wgid / NXCD; wgid = (xcd < r ? xcd * (q + 1) : r * (q + 1) + (xcd - r) * q) + off; }
        const int nig = WGM * nN, gid = wgid / nig, fm = gid * WGM, gsz = (nM - fm) < WGM ? (nM - fm) : WGM;
        u.pm = fm + ((wgid % nig) % gsz); u.pn = (wgid % nig) / gsz; return true;
    }
    __device__ __forceinline__ int arow(const Unit& u, int r) const { return u.pm * BM + r; }
};

template <class Epi, class Sched, bool ALIGN_EPI, bool GATHER>
__device__ __forceinline__ void gemm_phase(LAS unsigned char* lds, const Gemm g, const Sched& S, const Epi& E, const int wid) {
    const int lane = lane_id(), tid = wid * 64 + lane, wr = wid >> 2, wc = wid & 3, fr = lane & 15, fq = lane >> 4;
    const int K = g.K, nt = K / BK;
    int Rst[2], Cst[2];
    unsigned voffB[2], vAc[2][2], vAn[2][2];
#pragma unroll
    for (int i = 0; i < 2; ++i) { int R, C; stage_rc(tid * 16 + i * 8192, R, C); const int Rb = Epi::PERM ? ((R & ~31) + perm32(R & 31)) : R;
        Rst[i] = R; Cst[i] = C; voffB[i] = (unsigned)(Rb * K + C) * 2u; }
    const size_t kstep = (size_t)(BK * 2);
    const size_t hstep = (size_t)HALF * K * 2;
    const size_t tstep = 2 * hstep;
    const unsigned ldsw = (unsigned)wid * 1024u;
    const int aoff = lds_byte(wr * 64 + fr, fq * 8), boff = lds_byte(wc * 32 + fr, fq * 8);
#define PG8_SA(b, h) (((b) * 2 + (h)) * HTB)
#define PG8_SB(b, h) ((4 + (b) * 2 + (h)) * HTB)
#define PG8_STAGE(bufoff, gbase, voff) do { _Pragma("unroll") for (int _i = 0; _i < 2; ++_i) \
        __builtin_amdgcn_global_load_lds((const unsigned*)((const char*)(gbase) + (voff)[_i]), (LAS unsigned*)(lds + (bufoff) + ldsw + _i * 8192), 16, 0, 0); } while (0)
#define PG8_STAGE_SEL(bufoff, gbase, va, vb, sel) do { _Pragma("unroll") for (int _i = 0; _i < 2; ++_i) \
        __builtin_amdgcn_global_load_lds((const unsigned*)((const char*)(gbase) + ((sel) ? (vb)[_i] : (va)[_i])), (LAS unsigned*)(lds + (bufoff) + ldsw + _i * 8192), 16, 0, 0); } while (0)
#define PG8_LDA(dst, b, h) do { _Pragma("unroll") for (int m = 0; m < 4; ++m) _Pragma("unroll") for (int k = 0; k < 2; ++k) dst[m][k] = *(const LAS bf16x8*)(lds + PG8_SA(b, h) + aoff + m * 2048 + k * 1024); } while (0)
#define PG8_LDB(dst, b, h) do { _Pragma("unroll") for (int n = 0; n < 2; ++n) _Pragma("unroll") for (int k = 0; k < 2; ++k) dst[n][k] = *(const LAS bf16x8*)(lds + PG8_SB(b, h) + boff + n * 2048 + k * 1024); } while (0)
#define PG8_MMA(ai, bj, At, Bt) do { __builtin_amdgcn_s_setprio(1); _Pragma("unroll") for (int m = 0; m < 4; ++m) _Pragma("unroll") for (int n = 0; n < 2; ++n) _Pragma("unroll") for (int k = 0; k < 2; ++k) \
        acc[ai][bj][m][n] = __builtin_amdgcn_mfma_f32_16x16x32_bf16(Bt[n][k], At[m][k], acc[ai][bj][m][n], 0, 0, 0); __builtin_amdgcn_s_setprio(0); } while (0)
#define PG8_WAIT_V(n) asm volatile("s_waitcnt vmcnt(" #n ")" ::: "memory")
#define PG8_WAIT_L(n) asm volatile("s_waitcnt lgkmcnt(" #n ")" ::: "memory")
#define PG8_BAR __builtin_amdgcn_s_barrier()
#define PG8_SCHED __builtin_amdgcn_sched_barrier(0)
#define PG8_LOADOFF(dst, unit) do { _Pragma("unroll") for (int _h = 0; _h < 2; ++_h) _Pragma("unroll") for (int _i = 0; _i < 2; ++_i) \
        dst[_h][_i] = GATHER ? ((unsigned)S.arow(unit, _h * HALF + Rst[_i]) * (unsigned)(K * 2) + (unsigned)(Cst[_i] * 2)) : ((unsigned)((_h * HALF + Rst[_i]) * K + Cst[_i]) * 2u); } while (0)
    Unit cur, nxt; int ui = 0;
    if (!S.next(0, cur)) return;
    f32x4 acc[2][2][4][2];
#pragma unroll
    for (int a = 0; a < 2; ++a)
#pragma unroll
        for (int b = 0; b < 2; ++b)
#pragma unroll
            for (int m = 0; m < 4; ++m)
#pragma unroll
                for (int n = 0; n < 2; ++n) acc[a][b][m][n] = (f32x4){0.f, 0.f, 0.f, 0.f};
    bf16x8 At[4][2], B0[2][2], B1[2][2];
    const char* cA = GATHER ? (const char*)g.A : (const char*)g.A + (size_t)cur.pm * tstep; const char* cB = (const char*)g.Bt + (size_t)cur.pn * tstep;
    PG8_LOADOFF(vAc, cur);
    if constexpr (Epi::PREFETCH) E.prefetch(cur, 0, wid, lane);
    if (GATHER) { Unit u1; if (S.next(1, u1)) PG8_LOADOFF(vAn, u1); else PG8_LOADOFF(vAn, cur); } else { PG8_LOADOFF(vAn, cur); }
    PG8_STAGE(PG8_SB(0, 0), cB, voffB); PG8_STAGE(PG8_SB(0, 1), cB + hstep, voffB); PG8_STAGE(PG8_SA(0, 0), cA, vAc[0]); PG8_STAGE(PG8_SA(0, 1), cA, vAc[1]);
    if (wr == 1) PG8_BAR;
    PG8_WAIT_V(2); PG8_BAR;
    PG8_STAGE(PG8_SB(1, 0), cB + kstep, voffB); PG8_STAGE(PG8_SA(1, 0), cA + kstep, vAc[0]); PG8_STAGE(PG8_SB(1, 1), cB + hstep + kstep, voffB);
    PG8_WAIT_V(6); PG8_BAR;
    for (;;) {
        const bool has_next = S.next(ui + 1, nxt);
        const char* nA = GATHER ? cA : (has_next ? (const char*)g.A + (size_t)nxt.pm * tstep : cA); const char* nB = has_next ? (const char*)g.Bt + (size_t)nxt.pn * tstep : cB;
        const bool usen = GATHER && has_next;
        for (int t = 0; t < nt; t += 2) {
            const bool last = (t == nt - 2);
            const char* a1 = cA + (size_t)(t + 1) * kstep;
            const char* a2 = last ? nA : cA + (size_t)(t + 2) * kstep; const char* b2 = last ? nB : cB + (size_t)(t + 2) * kstep;
            const char* a3 = a2 + kstep; const char* b3 = b2 + kstep;
            const bool sel = last && usen;
            PG8_LDB(B0, 0, 0); PG8_LDB(B1, 0, 1); PG8_SCHED; PG8_LDA(At, 0, 0); PG8_STAGE(PG8_SA(1, 1), a1, vAc[1]);
            PG8_WAIT_V(8); PG8_WAIT_L(0); PG8_BAR; PG8_MMA(0, 0, At, B0); PG8_MMA(0, 1, At, B1); PG8_BAR; PG8_SCHED;
            PG8_LDA(At, 0, 1); PG8_STAGE(PG8_SB(0, 0), b2, voffB); PG8_STAGE(PG8_SB(0, 1), b2 + hstep, voffB); PG8_STAGE_SEL(PG8_SA(0, 0), a2, vAc[0], vAn[0], sel);
            PG8_WAIT_V(8); PG8_WAIT_L(0); PG8_BAR; PG8_MMA(1, 0, At, B0); PG8_MMA(1, 1, At, B1); PG8_BAR; PG8_SCHED;
            PG8_LDB(B0, 1, 0); PG8_LDB(B1, 1, 1); PG8_SCHED; PG8_LDA(At, 1, 0); PG8_STAGE_SEL(PG8_SA(0, 1), a2, vAc[1], vAn[1], sel);
            PG8_WAIT_V(8); PG8_WAIT_L(0); PG8_BAR; PG8_MMA(0, 0, At, B0); PG8_MMA(0, 1, At, B1); PG8_BAR; PG8_SCHED;
            PG8_LDA(At, 1, 1); PG8_STAGE(PG8_SB(1, 0), b3, voffB); PG8_STAGE(PG8_SB(1, 1), b3 + hstep, voffB); PG8_STAGE_SEL(PG8_SA(1, 0), a3, vAc[0], vAn[0], sel);
            PG8_WAIT_V(8); PG8_WAIT_L(0); PG8_BAR; PG8_MMA(1, 0, At, B0); PG8_MMA(1, 1, At, B1); PG8_BAR; PG8_SCHED;
        }
        if constexpr (ALIGN_EPI) { if (wr == 0) PG8_BAR; }
        if (GATHER && has_next) {
#pragma unroll
            for (int _h = 0; _h < 2; ++_h)
#pragma unroll
                for (int _i = 0; _i < 2; ++_i) vAc[_h][_i] = vAn[_h][_i];
            Unit u2; if (S.next(ui + 2, u2)) PG8_LOADOFF(vAn, u2);
        }
        if constexpr (Epi::PREFETCH) { if (has_next) E.prefetch(nxt, (ui + 1) & 1, wid, lane); E(acc, cur, wr, wc, fr, fq, ui & 1); } else E(acc, cur, wr, wc, fr, fq);
        if (!has_next) break;
#pragma unroll
        for (int a = 0; a < 2; ++a)
#pragma unroll
            for (int b = 0; b < 2; ++b)
#pragma unroll
                for (int m = 0; m < 4; ++m)
#pragma unroll
                    for (int n = 0; n < 2; ++n) acc[a][b][m][n] = (f32x4){0.f, 0.f, 0.f, 0.f};
        cur = nxt; cA = nA; cB = nB; ++ui;
        if constexpr (ALIGN_EPI) { if (wr == 1) PG8_BAR; }
    }
    PG8_WAIT_V(0);
    if constexpr (!ALIGN_EPI) { if (wr == 0) PG8_BAR; }
    PG8_BAR;
#undef PG8_SA
#undef PG8_SB
#undef PG8_STAGE
#undef PG8_STAGE_SEL
#undef PG8_LDA
#undef PG8_LDB
#undef PG8_MMA
#undef PG8_WAIT_V
#undef PG8_WAIT_L
#undef PG8_BAR
#undef PG8_SCHED
#undef PG8_LOADOFF
}
}
#define XB_TMO      128
#define XB_XCNT(j)  (256  + 64 * (j))
#define XB_XSUB(j)  (1280 + 64 * (j))
#define XB_XGEN(j)  (2304 + 64 * (j))
#define XB_TOP      3328
#define XB_TOPGEN   3392
#define XCD_BAR_WORDS 3456
#define XB_SPIN_CAP (1u << 18)

__device__ __forceinline__ unsigned xb_ld(unsigned* p)              { return __hip_atomic_load(p, __ATOMIC_RELAXED, __HIP_MEMORY_SCOPE_AGENT); }
__device__ __forceinline__ unsigned xb_add(unsigned* p, unsigned v) { return __hip_atomic_fetch_add(p, v, __ATOMIC_RELAXED, __HIP_MEMORY_SCOPE_AGENT); }
__device__ __forceinline__ unsigned xb_xcc_id() { return (unsigned)__builtin_amdgcn_s_getreg((3 << 11) | 20) & 0xFu; }
#define XB_SPIN(cond, bar) do { unsigned _sp = 0; while (cond) { __builtin_amdgcn_s_sleep(1); \
    if ((++_sp & 255u) == 0u) { if (xb_ld(&(bar)[XB_TMO])) break; if (_sp > XB_SPIN_CAP) { atomicAdd(&(bar)[XB_TMO], 1u); break; } } } } while (0)

struct XcdBarrier {
    unsigned* bar; unsigned x;
    volatile LAS unsigned* st;
};

__device__ __forceinline__ XcdBarrier xcd_barrier_post(unsigned* bar, volatile LAS unsigned* st) {
    XcdBarrier b; b.bar = bar; b.x = xb_xcc_id(); b.st = st;
    if (threadIdx.x == 0) (void)xb_add(&bar[XB_XCNT(b.x)], 1u);
    return b;
}
__device__ __forceinline__ void xcd_barrier_complete(unsigned* bar, unsigned x, unsigned& nloc, unsigned& nx) {
    const unsigned G = gridDim.x * gridDim.y * gridDim.z;
    unsigned sum, cnt, mine, sp = 0u;
    for (;;) {
        sum = 0u; cnt = 0u; mine = 0u;
#pragma unroll
        for (unsigned j = 0; j < 16; ++j) { const unsigned c = xb_ld(&bar[XB_XCNT(j)]); sum += c; cnt += (c > 0u) ? 1u : 0u; mine = (j == x) ? c : mine; }
        if (sum == G) break;
        __builtin_amdgcn_s_sleep(1);
        if ((++sp & 255u) == 0u) { if (xb_ld(&bar[XB_TMO])) break; if (sp > XB_SPIN_CAP) { atomicAdd(&bar[XB_TMO], 1u); break; } }
    }
    nloc = mine > 0u ? mine : 1u; nx = cnt > 0u ? cnt : 1u;
}

__device__ __forceinline__ void xcd_barrier(const XcdBarrier& b, const bool t0) {
    asm volatile("s_waitcnt vmcnt(0)" ::: "memory");
    __syncthreads();
    if (t0) {
        unsigned* bar = b.bar;
        __builtin_amdgcn_s_waitcnt(0);
        unsigned nloc = b.st[0], nx = b.st[1];
        if (nloc == 0u) { xcd_barrier_complete(bar, b.x, nloc, nx); b.st[0] = nloc; b.st[1] = nx; }
        const unsigned old = xb_add(&bar[XB_XSUB(b.x)], 1u);
        const unsigned gen = old / nloc;
        if (old + 1u == (gen + 1u) * nloc) {
            __builtin_amdgcn_fence(__ATOMIC_RELEASE, "agent");
            asm volatile("s_waitcnt vmcnt(0)" ::: "memory");
            const unsigned og = xb_add(&bar[XB_TOP], 1u);
            const unsigned tg = og / nx;
            if (og + 1u == (tg + 1u) * nx) xb_add(&bar[XB_TOPGEN], 1u);
            else XB_SPIN(xb_ld(&bar[XB_TOPGEN]) == tg, bar);
            __builtin_amdgcn_fence(__ATOMIC_ACQUIRE, "agent");
            xb_add(&bar[XB_XGEN(b.x)], 1u);
            asm volatile("s_waitcnt vmcnt(0)" ::: "memory");
        } else {
            XB_SPIN(xb_ld(&bar[XB_XGEN(b.x)]) == gen, bar);
            __builtin_amdgcn_fence(__ATOMIC_ACQUIRE, "agent");
            asm volatile("s_waitcnt vmcnt(0)" ::: "memory");
        }
    }
    __syncthreads();
}

constexpr int DM = 1024, NBATCH = 8, SEQ = 4096, NTOK = NBATCH * SEQ;
constexpr int DIN = 2304, DR = 512, DSSM = 512, NH = 8, HD = 64;
constexpr int COL_K = 512, COL_V = 1024, COL_LORA = 1536, COL_U = 1792;
constexpr int NE = 32, DFF = 1024, CAP = 32768, MAXTILES = 544;
constexpr int OPS_STRIDE = 388;
constexpr int NWAVES = 8, GRID = 256, NGW = GRID * NWAVES;
constexpr size_t MiB = 1u << 20;
constexpr size_t WS_CTL = 0, CTL_ZERO_BYTES = 1 * MiB;
constexpr size_t WS_WINT = 1 * MiB, WS_LORAB = 6 * MiB, WS_WGLUT = 7 * MiB, WS_WOUTT = 8 * MiB;
constexpr size_t WS_B1G = 10 * MiB, WS_B1L = 10 * MiB + 128 * 1024, WS_RWP = 10 * MiB + 256 * 1024, WS_RSTD1 = 10 * MiB + 512 * 1024;
constexpr size_t WS_SSQ = 11 * MiB, WS_EID = 12 * MiB, WS_GATE = 12 * MiB + 512 * 1024, WS_RELPOS = 13 * MiB, WS_STOK = 14 * MiB;
constexpr size_t WS_W2T = 20 * MiB, WS_W1T = 84 * MiB, WS_XB = 212 * MiB;
constexpr size_t WS_PROJ = 276 * MiB, WS_LORAIN = 420 * MiB, WS_LORAW = 436 * MiB, WS_LORAA = 500 * MiB, WS_LORAG = 564 * MiB, WS_OPS = 628 * MiB, WS_SRS = 1016 * MiB, WS_END = 1020 * MiB;
constexpr size_t WS_YRAW = WS_LORAW, WS_YGELU = WS_LORAA, WS_YGLU = WS_LORAA + 32 * MiB, WS_MIXED = WS_OPS + 200 * MiB, WS_ACT = WS_OPS, WS_YSORT = WS_PROJ;
constexpr size_t WS_QP = WS_OPS, WS_YG = WS_OPS + 64 * MiB, WS_RKB = WS_OPS + 192 * MiB;
static_assert(WS_OPS + (size_t)64 * 4096 * OPS_STRIDE * 4 <= WS_SRS, "ops fits");
constexpr int CW_TMO = 0, CW_BAR = 4096, CW_GCOUNT = 16384, CW_CVCTR = 16384 + 64, CW_CVT1 = 16512, CW_CVT2 = 16768;
constexpr int LDS_BYTES = 163840, TAB_OFF = 131072, MISC_OFF = 159744;
constexpr int TAB_SRC = TAB_OFF, TAB_VAL = TAB_OFF + MAXTILES * 4, TAB_E = TAB_OFF + 2 * MAXTILES * 4, TAB_BASE = TAB_OFF + 3 * MAXTILES * 4;

struct Params { const float* in[34]; float* out; unsigned char* ws; };
enum { I_X = 0, I_N1G, I_WIN, I_MU, I_W0, I_WUP, I_A0, I_AUP, I_GUP, I_KK, I_KA, I_RK, I_LNW, I_LNB, I_LRE, I_LIM, I_LSTEP, I_BRE, I_BIM, I_CRE, I_CIM, I_DSKIP, I_WGLU, I_BGLU, I_BETA, I_WOUT, I_N2G, I_RW, I_RB, I_W1, I_B1, I_W2, I_B2, I_FG };

using pg8::Unit; using pg8::HALF; using pg8::BM;
constexpr int EPB_OFF = 139264, EPB_BYTES = 2048;
struct EpiProj {
    static constexpr bool PERM = true, PREFETCH = true;
    bf16_t* O; int ldc; const float* rs; LAS unsigned char* lds;
    __device__ __forceinline__ void prefetch(const Unit& u, int buf, int wid, int lane) const {
        if (wid != 0) return;
        __builtin_amdgcn_global_load_lds((const unsigned*)(rs + u.pm * BM + 4 * lane), (LAS unsigned*)(lds + EPB_OFF + buf * EPB_BYTES), 16, 0, 0);
    }
    __device__ __forceinline__ void operator()(const f32x4 (&acc)[2][2][4][2], const Unit& u, int wr, int wc, int fr, int fq, int buf) const {
        const int row0 = u.pm * BM + wr * 64 + fr, col0 = u.pn * BM + wc * 32 + 8 * fq;
        const LAS float* pb = (const LAS float*)(lds + EPB_OFF + buf * EPB_BYTES) + wr * 64 + fr;
#pragma unroll
        for (int ai = 0; ai < 2; ++ai)
#pragma unroll
            for (int m = 0; m < 4; ++m) { const int row = row0 + ai * HALF + m * 16; const float s = pb[ai * HALF + m * 16]; bf16_t* rowp = O + (size_t)row * ldc + col0;
#pragma unroll
                for (int bj = 0; bj < 2; ++bj) { const f32x4 v0 = acc[ai][bj][m][0] * s, v1 = acc[ai][bj][m][1] * s;
                    u32x4 w; w.x = cvt_pk_bf16(v0[0], v0[1]); w.y = cvt_pk_bf16(v0[2], v0[3]); w.z = cvt_pk_bf16(v1[0], v1[1]); w.w = cvt_pk_bf16(v1[2], v1[3]);
                    *(u32x4*)(rowp + bj * HALF) = w; } }
    }
};
struct EpiLora {
    static constexpr bool PERM = false, PREFETCH = false;
    float* bw; bf16_t* ba; bf16_t* bg;
    __device__ __forceinline__ void operator()(const f32x4 (&acc)[2][2][4][2], const Unit& u, int wr, int wc, int fr, int fq) const {
        const int kind = u.pn >> 1; const int row0 = u.pm * BM + wr * 64 + fr, cc0 = (u.pn & 1) * 256 + wc * 32 + 4 * fq;
        bf16_t* hb = kind == 1 ? ba : bg;
#pragma unroll
        for (int ai = 0; ai < 2; ++ai)
#pragma unroll
            for (int m = 0; m < 4; ++m) { const size_t off = (size_t)(row0 + ai * HALF + m * 16) * 512 + cc0;
#pragma unroll
                for (int bj = 0; bj < 2; ++bj)
#pragma unroll
                    for (int n = 0; n < 2; ++n) { const f32x4 v = acc[ai][bj][m][n];
                        if (kind == 0) *(f32x4*)(bw + off + bj * HALF + n * 16) = v;
                        else { u32x2 w; w.x = cvt_pk_bf16(v[0], v[1]); w.y = cvt_pk_bf16(v[2], v[3]); *(u32x2*)(hb + off + bj * HALF + n * 16) = w; } } }
    }
};
struct EpiGlu {
    static constexpr bool PERM = true, PREFETCH = false;
    const bf16_t* Y; bf16_t* O; const float* bias; float* ssq;
    __device__ __forceinline__ void operator()(const f32x4 (&acc)[2][2][4][2], const Unit& u, int wr, int wc, int fr, int fq) const {
        const int row0 = u.pm * BM + wr * 64 + fr, col0 = u.pn * BM + wc * 32 + 8 * fq;
        f32x4 bv[2][2];
#pragma unroll
        for (int bj = 0; bj < 2; ++bj)
#pragma unroll
            for (int n = 0; n < 2; ++n) bv[bj][n] = *(const f32x4*)(bias + col0 + bj * HALF + 4 * n);
#pragma unroll
        for (int ai = 0; ai < 2; ++ai)
#pragma unroll
            for (int m = 0; m < 4; ++m) { const int row = row0 + ai * HALF + m * 16; float sq = 0.f;
#pragma unroll
                for (int bj = 0; bj < 2; ++bj) { const size_t off = (size_t)row * 512 + col0 + bj * HALF; const u32x4 yv = *(const u32x4*)(Y + off);
                    const f32x4 z0 = acc[ai][bj][m][0] + bv[bj][0], z1 = acc[ai][bj][m][1] + bv[bj][1];
                    float o[8]; o[0] = bflo(yv.x) * sigmoidf_(z0[0]); o[1] = bfhi(yv.x) * sigmoidf_(z0[1]); o[2] = bflo(yv.y) * sigmoidf_(z0[2]); o[3] = bfhi(yv.y) * sigmoidf_(z0[3]);
                    o[4] = bflo(yv.z) * sigmoidf_(z1[0]); o[5] = bfhi(yv.z) * sigmoidf_(z1[1]); o[6] = bflo(yv.w) * sigmoidf_(z1[2]); o[7] = bfhi(yv.w) * sigmoidf_(z1[3]);
#pragma unroll
                    for (int j = 0; j < 8; ++j) sq += o[j] * o[j];
                    u32x4 w; w.x = cvt_pk_bf16(o[0], o[1]); w.y = cvt_pk_bf16(o[2], o[3]); w.z = cvt_pk_bf16(o[4], o[5]); w.w = cvt_pk_bf16(o[6], o[7]);
                    *(u32x4*)(O + off) = w; }
                sq += __shfl_xor(sq, 16); sq += __shfl_xor(sq, 32);
                if (fq == 0) ssq[(size_t)row * 8 + u.pn * 4 + wc] = sq; }
    }
};
struct EpiOut {
    static constexpr bool PERM = true, PREFETCH = false;
    bf16_t* X1B;
    __device__ __forceinline__ void operator()(const f32x4 (&acc)[2][2][4][2], const Unit& u, int wr, int wc, int fr, int fq) const {
        const int row0 = u.pm * BM + wr * 64 + fr, col0 = u.pn * BM + wc * 32 + 8 * fq;
        u32x4 xin[2][4][2];
#pragma unroll
        for (int ai = 0; ai < 2; ++ai)
#pragma unroll
            for (int m = 0; m < 4; ++m)
#pragma unroll
                for (int bj = 0; bj < 2; ++bj) xin[ai][m][bj] = *(const u32x4*)(X1B + (size_t)(row0 + ai * HALF + m * 16) * DM + col0 + bj * HALF);
#pragma unroll
        for (int ai = 0; ai < 2; ++ai)
#pragma unroll
            for (int m = 0; m < 4; ++m) { const size_t off = (size_t)(row0 + ai * HALF + m * 16) * DM + col0;
#pragma unroll
                for (int bj = 0; bj < 2; ++bj) { const u32x4 xi = xin[ai][m][bj]; const f32x4 a0 = acc[ai][bj][m][0], a1 = acc[ai][bj][m][1];
                    u32x4 w; w.x = cvt_pk_bf16(bflo(xi.x) + a0[0], bfhi(xi.x) + a0[1]); w.y = cvt_pk_bf16(bflo(xi.y) + a0[2], bfhi(xi.y) + a0[3]);
                    w.z = cvt_pk_bf16(bflo(xi.z) + a1[0], bfhi(xi.z) + a1[1]); w.w = cvt_pk_bf16(bflo(xi.w) + a1[2], bfhi(xi.w) + a1[3]); *(u32x4*)(X1B + off + bj * HALF) = w; } }
    }
};
struct EpiSwiglu {
    static constexpr bool PERM = true, PREFETCH = true;
    bf16_t* O; const float* b1g; const float* b1l; const float* srs; const LAS int* tsrc; const LAS int* tval; int flags; LAS unsigned char* lds;
    __device__ __forceinline__ void prefetch(const Unit& u, int buf, int wid, int lane) const {
        if (wid != 0) return;
        const int e = u.pn >> 3, pnl = u.pn & 7, src = tsrc[u.pm];
        LAS unsigned char* d = lds + EPB_OFF + buf * EPB_BYTES;
        __builtin_amdgcn_global_load_lds((const unsigned*)(srs + src + 4 * lane), (LAS unsigned*)d, 16, 0, 0);
        const float* bsrc = (lane < 32 ? b1g : b1l) + e * DFF + pnl * 128 + 4 * (lane & 31);
        __builtin_amdgcn_global_load_lds((const unsigned*)bsrc, (LAS unsigned*)(d + 1024), 16, 0, 0);
    }
    __device__ __forceinline__ void operator()(const f32x4 (&acc)[2][2][4][2], const Unit& u, int wr, int wc, int fr, int fq, int buf) const {
#ifdef PROBE_VARIANT
        if (flags & 16) return;
#endif
        const int pnl = u.pn & 7; const int r0 = wr * 64 + fr, ol = wc * 32 + 8 * fq, o0 = pnl * 128 + ol;
        const int nval = tval[u.pm];
        const LAS float* pb = (const LAS float*)(lds + EPB_OFF + buf * EPB_BYTES);
        f32x4 bg[2], bl[2];
#pragma unroll
        for (int n = 0; n < 2; ++n) { bg[n] = *(const LAS f32x4*)(pb + 256 + ol + 4 * n); bl[n] = *(const LAS f32x4*)(pb + 384 + ol + 4 * n); }
#pragma unroll
        for (int ai = 0; ai < 2; ++ai)
#pragma unroll
            for (int m = 0; m < 4; ++m) { const int r = r0 + ai * HALF + m * 16; const float s = r < nval ? pb[r] : 0.f;
                float o[8];
#pragma unroll
                for (int n = 0; n < 2; ++n)
#pragma unroll
                    for (int j = 0; j < 4; ++j) { const float gl = fminf(acc[ai][0][m][n][j] * s + bg[n][j], 7.0f); const float li = fminf(fmaxf(acc[ai][1][m][n][j] * s + bl[n][j], -7.0f), 7.0f);
                        o[4 * n + j] = gl * sigmoidf_(1.702f * gl) * (li + 1.0f); }
                u32x4 w; w.x = cvt_pk_bf16(o[0], o[1]); w.y = cvt_pk_bf16(o[2], o[3]); w.z = cvt_pk_bf16(o[4], o[5]); w.w = cvt_pk_bf16(o[6], o[7]);
                *(u32x4*)(O + (size_t)(u.pm * BM + r) * DFF + o0) = w; }
    }
};
constexpr int YS_LD = DM;
struct EpiMoe2 {
    static constexpr bool PERM = true, PREFETCH = false;
    bf16_t* O; const float* b2; int flags;
    __device__ __forceinline__ void operator()(const f32x4 (&acc)[2][2][4][2], const Unit& u, int wr, int wc, int fr, int fq) const {
#ifdef PROBE_VPHASE
        if (flags & 16) return;
#endif
        const int e = u.pn >> 2, pnl = u.pn & 3; const int row0 = u.pm * BM + wr * 64 + fr, col0 = pnl * BM + wc * 32 + 8 * fq;
        f32x4 bv[2][2];
#pragma unroll
        for (int bj = 0; bj < 2; ++bj)
#pragma unroll
            for (int n = 0; n < 2; ++n) bv[bj][n] = *(const f32x4*)(b2 + e * DM + col0 + bj * HALF + 4 * n);
#pragma unroll
        for (int ai = 0; ai < 2; ++ai)
#pragma unroll
            for (int m = 0; m < 4; ++m) { bf16_t* rowp = O + (size_t)(row0 + ai * HALF + m * 16) * YS_LD + col0;
#pragma unroll
                for (int bj = 0; bj < 2; ++bj) { const f32x4 v0 = acc[ai][bj][m][0] + bv[bj][0], v1 = acc[ai][bj][m][1] + bv[bj][1];
                    u32x4 w; w.x = cvt_pk_bf16(v0[0], v0[1]); w.y = cvt_pk_bf16(v0[2], v0[3]); w.z = cvt_pk_bf16(v1[0], v1[1]); w.w = cvt_pk_bf16(v1[2], v1[3]);
#ifdef PROBE_VPHASE
                    if ((flags & 32) && w.x != 0x12345678u) continue;
                    if (flags & 64) { const int blk = (((u.pm * 4 + pnl) * 8 + wr * 4 + wc) * 16 + (ai * 4 + m) * 2 + bj); *(u32x4*)(O + (size_t)blk * 512 + (fq * 16 + fr) * 8) = w; continue; }
#endif
                    *(u32x4*)(rowp + bj * HALF) = w; } }
    }
};
struct MoeOrder {
    int G, c, NT, ntiles; const LAS int* tsrc; const LAS int* tval; const LAS int* te; const int* stok; const LAS int* tbase; int flags;
    __device__ __forceinline__ bool next(int i, Unit& u) const {
#if defined(MOE_STATIC)
        const int nwg = ntiles * NT; const int L0 = i * G + c; if (L0 >= nwg) return false;
        int wgid = L0; { const int q = nwg / 8, r = nwg % 8, xcd = wgid % 8, off = wgid / 8; wgid = (xcd < r ? xcd * (q + 1) : r * (q + 1) + (xcd - r) * q) + off; }
        const int nig = 8 * NT, gid = wgid / nig, fm = gid * 8, gsz = (ntiles - fm) < 8 ? (ntiles - fm) : 8;
        u.pm = fm + ((wgid % nig) % gsz); u.pn = te[u.pm] * NT + (wgid % nig) / gsz; return true; }
#elif defined(MOE_PLAIN)
        const int L = i * G + c; const int mt = L / NT; if (mt >= ntiles) return false;
        u.pm = mt; u.pn = te[mt] * NT + (L % NT); return true; }
#else
        const int L = i * G + c, xcd = L & 7, j = L >> 3; const int mt = (j / NT) * 8 + xcd; if (mt >= ntiles) return false;
        u.pm = mt; u.pn = te[mt] * NT + (j % NT); return true; }
#endif
    __device__ __forceinline__ int arow(const Unit& u, int r) const {
#ifdef PROBE_VARIANT
        if (flags & 4) return (u.pm * 256 + r) & (NTOK - 1);
#endif
        return r < tval[u.pm] ? stok[tsrc[u.pm] + r] : 0; }
};
struct KsOne { __device__ __forceinline__ float operator()(int) const { return 1.f; } };
struct KsVec { const float* g; __device__ __forceinline__ float operator()(int k) const { return g[k]; } };
struct KsOut { const float* beta; __device__ __forceinline__ float operator()(int k) const { return k < DR ? 1.f : beta[k - DR]; } };
struct RmId { int off; __device__ __forceinline__ int operator()(int c) const { return off + c; } };
struct RmW1 { int e; __device__ __forceinline__ int operator()(int c) const { const int o = c >> 1, bj = c & 1; return e * 2048 + (o >> 7) * 256 + bj * 128 + (o & 127); } };
template <class KS, class RM>
__device__ __forceinline__ void tr_item(const float* src, int N, int k0, int c0, bf16_t* dst, int ldk, const KS ks, const RM rm, LAS float* scr, int lane) {
#pragma unroll 4
    for (int it = 0; it < 16; ++it) { const int r = it * 4 + (lane >> 4); const f32x4 v = *(const f32x4*)(src + (size_t)(k0 + r) * N + c0 + 4 * (lane & 15)); const float s = ks(k0 + r);
        LAS float* d = scr + r * 65 + 4 * (lane & 15); d[0] = v[0] * s; d[1] = v[1] * s; d[2] = v[2] * s; d[3] = v[3] * s; }
    LDS_WAIT();
    const int c = lane & 7;
#pragma unroll
    for (int jj = 0; jj < 8; ++jj) { const int n = (lane >> 3) + 8 * jj; const LAS float* s = scr + (8 * c) * 65 + n;
        u32x4 o; o.x = cvt_pk_bf16(s[0 * 65], s[1 * 65]); o.y = cvt_pk_bf16(s[2 * 65], s[3 * 65]); o.z = cvt_pk_bf16(s[4 * 65], s[5 * 65]); o.w = cvt_pk_bf16(s[6 * 65], s[7 * 65]);
        *(u32x4*)(dst + (size_t)rm(c0 + n) * ldk + k0 + 8 * c) = o; }
    LDS_WAIT();
}
struct CvItem { const float* src; int N, k0, c0; bf16_t* dst; int e; const float* ks; };
__device__ __forceinline__ void cv_item(const Params& p, int it, CvItem& c) {
    constexpr int I_1 = NE * 16 * 64;
    if (it < I_1) { const int e = it >> 10, q = it & 1023, kb = q >> 6, nb = q & 63; c.src = p.in[I_W1] + (size_t)e * DM * 2048; c.N = 2048; c.k0 = kb * 64; c.c0 = nb * 32; c.dst = (bf16_t*)(p.ws + WS_W1T); c.e = e; c.ks = p.in[I_N2G]; }
    else { const int r = it - I_1, e = r >> 9, q = r & 511, kb = q >> 5, nb = q & 31; c.src = p.in[I_W2] + (size_t)e * DFF * DM; c.N = DM; c.k0 = kb * 64; c.c0 = nb * 32; c.dst = (bf16_t*)(p.ws + WS_W2T); c.e = -(e * DM) - 1; c.ks = nullptr; }
}
__device__ __forceinline__ void cv_load(const CvItem& c, f32x4 (&v)[8], float (&s)[8], int lane) {
#pragma unroll
    for (int i = 0; i < 8; ++i) v[i] = __builtin_nontemporal_load((const f32x4*)(c.src + (size_t)(c.k0 + 8 * (lane >> 3) + i) * c.N + c.c0 + 4 * (lane & 7)));
    if (c.ks) { const f32x4 a = *(const f32x4*)(c.ks + c.k0 + 8 * (lane >> 3)), b = *(const f32x4*)(c.ks + c.k0 + 8 * (lane >> 3) + 4);
        s[0] = a[0]; s[1] = a[1]; s[2] = a[2]; s[3] = a[3]; s[4] = b[0]; s[5] = b[1]; s[6] = b[2]; s[7] = b[3]; }
    else {
#pragma unroll
        for (int i = 0; i < 8; ++i) s[i] = 1.0f; }
}
__device__ __forceinline__ void cv_emit(const CvItem& c0, const f32x4 (&v0)[8], const float (&s0)[8], LAS float*, int lane) {
#pragma unroll
    for (int j = 0; j < 4; ++j) { const int c = c0.c0 + 4 * (lane & 7) + j;
        u32x4 o; o.x = cvt_pk_bf16(v0[0][j] * s0[0], v0[1][j] * s0[1]); o.y = cvt_pk_bf16(v0[2][j] * s0[2], v0[3][j] * s0[3]); o.z = cvt_pk_bf16(v0[4][j] * s0[4], v0[5][j] * s0[5]); o.w = cvt_pk_bf16(v0[6][j] * s0[6], v0[7][j] * s0[7]);
        int row; if (c0.e >= 0) { const int oo = c >> 1, bj = c & 1; row = c0.e * 2048 + (oo >> 7) * 256 + bj * 128 + (oo & 127); } else row = -(c0.e + 1) + c;
        *(u32x4*)(c0.dst + (size_t)row * DM + c0.k0 + 8 * (lane >> 3)) = o; }
}
constexpr int CV_NIT = NE * 16 * 64 + NE * 16 * 32;
constexpr int CV_A = 0, CV_B = 8192, CV_C = 40960;
__device__ __forceinline__ int cv_ticket(unsigned* ctr, int lane) { unsigned t = 0; if (lane == 0) t = __hip_atomic_fetch_add(ctr, 1u, __ATOMIC_RELAXED, __HIP_MEMORY_SCOPE_AGENT); return (int)__builtin_amdgcn_readfirstlane(t); }
template <int BATCH>
__device__ __forceinline__ void cv_queue(const Params& p, LAS float* scr, int lane, unsigned* ctr, const int lo, const int hi) {
    CvItem c0, c1, c2; f32x4 v0[8], v1[8], v2[8]; float s0[8], s1[8], s2[8];
    int tb = 0, tp = BATCH;
#define CV_NEXT() (tp == BATCH ? (tb = lo + cv_ticket(ctr, lane) * BATCH, tp = 1, tb) : tb + tp++)
    int i0 = CV_NEXT(), i1 = CV_NEXT();
    if (i0 >= hi) return;
    cv_item(p, i0, c0); cv_load(c0, v0, s0, lane);
    if (i1 < hi) { cv_item(p, i1, c1); cv_load(c1, v1, s1, lane); }
    for (;;) {
        const int i2 = CV_NEXT();
        if (i2 < hi) { cv_item(p, i2, c2); cv_load(c2, v2, s2, lane); }
        cv_emit(c0, v0, s0, scr, lane);
        if (i1 >= hi) break;
        c0 = c1; c1 = c2; i1 = i2;
#pragma unroll
        for (int i = 0; i < 8; ++i) { v0[i] = v1[i]; v1[i] = v2[i]; s0[i] = s1[i]; s1[i] = s2[i]; }
    }
}
__device__ __forceinline__ void p5_convert(const Params& p, LAS float* scr, int lane) { cv_queue<16>(p, scr, lane, (unsigned*)(p.ws + WS_CTL) + CW_CVCTR, CV_B, CV_C); }
__device__ __forceinline__ void cv_tail(const Params& p, LAS unsigned char* lds, int wave, int lane, int cw, int lo, int n) {
    const int x = (int)blockIdx.x & 7, per = n >> 3; cv_queue<8>(p, (LAS float*)lds, lane, (unsigned*)(p.ws + WS_CTL) + cw + x * 32, lo + x * per, lo + (x + 1) * per); }
#undef CV_NEXT
__device__ __forceinline__ void p0_prologue(const Params& p, LAS unsigned char* lds, int wave, int lane) {
    unsigned char* ws = p.ws;
    LAS float* scr = (LAS float*)(lds + wave * 16640);
    const int gw = blockIdx.x * NWAVES + wave;
    bf16_t* WinT = (bf16_t*)(ws + WS_WINT); bf16_t* WoutT = (bf16_t*)(ws + WS_WOUTT); bf16_t* WgluT = (bf16_t*)(ws + WS_WGLUT);
    constexpr int I_IN = 16 * 36, I_OUT = 16 * 16, I_GLU = 8 * 8, NITEMS = I_IN + I_OUT + I_GLU;
    for (int it = gw; it < NITEMS; it += NGW) {
        int r = it;
        if (r < I_IN) { const int kb = r / 36, nb = r % 36; tr_item(p.in[I_WIN], DIN, kb * 64, nb * 64, WinT, DM, KsVec{p.in[I_N1G]}, RmId{0}, scr, lane); continue; } r -= I_IN;
        if (r < I_OUT) { const int kb = r >> 4, nb = r & 15; tr_item(p.in[I_WOUT], DM, kb * 64, nb * 64, WoutT, DM, KsOut{p.in[I_BETA]}, RmId{0}, scr, lane); continue; } r -= I_OUT;
        { const int kb = r >> 3, nb = r & 7; tr_item(p.in[I_WGLU], DSSM, kb * 64, nb * 64, WgluT, DSSM, KsOne{}, RmId{0}, scr, lane); }
    }
    { const float* x = p.in[I_X]; bf16_t* xb = (bf16_t*)(ws + WS_XB); float* rs = (float*)(ws + WS_RSTD1);
      for (int m0 = gw; m0 < NTOK; m0 += 4 * NGW) {
          f32x4 v[4][4];
#pragma unroll
          for (int q = 0; q < 4; ++q) { const f32x4* xr = (const f32x4*)(x + (size_t)(m0 + q * NGW) * DM) + lane;
#pragma unroll
              for (int j = 0; j < 4; ++j) v[q][j] = __builtin_nontemporal_load(xr + 64 * j); }
#pragma unroll
          for (int q = 0; q < 4; ++q) { const int m = m0 + q * NGW; float s = 0.f;
#pragma unroll
              for (int j = 0; j < 4; ++j) s += (v[q][j][0] * v[q][j][0] + v[q][j][1] * v[q][j][1]) + (v[q][j][2] * v[q][j][2] + v[q][j][3] * v[q][j][3]);
              s = wave_sum(s); if (lane == 0) rs[m] = 1.0f / sqrtf(s * (1.0f / DM) + 1e-5f);
              u32x2* o8 = (u32x2*)(xb + (size_t)m * DM) + lane;
#pragma unroll
              for (int j = 0; j < 4; ++j) { u32x2 w; w.x = cvt_pk_bf16(v[q][j][0], v[q][j][1]); w.y = cvt_pk_bf16(v[q][j][2], v[q][j][3]); o8[64 * j] = w; } } } }
    const int gt = blockIdx.x * (NWAVES * 64) + wave * 64 + lane, NT_ = GRID * NWAVES * 64;
    { float* b1g = (float*)(ws + WS_B1G); float* b1l = (float*)(ws + WS_B1L); const float* b1 = p.in[I_B1];
      for (int i = gt; i < NE * DFF; i += NT_) { const int e = i >> 10, o = i & 1023; b1g[i] = b1[e * 2048 + 2 * o]; b1l[i] = b1[e * 2048 + 2 * o + 1]; } }
    { bf16_t* rwh = (bf16_t*)(ws + WS_RWP); bf16_t* rwl = rwh + NE * DM; const float* rw = p.in[I_RW]; const float* g2 = p.in[I_N2G];
      for (int i = gt; i < DM * NE; i += NT_) { const int e = i >> 10, k = i & 1023; const float v = g2[k] * rw[k * NE + e]; const bf16_t h = f2bf(v); rwh[i] = h; rwl[i] = f2bf(v - bf2f(h)); } }
    { bf16_t* LB = (bf16_t*)(ws + WS_LORAB); const float* wup = p.in[I_WUP]; const float* aup = p.in[I_AUP]; const float* gup = p.in[I_GUP];
      for (int i = gt; i < 1536 * 256; i += NT_) { const int n = i >> 8, k = i & 255; float v = 0.f;
          if (n < 512) { if (k < 64) v = wup[k * 512 + n]; } else if (n < 1024) { if (k >= 64 && k < 128) v = aup[(k - 64) * 512 + (n - 512)]; } else { if (k >= 128) v = gup[(k - 128) * 512 + (n - 1024)]; }
          LB[i] = f2bf(v); } }
}
__device__ __forceinline__ void p2_lora_in(const Params& p, int wave, int lane) {
    const bf16_t* proj = (const bf16_t*)(p.ws + WS_PROJ); bf16_t* li = (bf16_t*)(p.ws + WS_LORAIN); const float* mu = p.in[I_MU] + COL_LORA;
    const int gt = blockIdx.x * (NWAVES * 64) + wave * 64 + lane, NT_ = GRID * NWAVES * 64;
    for (int idx = gt; idx < NTOK * 32; idx += NT_) { const int tok = idx >> 5, c = (idx & 31) * 8;
        const bf16_t* pr = proj + (size_t)tok * DIN + COL_LORA + c; const u32x4 cur = *(const u32x4*)pr; u32x4 prv = (u32x4){0u, 0u, 0u, 0u}; if (tok & (SEQ - 1)) prv = *(const u32x4*)(pr - DIN);
        float v[8], q[8];
        v[0] = bflo(cur.x); v[1] = bfhi(cur.x); v[2] = bflo(cur.y); v[3] = bfhi(cur.y); v[4] = bflo(cur.z); v[5] = bfhi(cur.z); v[6] = bflo(cur.w); v[7] = bfhi(cur.w);
        q[0] = bflo(prv.x); q[1] = bfhi(prv.x); q[2] = bflo(prv.y); q[3] = bfhi(prv.y); q[4] = bflo(prv.z); q[5] = bfhi(prv.z); q[6] = bflo(prv.w); q[7] = bfhi(prv.w);
#pragma unroll
        for (int j = 0; j < 8; ++j) { float s = v[j] + mu[c + j] * (q[j] - v[j]); if (c < 64) s = tanhf(s); else if (c >= 128) s = sigmoidf_(s); v[j] = s; }
        u32x4 w; w.x = cvt_pk_bf16(v[0], v[1]); w.y = cvt_pk_bf16(v[2], v[3]); w.z = cvt_pk_bf16(v[4], v[5]); w.w = cvt_pk_bf16(v[6], v[7]);
        *(u32x4*)(li + (size_t)tok * 256 + c) = w; }
}
template <int CTRL> __device__ __forceinline__ float dpp_mov(float x) { return __int_as_float(__builtin_amdgcn_update_dpp(0, __float_as_int(x), CTRL, 0xF, 0xF, true)); }
__device__ __forceinline__ float sum8(float x) { x += dpp_mov<0xB1>(x); x += dpp_mov<0x4E>(x); x += dpp_mov<0x141>(x); return x; }
__device__ __forceinline__ float rowsum16(float x) { x = sum8(x); x += dpp_mov<0x140>(x); return x; }
__device__ __forceinline__ void unpack8(const u32x4 w, float (&f)[8]) { f[0] = bflo(w.x); f[1] = bfhi(w.x); f[2] = bflo(w.y); f[3] = bfhi(w.y); f[4] = bflo(w.z); f[5] = bfhi(w.z); f[6] = bflo(w.w); f[7] = bfhi(w.w); }
__device__ __forceinline__ void ld8(const float* p_, float (&f)[8]) { const f32x4 a = *(const f32x4*)p_, b = *(const f32x4*)(p_ + 4); f[0] = a[0]; f[1] = a[1]; f[2] = a[2]; f[3] = a[3]; f[4] = b[0]; f[5] = b[1]; f[6] = b[2]; f[7] = b[3]; }
__device__ __forceinline__ float gelu_tanh(float y) { const float t = 0.7978845608028654f * (y + 0.044715f * y * y * y); return y * sigmoidf_(2.0f * t); }
#define S5_ROLE(w, s) ((w) & 3)
#if !defined(S5_MAP)
#define S5_MAP 0
#endif
#if S5_MAP == 0
#define S5_SQ(w) ((w) >> 2)
#define S5_WQ(w) ((w) & 3)
#elif S5_MAP == 1
#define S5_SQ(w) (1 - ((w) >> 2))
#define S5_WQ(w) ((w) & 3)
#elif S5_MAP == 4
#define S5_SQ(w) ((w) >> 2)
#define S5_WQ(w) (((w) & 3) ^ ((w) >> 2))
#elif S5_MAP == 2
#define S5_SQ(w) ((w) >> 2)
#define S5_WQ(w) (3 - ((w) & 3))
#else
#define S5_SQ(w) ((w) & 1)
#define S5_WQ(w) ((w) >> 1)
#endif
#ifdef S5_DELAY_ROLE
#define S5_DELAY(w) do { if ((w) == S5_DELAY_ROLE) __builtin_amdgcn_s_sleep(4); } while (0)
#else
#define S5_DELAY(w) do { } while (0)
#endif
#ifdef S5_SYNC
#define S5_BARRIER() __syncthreads()
#else
#define S5_BARRIER() lds_barrier()
#endif
constexpr int S5_T = 32, S5_NT = SEQ / S5_T, S5_BU = S5_T * 64 * 8, S5_ST = S5_T * 272, S5_SEQB = 2 * S5_BU + 2 * S5_ST;
__device__ __forceinline__ void p5_s5(const Params& p, LAS unsigned char* lds, int wave, int lane, const int vf = 0) {
    const int sq = S5_SQ(wave), wq = S5_WQ(wave), q = (blockIdx.x - 128) * 2 + sq, b = q >> 5, g = q & 31;
    LAS unsigned char* L = lds + sq * 51200;
    const float dt = expf(p.in[I_LSTEP][g]);
    const bf16_t* ubase = (const bf16_t*)(p.ws + WS_PROJ) + (size_t)b * SEQ * DIN + COL_U + g * 16;
    bf16_t* yg = (bf16_t*)(p.ws + WS_YGELU) + (size_t)b * SEQ * DSSM + g * 16;
    f32x2 l1 = (f32x2){0.f, 0.f}, l2 = (f32x2){0.f, 0.f}, sv = (f32x2){0.f, 0.f};
    bf16x8 Bop[4], Bout[4], Dop; bf16x8 An[8], Un[8];
    const u32x4 z4 = (u32x4){0u, 0u, 0u, 0u};
    Dop = __builtin_bit_cast(bf16x8, z4);
#pragma unroll
    for (int k = 0; k < 4; ++k) Bop[k] = Bout[k] = __builtin_bit_cast(bf16x8, z4);
#pragma unroll
    for (int k = 0; k < 8; ++k) An[k] = Un[k] = __builtin_bit_cast(bf16x8, z4);
    const int rt3 = wq - 1;
    if (wq == 0) { const float lre = fminf(p.in[I_LRE][g * 64 + lane], -1e-4f), lim = p.in[I_LIM][g * 64 + lane]; const float mag = expf(lre * dt), ang = lim * dt; const float lbr = mag * cosf(ang), lbi = mag * sinf(ang);
        l1 = (f32x2){lbr, lbr}; l2 = (f32x2){-lbi, lbi}; }
    else if (wq == 3) {
#pragma unroll
        for (int ct = 0; ct < 4; ++ct) { const int c = 32 * ct + (lane & 31), pp = c & 63, isim = c >> 6; const float lre = fminf(p.in[I_LRE][g * 64 + pp], -1e-4f), lim = p.in[I_LIM][g * 64 + pp];
            const float mag = expf(lre * dt), ang = lim * dt, cr = mag * cosf(ang), ci = mag * sinf(ang), den = lre * lre + lim * lim, nre = cr - 1.0f;
            const float zre = (nre * lre + ci * lim) / den, zim = (ci * lre - nre * lim) / den;
            const float* bre = p.in[I_BRE] + (size_t)(g * 64 + pp) * 16 + 8 * (lane >> 5); const float* bim = p.in[I_BIM] + (size_t)(g * 64 + pp) * 16 + 8 * (lane >> 5);
            float t[8];
#pragma unroll
            for (int jj = 0; jj < 8; ++jj) t[jj] = isim ? (zre * bim[jj] + zim * bre[jj]) : (zre * bre[jj] - zim * bim[jj]);
            u32x4 w; w.x = cvt_pk_bf16(t[0], t[1]); w.y = cvt_pk_bf16(t[2], t[3]); w.z = cvt_pk_bf16(t[4], t[5]); w.w = cvt_pk_bf16(t[6], t[7]); Bop[ct] = __builtin_bit_cast(bf16x8, w); }
#pragma unroll
        for (int k = 0; k < 8; ++k) An[k] = *(const bf16x8*)(ubase + (size_t)(k * S5_T + (lane & 31)) * DIN + 8 * (lane >> 5)); }
    else { const int m = lane & 15;
#pragma unroll
        for (int ks = 0; ks < 4; ++ks) { float t[8];
#pragma unroll
            for (int jj = 0; jj < 8; ++jj) { const int k = 32 * ks + 8 * (lane >> 4) + jj, pp = k >> 1; t[jj] = (k & 1) ? -p.in[I_CIM][(size_t)(g * 16 + m) * 64 + pp] : p.in[I_CRE][(size_t)(g * 16 + m) * 64 + pp]; }
            u32x4 w; w.x = cvt_pk_bf16(t[0], t[1]); w.y = cvt_pk_bf16(t[2], t[3]); w.z = cvt_pk_bf16(t[4], t[5]); w.w = cvt_pk_bf16(t[6], t[7]); Bout[ks] = __builtin_bit_cast(bf16x8, w); }
        { const float dsk = p.in[I_DSKIP][g * 16 + m]; float t[8];
#pragma unroll
          for (int jj = 0; jj < 8; ++jj) t[jj] = (8 * (lane >> 4) + jj == m) ? dsk : 0.f;
          u32x4 w; w.x = cvt_pk_bf16(t[0], t[1]); w.y = cvt_pk_bf16(t[2], t[3]); w.z = cvt_pk_bf16(t[4], t[5]); w.w = cvt_pk_bf16(t[6], t[7]); Dop = __builtin_bit_cast(bf16x8, w); }
        if (lane < 32) {
#pragma unroll
            for (int k = 0; k < 8; ++k) Un[k] = *(const bf16x8*)(ubase + (size_t)(k * S5_T + 16 * rt3 + (lane & 15)) * DIN + 8 * (lane >> 4)); } }
    const f32x16 z16 = {0.f, 0.f, 0.f, 0.f, 0.f, 0.f, 0.f, 0.f, 0.f, 0.f, 0.f, 0.f, 0.f, 0.f, 0.f, 0.f};
#ifdef PROBE_S5
#define S5_SKIP(b) if (vf & (b)) break;
#else
#define S5_SKIP(b)
#endif
#define S5_STAGE1(tileidx, sl) do { S5_SKIP(4) LAS float* bu_ = (LAS float*)(L + ((tileidx) & 1) * S5_BU); \
        _Pragma("unroll") for (int hh = 0; hh < 2; ++hh) { const f32x16 dre = __builtin_amdgcn_mfma_f32_32x32x16_bf16(An[sl], Bop[hh], z16, 0, 0, 0), dim = __builtin_amdgcn_mfma_f32_32x32x16_bf16(An[sl], Bop[hh + 2], z16, 0, 0, 0); const int pp = 32 * hh + (lane & 31); \
            _Pragma("unroll") for (int r = 0; r < 16; ++r) { const int rw = (r & 3) + 8 * (r >> 2) + 4 * (lane >> 5); *(LAS f32x2*)(bu_ + (rw * 64 + pp) * 2) = (f32x2){dre[r], dim[r]}; } }     \
        } while (0)
#define S5_LD1(sl, t) do { const int tn_ = (t) < S5_NT ? (t) : S5_NT - 1; An[sl] = *(const bf16x8*)(ubase + (size_t)(tn_ * S5_T + (lane & 31)) * DIN + 8 * (lane >> 5)); } while (0)
#define S5_STAGE3(tileidx, sl) do { S5_SKIP(8) const LAS unsigned char* st_ = L + 2 * S5_BU + ((tileidx) & 1) * S5_ST; \
        f32x4 acc = __builtin_amdgcn_mfma_f32_16x16x32_bf16(Un[sl], Dop, (f32x4){0.f, 0.f, 0.f, 0.f}, 0, 0, 0); \
        _Pragma("unroll") for (int ks = 0; ks < 4; ++ks) { const bf16x8 a = *(const LAS bf16x8*)(st_ + (16 * rt3 + (lane & 15)) * 272 + (32 * ks + 8 * (lane >> 4)) * 2); acc = __builtin_amdgcn_mfma_f32_16x16x32_bf16(a, Bout[ks], acc, 0, 0, 0); } \
        _Pragma("unroll") for (int r = 0; r < 4; ++r) { const int tok = (tileidx) * S5_T + 16 * rt3 + 4 * (lane >> 4) + r; yg[(size_t)tok * DSSM + (lane & 15)] = f2bf(gelu_tanh(acc[r])); } } while (0)
#define S5_LD3(sl, t) do { const int tn_ = (t) < S5_NT ? (t) : S5_NT - 1; if (lane < 32) Un[sl] = *(const bf16x8*)(ubase + (size_t)(tn_ * S5_T + 16 * rt3 + (lane & 15)) * DIN + 8 * (lane >> 4)); } while (0)
#define S5_SCAN(ii) do { S5_SKIP(16) const LAS float* bu_ = (const LAS float*)(L + ((ii) & 1) * S5_BU); LAS unsigned char* st_ = L + 2 * S5_BU + ((ii) & 1) * S5_ST; \
            f32x2 xa[16], xb[16];     \
            _Pragma("unroll") for (int t = 0; t < 16; ++t) xa[t] = *(const LAS f32x2*)(bu_ + (t * 64 + lane) * 2); \
            __builtin_amdgcn_sched_barrier(0); \
            _Pragma("unroll") for (int t = 0; t < 8; ++t) { const f32x2 t1 = l1 * sv + xa[t]; const f32x2 sw = __builtin_shufflevector(sv, sv, 1, 0); sv = l2 * sw + t1; *(LAS unsigned*)(st_ + t * 272 + lane * 4) = cvt_pk_bf16(sv.x, sv.y); } \
            __builtin_amdgcn_sched_barrier(0); \
            _Pragma("unroll") for (int t = 0; t < 16; ++t) xb[t] = *(const LAS f32x2*)(bu_ + ((16 + t) * 64 + lane) * 2); \
            __builtin_amdgcn_sched_barrier(0); \
            _Pragma("unroll") for (int t = 8; t < 16; ++t) { const f32x2 t1 = l1 * sv + xa[t]; const f32x2 sw = __builtin_shufflevector(sv, sv, 1, 0); sv = l2 * sw + t1; *(LAS unsigned*)(st_ + t * 272 + lane * 4) = cvt_pk_bf16(sv.x, sv.y); } \
            _Pragma("unroll") for (int t = 0; t < 16; ++t) { const f32x2 t1 = l1 * sv + xb[t]; const f32x2 sw = __builtin_shufflevector(sv, sv, 1, 0); sv = l2 * sw + t1; *(LAS unsigned*)(st_ + (16 + t) * 272 + lane * 4) = cvt_pk_bf16(sv.x, sv.y); } } while (0)
    if (wq == 3) S5_STAGE1(0, 0);
    S5_BARRIER();
#define BAR_ S5_BARRIER()
    if (wq == 0) { for (int i = 0; i < S5_NT; ++i) { S5_SCAN(i); BAR_; } }
    else if (wq == 3) {
        for (int t0 = 0; t0 < S5_NT - 8; t0 += 8) {
            S5_STAGE1(t0 + 1, 1); BAR_; S5_STAGE1(t0 + 2, 2); BAR_;
            S5_LD1(6, t0 + 6); S5_LD1(7, t0 + 7); S5_LD1(0, t0 + 8); S5_LD1(1, t0 + 9); S5_LD1(2, t0 + 10);
            S5_STAGE1(t0 + 3, 3); BAR_; S5_STAGE1(t0 + 4, 4); BAR_; S5_STAGE1(t0 + 5, 5); BAR_;
            S5_LD1(3, t0 + 11); S5_LD1(4, t0 + 12); S5_LD1(5, t0 + 13);
            S5_STAGE1(t0 + 6, 6); BAR_; S5_STAGE1(t0 + 7, 7); BAR_; S5_STAGE1(t0 + 8, 0); BAR_; }
        { constexpr int t0 = S5_NT - 8;
            S5_STAGE1(t0 + 1, 1); BAR_; S5_STAGE1(t0 + 2, 2); BAR_; S5_LD1(6, t0 + 6); S5_LD1(7, t0 + 7);
            S5_STAGE1(t0 + 3, 3); BAR_; S5_STAGE1(t0 + 4, 4); BAR_; S5_STAGE1(t0 + 5, 5); BAR_; S5_STAGE1(t0 + 6, 6); BAR_; S5_STAGE1(t0 + 7, 7); BAR_; BAR_; } }
    else {
        BAR_;
        for (int t0 = 0; t0 < S5_NT - 8; t0 += 8) {
            S5_STAGE3(t0, 0); BAR_; S5_STAGE3(t0 + 1, 1); BAR_;
            S5_LD3(5, t0 + 5); S5_LD3(6, t0 + 6); S5_LD3(7, t0 + 7); S5_LD3(0, t0 + 8); S5_LD3(1, t0 + 9);
            S5_STAGE3(t0 + 2, 2); BAR_; S5_STAGE3(t0 + 3, 3); BAR_; S5_STAGE3(t0 + 4, 4); BAR_;
            S5_LD3(2, t0 + 10); S5_LD3(3, t0 + 11); S5_LD3(4, t0 + 12);
            S5_STAGE3(t0 + 5, 5); BAR_; S5_STAGE3(t0 + 6, 6); BAR_; S5_STAGE3(t0 + 7, 7); BAR_; }
        { constexpr int t0 = S5_NT - 8;
            S5_STAGE3(t0, 0); BAR_; S5_STAGE3(t0 + 1, 1); BAR_; S5_LD3(5, t0 + 5); S5_LD3(6, t0 + 6); S5_LD3(7, t0 + 7);
            S5_STAGE3(t0 + 2, 2); BAR_; S5_STAGE3(t0 + 3, 3); BAR_; S5_STAGE3(t0 + 4, 4); BAR_; S5_STAGE3(t0 + 5, 5); BAR_; S5_STAGE3(t0 + 6, 6); BAR_; S5_STAGE3(t0 + 7, 7); } }
#undef BAR_
#undef S5_LD1
#undef S5_LD3
#undef S5_SCAN
#undef S5_ITER
#undef S5_STAGE1
#undef S5_STAGE3
}
struct P7In { f32x4 s0, s1; float rk; u32x4 yr, yg, cv, qv, gg; };
__device__ __forceinline__ void p7_load(P7In& in, const bf16_t* yraw, const bf16_t* proj, const float* rkb, const bf16_t* lg, const bf16_t* yglu, const float* ssq, int tok, int lane) {
    const int c0 = lane * 8, h = lane >> 3;
    in.yr = *(const u32x4*)(yraw + (size_t)tok * DR + c0);
    { const bf16_t* pv = proj + (size_t)tok * DIN + COL_V + c0; in.cv = *(const u32x4*)pv; in.qv = (tok & (SEQ - 1)) ? *(const u32x4*)(pv - DIN) : (u32x4){0u, 0u, 0u, 0u}; in.rk = rkb[(size_t)tok * NH + h]; }
    in.gg = *(const u32x4*)(lg + (size_t)tok * DR + c0);
    in.s0 = *(const f32x4*)(ssq + (size_t)tok * 8); in.s1 = *(const f32x4*)(ssq + (size_t)tok * 8 + 4);
    in.yg = *(const u32x4*)(yglu + (size_t)tok * DSSM + c0);
}
__device__ __forceinline__ void p7_mix(const Params& p, int wave, int lane) {
    const bf16_t* yraw = (const bf16_t*)(p.ws + WS_YRAW); const bf16_t* proj = (const bf16_t*)(p.ws + WS_PROJ); const float* rkb = (const float*)(p.ws + WS_RKB); const bf16_t* lg = (const bf16_t*)(p.ws + WS_LORAG); bf16_t* mixed = (bf16_t*)(p.ws + WS_MIXED);
    const bf16_t* yglu = (const bf16_t*)(p.ws + WS_YGLU); const float* ssq = (const float*)(p.ws + WS_SSQ);
    const int c0 = lane * 8;
    float lnw[8], lnb[8], muv[8]; ld8(p.in[I_LNW] + c0, lnw); ld8(p.in[I_LNB] + c0, lnb); ld8(p.in[I_MU] + COL_V + c0, muv);
    const int gw = blockIdx.x * NWAVES + wave;
    P7In cur, nxt; p7_load(cur, yraw, proj, rkb, lg, yglu, ssq, gw, lane);
    for (int tok = gw; tok < NTOK; tok += NGW) {
        if (tok + NGW < NTOK) p7_load(nxt, yraw, proj, rkb, lg, yglu, ssq, tok + NGW, lane);
        float y[8], v[8], g[8], o[8], cvv[8], qvv[8]; unpack8(cur.cv, cvv); unpack8(cur.qv, qvv); unpack8(cur.gg, g); unpack8(cur.yr, y);
#pragma unroll
        for (int j = 0; j < 8; ++j) v[j] = cvv[j] + muv[j] * (qvv[j] - cvv[j]);
        float sm = 0.f;
#pragma unroll
        for (int j = 0; j < 8; ++j) sm += y[j];
        const float mu = sum8(sm) * (1.0f / 64.0f); float sq = 0.f;
#pragma unroll
        for (int j = 0; j < 8; ++j) { y[j] -= mu; sq += y[j] * y[j]; }
        const float rstd = 1.0f / sqrtf(sum8(sq) * (1.0f / 64.0f) + 64e-5f);
#pragma unroll
        for (int j = 0; j < 8; ++j) { o[j] = (y[j] * rstd * lnw[j] + lnb[j] + cur.rk * v[j]) * g[j];
#ifdef SCRUB7
            o[j] = (o[j] == o[j] && fabsf(o[j]) < 1e30f) ? o[j] : 0.f;
#endif
        }
        u32x4 w; w.x = cvt_pk_bf16(o[0], o[1]); w.y = cvt_pk_bf16(o[2], o[3]); w.z = cvt_pk_bf16(o[4], o[5]); w.w = cvt_pk_bf16(o[6], o[7]);
        *(u32x4*)(mixed + (size_t)tok * DM + c0) = w;
        const float ss = ((cur.s0[0] + cur.s0[1]) + (cur.s0[2] + cur.s0[3])) + ((cur.s1[0] + cur.s1[1]) + (cur.s1[2] + cur.s1[3])); const float rs = 1.0f / sqrtf(ss * (1.0f / DSSM) + 1e-5f);
        float yv[8]; unpack8(cur.yg, yv);
        u32x4 w2; w2.x = cvt_pk_bf16(yv[0] * rs, yv[1] * rs); w2.y = cvt_pk_bf16(yv[2] * rs, yv[3] * rs); w2.z = cvt_pk_bf16(yv[4] * rs, yv[5] * rs); w2.w = cvt_pk_bf16(yv[6] * rs, yv[7] * rs);
        *(u32x4*)(mixed + (size_t)tok * DM + DR + c0) = w2;
        cur = nxt;
    }
}
constexpr int CT = 72;
constexpr int SLOT = 64 * CT * 2;
constexpr int SL_AH = 0, SL_BH = 1, SL_KH = 2, SL_RH = 3, SL_AHT = 4, SL_BTT = 5, SL_KTT = 6, SL_VT = 7, SL_PA = 8, SL_PAT = 9, SL_TA = 10, SL_AAK = 11, SL_ARB = 12, SL_ARK = 13, SL_XT = 14, SL_UVT = 15;
constexpr int SL_PB = 0, SL_PBT = 1, SL_TB = 2, SL_WT = 11;
constexpr int LC_OFF = SL_PA * SLOT, TOT_OFF = LC_OFF + 64 * 64 * 4;
constexpr int GT_OFF = 16 * SLOT;
constexpr int PC_OFF = GT_OFF + 256;
__device__ __forceinline__ LAS bf16_t* slot(LAS unsigned char* lds, int s) { return (LAS bf16_t*)(lds + s * SLOT); }
template <bool TR> __device__ __forceinline__ void mm2(const LAS bf16_t* X, const LAS bf16_t* YT, int mi, int ni0, int lane, f32x4 (&acc)[2]) {
    const int fr = lane & 15, fq = lane >> 4;
#pragma unroll
    for (int ks = 0; ks < 2; ++ks) { const bf16x8 a = *(const LAS bf16x8*)(X + (16 * mi + fr) * CT + 32 * ks + 8 * fq);
#pragma unroll
        for (int t = 0; t < 2; ++t) { const bf16x8 b = *(const LAS bf16x8*)(YT + (16 * (ni0 + t) + fr) * CT + 32 * ks + 8 * fq);
            acc[t] = TR ? __builtin_amdgcn_mfma_f32_16x16x32_bf16(a, b, acc[t], 0, 0, 0) : __builtin_amdgcn_mfma_f32_16x16x32_bf16(b, a, acc[t], 0, 0, 0); } }
}
__device__ __forceinline__ void ldA(const LAS bf16_t* X, int mi, int lane, bf16x8 (&a)[2]) {
#pragma unroll
    for (int ks = 0; ks < 2; ++ks) a[ks] = *(const LAS bf16x8*)(X + (16 * mi + (lane & 15)) * CT + 32 * ks + 8 * (lane >> 4)); }
__device__ __forceinline__ void ldB(const LAS bf16_t* YT, int ni0, int lane, bf16x8 (&b)[2][2]) {
#pragma unroll
    for (int t = 0; t < 2; ++t)
#pragma unroll
        for (int ks = 0; ks < 2; ++ks) b[t][ks] = *(const LAS bf16x8*)(YT + (16 * (ni0 + t) + (lane & 15)) * CT + 32 * ks + 8 * (lane >> 4)); }
template <bool TR> __device__ __forceinline__ void mma(const bf16x8 (&a)[2], const bf16x8 (&b)[2][2], f32x4 (&acc)[2]) {
#pragma unroll
    for (int ks = 0; ks < 2; ++ks)
#pragma unroll
        for (int t = 0; t < 2; ++t) acc[t] = TR ? __builtin_amdgcn_mfma_f32_16x16x32_bf16(a[ks], b[t][ks], acc[t], 0, 0, 0) : __builtin_amdgcn_mfma_f32_16x16x32_bf16(b[t][ks], a[ks], acc[t], 0, 0, 0); }
#define ZACC(x) x[0] = x[1] = (f32x4){0.f, 0.f, 0.f, 0.f}
__device__ __forceinline__ void st_rm(LAS bf16_t* Z, int mi, int ni, int lane, const f32x4 v) { u32x2 w; w.x = cvt_pk_bf16(v[0], v[1]); w.y = cvt_pk_bf16(v[2], v[3]); *(LAS u32x2*)(Z + (16 * mi + (lane & 15)) * CT + 16 * ni + 4 * (lane >> 4)) = w; }
__device__ __forceinline__ void st_tr(LAS bf16_t* ZT, int mi, int ni, int lane, const f32x4 v) {
#pragma unroll
    for (int r = 0; r < 4; ++r) ZT[(16 * ni + 4 * (lane >> 4) + r) * CT + 16 * mi + (lane & 15)] = f2bf(v[r]); }
__device__ __forceinline__ void st_trT(LAS bf16_t* ZT, int mi, int ni, int lane, const f32x4 v) { u32x2 w; w.x = cvt_pk_bf16(v[0], v[1]); w.y = cvt_pk_bf16(v[2], v[3]); *(LAS u32x2*)(ZT + (16 * ni + (lane & 15)) * CT + 16 * mi + 4 * (lane >> 4)) = w; }
__device__ __forceinline__ void ld8l(const LAS float* s, float (&d)[8]) { const f32x4 a = *(const LAS f32x4*)s, b = *(const LAS f32x4*)(s + 4); d[0] = a[0]; d[1] = a[1]; d[2] = a[2]; d[3] = a[3]; d[4] = b[0]; d[5] = b[1]; d[6] = b[2]; d[7] = b[3]; }
struct PaIn { u32x4 cr, ck, cv, qr, qk, qv, ap; float lwr[8]; };
__device__ __forceinline__ void pa_load(PaIn& in, const bf16_t* proj, const bf16_t* la, const float* lw, int job, int wave, int lane) {
    const int bh = job >> 6, c = job & 63, b = bh >> 3, h = bh & 7; const int tok0 = b * SEQ + c * 64;
    { const int t = wave * 8 + (lane >> 3), cg = lane & 7, tok = tok0 + t; const bf16_t* row = proj + (size_t)tok * DIN + h * HD + cg * 8; const bool first = (c == 0 && t == 0); const u32x4 z = (u32x4){0u, 0u, 0u, 0u};
      in.cr = *(const u32x4*)row; in.ck = *(const u32x4*)(row + COL_K); in.cv = *(const u32x4*)(row + COL_V);
      in.qr = first ? z : *(const u32x4*)(row - DIN); in.qk = first ? z : *(const u32x4*)(row - DIN + COL_K); in.qv = first ? z : *(const u32x4*)(row - DIN + COL_V);
      in.ap = *(const u32x4*)(la + (size_t)tok * DR + h * HD + cg * 8); }
#pragma unroll
    for (int i = 0; i < 8; ++i) in.lwr[i] = lw[(size_t)(tok0 + wave * 8 + i) * DR + h * HD + lane];
}
__device__ __forceinline__ float logdecay(float x) { const float z = -x; const float sp = fmaxf(z, 0.f) + __logf(1.0f + __expf(-fabsf(z))); return -__expf(-sp - 0.5f); }
__device__ __forceinline__ void p4_chunks(const Params& p, LAS unsigned char* lds, int wave, int lane, const int vflags) {
    const bf16_t* proj = (const bf16_t*)(p.ws + WS_PROJ); const float* lwp = (const float*)(p.ws + WS_LORAW); const bf16_t* lap = (const bf16_t*)(p.ws + WS_LORAA);
    bf16_t* QP = (bf16_t*)(p.ws + WS_QP); bf16_t* YG = (bf16_t*)(p.ws + WS_YG); float* rkb = (float*)(p.ws + WS_RKB);
    LAS float* lct = (LAS float*)(lds + LC_OFF); LAS float* tot = (LAS float*)(lds + TOT_OFF); LAS float* gtab = (LAS float*)(lds + GT_OFF); LAS bf16_t* ewt = slot(lds, SL_TA);
    const int mi = wave >> 1, ni0 = (wave & 1) * 2, fr = lane & 15, fq = lane >> 4;
    PaIn in; pa_load(in, proj, lap, lwp, blockIdx.x, wave, lane);
    bf16x8 aI[2];
    { const int m = 16 * (wave >> 1) + (lane & 15);
#pragma unroll
      for (int ks = 0; ks < 2; ++ks) { u32x4 w = (u32x4){0u, 0u, 0u, 0u}; const int e = m - 32 * ks - 8 * (lane >> 4);
          if (e >= 0 && e < 8) { const unsigned one = (e & 1) ? 0x3F800000u : 0x00003F80u; if ((e >> 1) == 0) w.x = one; else if ((e >> 1) == 1) w.y = one; else if ((e >> 1) == 2) w.z = one; else w.w = one; }
          aI[ks] = __builtin_bit_cast(bf16x8, w); } }
    LAS float* pcs = (LAS float*)(lds + PC_OFF);
    { const int tid = wave * 64 + lane;
#pragma unroll
      for (int q = 0; q < 2; ++q) { const int e = tid + q * 512, hs = e >> 9, ar = (e >> 6) & 7, k = e & 63, hh = (int)(blockIdx.x >> 6) + 4 * hs, col = hh * HD + k;
          const float* src = ar == 0 ? p.in[I_W0] + col : ar == 1 ? p.in[I_MU] + col : ar == 2 ? p.in[I_MU] + COL_K + col : ar == 3 ? p.in[I_MU] + COL_V + col : ar == 4 ? p.in[I_KK] + col : ar == 5 ? p.in[I_KA] + col : ar == 6 ? p.in[I_RK] + col : p.in[I_A0] + col;
          pcs[e] = *src; } }
    lds_barrier();
    for (int job = blockIdx.x; job < 64 * 64; job += GRID) {
        const int bh = job >> 6, c = job & 63, b = bh >> 3, h = bh & 7; const int tok0 = b * SEQ + c * 64;
        const LAS float* pch = pcs + (h >> 2) * 512;
        { const float w0k = pch[lane]; float pre[8]; float run = 0.f;
#pragma unroll
          for (int i = 0; i < 8; ++i) { const float lw_ = logdecay(w0k + in.lwr[i]); run += lw_; pre[i] = run; ewt[(wave * 8 + i) * 64 + lane] = f2bf(__expf(-lw_)); }
          tot[wave * 64 + lane] = run;
          lds_barrier();
          float off = 0.f;
#pragma unroll
          for (int w2 = 0; w2 < 7; ++w2) off += (w2 < wave) ? tot[w2 * 64 + lane] : 0.f;
#pragma unroll
          for (int i = 0; i < 8; ++i) lct[(wave * 8 + i) * 64 + lane] = off + pre[i];
          if (wave == 7) gtab[lane] = __expf(off + pre[7]); }
        lds_barrier();
        { const int t = wave * 8 + (lane >> 3), cg = lane & 7, k0 = cg * 8, col = h * HD + k0;
          float cr[8], ck[8], cv[8], qr[8], qk[8], qv[8], lc[8], gc[8], mur[8], muk[8], muv[8], kkw[8], kaw[8], rkw[8], a0c[8];
          unpack8(in.cr, cr); unpack8(in.ck, ck); unpack8(in.cv, cv); unpack8(in.qr, qr); unpack8(in.qk, qk); unpack8(in.qv, qv);
          { const f32x4 x0 = *(const LAS f32x4*)(lct + t * 64 + k0), x1 = *(const LAS f32x4*)(lct + t * 64 + k0 + 4), g0 = *(const LAS f32x4*)(gtab + k0), g1 = *(const LAS f32x4*)(gtab + k0 + 4);
#pragma unroll
            for (int j = 0; j < 4; ++j) { lc[j] = x0[j]; lc[j + 4] = x1[j]; gc[j] = g0[j]; gc[j + 4] = g1[j]; } }
          ld8l(pch + 64 + k0, mur); ld8l(pch + 128 + k0, muk); ld8l(pch + 192 + k0, muv); ld8l(pch + 256 + k0, kkw); ld8l(pch + 320 + k0, kaw); ld8l(pch + 384 + k0, rkw); ld8l(pch + 448 + k0, a0c);
          float ah[8], bh_[8], kh[8], rh[8], bt[8], kt[8], vv[8], kk[8], ew[8], apv[8]; float n2 = 0.f, rk = 0.f; unpack8(in.ap, apv);
          unpack8(*(const LAS u32x4*)(ewt + t * 64 + k0), ew);
#pragma unroll
          for (int j = 0; j < 8; ++j) { const float r = cr[j] + mur[j] * (qr[j] - cr[j]), kraw = ck[j] + muk[j] * (qk[j] - ck[j]); vv[j] = cv[j] + muv[j] * (qv[j] - cv[j]);
              const float ap = apv[j];
              const float a = sigmoidf_(a0c[j] + ap);
              kk[j] = kraw * kkw[j]; n2 += kk[j] * kk[j]; const float km = kraw * (1.0f + (a - 1.0f) * kaw[j]); rk += r * km * rkw[j];
              const float e1 = __expf(lc[j]), e2 = __builtin_amdgcn_rcpf(e1), g = gc[j];
              rh[j] = r * e1; kh[j] = km * e2; kt[j] = kh[j] * g; ah[j] = -e1 * ew[j]; bh_[j] = a * e2; bt[j] = g; }
          n2 = sum8(n2); rk = sum8(rk);
          const float inv = 1.0f / fmaxf(sqrtf(n2), 1e-12f);
#pragma unroll
          for (int j = 0; j < 8; ++j) { const float kn = kk[j] * inv; ah[j] *= kn; bh_[j] *= kn; bt[j] *= bh_[j]; }
          if (cg == 0) rkb[(size_t)(tok0 + t) * NH + h] = rk;
          u32x4 w;
          w.x = cvt_pk_bf16(ah[0], ah[1]); w.y = cvt_pk_bf16(ah[2], ah[3]); w.z = cvt_pk_bf16(ah[4], ah[5]); w.w = cvt_pk_bf16(ah[6], ah[7]); *(LAS u32x4*)(slot(lds, SL_AH) + t * CT + k0) = w;
          w.x = cvt_pk_bf16(bh_[0], bh_[1]); w.y = cvt_pk_bf16(bh_[2], bh_[3]); w.z = cvt_pk_bf16(bh_[4], bh_[5]); w.w = cvt_pk_bf16(bh_[6], bh_[7]); *(LAS u32x4*)(slot(lds, SL_BH) + t * CT + k0) = w;
          w.x = cvt_pk_bf16(kh[0], kh[1]); w.y = cvt_pk_bf16(kh[2], kh[3]); w.z = cvt_pk_bf16(kh[4], kh[5]); w.w = cvt_pk_bf16(kh[6], kh[7]); *(LAS u32x4*)(slot(lds, SL_KH) + t * CT + k0) = w;
          w.x = cvt_pk_bf16(rh[0], rh[1]); w.y = cvt_pk_bf16(rh[2], rh[3]); w.z = cvt_pk_bf16(rh[4], rh[5]); w.w = cvt_pk_bf16(rh[6], rh[7]); *(LAS u32x4*)(slot(lds, SL_RH) + t * CT + k0) = w;
          w.x = cvt_pk_bf16(bt[0], bt[1]); w.y = cvt_pk_bf16(bt[2], bt[3]); w.z = cvt_pk_bf16(bt[4], bt[5]); w.w = cvt_pk_bf16(bt[6], bt[7]); *(LAS u32x4*)(slot(lds, SL_BTT) + t * CT + k0) = w;
          w.x = cvt_pk_bf16(kt[0], kt[1]); w.y = cvt_pk_bf16(kt[2], kt[3]); w.z = cvt_pk_bf16(kt[4], kt[5]); w.w = cvt_pk_bf16(kt[6], kt[7]); *(LAS u32x4*)(slot(lds, SL_KTT) + t * CT + k0) = w;
          w.x = cvt_pk_bf16(vv[0], vv[1]); w.y = cvt_pk_bf16(vv[2], vv[3]); w.z = cvt_pk_bf16(vv[4], vv[5]); w.w = cvt_pk_bf16(vv[6], vv[7]); *(LAS u32x4*)(slot(lds, SL_XT) + t * CT + k0) = w; }
        if (job + GRID < 64 * 64) pa_load(in, proj, lap, lwp, job + GRID, wave, lane);
        lds_barrier();
#ifdef PROBE_VPHASE
        if (vflags & 4) { lds_barrier(); continue; }
#endif
        f32x4 accT[2];
        { bf16x8 aA[2], aR[2], bB[2][2], bK[2][2]; ldA(slot(lds, SL_AH), mi, lane, aA); ldA(slot(lds, SL_RH), mi, lane, aR); ldB(slot(lds, SL_BH), ni0, lane, bB); ldB(slot(lds, SL_KH), ni0, lane, bK);
          f32x4 c1[2], c2[2], c3[2], c4[2]; ZACC(c1); ZACC(c2); ZACC(c3); ZACC(c4);
          mma<false>(aA, bB, c1); mma<false>(aA, bK, c2); mma<false>(aR, bB, c3); mma<false>(aR, bK, c4);
          { bf16x8 bA2[2][2], bV2[2][2]; ldB(slot(lds, SL_AH), ni0, lane, bA2); ldB(slot(lds, SL_XT), ni0, lane, bV2); f32x4 t1[2], t2[2]; ZACC(t1); ZACC(t2); mma<false>(aI, bA2, t1); mma<false>(aI, bV2, t2);
#pragma unroll
            for (int t = 0; t < 2; ++t) { st_rm(slot(lds, SL_AHT), mi, ni0 + t, lane, t1[t]); st_rm(slot(lds, SL_VT), mi, ni0 + t, lane, t2[t]); } }
#pragma unroll
          for (int t = 0; t < 2; ++t) { const int m = 16 * mi + fr, n = 16 * (ni0 + t) + 4 * fq;
#pragma unroll
              for (int r = 0; r < 4; ++r) { c1[t][r] = (n + r < m) ? c1[t][r] : 0.f; c2[t][r] = (n + r < m) ? c2[t][r] : 0.f; c3[t][r] = (n + r <= m) ? c3[t][r] : 0.f; c4[t][r] = (n + r <= m) ? c4[t][r] : 0.f;
                  accT[t][r] = c1[t][r] + ((n + r == m) ? 1.0f : 0.f); }
              st_rm(slot(lds, SL_PA), mi, ni0 + t, lane, c1[t]); st_tr(slot(lds, SL_PAT), mi, ni0 + t, lane, c1[t]); st_rm(slot(lds, SL_TA), mi, ni0 + t, lane, accT[t]);
              st_rm(slot(lds, SL_AAK), mi, ni0 + t, lane, c2[t]); st_rm(slot(lds, SL_ARB), mi, ni0 + t, lane, c3[t]); st_rm(slot(lds, SL_ARK), mi, ni0 + t, lane, c4[t]); } }
        lds_barrier();
        { bf16x8 aP[2], aK[2], bP[2][2], bV[2][2]; ldA(slot(lds, SL_PA), mi, lane, aP); ldA(slot(lds, SL_AAK), mi, lane, aK); ldB(slot(lds, SL_PAT), ni0, lane, bP); ldB(slot(lds, SL_VT), ni0, lane, bV);
          f32x4 c1[2], c2[2]; ZACC(c1); ZACC(c2); mma<false>(aP, bP, c1); mma<true>(aK, bV, c2);
#pragma unroll
          for (int t = 0; t < 2; ++t) { st_rm(slot(lds, SL_PB), mi, ni0 + t, lane, c1[t]); st_tr(slot(lds, SL_PBT), mi, ni0 + t, lane, c1[t]); st_trT(slot(lds, SL_XT), mi, ni0 + t, lane, c2[t]); } }
        lds_barrier();
#pragma unroll
        for (int it = 1; it <= 5; ++it) { const bool odd = (it & 1) != 0;
#ifdef PROBE_VPHASE
            if (vflags & 1) continue;
#endif
            LAS bf16_t* Pr = slot(lds, odd ? SL_PB : SL_PA); LAS bf16_t* PrT = slot(lds, odd ? SL_PBT : SL_PAT); LAS bf16_t* Pw = slot(lds, odd ? SL_PA : SL_PB); LAS bf16_t* PwT = slot(lds, odd ? SL_PAT : SL_PBT);
            LAS bf16_t* Tr = slot(lds, odd ? SL_TA : SL_TB); LAS bf16_t* Tw = slot(lds, odd ? SL_TB : SL_TA);
            bf16x8 aT[2], aP[2], bP[2][2]; ldA(Tr, mi, lane, aT); ldB(PrT, ni0, lane, bP); if (it < 5) ldA(Pr, mi, lane, aP);
            f32x4 c1[2]; ZACC(c1);
            mma<false>(aT, bP, accT); if (it < 5) mma<false>(aP, bP, c1);
#pragma unroll
            for (int t = 0; t < 2; ++t) { st_rm(Tw, mi, ni0 + t, lane, accT[t]); if (it < 5) { st_rm(Pw, mi, ni0 + t, lane, c1[t]); st_tr(PwT, mi, ni0 + t, lane, c1[t]); } }
            lds_barrier(); }
        { bf16x8 aT[2], bA[2][2], bX[2][2]; ldA(slot(lds, SL_TB), mi, lane, aT); ldB(slot(lds, SL_AHT), ni0, lane, bA); ldB(slot(lds, SL_XT), ni0, lane, bX);
          f32x4 c1[2], c2[2]; ZACC(c1); ZACC(c2); mma<true>(aT, bA, c1); mma<true>(aT, bX, c2);
          { bf16x8 bB2[2][2], bK2[2][2]; ldB(slot(lds, SL_BTT), ni0, lane, bB2); ldB(slot(lds, SL_KTT), ni0, lane, bK2); f32x4 t1[2], t2[2]; ZACC(t1); ZACC(t2); mma<false>(aI, bB2, t1); mma<false>(aI, bK2, t2);
#pragma unroll
            for (int t = 0; t < 2; ++t) { st_rm(slot(lds, SL_PA), mi, ni0 + t, lane, t1[t]); st_rm(slot(lds, SL_PAT), mi, ni0 + t, lane, t2[t]); } }
#pragma unroll
          for (int t = 0; t < 2; ++t) { st_trT(slot(lds, SL_WT), mi, ni0 + t, lane, c1[t]); st_trT(slot(lds, SL_UVT), mi, ni0 + t, lane, c2[t]); } }
        lds_barrier();
        { bf16_t* qp = QP + (size_t)job * 2 * 4096; bf16_t* yg = YG + (size_t)job * 2 * 4096; const int m = 16 * mi + fr, qs = 2 * (fq & 1) + (fq >> 1);
          bf16x8 aRB[2], aRK[2], aBT[2], aKT[2], bW[2][2], bU[2][2], bV[2][2];
          ldA(slot(lds, SL_ARB), mi, lane, aRB); ldA(slot(lds, SL_ARK), mi, lane, aRK); ldA(slot(lds, SL_PA), mi, lane, aBT); ldA(slot(lds, SL_PAT), mi, lane, aKT);
          ldB(slot(lds, SL_WT), ni0, lane, bW); ldB(slot(lds, SL_UVT), ni0, lane, bU); ldB(slot(lds, SL_VT), ni0, lane, bV);
          u32x2 rr[2];
#pragma unroll
          for (int t = 0; t < 2; ++t) rr[t] = *(const LAS u32x2*)(slot(lds, SL_RH) + m * CT + 16 * (ni0 + t) + 4 * fq);
          const float gm = gtab[m];
          f32x4 cq[2], cy[2], cp[2], cg[2]; ZACC(cq); ZACC(cy); ZACC(cp); ZACC(cg);
          mma<false>(aRB, bW, cq); mma<false>(aRB, bU, cy); mma<false>(aBT, bW, cp); mma<false>(aBT, bU, cg); mma<false>(aRK, bV, cy); mma<false>(aKT, bV, cg);
#pragma unroll
          for (int t = 0; t < 2; ++t) { const int n = 16 * (ni0 + t) + 4 * fq; u32x2 w;
              w.x = cvt_pk_bf16(cq[t][0] + bflo(rr[t].x), cq[t][1] + bfhi(rr[t].x)); w.y = cvt_pk_bf16(cq[t][2] + bflo(rr[t].y), cq[t][3] + bfhi(rr[t].y)); *(u32x2*)(qp + m * 64 + 16 * (ni0 + t) + 4 * qs) = w;
              w.x = cvt_pk_bf16(cy[t][0], cy[t][1]); w.y = cvt_pk_bf16(cy[t][2], cy[t][3]); *(u32x2*)(yg + m * 64 + n) = w;
#pragma unroll
              for (int r = 0; r < 4; ++r) cp[t][r] += (n + r == m) ? gm : 0.f;
              w.x = cvt_pk_bf16(cp[t][0], cp[t][1]); w.y = cvt_pk_bf16(cp[t][2], cp[t][3]); *(u32x2*)(qp + 4096 + m * 64 + 16 * (ni0 + t) + 4 * qs) = w;
              w.x = cvt_pk_bf16(cg[t][0], cg[t][1]); w.y = cvt_pk_bf16(cg[t][2], cg[t][3]); *(u32x2*)(yg + 4096 + m * 64 + n) = w; } }
        lds_barrier();
    }
}
#undef ZACC

constexpr int PB_BUF = 32768;
__device__ __forceinline__ void pb_dma(const bf16_t* qt, const bf16_t* yl, int jv, LAS unsigned char* dst, int lane) {
    const int rr = lane >> 3, cc = lane & 7;
#pragma unroll
    for (int pc = 0; pc < 16; ++pc)
        __builtin_amdgcn_global_load_lds((const unsigned*)((const char*)qt + pc * 1024 + rr * 128 + ((cc ^ rr) * 16)), (LAS unsigned*)(dst + pc * 1024), 16, 0, 0);
#pragma unroll
    for (int q = 0; q < 2; ++q)
#pragma unroll
        for (int pc = 0; pc < 4; ++pc) { const bf16_t* base = yl + q * 4096;
            __builtin_amdgcn_global_load_lds((const unsigned*)((const char*)(base + (pc * 16 + (lane >> 2)) * 64 + jv * 32) + (lane & 3) * 16), (LAS unsigned*)(dst + 16384 + q * 4096 + pc * 1024), 16, 0, 0); }
}
__device__ __forceinline__ void p5_seq(const Params& p, LAS unsigned char* lds, int lane) {
    const int bh = blockIdx.x >> 1, jv = blockIdx.x & 1, b = bh >> 3, h = bh & 7, r31 = lane & 31, hh = lane >> 5;
    const bf16_t* QP = (const bf16_t*)(p.ws + WS_QP) + (size_t)bh * 64 * 2 * 4096; const bf16_t* YG = (const bf16_t*)(p.ws + WS_YG) + (size_t)bh * 64 * 2 * 4096;
    bf16_t* yraw = (bf16_t*)(p.ws + WS_YRAW) + (size_t)b * SEQ * DR + h * HD + 32 * jv + r31;
    f32x16 H[2];
#pragma unroll
    for (int i = 0; i < 2; ++i)
#pragma unroll
        for (int r = 0; r < 16; ++r) H[i][r] = 0.f;
    pb_dma(QP, YG, jv, lds, lane);
    VM_WAIT();
    for (int c = 0; c < 64; ++c) { const LAS unsigned char* bp = lds + (c & 1) * PB_BUF;
        if (c + 1 < 64) pb_dma(QP + (size_t)(c + 1) * 2 * 4096, YG + (size_t)(c + 1) * 2 * 4096, jv, lds + ((c + 1) & 1) * PB_BUF, lane);
        {
            bf16x8 Bf[4];
#pragma unroll
            for (int i = 0; i < 2; ++i)
#pragma unroll
                for (int s2 = 0; s2 < 2; ++s2) { u32x4 w; w.x = cvt_pk_bf16(H[i][8 * s2 + 0], H[i][8 * s2 + 1]); w.y = cvt_pk_bf16(H[i][8 * s2 + 2], H[i][8 * s2 + 3]); w.z = cvt_pk_bf16(H[i][8 * s2 + 4], H[i][8 * s2 + 5]); w.w = cvt_pk_bf16(H[i][8 * s2 + 6], H[i][8 * s2 + 7]);
                    Bf[2 * i + s2] = __builtin_bit_cast(bf16x8, w); }
#pragma unroll
            for (int tt = 0; tt < 2; ++tt) { f32x16 acc; const int row = 32 * tt + r31;
#pragma unroll
                for (int r = 0; r < 16; ++r) acc[r] = bf2f(*(const LAS bf16_t*)(bp + 16384 + ((32 * tt + (r & 3) + 8 * (r >> 2) + 4 * hh) * 32 + r31) * 2));
#pragma unroll
                for (int kq = 0; kq < 4; ++kq) { const bf16x8 a = *(const LAS bf16x8*)(bp + row * 128 + (((2 * kq + hh) ^ (row & 7)) * 16)); acc = __builtin_amdgcn_mfma_f32_32x32x16_bf16(a, Bf[kq], acc, 0, 0, 0); }
#pragma unroll
                for (int r = 0; r < 16; ++r) yraw[(size_t)(c * 64 + 32 * tt + (r & 3) + 8 * (r >> 2) + 4 * hh) * DR] = f2bf(acc[r]); }
            f32x16 Hn[2];
#pragma unroll
            for (int i = 0; i < 2; ++i) { const int row = 32 * i + r31;
#pragma unroll
                for (int r = 0; r < 16; ++r) Hn[i][r] = bf2f(*(const LAS bf16_t*)(bp + 20480 + ((32 * i + (r & 3) + 8 * (r >> 2) + 4 * hh) * 32 + r31) * 2));
#pragma unroll
                for (int kq = 0; kq < 4; ++kq) { const bf16x8 a = *(const LAS bf16x8*)(bp + 8192 + row * 128 + (((2 * kq + hh) ^ (row & 7)) * 16)); Hn[i] = __builtin_amdgcn_mfma_f32_32x32x16_bf16(a, Bf[kq], Hn[i], 0, 0, 0); } }
            H[0] = Hn[0]; H[1] = Hn[1];
        }
        VM_WAIT();
    }
}
constexpr int RT_BROW = 2064, RT_LO = 32 * RT_BROW;
constexpr int RT_HIST = 147456, RT_BASE = RT_HIST + 128, RT_ETAB = RT_HIST + 256, RT_RS = RT_HIST + 256 + 2048;
__device__ __forceinline__ float rowmax16(float x) { x = fmaxf(x, dpp_mov<0xB1>(x)); x = fmaxf(x, dpp_mov<0x4E>(x)); x = fmaxf(x, dpp_mov<0x141>(x)); x = fmaxf(x, dpp_mov<0x140>(x)); return x; }
__device__ __forceinline__ float rt_key(float v, int e) { v = (v == v) ? fminf(fmaxf(v, -1.0e30f), 1.0e30f) : -1.0e30f; return __uint_as_float((__float_as_uint(v) & ~31u) | (unsigned)(31 - e)); }
__device__ __forceinline__ void p9_router(const Params& p, LAS unsigned char* lds, int wave, int lane) {
    const bf16_t* x1 = (const bf16_t*)(p.ws + WS_XB); const unsigned char* rwp = (const unsigned char*)(p.ws + WS_RWP); const float* rb = p.in[I_RB];
    int* eid = (int*)(p.ws + WS_EID); float* gate = (float*)(p.ws + WS_GATE); int* relpos = (int*)(p.ws + WS_RELPOS); int* stok = (int*)(p.ws + WS_STOK); float* srs = (float*)(p.ws + WS_SRS);
    unsigned* gcount = (unsigned*)(p.ws + WS_CTL) + CW_GCOUNT;
    const int tid = wave * 64 + lane, fr = lane & 15, q = lane >> 4;
    LAS unsigned* hist = (LAS unsigned*)(lds + RT_HIST); LAS unsigned* base = (LAS unsigned*)(lds + RT_BASE); LAS unsigned* etab = (LAS unsigned*)(lds + RT_ETAB); LAS float* rsl = (LAS float*)(lds + RT_RS);
#pragma unroll
    for (int i = 0; i < 16; ++i) { const int c = tid + 512 * i, which = c >> 12, cc = c & 4095, e = cc >> 7, kc = cc & 127; *(LAS u32x4*)(lds + which * RT_LO + e * RT_BROW + kc * 16) = *(const u32x4*)(rwp + (size_t)c * 16); }
    if (tid < 32) hist[tid] = 0u;
    const int tok0 = blockIdx.x * 128 + wave * 16;
    const bf16_t* arow = x1 + (size_t)(tok0 + fr) * DM + 8 * q;
    bf16x8 a_n[4];
#pragma unroll
    for (int k = 0; k < 4; ++k) a_n[k] = *(const bf16x8*)(arow + 32 * k);
    __syncthreads();
    f32x4 acc[2], accs; acc[0] = acc[1] = accs = (f32x4){0.f, 0.f, 0.f, 0.f};
#pragma unroll
    for (int ks = 0; ks < 32; ++ks) { const bf16x8 a = a_n[ks & 3];
        if (ks + 4 < 32) a_n[ks & 3] = *(const bf16x8*)(arow + 32 * (ks + 4));
        accs = __builtin_amdgcn_mfma_f32_16x16x32_bf16(a, a, accs, 0, 0, 0);
#pragma unroll
        for (int h2 = 0; h2 < 2; ++h2) { const LAS unsigned char* bp = lds + (16 * h2 + fr) * RT_BROW + (32 * ks + 8 * q) * 2;
            acc[h2] = __builtin_amdgcn_mfma_f32_16x16x32_bf16(a, *(const LAS bf16x8*)bp, acc[h2], 0, 0, 0);
            acc[h2] = __builtin_amdgcn_mfma_f32_16x16x32_bf16(a, *(const LAS bf16x8*)(bp + RT_LO), acc[h2], 0, 0, 0); } }
    const float rb0 = rb[fr], rb1 = rb[16 + fr];
#pragma unroll
    for (int r = 0; r < 4; ++r) { const int tl = wave * 16 + 4 * q + r, tok = blockIdx.x * 128 + tl;
        const float ss = __shfl(accs[r], 20 * q + r); const float rstd = 1.0f / sqrtf(ss * (1.0f / DM) + 1e-5f);
        float k0 = rt_key(acc[0][r] * rstd + rb0, fr), k1 = rt_key(acc[1][r] * rstd + rb1, 16 + fr);
        float tv[4]; int te[4];
#pragma unroll
        for (int rd = 0; rd < 4; ++rd) { const float m = rowmax16(fmaxf(k0, k1)); tv[rd] = m; te[rd] = 31 - (int)(__float_as_uint(m) & 31u); k0 = (k0 == m) ? -3.0e38f : k0; k1 = (k1 == m) ? -3.0e38f : k1; }
        const float ex1 = __expf(tv[1] - tv[0]), ex2 = __expf(tv[2] - tv[0]), ex3 = __expf(tv[3] - tv[0]); const float inv = 1.0f / (1.0f + ex1 + ex2 + ex3);
        if (fr < 4) { const int e = fr == 0 ? te[0] : (fr == 1 ? te[1] : (fr == 2 ? te[2] : te[3])); const float g = (fr == 0 ? 1.0f : (fr == 1 ? ex1 : (fr == 2 ? ex2 : ex3))) * inv;
            const unsigned lr = atomicAdd((unsigned*)&hist[e], 1u); eid[(size_t)tok * 4 + fr] = e; gate[(size_t)tok * 4 + fr] = g; etab[tl * 4 + fr] = (lr << 5) | (unsigned)e; }
        if (fr == 0) rsl[tl] = rstd; }
    __syncthreads();
    if (tid < 32) { const unsigned hc = hist[tid]; base[tid] = hc ? atomicAdd(&gcount[tid], hc) : 0u; }
    __syncthreads();
    { const int tl = tid >> 2, k = tid & 3, tok = blockIdx.x * 128 + tl; const unsigned pk = etab[tid]; const int e = pk & 31; const unsigned rel = base[e] + (pk >> 5);
      relpos[(size_t)tok * 4 + k] = (int)rel; stok[(size_t)e * CAP + rel] = tok; srs[(size_t)e * CAP + rel] = rsl[tl]; }
}
__device__ __forceinline__ void moe_tables(const Params& p, LAS unsigned char* lds, int wave, int lane) {
    const unsigned* gcount = (const unsigned*)(p.ws + WS_CTL) + CW_GCOUNT;
    LAS int* tsrc = (LAS int*)(lds + TAB_SRC); LAS int* tval = (LAS int*)(lds + TAB_VAL); LAS int* te = (LAS int*)(lds + TAB_E); LAS int* tbase = (LAS int*)(lds + TAB_BASE);
    if (wave == 0) {
        const int c = lane < NE ? (int)__hip_atomic_load(&gcount[lane & 31], __ATOMIC_RELAXED, __HIP_MEMORY_SCOPE_AGENT) : 0; const int nt = (c + 255) >> 8;
        int inc = nt;
#pragma unroll
        for (int o = 1; o < 32; o <<= 1) { const int v = __shfl_up(inc, o); inc += (lane & 31) >= o ? v : 0; }
        const int tb = inc - nt;
        if (lane < NE) { tbase[lane] = tb; if (lane == NE - 1) tbase[NE] = inc;
            for (int lt = 0; lt < nt; ++lt) { tsrc[tb + lt] = lane * CAP + lt * 256; const int rem = c - lt * 256; tval[tb + lt] = rem < 256 ? rem : 256; te[tb + lt] = lane; } } }
    __syncthreads();
}
typedef int i32x4 __attribute__((ext_vector_type(4)));
struct P12Meta { i32x4 e, rp; f32x4 g; };
struct P12Rows { u32x2 x[4]; u32x2 y[4][4]; f32x4 g; };
__device__ __forceinline__ void p12_meta(P12Meta& m, const int* eid, const float* gate, const int* relpos, int tok) {
    m.e = *(const i32x4*)(eid + (size_t)tok * 4); m.g = *(const f32x4*)(gate + (size_t)tok * 4); m.rp = *(const i32x4*)(relpos + (size_t)tok * 4); }
__device__ __forceinline__ void p12_rows(P12Rows& r, const P12Meta& m, const bf16_t* x1, const bf16_t* ys, const LAS int* tbase, int tok, int lane) {
#pragma unroll
    for (int j = 0; j < 4; ++j) r.x[j] = *(const u32x2*)(x1 + (size_t)tok * DM + 4 * lane + 256 * j);
#pragma unroll
    for (int k = 0; k < 4; ++k) { const bf16_t* yr = ys + ((size_t)tbase[m.e[k]] * 256 + m.rp[k]) * YS_LD + 4 * lane;
#pragma unroll
        for (int j = 0; j < 4; ++j) r.y[k][j] = *(const u32x2*)(yr + 256 * j); }
    r.g = m.g;
}
__device__ __forceinline__ void p12_combine(const Params& p, LAS unsigned char* lds, int wave, int lane) {
    const bf16_t* x1 = (const bf16_t*)(p.ws + WS_XB); float* outp = p.out; const bf16_t* ys = (const bf16_t*)(p.ws + WS_YSORT); const int* eid = (const int*)(p.ws + WS_EID); const float* gate = (const float*)(p.ws + WS_GATE); const int* relpos = (const int*)(p.ws + WS_RELPOS);
    const float* fg = p.in[I_FG]; const LAS int* tbase = (const LAS int*)(lds + TAB_BASE);
    const int gw = blockIdx.x * NWAVES + wave;
    f32x4 gv[4];
#pragma unroll
    for (int j = 0; j < 4; ++j) gv[j] = *(const f32x4*)(fg + 4 * lane + 256 * j);
    P12Meta m0, m1; P12Rows rc, rn;
    p12_meta(m0, eid, gate, relpos, gw); p12_meta(m1, eid, gate, relpos, gw + NGW);
    p12_rows(rc, m0, x1, ys, tbase, gw, lane);
    for (int tok = gw; tok < NTOK; tok += NGW) {
        m0 = m1;
        if (tok + 2 * NGW < NTOK) p12_meta(m1, eid, gate, relpos, tok + 2 * NGW);
        if (tok + NGW < NTOK) p12_rows(rn, m0, x1, ys, tbase, tok + NGW, lane);
        f32x4 v[4];
#pragma unroll
        for (int j = 0; j < 4; ++j) v[j] = (f32x4){bflo(rc.x[j].x), bfhi(rc.x[j].x), bflo(rc.x[j].y), bfhi(rc.x[j].y)};
#pragma unroll
        for (int k = 0; k < 4; ++k) { const float gt = rc.g[k];
#pragma unroll
            for (int j = 0; j < 4; ++j) { const u32x2 w = rc.y[k][j]; v[j][0] += gt * bflo(w.x); v[j][1] += gt * bfhi(w.x); v[j][2] += gt * bflo(w.y); v[j][3] += gt * bfhi(w.y); } }
        float ss = 0.f;
#pragma unroll
        for (int j = 0; j < 4; ++j) ss += (v[j][0] * v[j][0] + v[j][1] * v[j][1]) + (v[j][2] * v[j][2] + v[j][3] * v[j][3]);
        ss = wave_sum(ss); const float rs = 1.0f / sqrtf(ss * (1.0f / DM) + 1e-5f);
#pragma unroll
        for (int j = 0; j < 4; ++j) { f32x4 o = v[j] * rs * gv[j];
#ifdef SCRUB_NAN
#pragma unroll
            for (int q = 0; q < 4; ++q) o[q] = (o[q] == o[q] && fabsf(o[q]) < 1e30f) ? o[q] : 0.f;
#endif
            *(f32x4*)(outp + (size_t)tok * DM + 4 * lane + 256 * j) = o; }
        rc = rn;
    }
}
#ifndef MOE_ALIGN
#define MOE_ALIGN true
#endif
#ifndef N_PHASES
#define N_PHASES 13
#endif
struct Args { Params p; int ph_lo, ph_hi, li, pad; };
__global__ void __launch_bounds__(NWAVES * 64, 2) hymba_fwd(Args a) {
    extern __shared__ __attribute__((aligned(16))) unsigned char lds_raw[];
    LAS unsigned char* lds = (LAS unsigned char*)lds_raw;
    const Params& p = a.p;
    const int wave = __builtin_amdgcn_readfirstlane((int)threadIdx.x >> 6);
    volatile LAS unsigned* misc = (volatile LAS unsigned*)(lds + MISC_OFF);
    if (threadIdx.x < 4) misc[threadIdx.x] = 0u;
    __syncthreads();
    unsigned* ctl = (unsigned*)(p.ws + WS_CTL);
    XcdBarrier bar = xcd_barrier_post(ctl + CW_BAR + a.li * XCD_BAR_WORDS, misc);
    const int lo = a.ph_lo & 0xFF, hi = a.ph_hi, padf = a.ph_lo >> 8;
#ifdef DIAG_A
    volatile LAS unsigned long long* tsl = (volatile LAS unsigned long long*)(lds + MISC_OFF + 64);
#define STAMP(k) do { if (blockIdx.x == 0 && wave == 0 && lane_id() == 0) tsl[k] = __builtin_amdgcn_s_memrealtime(); } while (0)
#else
#define STAMP(k) do { } while (0)
#endif
#ifndef PH_MASK
#define PH_MASK 0x1FFF
#endif
#define STAGGER_BY(grp, us) do { const unsigned long long t0_ = __builtin_amdgcn_s_memrealtime(); const unsigned long long dl_ = (unsigned long long)(((grp) & 3) * (us) * 100); \
        while (__builtin_amdgcn_s_memrealtime() - t0_ < dl_) __builtin_amdgcn_s_sleep(32); } while (0)
#ifdef STAGGER_P10
#define STAGGER() STAGGER_BY(blockIdx.x >> 6, STAGGER_P10)
#else
#define STAGGER() do {} while (0)
#endif
#define STAGGER1() do {} while (0)
#ifdef STAGGER_P11
#define STAGGER2() STAGGER_BY(blockIdx.x >> 5, STAGGER_P11)
#else
#define STAGGER2() do {} while (0)
#endif
#define IN(k) ((((PH_MASK) >> (k)) & 1) && lo <= (k) && (k) < hi)
#define SEAM(k) do { if (IN(k) && IN((k) + 1)) xcd_barrier(bar, wave == 0 && lane_id() == 0); } while (0)
#define LN lane_id()
    unsigned char* ws = p.ws;
    STAMP(0); if (IN(0)) { p0_prologue(p, lds, wave, LN); } SEAM(0);
    STAMP(1); if (IN(1)) { pg8::Gemm g{(const bf16_t*)(ws + WS_XB), (const bf16_t*)(ws + WS_WINT), NTOK, DIN, DM}; pg8::StaticOrder S; S.init(NTOK, DIN, GRID, (int)blockIdx.x);
        EpiProj E{(bf16_t*)(ws + WS_PROJ), DIN, (const float*)(ws + WS_RSTD1), lds}; STAGGER1(); pg8::gemm_phase<EpiProj, pg8::StaticOrder, true, false>(lds, g, S, E, wave); cv_tail(p, lds, wave, LN, CW_CVT1, CV_A, CV_B - CV_A); } SEAM(1);
    STAMP(2); if (IN(2)) { p2_lora_in(p, wave, LN); } SEAM(2);
    STAMP(3); if (IN(3)) { pg8::Gemm g{(const bf16_t*)(ws + WS_LORAIN), (const bf16_t*)(ws + WS_LORAB), NTOK, 1536, 256}; pg8::StaticOrder S; S.init(NTOK, 1536, GRID, (int)blockIdx.x);
        EpiLora E{(float*)(ws + WS_LORAW), (bf16_t*)(ws + WS_LORAA), (bf16_t*)(ws + WS_LORAG)}; pg8::gemm_phase<EpiLora, pg8::StaticOrder, true, false>(lds, g, S, E, wave); } SEAM(3);
    STAMP(4); if (IN(4)) { p4_chunks(p, lds, wave, LN, padf); } SEAM(4);
    STAMP(5); if (IN(5)) {
#ifdef PROBE_PAD
        if (blockIdx.x < 128) { if (!(padf & 2)) { if (wave == 0) p5_seq(p, lds, LN); else p5_convert(p, (LAS float*)(lds + 65536 + (wave - 1) * 8448), LN); } } else { if (!(padf & 1)) { p5_s5(p, lds, wave, LN, padf); __syncthreads(); if (!(padf & 32)) p5_convert(p, (LAS float*)(lds + wave * 8448), LN); } }
#else
        if (blockIdx.x < 128) { if (wave == 0) p5_seq(p, lds, LN); else p5_convert(p, (LAS float*)(lds + 65536 + (wave - 1) * 8448), LN); } else { p5_s5(p, lds, wave, LN); __syncthreads(); p5_convert(p, (LAS float*)(lds + wave * 8448), LN); }
#endif
 } SEAM(5);
    STAMP(6); if (IN(6)) { pg8::Gemm g{(const bf16_t*)(ws + WS_YGELU), (const bf16_t*)(ws + WS_WGLUT), NTOK, DSSM, DSSM}; pg8::StaticOrder S; S.init(NTOK, DSSM, GRID, (int)blockIdx.x);
        EpiGlu E{(const bf16_t*)(ws + WS_YGELU), (bf16_t*)(ws + WS_YGLU), p.in[I_BGLU], (float*)(ws + WS_SSQ)}; pg8::gemm_phase<EpiGlu, pg8::StaticOrder, false, false>(lds, g, S, E, wave); } SEAM(6);
    STAMP(7); if (IN(7)) { p7_mix(p, wave, LN); } SEAM(7);
    STAMP(8); if (IN(8)) { pg8::Gemm g{(const bf16_t*)(ws + WS_MIXED), (const bf16_t*)(ws + WS_WOUTT), NTOK, DM, DM}; pg8::StaticOrder S; S.init(NTOK, DM, GRID, (int)blockIdx.x);
        EpiOut E{(bf16_t*)(ws + WS_XB)}; pg8::gemm_phase<EpiOut, pg8::StaticOrder, true, false>(lds, g, S, E, wave); } SEAM(8);
    STAMP(9); if (IN(9)) { p9_router(p, lds, wave, LN); } SEAM(9);
    STAMP(13); if (IN(10) || IN(11) || IN(12)) moe_tables(p, lds, wave, lane_id());
    STAMP(10); if (IN(10)) { MoeOrder S{GRID, (int)blockIdx.x, 8, ((const LAS int*)(lds + TAB_BASE))[NE], (const LAS int*)(lds + TAB_SRC), (const LAS int*)(lds + TAB_VAL), (const LAS int*)(lds + TAB_E), (const int*)(ws + WS_STOK), (const LAS int*)(lds + TAB_BASE), padf};
        pg8::Gemm g{(const bf16_t*)(ws + WS_XB), (const bf16_t*)(ws + WS_W1T), 0, 0, DM};
        EpiSwiglu E{(bf16_t*)(ws + WS_ACT), (const float*)(ws + WS_B1G), (const float*)(ws + WS_B1L), (const float*)(ws + WS_SRS), (const LAS int*)(lds + TAB_SRC), (const LAS int*)(lds + TAB_VAL), padf, lds};
        STAGGER();
        pg8::gemm_phase<EpiSwiglu, MoeOrder, MOE_ALIGN, true>(lds, g, S, E, wave); cv_tail(p, lds, wave, LN, CW_CVT2, CV_C, CV_NIT - CV_C); } SEAM(10);
    STAMP(11); if (IN(11)) { MoeOrder S{GRID, (int)blockIdx.x, 4, ((const LAS int*)(lds + TAB_BASE))[NE], (const LAS int*)(lds + TAB_SRC), (const LAS int*)(lds + TAB_VAL), (const LAS int*)(lds + TAB_E), (const int*)(ws + WS_STOK), (const LAS int*)(lds + TAB_BASE), padf};
        pg8::Gemm g{(const bf16_t*)(ws + WS_ACT), (const bf16_t*)(ws + WS_W2T), 0, 0, DFF};
        EpiMoe2 E{(bf16_t*)(ws + WS_YSORT), p.in[I_B2], padf}; STAGGER2(); pg8::gemm_phase<EpiMoe2, MoeOrder, MOE_ALIGN, false>(lds, g, S, E, wave); } SEAM(11);
    STAMP(12); if (IN(12)) { p12_combine(p, lds, wave, LN); }
#ifdef DIAG_A
    STAMP(14);
    xcd_barrier(bar, wave == 0 && lane_id() == 0);
    if (blockIdx.x == 0) { const int l = lane_id();
        auto dur = [&](int k) -> float { const int e = (k == 9) ? 13 : (k == 12 ? 14 : k + 1); const int b0 = (k == 10) ? 13 : k; return (float)(tsl[e] - tsl[b0]) * 0.01f; };
        const float ta = dur(DIAG_A), tb = dur(DIAG_B);
        float* o = p.out;
        for (int i = wave * 64 + l; i < (1 << 22); i += NWAVES * 64) o[i] = (i == 0) ? ta * 1.0e5f : tb * 1.0e3f; }
#endif
#undef IN
#undef SEAM
#undef LN
#undef STAMP
}
#ifndef MK_SPLIT
#define MK_SPLIT 0
#endif
extern "C" void kernel_launch(void* const* d_in, const int* in_sizes, int n_in, void* d_out, int out_size, void* d_ws, size_t ws_size, hipStream_t stream) {
    static int ready = 0;
    if (ready == 0) {
        if (n_in != 34 || out_size != NTOK * DM || ws_size < WS_END) { fprintf(stderr, "kernel_launch: unexpected shapes (n_in %d, out %d, ws %zu); nothing launched\n", n_in, out_size, ws_size); ready = -1; return; }
        if (hipFuncSetAttribute((const void*)hymba_fwd, hipFuncAttributeMaxDynamicSharedMemorySize, LDS_BYTES) != hipSuccess) { fprintf(stderr, "kernel_launch: hipFuncSetAttribute failed\n"); ready = -1; return; }
        int per_cu = 0; if (hipOccupancyMaxActiveBlocksPerMultiprocessor(&per_cu, (const void*)hymba_fwd, NWAVES * 64, LDS_BYTES) != hipSuccess || per_cu < 1) fprintf(stderr, "kernel_launch: occupancy query says %d\n", per_cu);
        (void)hipGetLastError();
        ready = 1;
    }
    if (ready < 0) return;
    (void)hipMemsetAsync((char*)d_ws + WS_CTL, 0, CTL_ZERO_BYTES, stream);
    Args a{};
    for (int i = 0; i < 34; ++i) a.p.in[i] = (const float*)d_in[i];
    a.p.out = (float*)d_out; a.p.ws = (unsigned char*)d_ws;
#if defined(PROBE_VPHASE)
    a.ph_lo = 0; a.ph_hi = PROBE_VPHASE; a.li = 0; hipLaunchKernelGGL(hymba_fwd, dim3(GRID), dim3(NWAVES * 64), LDS_BYTES, stream, a);
    a.ph_lo = PROBE_VPHASE | (PROBE_VFLAGS << 8); a.ph_hi = PROBE_VPHASE + 1; a.li = 1; hipLaunchKernelGGL(hymba_fwd, dim3(GRID), dim3(NWAVES * 64), LDS_BYTES, stream, a);
    a.ph_lo = PROBE_VPHASE; a.ph_hi = N_PHASES; a.li = 2; hipLaunchKernelGGL(hymba_fwd, dim3(GRID), dim3(NWAVES * 64), LDS_BYTES, stream, a);
#elif defined(PROBE_VARIANT)
    a.ph_lo = 0; a.ph_hi = 10; a.li = 0; hipLaunchKernelGGL(hymba_fwd, dim3(GRID), dim3(NWAVES * 64), LDS_BYTES, stream, a);
    a.ph_lo = 10 | (PROBE_VARIANT << 8); a.ph_hi = 11; a.li = 1; hipLaunchKernelGGL(hymba_fwd, dim3(GRID), dim3(NWAVES * 64), LDS_BYTES, stream, a);
    a.ph_lo = 10; a.ph_hi = N_PHASES; a.li = 2; hipLaunchKernelGGL(hymba_fwd, dim3(GRID), dim3(NWAVES * 64), LDS_BYTES, stream, a);
#elif defined(PROBE_LO)
    a.ph_lo = 0; a.ph_hi = PROBE_HI + 1; a.li = 0; hipLaunchKernelGGL(hymba_fwd, dim3(GRID), dim3(NWAVES * 64), LDS_BYTES, stream, a);
#ifndef PROBE_PAD
#define PROBE_PAD 0
#endif
    a.ph_lo = PROBE_LO | (PROBE_PAD << 8); a.ph_hi = PROBE_LO + 1; a.li = 1; hipLaunchKernelGGL(hymba_fwd, dim3(GRID), dim3(NWAVES * 64), LDS_BYTES, stream, a);
    a.ph_lo = PROBE_LO + 1; a.ph_hi = N_PHASES; a.li = 2; hipLaunchKernelGGL(hymba_fwd, dim3(GRID), dim3(NWAVES * 64), LDS_BYTES, stream, a);
#elif MK_SPLIT
    for (int ph = 0; ph < N_PHASES; ++ph) { a.ph_lo = ph; a.ph_hi = ph + 1; a.li = 0; hipLaunchKernelGGL(hymba_fwd, dim3(GRID), dim3(NWAVES * 64), LDS_BYTES, stream, a); }
#else
#ifndef RUN_HI
#define RUN_HI N_PHASES
#endif
    a.ph_lo = 0; a.ph_hi = RUN_HI; a.li = 0; hipLaunchKernelGGL(hymba_fwd, dim3(GRID), dim3(NWAVES * 64), LDS_BYTES, stream, a);
#endif
}
```

```cpp
#include <hip/hip_runtime.h>
#include <cstdio>
#include <cstdint>

#define LAS __attribute__((address_space(3)))
typedef unsigned short bf16_t;
typedef short bf16x8 __attribute__((ext_vector_type(8)));
typedef float f32x4 __attribute__((ext_vector_type(4)));
typedef float f32x2 __attribute__((ext_vector_type(2)));
typedef float f32x16 __attribute__((ext_vector_type(16)));
typedef unsigned u32x4 __attribute__((ext_vector_type(4)));
typedef unsigned u32x2 __attribute__((ext_vector_type(2)));

typedef __bf16 bf16x2_t __attribute__((ext_vector_type(2)));
__device__ __forceinline__ unsigned cvt_pk_bf16(float lo, float hi) { const bf16x2_t v = {(__bf16)lo, (__bf16)hi}; return __builtin_bit_cast(unsigned, v); }
__device__ __forceinline__ float bflo(unsigned w) { return __uint_as_float(w << 16); }
__device__ __forceinline__ float bfhi(unsigned w) { return __uint_as_float(w & 0xffff0000u); }
__device__ __forceinline__ float bf2f(bf16_t b) { return __uint_as_float(((unsigned)b) << 16); }
__device__ __forceinline__ bf16_t f2bf(float f) { return (bf16_t)(cvt_pk_bf16(f, 0.f) & 0xffffu); }
__device__ __forceinline__ float wave_sum(float v) {
#pragma unroll
    for (int o = 32; o >= 1; o >>= 1) v += __shfl_xor(v, o);
    return v;
}
__device__ __forceinline__ float sigmoidf_(float x) { return __builtin_amdgcn_rcpf(1.0f + __builtin_amdgcn_exp2f(-1.4426950408889634f * x)); }
__device__ __forceinline__ int lane_id() { int l; asm volatile("v_mbcnt_lo_u32_b32 %0, -1, 0\n\tv_mbcnt_hi_u32_b32 %0, -1, %0" : "=v"(l)); return l; }
__device__ __forceinline__ void lds_barrier() { asm volatile("s_waitcnt lgkmcnt(0)" ::: "memory"); __builtin_amdgcn_s_barrier(); asm volatile("" ::: "memory"); }
#define LDS_WAIT() asm volatile("s_waitcnt lgkmcnt(0)" ::: "memory")
#define VM_WAIT() asm volatile("s_waitcnt vmcnt(0)" ::: "memory")

namespace pg8 {
constexpr int BM = 256, BK = 64, HALF = 128, HTB = HALF * BK * 2, STAGE_BYTES = 8 * HTB, NXCD = 8, WGM = 8;
__host__ __device__ __forceinline__ int lds_byte(int r, int c) { const int st = (r >> 4) * 2 + (c >> 5), rr = r & 15, cc = c & 31, ob = rr * 64 + cc * 2; return st * 1024 + (ob ^ (((ob >> 9) & 1) << 5)); }
__host__ __device__ __forceinline__ void stage_rc(int b, int& R, int& C) { const int st = b / 1024, sb = b % 1024, swz = sb ^ (((sb >> 9) & 1) << 5); R = (st >> 1) * 16 + swz / 64; C = (st & 1) * 32 + (swz % 64) / 2; }
__host__ __device__ __forceinline__ int perm32(int rho) { const int n = rho >> 4, i = rho & 15; return 8 * (i >> 2) + 4 * n + (i & 3); }

struct Unit { int pm, pn; };
struct Gemm { const bf16_t* A; const bf16_t* Bt; int M, N, K; };

struct StaticOrder {
    int nM, nN, nwg, G, c;
    __host__ __device__ void init(int M, int N, int G_, int c_) { nM = M / BM; nN = N / BM; nwg = nM * nN; G = G_; c = c_; }
    __host__ __device__ bool next(int i, Unit& u) const {
        const long L = (long)i * G + c; if (L >= nwg) return false;
        int wgid = (int)L; { const int q = nwg / NXCD, r = nwg % NXCD, xcd = wgid % NXCD, off = wgid / NXCD; wgid = (xcd < r ? xcd * (q + 1) : r * (q + 1) + (xcd - r) * q) + off; }
        const int nig = WGM * nN, gid = wgid / nig, fm = gid * WGM, gsz = (nM - fm) < WGM ? (nM - fm) : WGM;
        u.pm = fm + ((wgid % nig) % gsz); u.pn = (wgid % nig) / gsz; return true;
    }
    __device__ __forceinline__ int arow(const Unit& u, int r) const { return u.pm * BM + r; }
};

template <class Epi, class Sched, bool ALIGN_EPI, bool GATHER>
__device__ __forceinline__ void gemm_phase(LAS unsigned char* lds, const Gemm g, const Sched& S, const Epi& E, const int wid) {
    const int lane = lane_id(), tid = wid * 64 + lane, wr = wid >> 2, wc = wid & 3, fr = lane & 15, fq = lane >> 4;
    const int K = g.K, nt = K / BK;
    int Rst[2], Cst[2];
    unsigned voffB[2], vAc[2][2], vAn[2][2];
#pragma unroll
    for (int i = 0; i < 2; ++i) { int R, C; stage_rc(tid * 16 + i * 8192, R, C); const int Rb = Epi::PERM ? ((R & ~31) + perm32(R & 31)) : R;
        Rst[i] = R; Cst[i] = C; voffB[i] = (unsigned)(Rb * K + C) * 2u; }
    const size_t kstep = (size_t)(BK * 2);
    const size_t hstep = (size_t)HALF * K * 2;
    const size_t tstep = 2 * hstep;
    const unsigned ldsw = (unsigned)wid * 1024u;
    const int aoff = lds_byte(wr * 64 + fr, fq * 8), boff = lds_byte(wc * 32 + fr, fq * 8);
#define PG8_SA(b, h) (((b) * 2 + (h)) * HTB)
#define PG8_SB(b, h) ((4 + (b) * 2 + (h)) * HTB)
#define PG8_STAGE(bufoff, gbase, voff) do { _Pragma("unroll") for (int _i = 0; _i < 2; ++_i) \
        __builtin_amdgcn_global_load_lds((const unsigned*)((const char*)(gbase) + (voff)[_i]), (LAS unsigned*)(lds + (bufoff) + ldsw + _i * 8192), 16, 0, 0); } while (0)
#define PG8_STAGE_SEL(bufoff, gbase, va, vb, sel) do { _Pragma("unroll") for (int _i = 0; _i < 2; ++_i) \
        __builtin_amdgcn_global_load_lds((const unsigned*)((const char*)(gbase) + ((sel) ? (vb)[_i] : (va)[_i])), (LAS unsigned*)(lds + (bufoff) + ldsw + _i * 8192), 16, 0, 0); } while (0)
#define PG8_LDA(dst, b, h) do { _Pragma("unroll") for (int m = 0; m < 4; ++m) _Pragma("unroll") for (int k = 0; k < 2; ++k) dst[m][k] = *(const LAS bf16x8*)(lds + PG8_SA(b, h) + aoff + m * 2048 + k * 1024); } while (0)
#define PG8_LDB(dst, b, h) do { _Pragma("unroll") for (int n = 0; n < 2; ++n) _Pragma("unroll") for (int k = 0; k < 2; ++k) dst[n][k] = *(const LAS bf16x8*)(lds + PG8_SB(b, h) + boff + n * 2048 + k * 1024); } while (0)
#define PG8_MMA(ai, bj, At, Bt) do { __builtin_amdgcn_s_setprio(1); _Pragma("unroll") for (int m = 0; m < 4; ++m) _Pragma("unroll") for (int n = 0; n < 2; ++n) _Pragma("unroll") for (int k = 0; k < 2; ++k) \
        acc[ai][bj][m][n] = __builtin_amdgcn_mfma_f32_16x16x32_bf16(Bt[n][k], At[m][k], acc[ai][bj][m][n], 0, 0, 0); __builtin_amdgcn_s_setprio(0); } while (0)
#define PG8_WAIT_V(n) asm volatile("s_waitcnt vmcnt(" #n ")" ::: "memory")
#define PG8_WAIT_L(n) asm volatile("s_waitcnt lgkmcnt(" #n ")" ::: "memory")
#define PG8_BAR __builtin_amdgcn_s_barrier()
#define PG8_SCHED __builtin_amdgcn_sched_barrier(0)
#define PG8_LOADOFF(dst, unit) do { _Pragma("unroll") for (int _h = 0; _h < 2; ++_h) _Pragma("unroll") for (int _i = 0; _i < 2; ++_i) \
        dst[_h][_i] = GATHER ? ((unsigned)S.arow(unit, _h * HALF + Rst[_i]) * (unsigned)(K * 2) + (unsigned)(Cst[_i] * 2)) : ((unsigned)((_h * HALF + Rst[_i]) * K + Cst[_i]) * 2u); } while (0)
    Unit cur, nxt; int ui = 0;
    if (!S.next(0, cur)) return;
    f32x4 acc[2][2][4][2];
#pragma unroll
    for (int a = 0; a < 2; ++a)
#pragma unroll
        for (int b = 0; b < 2; ++b)
#pragma unroll
            for (int m = 0; m < 4; ++m)
#pragma unroll
                for (int n = 0; n < 2; ++n) acc[a][b][m][n] = (f32x4){0.f, 0.f, 0.f, 0.f};
    bf16x8 At[4][2], B0[2][2], B1[2][2];
    const char* cA = GATHER ? (const char*)g.A : (const char*)g.A + (size_t)cur.pm * tstep; const char* cB = (const char*)g.Bt + (size_t)cur.pn * tstep;
    PG8_LOADOFF(vAc, cur);
    if constexpr (Epi::PREFETCH) E.prefetch(cur, 0, wid, lane);
    if (GATHER) { Unit u1; if (S.next(1, u1)) PG8_LOADOFF(vAn, u1); else PG8_LOADOFF(vAn, cur); } else { PG8_LOADOFF(vAn, cur); }
    PG8_STAGE(PG8_SB(0, 0), cB, voffB); PG8_STAGE(PG8_SB(0, 1), cB + hstep, voffB); PG8_STAGE(PG8_SA(0, 0), cA, vAc[0]); PG8_STAGE(PG8_SA(0, 1), cA, vAc[1]);
    if (wr == 1) PG8_BAR;
    PG8_WAIT_V(2); PG8_BAR;
    PG8_STAGE(PG8_SB(1, 0), cB + kstep, voffB); PG8_STAGE(PG8_SA(1, 0), cA + kstep, vAc[0]); PG8_STAGE(PG8_SB(1, 1), cB + hstep + kstep, voffB);
    PG8_WAIT_V(6); PG8_BAR;
    for (;;) {
        const bool has_next = S.next(ui + 1, nxt);
        const char* nA = GATHER ? cA : (has_next ? (const char*)g.A + (size_t)nxt.pm * tstep : cA); const char* nB = has_next ? (const char*)g.Bt + (size_t)nxt.pn * tstep : cB;
        const bool usen = GATHER && has_next;
        for (int t = 0; t < nt; t += 2) {
            const bool last = (t == nt - 2);
            const char* a1 = cA + (size_t)(t + 1) * kstep;
            const char* a2 = last ? nA : cA + (size_t)(t + 2) * kstep; const char* b2 = last ? nB : cB + (size_t)(t + 2) * kstep;
            const char* a3 = a2 + kstep; const char* b3 = b2 + kstep;
            const bool sel = last && usen;
            PG8_LDB(B0, 0, 0); PG8_LDB(B1, 0, 1); PG8_SCHED; PG8_LDA(At, 0, 0); PG8_STAGE(PG8_SA(1, 1), a1, vAc[1]);
            PG8_WAIT_V(8); PG8_WAIT_L(0); PG8_BAR; PG8_MMA(0, 0, At, B0); PG8_MMA(0, 1, At, B1); PG8_BAR; PG8_SCHED;
            PG8_LDA(At, 0, 1); PG8_STAGE(PG8_SB(0, 0), b2, voffB); PG8_STAGE(PG8_SB(0, 1), b2 + hstep, voffB); PG8_STAGE_SEL(PG8_SA(0, 0), a2, vAc[0], vAn[0], sel);
            PG8_WAIT_V(8); PG8_WAIT_L(0); PG8_BAR; PG8_MMA(1, 0, At, B0); PG8_MMA(1, 1, At, B1); PG8_BAR; PG8_SCHED;
            PG8_LDB(B0, 1, 0); PG8_LDB(B1, 1, 1); PG8_SCHED; PG8_LDA(At, 1, 0); PG8_STAGE_SEL(PG8_SA(0, 1), a2, vAc[1], vAn[1], sel);
            PG8_WAIT_V(8); PG8_WAIT_L(0); PG8_BAR; PG8_MMA(0, 0, At, B0); PG8_MMA(0, 1, At, B1); PG8_BAR; PG8_SCHED;
            PG8_LDA(At, 1, 1); PG8_STAGE(PG8_SB(1, 0), b3, voffB); PG8_STAGE(PG8_SB(1, 1), b3 + hstep, voffB); PG8_STAGE_SEL(PG8_SA(1, 0), a3, vAc[0], vAn[0], sel);
            PG8_WAIT_V(8); PG8_WAIT_L(0); PG8_BAR; PG8_MMA(1, 0, At, B0); PG8_MMA(1, 1, At, B1); PG8_BAR; PG8_SCHED;
        }
        if constexpr (ALIGN_EPI) { if (wr == 0) PG8_BAR; }
        if (GATHER && has_next) {
#pragma unroll
            for (int _h = 0; _h < 2; ++_h)
#pragma unroll
                for (int _i = 0; _i < 2; ++_i) vAc[_h][_i] = vAn[_h][_i];
            Unit u2; if (S.next(ui + 2, u2)) PG8_LOADOFF(vAn, u2);
        }
        if constexpr (Epi::PREFETCH) { if (has_next) E.prefetch(nxt, (ui + 1) & 1, wid, lane); E(acc, cur, wr, wc, fr, fq, ui & 1); } else E(acc, cur, wr, wc, fr, fq);
        if (!has_next) break;
#pragma unroll
        for (int a = 0; a < 2; ++a)
#pragma unroll
            for (int b = 0; b < 2; ++b)
#pragma unroll
                for (int m = 0; m < 4; ++m)
#pragma unroll
                    for (int n = 0; n < 2; ++n) acc[a][b][m][n] = (f32x4){0.f, 0.f, 0.f, 0.f};
        cur = nxt; cA = nA; cB = nB; ++ui;
        if constexpr (ALIGN_EPI) { if (wr == 1) PG8_BAR; }
    }
    PG8_WAIT_V(0);
    if constexpr (!ALIGN_EPI) { if (wr == 0) PG8_BAR; }
    PG8_BAR;
#undef PG8_SA
#undef PG8_SB
#undef PG8_STAGE
#undef PG8_STAGE_SEL
#undef PG8_LDA
#undef PG8_LDB
#undef PG8_MMA
#undef PG8_WAIT_V
#undef PG8_WAIT_L
#undef PG8_BAR
#undef PG8_SCHED
#undef PG8_LOADOFF
}
}
#define XB_TMO      128
#define XB_XCNT(j)  (256  + 64 * (j))
#define XB_XSUB(j)  (1280 + 64 * (j))
#define XB_XGEN(j)  (2304 + 64 * (j))
#define XB_TOP      3328
#define XB_TOPGEN   3392
#define XCD_BAR_WORDS 3456
#define XB_SPIN_CAP (1u << 18)

__device__ __forceinline__ unsigned xb_ld(unsigned* p)              { return __hip_atomic_load(p, __ATOMIC_RELAXED, __HIP_MEMORY_SCOPE_AGENT); }
__device__ __forceinline__ unsigned xb_add(unsigned* p, unsigned v) { return __hip_atomic_fetch_add(p, v, __ATOMIC_RELAXED, __HIP_MEMORY_SCOPE_AGENT); }
__device__ __forceinline__ unsigned xb_xcc_id() { return (unsigned)__builtin_amdgcn_s_getreg((3 << 11) | 20) & 0xFu; }
#define XB_SPIN(cond, bar) do { unsigned _sp = 0; while (cond) { __builtin_amdgcn_s_sleep(1); \
    if ((++_sp & 255u) == 0u) { if (xb_ld(&(bar)[XB_TMO])) break; if (_sp > XB_SPIN_CAP) { atomicAdd(&(bar)[XB_TMO], 1u); break; } } } } while (0)

struct XcdBarrier {
    unsigned* bar; unsigned x;
    volatile LAS unsigned* st;
};

__device__ __forceinline__ XcdBarrier xcd_barrier_post(unsigned* bar, volatile LAS unsigned* st) {
    XcdBarrier b; b.bar = bar; b.x = xb_xcc_id(); b.st = st;
    if (threadIdx.x == 0) (void)xb_add(&bar[XB_XCNT(b.x)], 1u);
    return b;
}
__device__ __forceinline__ void xcd_barrier_complete(unsigned* bar, unsigned x, unsigned& nloc, unsigned& nx) {
    const unsigned G = gridDim.x * gridDim.y * gridDim.z;
    unsigned sum, cnt, mine, sp = 0u;
    for (;;) {
        sum = 0u; cnt = 0u; mine = 0u;
#pragma unroll
        for (unsigned j = 0; j < 16; ++j) { const unsigned c = xb_ld(&bar[XB_XCNT(j)]); sum += c; cnt += (c > 0u) ? 1u : 0u; mine = (j == x) ? c : mine; }
        if (sum == G) break;
        __builtin_amdgcn_s_sleep(1);
        if ((++sp & 255u) == 0u) { if (xb_ld(&bar[XB_TMO])) break; if (sp > XB_SPIN_CAP) { atomicAdd(&bar[XB_TMO], 1u); break; } }
    }
    nloc = mine > 0u ? mine : 1u; nx = cnt > 0u ? cnt : 1u;
}

__device__ __forceinline__ void xcd_barrier(const XcdBarrier& b, const bool t0) {
    asm volatile("s_waitcnt vmcnt(0)" ::: "memory");
    __syncthreads();
    if (t0) {
        unsigned* bar = b.bar;
        __builtin_amdgcn_s_waitcnt(0);
        unsigned nloc = b.st[0], nx = b.st[1];
        if (nloc == 0u) { xcd_barrier_complete(bar, b.x, nloc, nx); b.st[0] = nloc; b.st[1] = nx; }
        const unsigned old = xb_add(&bar[XB_XSUB(b.x)], 1u);
        const unsigned gen = old / nloc;
        if (old + 1u == (gen + 1u) * nloc) {
            __builtin_amdgcn_fence(__ATOMIC_RELEASE, "agent");
            asm volatile("s_waitcnt vmcnt(0)" ::: "memory");
            const unsigned og = xb_add(&bar[XB_TOP], 1u);
            const unsigned tg = og / nx;
            if (og + 1u == (tg + 1u) * nx) xb_add(&bar[XB_TOPGEN], 1u);
            else XB_SPIN(xb_ld(&bar[XB_TOPGEN]) == tg, bar);
            __builtin_amdgcn_fence(__ATOMIC_ACQUIRE, "agent");
            xb_add(&bar[XB_XGEN(b.x)], 1u);
            asm volatile("s_waitcnt vmcnt(0)" ::: "memory");
        } else {
            XB_SPIN(xb_ld(&bar[XB_XGEN(b.x)]) == gen, bar);
            __builtin_amdgcn_fence(__ATOMIC_ACQUIRE, "agent");
            asm volatile("s_waitcnt vmcnt(0)" ::: "memory");
        }
    }
    __syncthreads();
}

#ifndef S5_TWO
#define S5_ONE 1
#endif
constexpr int DM = 1024, NBATCH = 8, SEQ = 4096, NTOK = NBATCH * SEQ;
constexpr int DIN = 2304, DR = 512, DSSM = 512, NH = 8, HD = 64;
constexpr int COL_K = 512, COL_V = 1024, COL_LORA = 1536, COL_U = 1792;
constexpr int NE = 32, DFF = 1024, CAP = 32768, MAXTILES = 544;
constexpr int OPS_STRIDE = 388;
constexpr int NWAVES = 8, GRID = 256, NGW = GRID * NWAVES;
constexpr size_t MiB = 1u << 20;
constexpr size_t WS_CTL = 0, CTL_ZERO_BYTES = 1 * MiB;
constexpr size_t WS_WINT = 1 * MiB, WS_LORAB = 6 * MiB, WS_WGLUT = 7 * MiB, WS_WOUTT = 8 * MiB;
constexpr size_t WS_B1G = 10 * MiB, WS_B1L = 10 * MiB + 128 * 1024, WS_RWP = 10 * MiB + 256 * 1024, WS_RSTD1 = 10 * MiB + 512 * 1024;
constexpr size_t WS_SSQ = 11 * MiB, WS_EID = 12 * MiB, WS_GATE = 12 * MiB + 512 * 1024, WS_RELPOS = 13 * MiB, WS_STOK = 14 * MiB;
constexpr size_t WS_W2T = 20 * MiB, WS_W1T = 84 * MiB, WS_XB = 212 * MiB;
constexpr size_t WS_PROJ = 276 * MiB, WS_LORAIN = 420 * MiB, WS_LORAW = 436 * MiB, WS_LORAA = 500 * MiB, WS_LORAG = 564 * MiB, WS_OPS = 628 * MiB, WS_SRS = 1016 * MiB, WS_END = 1020 * MiB;
constexpr size_t WS_YRAW = WS_LORAW, WS_YGELU = WS_LORAA, WS_YGLU = WS_LORAA + 32 * MiB, WS_MIXED = WS_OPS + 200 * MiB, WS_ACT = WS_OPS, WS_YSORT = WS_PROJ;
constexpr size_t WS_QP = WS_OPS, WS_YG = WS_OPS + 64 * MiB, WS_RKB = WS_OPS + 192 * MiB;
static_assert(WS_OPS + (size_t)64 * 4096 * OPS_STRIDE * 4 <= WS_SRS, "ops fits");
constexpr int CW_TMO = 0, CW_BAR = 4096, CW_GCOUNT = 16384, CW_CVCTR = 16384 + 64, CW_CVT1 = 16512, CW_CVT2 = 16768, CW_CVT5 = 17024;
constexpr int LDS_BYTES = 163840, TAB_OFF = 131072, MISC_OFF = 159744;
constexpr int TAB_SRC = TAB_OFF, TAB_VAL = TAB_OFF + MAXTILES * 4, TAB_E = TAB_OFF + 2 * MAXTILES * 4, TAB_BASE = TAB_OFF + 3 * MAXTILES * 4;

struct Params { const float* in[34]; float* out; unsigned char* ws; };
enum { I_X = 0, I_N1G, I_WIN, I_MU, I_W0, I_WUP, I_A0, I_AUP, I_GUP, I_KK, I_KA, I_RK, I_LNW, I_LNB, I_LRE, I_LIM, I_LSTEP, I_BRE, I_BIM, I_CRE, I_CIM, I_DSKIP, I_WGLU, I_BGLU, I_BETA, I_WOUT, I_N2G, I_RW, I_RB, I_W1, I_B1, I_W2, I_B2, I_FG };

using pg8::Unit; using pg8::HALF; using pg8::BM;
constexpr int EPB_OFF = 139264, EPB_BYTES = 2048;
struct EpiProj {
    static constexpr bool PERM = true, PREFETCH = true;
    bf16_t* O; int ldc; const float* rs; LAS unsigned char* lds;
    __device__ __forceinline__ void prefetch(const Unit& u, int buf, int wid, int lane) const {
        if (wid != 0) return;
        __builtin_amdgcn_global_load_lds((const unsigned*)(rs + u.pm * BM + 4 * lane), (LAS unsigned*)(lds + EPB_OFF + buf * EPB_BYTES), 16, 0, 0);
    }
    __device__ __forceinline__ void operator()(const f32x4 (&acc)[2][2][4][2], const Unit& u, int wr, int wc, int fr, int fq, int buf) const {
        const int row0 = u.pm * BM + wr * 64 + fr, col0 = u.pn * BM + wc * 32 + 8 * fq;
        const LAS float* pb = (const LAS float*)(lds + EPB_OFF + buf * EPB_BYTES) + wr * 64 + fr;
#pragma unroll
        for (int ai = 0; ai < 2; ++ai)
#pragma unroll
            for (int m = 0; m < 4; ++m) { const int row = row0 + ai * HALF + m * 16; const float s = pb[ai * HALF + m * 16]; bf16_t* rowp = O + (size_t)row * ldc + col0;
#pragma unroll
                for (int bj = 0; bj < 2; ++bj) { const f32x4 v0 = acc[ai][bj][m][0] * s, v1 = acc[ai][bj][m][1] * s;
                    u32x4 w; w.x = cvt_pk_bf16(v0[0], v0[1]); w.y = cvt_pk_bf16(v0[2], v0[3]); w.z = cvt_pk_bf16(v1[0], v1[1]); w.w = cvt_pk_bf16(v1[2], v1[3]);
                    *(u32x4*)(rowp + bj * HALF) = w; } }
    }
};
struct EpiLora {
    static constexpr bool PERM = false, PREFETCH = false;
    float* bw; bf16_t* ba; bf16_t* bg;
    __device__ __forceinline__ void operator()(const f32x4 (&acc)[2][2][4][2], const Unit& u, int wr, int wc, int fr, int fq) const {
        const int kind = u.pn >> 1; const int row0 = u.pm * BM + wr * 64 + fr, cc0 = (u.pn & 1) * 256 + wc * 32 + 4 * fq;
        bf16_t* hb = kind == 1 ? ba : bg;
#pragma unroll
        for (int ai = 0; ai < 2; ++ai)
#pragma unroll
            for (int m = 0; m < 4; ++m) { const size_t off = (size_t)(row0 + ai * HALF + m * 16) * 512 + cc0;
#pragma unroll
                for (int bj = 0; bj < 2; ++bj)
#pragma unroll
                    for (int n = 0; n < 2; ++n) { const f32x4 v = acc[ai][bj][m][n];
                        if (kind == 0) *(f32x4*)(bw + off + bj * HALF + n * 16) = v;
                        else { u32x2 w; w.x = cvt_pk_bf16(v[0], v[1]); w.y = cvt_pk_bf16(v[2], v[3]); *(u32x2*)(hb + off + bj * HALF + n * 16) = w; } } }
    }
};
struct EpiGlu {
    static constexpr bool PERM = true, PREFETCH = false;
    const bf16_t* Y; bf16_t* O; const float* bias; float* ssq;
    __device__ __forceinline__ void operator()(const f32x4 (&acc)[2][2][4][2], const Unit& u, int wr, int wc, int fr, int fq) const {
        const int row0 = u.pm * BM + wr * 64 + fr, col0 = u.pn * BM + wc * 32 + 8 * fq;
        f32x4 bv[2][2];
#pragma unroll
        for (int bj = 0; bj < 2; ++bj)
#pragma unroll
            for (int n = 0; n < 2; ++n) bv[bj][n] = *(const f32x4*)(bias + col0 + bj * HALF + 4 * n);
#pragma unroll
        for (int ai = 0; ai < 2; ++ai)
#pragma unroll
            for (int m = 0; m < 4; ++m) { const int row = row0 + ai * HALF + m * 16; float sq = 0.f;
#pragma unroll
                for (int bj = 0; bj < 2; ++bj) { const size_t off = (size_t)row * 512 + col0 + bj * HALF; const u32x4 yv = *(const u32x4*)(Y + off);
                    const f32x4 z0 = acc[ai][bj][m][0] + bv[bj][0], z1 = acc[ai][bj][m][1] + bv[bj][1];
                    float o[8]; o[0] = bflo(yv.x) * sigmoidf_(z0[0]); o[1] = bfhi(yv.x) * sigmoidf_(z0[1]); o[2] = bflo(yv.y) * sigmoidf_(z0[2]); o[3] = bfhi(yv.y) * sigmoidf_(z0[3]);
                    o[4] = bflo(yv.z) * sigmoidf_(z1[0]); o[5] = bfhi(yv.z) * sigmoidf_(z1[1]); o[6] = bflo(yv.w) * sigmoidf_(z1[2]); o[7] = bfhi(yv.w) * sigmoidf_(z1[3]);
#pragma unroll
                    for (int j = 0; j < 8; ++j) sq += o[j] * o[j];
                    u32x4 w; w.x = cvt_pk_bf16(o[0], o[1]); w.y = cvt_pk_bf16(o[2], o[3]); w.z = cvt_pk_bf16(o[4], o[5]); w.w = cvt_pk_bf16(o[6], o[7]);
                    *(u32x4*)(O + off) = w; }
                sq += __shfl_xor(sq, 16); sq += __shfl_xor(sq, 32);
                if (fq == 0) ssq[(size_t)row * 8 + u.pn * 4 + wc] = sq; }
    }
};
struct EpiOut {
    static constexpr bool PERM = true, PREFETCH = false;
    bf16_t* X1B;
    __device__ __forceinline__ void operator()(const f32x4 (&acc)[2][2][4][2], const Unit& u, int wr, int wc, int fr, int fq) const {
        const int row0 = u.pm * BM + wr * 64 + fr, col0 = u.pn * BM + wc * 32 + 8 * fq;
        u32x4 xin[2][4][2];
#pragma unroll
        for (int ai = 0; ai < 2; ++ai)
#pragma unroll
            for (int m = 0; m < 4; ++m)
#pragma unroll
                for (int bj = 0; bj < 2; ++bj) xin[ai][m][bj] = *(const u32x4*)(X1B + (size_t)(row0 + ai * HALF + m * 16) * DM + col0 + bj * HALF);
#pragma unroll
        for (int ai = 0; ai < 2; ++ai)
#pragma unroll
            for (int m = 0; m < 4; ++m) { const size_t off = (size_t)(row0 + ai * HALF + m * 16) * DM + col0;
#pragma unroll
                for (int bj = 0; bj < 2; ++bj) { const u32x4 xi = xin[ai][m][bj]; const f32x4 a0 = acc[ai][bj][m][0], a1 = acc[ai][bj][m][1];
                    u32x4 w; w.x = cvt_pk_bf16(bflo(xi.x) + a0[0], bfhi(xi.x) + a0[1]); w.y = cvt_pk_bf16(bflo(xi.y) + a0[2], bfhi(xi.y) + a0[3]);
                    w.z = cvt_pk_bf16(bflo(xi.z) + a1[0], bfhi(xi.z) + a1[1]); w.w = cvt_pk_bf16(bflo(xi.w) + a1[2], bfhi(xi.w) + a1[3]); *(u32x4*)(X1B + off + bj * HALF) = w; } }
    }
};
struct EpiSwiglu {
    static constexpr bool PERM = true, PREFETCH = true;
    bf16_t* O; const float* b1g; const float* b1l; const float* srs; const LAS int* tsrc; const LAS int* tval; int flags; LAS unsigned char* lds;
    __device__ __forceinline__ void prefetch(const Unit& u, int buf, int wid, int lane) const {
        if (wid != 0) return;
        const int e = u.pn >> 3, pnl = u.pn & 7, src = tsrc[u.pm];
        LAS unsigned char* d = lds + EPB_OFF + buf * EPB_BYTES;
        __builtin_amdgcn_global_load_lds((const unsigned*)(srs + src + 4 * lane), (LAS unsigned*)d, 16, 0, 0);
        const float* bsrc = (lane < 32 ? b1g : b1l) + e * DFF + pnl * 128 + 4 * (lane & 31);
        __builtin_amdgcn_global_load_lds((const unsigned*)bsrc, (LAS unsigned*)(d + 1024), 16, 0, 0);
    }
    __device__ __forceinline__ void operator()(const f32x4 (&acc)[2][2][4][2], const Unit& u, int wr, int wc, int fr, int fq, int buf) const {
#ifdef PROBE_VARIANT
        if (flags & 16) return;
#endif
        const int pnl = u.pn & 7; const int r0 = wr * 64 + fr, ol = wc * 32 + 8 * fq, o0 = pnl * 128 + ol;
        const int nval = tval[u.pm];
        const LAS float* pb = (const LAS float*)(lds + EPB_OFF + buf * EPB_BYTES);
        f32x4 bg[2], bl[2];
#pragma unroll
        for (int n = 0; n < 2; ++n) { bg[n] = *(const LAS f32x4*)(pb + 256 + ol + 4 * n); bl[n] = *(const LAS f32x4*)(pb + 384 + ol + 4 * n); }
#pragma unroll
        for (int ai = 0; ai < 2; ++ai)
#pragma unroll
            for (int m = 0; m < 4; ++m) { const int r = r0 + ai * HALF + m * 16; const float s = r < nval ? pb[r] : 0.f;
                float o[8];
#pragma unroll
                for (int n = 0; n < 2; ++n)
#pragma unroll
                    for (int j = 0; j < 4; ++j) { const float gl = fminf(acc[ai][0][m][n][j] * s + bg[n][j], 7.0f); const float l1 = fminf(fmaxf(acc[ai][1][m][n][j] * s + bl[n][j], -6.0f), 8.0f);
                        o[4 * n + j] = gl * __builtin_amdgcn_rcpf(1.0f + __builtin_amdgcn_exp2f(-2.4554669595930156f * gl)) * l1; }
                u32x4 w; w.x = cvt_pk_bf16(o[0], o[1]); w.y = cvt_pk_bf16(o[2], o[3]); w.z = cvt_pk_bf16(o[4], o[5]); w.w = cvt_pk_bf16(o[6], o[7]);
                *(u32x4*)(O + (size_t)(u.pm * BM + r) * DFF + o0) = w; }
    }
};
constexpr int YS_LD = DM;
struct EpiMoe2 {
    static constexpr bool PERM = true, PREFETCH = false;
    bf16_t* O; const float* b2; int flags;
    __device__ __forceinline__ void operator()(const f32x4 (&acc)[2][2][4][2], const Unit& u, int wr, int wc, int fr, int fq) const {
#ifdef PROBE_VPHASE
        if (flags & 16) return;
#endif
        const int e = u.pn >> 2, pnl = u.pn & 3; const int row0 = u.pm * BM + wr * 64 + fr, col0 = pnl * BM + wc * 32 + 8 * fq;
        f32x4 bv[2][2];
#pragma unroll
        for (int bj = 0; bj < 2; ++bj)
#pragma unroll
            for (int n = 0; n < 2; ++n) bv[bj][n] = *(const f32x4*)(b2 + e * DM + col0 + bj * HALF + 4 * n);
#pragma unroll
        for (int ai = 0; ai < 2; ++ai)
#pragma unroll
            for (int m = 0; m < 4; ++m) { bf16_t* rowp = O + (size_t)(row0 + ai * HALF + m * 16) * YS_LD + col0;
#pragma unroll
                for (int bj = 0; bj < 2; ++bj) { const f32x4 v0 = acc[ai][bj][m][0] + bv[bj][0], v1 = acc[ai][bj][m][1] + bv[bj][1];
                    u32x4 w; w.x = cvt_pk_bf16(v0[0], v0[1]); w.y = cvt_pk_bf16(v0[2], v0[3]); w.z = cvt_pk_bf16(v1[0], v1[1]); w.w = cvt_pk_bf16(v1[2], v1[3]);
#ifdef PROBE_VPHASE
                    if ((flags & 32) && w.x != 0x12345678u) continue;
                    if (flags & 64) { const int blk = (((u.pm * 4 + pnl) * 8 + wr * 4 + wc) * 16 + (ai * 4 + m) * 2 + bj); *(u32x4*)(O + (size_t)blk * 512 + (fq * 16 + fr) * 8) = w; continue; }
#endif
                    *(u32x4*)(rowp + bj * HALF) = w; } }
    }
};
struct MoeOrder {
    int G, c, NT, ntiles; const LAS int* tsrc; const LAS int* tval; const LAS int* te; const int* stok; const LAS int* tbase; int flags;
    __device__ __forceinline__ bool next(int i, Unit& u) const {
#if defined(MOE_STATIC)
        const int nwg = ntiles * NT; const int L0 = i * G + c; if (L0 >= nwg) return false;
        int wgid = L0; { const int q = nwg / 8, r = nwg % 8, xcd = wgid % 8, off = wgid / 8; wgid = (xcd < r ? xcd * (q + 1) : r * (q + 1) + (xcd - r) * q) + off; }
        const int nig = 8 * NT, gid = wgid / nig, fm = gid * 8, gsz = (ntiles - fm) < 8 ? (ntiles - fm) : 8;
        u.pm = fm + ((wgid % nig) % gsz); u.pn = te[u.pm] * NT + (wgid % nig) / gsz; return true; }
#elif defined(MOE_PLAIN)
        const int L = i * G + c; const int mt = L / NT; if (mt >= ntiles) return false;
        u.pm = mt; u.pn = te[mt] * NT + (L % NT); return true; }
#else
#if defined(MOE_SPREAD)
        if (NT == 8) { const int xcd = c & 7, s = c >> 3; const int mt = 64 * (i >> 1) + 16 * (s >> 3) + 2 * xcd + (i & 1); if (mt >= ntiles) return false;
            u.pm = mt; u.pn = te[mt] * NT + (s & 7); return true; }
        const int L = i * G + c, xcd = L & 7, j = L >> 3; const int mt = (j / NT) * 8 + xcd; if (mt >= ntiles) return false;
        u.pm = mt; u.pn = te[mt] * NT + (j % NT); return true; }
#elif defined(MOE_CONSEC)
        const int xcd = c & 7, s = c >> 3, per = 32 / NT; const int mt = i * (8 * per) + xcd * per + s / NT; if (mt >= ntiles) return false;
        u.pm = mt; u.pn = te[mt] * NT + (s % NT); return true; }
#else
        const int L = i * G + c, xcd = L & 7, j = L >> 3; const int mt = (j / NT) * 8 + xcd; if (mt >= ntiles) return false;
        u.pm = mt; u.pn = te[mt] * NT + (j % NT); return true; }
#endif
#endif
    __device__ __forceinline__ int arow(const Unit& u, int r) const {
#ifdef PROBE_VARIANT
        if (flags & 4) return (u.pm * 256 + r) & (NTOK - 1);
#endif
        return r < tval[u.pm] ? stok[tsrc[u.pm] + r] : 0; }
};
struct KsOne { __device__ __forceinline__ float operator()(int) const { return 1.f; } };
struct KsVec { const float* g; __device__ __forceinline__ float operator()(int k) const { return g[k]; } };
struct KsOut { const float* beta; __device__ __forceinline__ float operator()(int k) const { return k < DR ? 1.f : beta[k - DR]; } };
struct RmId { int off; __device__ __forceinline__ int operator()(int c) const { return off + c; } };
struct RmW1 { int e; __device__ __forceinline__ int operator()(int c) const { const int o = c >> 1, bj = c & 1; return e * 2048 + (o >> 7) * 256 + bj * 128 + (o & 127); } };
template <class KS, class RM>
__device__ __forceinline__ void tr_item(const float* src, int N, int k0, int c0, bf16_t* dst, int ldk, const KS ks, const RM rm, LAS float* scr, int lane) {
#pragma unroll 4
    for (int it = 0; it < 16; ++it) { const int r = it * 4 + (lane >> 4); const f32x4 v = *(const f32x4*)(src + (size_t)(k0 + r) * N + c0 + 4 * (lane & 15)); const float s = ks(k0 + r);
        LAS float* d = scr + r * 65 + 4 * (lane & 15); d[0] = v[0] * s; d[1] = v[1] * s; d[2] = v[2] * s; d[3] = v[3] * s; }
    LDS_WAIT();
    const int c = lane & 7;
#pragma unroll
    for (int jj = 0; jj < 8; ++jj) { const int n = (lane >> 3) + 8 * jj; const LAS float* s = scr + (8 * c) * 65 + n;
        u32x4 o; o.x = cvt_pk_bf16(s[0 * 65], s[1 * 65]); o.y = cvt_pk_bf16(s[2 * 65], s[3 * 65]); o.z = cvt_pk_bf16(s[4 * 65], s[5 * 65]); o.w = cvt_pk_bf16(s[6 * 65], s[7 * 65]);
        *(u32x4*)(dst + (size_t)rm(c0 + n) * ldk + k0 + 8 * c) = o; }
    LDS_WAIT();
}
struct CvItem { const float* src; int N, k0, c0; bf16_t* dst; int e; const float* ks; };
__device__ __forceinline__ void cv_item(const Params& p, int it, CvItem& c) {
    constexpr int I_1 = NE * 16 * 64;
    if (it < I_1) { const int e = it >> 10, q = it & 1023, kb = q >> 6, nb = q & 63; c.src = p.in[I_W1] + (size_t)e * DM * 2048; c.N = 2048; c.k0 = kb * 64; c.c0 = nb * 32; c.dst = (bf16_t*)(p.ws + WS_W1T); c.e = e; c.ks = p.in[I_N2G]; }
    else { const int r = it - I_1, e = r >> 9, q = r & 511, kb = q >> 5, nb = q & 31; c.src = p.in[I_W2] + (size_t)e * DFF * DM; c.N = DM; c.k0 = kb * 64; c.c0 = nb * 32; c.dst = (bf16_t*)(p.ws + WS_W2T); c.e = -(e * DM) - 1; c.ks = nullptr; }
}
__device__ __forceinline__ void cv_load(const CvItem& c, f32x4 (&v)[8], float (&s)[8], int lane) {
#pragma unroll
    for (int i = 0; i < 8; ++i) v[i] = __builtin_nontemporal_load((const f32x4*)(c.src + (size_t)(c.k0 + 8 * (lane >> 3) + i) * c.N + c.c0 + 4 * (lane & 7)));
    if (c.ks) { const f32x4 a = *(const f32x4*)(c.ks + c.k0 + 8 * (lane >> 3)), b = *(const f32x4*)(c.ks + c.k0 + 8 * (lane >> 3) + 4);
        s[0] = a[0]; s[1] = a[1]; s[2] = a[2]; s[3] = a[3]; s[4] = b[0]; s[5] = b[1]; s[6] = b[2]; s[7] = b[3]; }
    else {
#pragma unroll
        for (int i = 0; i < 8; ++i) s[i] = 1.0f; }
}
__device__ __forceinline__ void cv_emit(const CvItem& c0, const f32x4 (&v0)[8], const float (&s0)[8], LAS float*, int lane) {
#pragma unroll
    for (int j = 0; j < 4; ++j) { const int c = c0.c0 + 4 * (lane & 7) + j;
        u32x4 o; o.x = cvt_pk_bf16(v0[0][j] * s0[0], v0[1][j] * s0[1]); o.y = cvt_pk_bf16(v0[2][j] * s0[2], v0[3][j] * s0[3]); o.z = cvt_pk_bf16(v0[4][j] * s0[4], v0[5][j] * s0[5]); o.w = cvt_pk_bf16(v0[6][j] * s0[6], v0[7][j] * s0[7]);
        int row; if (c0.e >= 0) { const int oo = c >> 1, bj = c & 1; row = c0.e * 2048 + (oo >> 7) * 256 + bj * 128 + (oo & 127); } else row = -(c0.e + 1) + c;
        __builtin_nontemporal_store(o, (u32x4*)(c0.dst + (size_t)row * DM + c0.k0 + 8 * (lane >> 3))); }
}
constexpr int CV_NIT = NE * 16 * 64 + NE * 16 * 32;
constexpr int CV_A = 0, CV_B = 8192, CV_C = 40960;
__device__ __forceinline__ int cv_ticket(unsigned* ctr, int lane) { unsigned t = 0; if (lane == 0) t = __hip_atomic_fetch_add(ctr, 1u, __ATOMIC_RELAXED, __HIP_MEMORY_SCOPE_AGENT); return (int)__builtin_amdgcn_readfirstlane(t); }
template <int BATCH>
__device__ __forceinline__ void cv_queue(const Params& p, LAS float* scr, int lane, unsigned* ctr, const int lo, const int hi) {
    CvItem c0, c1, c2; f32x4 v0[8], v1[8], v2[8]; float s0[8], s1[8], s2[8];
    int tb = 0, tp = BATCH;
#define CV_NEXT() (tp == BATCH ? (tb = lo + cv_ticket(ctr, lane) * BATCH, tp = 1, tb) : tb + tp++)
    int i0 = CV_NEXT(), i1 = CV_NEXT();
    if (i0 >= hi) return;
    cv_item(p, i0, c0); cv_load(c0, v0, s0, lane);
    if (i1 < hi) { cv_item(p, i1, c1); cv_load(c1, v1, s1, lane); }
    for (;;) {
        const int i2 = CV_NEXT();
        if (i2 < hi) { cv_item(p, i2, c2); cv_load(c2, v2, s2, lane); }
        cv_emit(c0, v0, s0, scr, lane);
        if (i1 >= hi) break;
        c0 = c1; c1 = c2; i1 = i2;
#pragma unroll
        for (int i = 0; i < 8; ++i) { v0[i] = v1[i]; v1[i] = v2[i]; s0[i] = s1[i]; s1[i] = s2[i]; }
    }
}
__device__ __forceinline__ void p5_convert(const Params& p, LAS float* scr, int lane) {
    constexpr int per = (CV_C - CV_B) / 8; const int x = (int)blockIdx.x & 7;
    cv_queue<4>(p, scr, lane, (unsigned*)(p.ws + WS_CTL) + CW_CVT5 + x * 32, CV_B + x * per, CV_B + (x + 1) * per);
}
__device__ __forceinline__ void cv_tail(const Params& p, LAS unsigned char* lds, int wave, int lane, int cw, int lo, int n) {
    const int x = (int)blockIdx.x & 7, per = n >> 3; cv_queue<8>(p, (LAS float*)lds, lane, (unsigned*)(p.ws + WS_CTL) + cw + x * 32, lo + x * per, lo + (x + 1) * per); }
#undef CV_NEXT
__device__ __forceinline__ void p0_prologue(const Params& p, LAS unsigned char* lds, int wave, int lane) {
    unsigned char* ws = p.ws;
    LAS float* scr = (LAS float*)(lds + wave * 16640);
    const int gw = blockIdx.x * NWAVES + wave;
    bf16_t* WinT = (bf16_t*)(ws + WS_WINT); bf16_t* WoutT = (bf16_t*)(ws + WS_WOUTT); bf16_t* WgluT = (bf16_t*)(ws + WS_WGLUT);
    constexpr int I_IN = 16 * 36, I_OUT = 16 * 16, I_GLU = 8 * 8, NITEMS = I_IN + I_OUT + I_GLU;
    for (int it = gw; it < NITEMS; it += NGW) {
        int r = it;
        if (r < I_IN) { const int kb = r / 36, nb = r % 36; tr_item(p.in[I_WIN], DIN, kb * 64, nb * 64, WinT, DM, KsVec{p.in[I_N1G]}, RmId{0}, scr, lane); continue; } r -= I_IN;
        if (r < I_OUT) { const int kb = r >> 4, nb = r & 15; tr_item(p.in[I_WOUT], DM, kb * 64, nb * 64, WoutT, DM, KsOut{p.in[I_BETA]}, RmId{0}, scr, lane); continue; } r -= I_OUT;
        { const int kb = r >> 3, nb = r & 7; tr_item(p.in[I_WGLU], DSSM, kb * 64, nb * 64, WgluT, DSSM, KsOne{}, RmId{0}, scr, lane); }
    }
    { const float* x = p.in[I_X]; bf16_t* xb = (bf16_t*)(ws + WS_XB); float* rs = (float*)(ws + WS_RSTD1);
      for (int m0 = gw; m0 < NTOK; m0 += 4 * NGW) {
          f32x4 v[4][4];
#pragma unroll
          for (int q = 0; q < 4; ++q) { const f32x4* xr = (const f32x4*)(x + (size_t)(m0 + q * NGW) * DM) + lane;
#pragma unroll
              for (int j = 0; j < 4; ++j) v[q][j] = __builtin_nontemporal_load(xr + 64 * j); }
#pragma unroll
          for (int q = 0; q < 4; ++q) { const int m = m0 + q * NGW; float s = 0.f;
#pragma unroll
              for (int j = 0; j < 4; ++j) s += (v[q][j][0] * v[q][j][0] + v[q][j][1] * v[q][j][1]) + (v[q][j][2] * v[q][j][2] + v[q][j][3] * v[q][j][3]);
              s = wave_sum(s); if (lane == 0) rs[m] = 1.0f / sqrtf(s * (1.0f / DM) + 1e-5f);
              u32x2* o8 = (u32x2*)(xb + (size_t)m * DM) + lane;
#pragma unroll
              for (int j = 0; j < 4; ++j) { u32x2 w; w.x = cvt_pk_bf16(v[q][j][0], v[q][j][1]); w.y = cvt_pk_bf16(v[q][j][2], v[q][j][3]); o8[64 * j] = w; } } } }
    const int gt = blockIdx.x * (NWAVES * 64) + wave * 64 + lane, NT_ = GRID * NWAVES * 64;
    { float* b1g = (float*)(ws + WS_B1G); float* b1l = (float*)(ws + WS_B1L); const float* b1 = p.in[I_B1];
      bf16_t* rwh = (bf16_t*)(ws + WS_RWP); bf16_t* rwl = rwh + NE * DM; const float* rw = p.in[I_RW]; const float* g2 = p.in[I_N2G];
      bf16_t* LB = (bf16_t*)(ws + WS_LORAB); const float* wup = p.in[I_WUP]; const float* aup = p.in[I_AUP]; const float* gup = p.in[I_GUP];
      const bool small = gt < NE * DFF;
      float bg = 0.f, bl = 0.f, gk = 0.f, rwv = 0.f;
      if (small) { const int e = gt >> 10, o = gt & 1023; bg = b1[e * 2048 + 2 * o]; bl = b1[e * 2048 + 2 * o + 1]; gk = g2[o]; rwv = rw[o * NE + e]; }
      float v3[3];
#pragma unroll
      for (int q = 0; q < 3; ++q) { const int i = gt + q * NT_, n = i >> 8, k = i & 255; const float* src = nullptr;
          if (n < 512) { if (k < 64) src = wup + k * 512 + n; } else if (n < 1024) { if (k >= 64 && k < 128) src = aup + (k - 64) * 512 + (n - 512); } else { if (k >= 128) src = gup + (k - 128) * 512 + (n - 1024); }
          v3[q] = src ? *src : 0.f; }
      if (small) { b1g[gt] = bg; b1l[gt] = bl + 1.0f;
                   const float v = gk * rwv; const bf16_t h = f2bf(v); rwh[gt] = h; rwl[gt] = f2bf(v - bf2f(h)); }
#pragma unroll
      for (int q = 0; q < 3; ++q) LB[gt + q * NT_] = f2bf(v3[q]); }
}
__device__ __forceinline__ void p2_lora_in(const Params& p, int wave, int lane) {
    const bf16_t* proj = (const bf16_t*)(p.ws + WS_PROJ); bf16_t* li = (bf16_t*)(p.ws + WS_LORAIN); const float* mu = p.in[I_MU] + COL_LORA;
    const int gt = blockIdx.x * (NWAVES * 64) + wave * 64 + lane, NT_ = GRID * NWAVES * 64;
    const int c = (gt & 31) * 8;
    float muc[8];
#pragma unroll
    for (int j = 0; j < 8; ++j) muc[j] = mu[c + j];
    for (int idx0 = gt; idx0 < NTOK * 32; idx0 += 4 * NT_) {
        u32x4 cur[4], prv[4];
#pragma unroll
        for (int q4 = 0; q4 < 4; ++q4) { const int tok = (idx0 + q4 * NT_) >> 5; const bf16_t* pr = proj + (size_t)tok * DIN + COL_LORA + c; cur[q4] = *(const u32x4*)pr; prv[q4] = (u32x4){0u, 0u, 0u, 0u}; if (tok & (SEQ - 1)) prv[q4] = *(const u32x4*)(pr - DIN); }
#pragma unroll
        for (int q4 = 0; q4 < 4; ++q4) { const int tok = (idx0 + q4 * NT_) >> 5;
            float v[8], q[8];
            v[0] = bflo(cur[q4].x); v[1] = bfhi(cur[q4].x); v[2] = bflo(cur[q4].y); v[3] = bfhi(cur[q4].y); v[4] = bflo(cur[q4].z); v[5] = bfhi(cur[q4].z); v[6] = bflo(cur[q4].w); v[7] = bfhi(cur[q4].w);
            q[0] = bflo(prv[q4].x); q[1] = bfhi(prv[q4].x); q[2] = bflo(prv[q4].y); q[3] = bfhi(prv[q4].y); q[4] = bflo(prv[q4].z); q[5] = bfhi(prv[q4].z); q[6] = bflo(prv[q4].w); q[7] = bfhi(prv[q4].w);
#pragma unroll
            for (int j = 0; j < 8; ++j) { float s = v[j] + muc[j] * (q[j] - v[j]); if (c < 64) s = 1.0f - 2.0f * __builtin_amdgcn_rcpf(1.0f + __builtin_amdgcn_exp2f(2.8853900817779268f * s));   else if (c >= 128) s = sigmoidf_(s); v[j] = s; }
            u32x4 w; w.x = cvt_pk_bf16(v[0], v[1]); w.y = cvt_pk_bf16(v[2], v[3]); w.z = cvt_pk_bf16(v[4], v[5]); w.w = cvt_pk_bf16(v[6], v[7]);
            *(u32x4*)(li + (size_t)tok * 256 + c) = w; } }
}
template <int CTRL> __device__ __forceinline__ float dpp_mov(float x) { return __int_as_float(__builtin_amdgcn_update_dpp(0, __float_as_int(x), CTRL, 0xF, 0xF, true)); }
__device__ __forceinline__ float sum8(float x) { x += dpp_mov<0xB1>(x); x += dpp_mov<0x4E>(x); x += dpp_mov<0x141>(x); return x; }
__device__ __forceinline__ float rowsum16(float x) { x = sum8(x); x += dpp_mov<0x140>(x); return x; }
__device__ __forceinline__ void unpack8(const u32x4 w, float (&f)[8]) { f[0] = bflo(w.x); f[1] = bfhi(w.x); f[2] = bflo(w.y); f[3] = bfhi(w.y); f[4] = bflo(w.z); f[5] = bfhi(w.z); f[6] = bflo(w.w); f[7] = bfhi(w.w); }
__device__ __forceinline__ void ld8(const float* p_, float (&f)[8]) { const f32x4 a = *(const f32x4*)p_, b = *(const f32x4*)(p_ + 4); f[0] = a[0]; f[1] = a[1]; f[2] = a[2]; f[3] = a[3]; f[4] = b[0]; f[5] = b[1]; f[6] = b[2]; f[7] = b[3]; }
__device__ __forceinline__ float gelu_tanh(float y) { const float e = __builtin_amdgcn_exp2f(y * (-2.302208198144325f + -0.1029432395800235f * (y * y))); return y * __builtin_amdgcn_rcpf(1.0f + e); }
#define S5_ROLE(w, s) ((w) & 3)
#if !defined(S5_MAP)
#define S5_MAP 0
#endif
#if S5_MAP == 0
#define S5_SQ(w) ((w) >> 2)
#define S5_WQ(w) ((w) & 3)
#elif S5_MAP == 1
#define S5_SQ(w) (1 - ((w) >> 2))
#define S5_WQ(w) ((w) & 3)
#elif S5_MAP == 4
#define S5_SQ(w) ((w) >> 2)
#define S5_WQ(w) (((w) & 3) ^ ((w) >> 2))
#elif S5_MAP == 2
#define S5_SQ(w) ((w) >> 2)
#define S5_WQ(w) (3 - ((w) & 3))
#else
#define S5_SQ(w) ((w) & 1)
#define S5_WQ(w) ((w) >> 1)
#endif
#ifdef S5_DELAY_ROLE
#define S5_DELAY(w) do { if ((w) == S5_DELAY_ROLE) __builtin_amdgcn_s_sleep(4); } while (0)
#else
#define S5_DELAY(w) do { } while (0)
#endif
#ifdef S5_ONE
#undef S5_SQ
#undef S5_WQ
#define S5_SQ(w) 0
#define S5_WQ(w) ((w) < 2 ? 1 - (w) : (w))
__device__ __forceinline__ void s5_sync(const unsigned fbase, const int w, const int lane, const unsigned k) {
    asm volatile("s_waitcnt lgkmcnt(0)" ::: "memory");
    if (lane == 0) asm volatile("ds_write_b32 %0, %1" :: "v"(fbase + 4u * (unsigned)w), "v"(k) : "memory");
    for (;;) { u32x4 v; asm volatile("ds_read_b128 %0, %1\n\ts_waitcnt lgkmcnt(0)" : "=v"(v) : "v"(fbase) : "memory");
        const unsigned a = v.x < v.y ? v.x : v.y, b = v.z < v.w ? v.z : v.w, m = a < b ? a : b;
        if (__builtin_amdgcn_readfirstlane(m) >= k) break; }
}
#define S5_BARRIER() s5_sync(s5fl, wave, lane, ++s5n)
#elif defined(S5_SYNC)
#define S5_BARRIER() __syncthreads()
#else
#define S5_BARRIER() lds_barrier()
#endif
constexpr int S5_T = 32, S5_NT = SEQ / S5_T, S5_BU = S5_T * 64 * 8, S5_ST = S5_T * 272, S5_SEQB = 2 * S5_BU + 2 * S5_ST;
__device__ __forceinline__ void p5_s5(const Params& p, LAS unsigned char* lds, int wave, int lane, const int vf = 0) {
#ifdef S5_ONE
    const int sq = 0, wq = S5_WQ(wave), q = (int)blockIdx.x, b = q >> 5, g = q & 31;
    LAS unsigned char* L = lds + 65536;
    const unsigned s5fl = (unsigned)(size_t)(lds + MISC_OFF + 256); unsigned s5n = 0;
    if (wq == 0) __builtin_amdgcn_s_setprio(2);
#else
    const int sq = S5_SQ(wave), wq = S5_WQ(wave), q = (blockIdx.x - 128) * 2 + sq, b = q >> 5, g = q & 31;
    LAS unsigned char* L = lds + sq * 51200;
#endif
    const float dt = expf(p.in[I_LSTEP][g]);
    const bf16_t* ubase = (const bf16_t*)(p.ws + WS_PROJ) + (size_t)b * SEQ * DIN + COL_U + g * 16;
    bf16_t* yg = (bf16_t*)(p.ws + WS_YGELU) + (size_t)b * SEQ * DSSM + g * 16;
    f32x2 l1 = (f32x2){0.f, 0.f}, l2 = (f32x2){0.f, 0.f}, q1 = (f32x2){0.f, 0.f}, q2 = (f32x2){0.f, 0.f}, sv = (f32x2){0.f, 0.f};
    float lbr3[2] = {0.f, 0.f}, lbi3[2] = {0.f, 0.f};
    bf16x8 Bop[4], Bout[4], Dop; bf16x8 An[8], Un[8];
    const u32x4 z4 = (u32x4){0u, 0u, 0u, 0u};
    Dop = __builtin_bit_cast(bf16x8, z4);
#pragma unroll
    for (int k = 0; k < 4; ++k) Bop[k] = Bout[k] = __builtin_bit_cast(bf16x8, z4);
#pragma unroll
    for (int k = 0; k < 8; ++k) An[k] = Un[k] = __builtin_bit_cast(bf16x8, z4);
    const int rt3 = wq - 1;
    if (wq == 0) { const float lre = fminf(p.in[I_LRE][g * 64 + lane], -1e-4f), lim = p.in[I_LIM][g * 64 + lane]; const float mag = expf(lre * dt), ang = lim * dt; const float lbr = mag * cosf(ang), lbi = mag * sinf(ang);
        l1 = (f32x2){lbr, lbr}; l2 = (f32x2){-lbi, lbi}; const float sr = lbr * lbr - lbi * lbi, si = 2.0f * lbr * lbi; q1 = (f32x2){sr, sr}; q2 = (f32x2){-si, si}; }
    else if (wq == 3) {
#pragma unroll
        for (int hh = 0; hh < 2; ++hh) { const int pp = 32 * hh + (lane & 31); const float lre = fminf(p.in[I_LRE][g * 64 + pp], -1e-4f), lim = p.in[I_LIM][g * 64 + pp]; const float mag = expf(lre * dt), ang = lim * dt;
            lbr3[hh] = mag * cosf(ang); lbi3[hh] = mag * sinf(ang); }
#pragma unroll
        for (int ct = 0; ct < 4; ++ct) { const int c = 32 * ct + (lane & 31), pp = c & 63, isim = c >> 6; const float lre = fminf(p.in[I_LRE][g * 64 + pp], -1e-4f), lim = p.in[I_LIM][g * 64 + pp];
            const float mag = expf(lre * dt), ang = lim * dt, cr = mag * cosf(ang), ci = mag * sinf(ang), den = lre * lre + lim * lim, nre = cr - 1.0f;
            const float zre = (nre * lre + ci * lim) / den, zim = (ci * lre - nre * lim) / den;
            const float* bre = p.in[I_BRE] + (size_t)(g * 64 + pp) * 16 + 8 * (lane >> 5); const float* bim = p.in[I_BIM] + (size_t)(g * 64 + pp) * 16 + 8 * (lane >> 5);
            float t[8];
#pragma unroll
            for (int jj = 0; jj < 8; ++jj) t[jj] = isim ? (zre * bim[jj] + zim * bre[jj]) : (zre * bre[jj] - zim * bim[jj]);
            u32x4 w; w.x = cvt_pk_bf16(t[0], t[1]); w.y = cvt_pk_bf16(t[2], t[3]); w.z = cvt_pk_bf16(t[4], t[5]); w.w = cvt_pk_bf16(t[6], t[7]); Bop[ct] = __builtin_bit_cast(bf16x8, w); }
#pragma unroll
        for (int k = 0; k < 8; ++k) An[k] = *(const bf16x8*)(ubase + (size_t)(k * S5_T + (lane & 31)) * DIN + 8 * (lane >> 5)); }
    else { const int m = lane & 15;
#pragma unroll
        for (int ks = 0; ks < 4; ++ks) { float t[8];
#pragma unroll
            for (int jj = 0; jj < 8; ++jj) { const int k = 32 * ks + 8 * (lane >> 4) + jj, pp = k >> 1; t[jj] = (k & 1) ? -p.in[I_CIM][(size_t)(g * 16 + m) * 64 + pp] : p.in[I_CRE][(size_t)(g * 16 + m) * 64 + pp]; }
            u32x4 w; w.x = cvt_pk_bf16(t[0], t[1]); w.y = cvt_pk_bf16(t[2], t[3]); w.z = cvt_pk_bf16(t[4], t[5]); w.w = cvt_pk_bf16(t[6], t[7]); Bout[ks] = __builtin_bit_cast(bf16x8, w); }
        { const float dsk = p.in[I_DSKIP][g * 16 + m]; float t[8];
#pragma unroll
          for (int jj = 0; jj < 8; ++jj) t[jj] = (8 * (lane >> 4) + jj == m) ? dsk : 0.f;
          u32x4 w; w.x = cvt_pk_bf16(t[0], t[1]); w.y = cvt_pk_bf16(t[2], t[3]); w.z = cvt_pk_bf16(t[4], t[5]); w.w = cvt_pk_bf16(t[6], t[7]); Dop = __builtin_bit_cast(bf16x8, w); }
        if (lane < 32) {
#pragma unroll
            for (int k = 0; k < 8; ++k) Un[k] = *(const bf16x8*)(ubase + (size_t)(k * S5_T + 16 * rt3 + (lane & 15)) * DIN + 8 * (lane >> 4)); } }
    const f32x16 z16 = {0.f, 0.f, 0.f, 0.f, 0.f, 0.f, 0.f, 0.f, 0.f, 0.f, 0.f, 0.f, 0.f, 0.f, 0.f, 0.f};
#ifdef PROBE_S5
#define S5_SKIP(b) if (vf & (b)) break;
#else
#define S5_SKIP(b)
#endif
#define S5_STAGE1(tileidx, sl) do { S5_SKIP(4) LAS float* bu_ = (LAS float*)(L + ((tileidx) & 1) * S5_BU); \
        _Pragma("unroll") for (int hh = 0; hh < 2; ++hh) { const f32x16 dre = __builtin_amdgcn_mfma_f32_32x32x16_bf16(An[sl], Bop[hh], z16, 0, 0, 0), dim = __builtin_amdgcn_mfma_f32_32x32x16_bf16(An[sl], Bop[hh + 2], z16, 0, 0, 0); const int pp = 32 * hh + (lane & 31); \
            _Pragma("unroll") for (int r = 0; r < 16; r += 2) { const int rw = (r & 3) + 8 * (r >> 2) + 4 * (lane >> 5);     \
                const float yre = lbr3[hh] * dre[r] + (dre[r + 1] - lbi3[hh] * dim[r]), yim = lbr3[hh] * dim[r] + (dim[r + 1] + lbi3[hh] * dre[r]); \
                *(LAS f32x2*)(bu_ + (rw * 64 + pp) * 2) = (f32x2){dre[r], dim[r]}; *(LAS f32x2*)(bu_ + ((rw + 1) * 64 + pp) * 2) = (f32x2){yre, yim}; } }     \
        } while (0)
#define S5_LD1(sl, t) do { const int tn_ = (t) < S5_NT ? (t) : S5_NT - 1; An[sl] = *(const bf16x8*)(ubase + (size_t)(tn_ * S5_T + (lane & 31)) * DIN + 8 * (lane >> 5)); } while (0)
#define S5_STAGE3(tileidx, sl) do { S5_SKIP(8) const LAS unsigned char* st_ = L + 2 * S5_BU + ((tileidx) & 1) * S5_ST; \
        f32x4 acc = __builtin_amdgcn_mfma_f32_16x16x32_bf16(Un[sl], Dop, (f32x4){0.f, 0.f, 0.f, 0.f}, 0, 0, 0); \
        _Pragma("unroll") for (int ks = 0; ks < 4; ++ks) { const bf16x8 a = *(const LAS bf16x8*)(st_ + (16 * rt3 + (lane & 15)) * 272 + (32 * ks + 8 * (lane >> 4)) * 2); acc = __builtin_amdgcn_mfma_f32_16x16x32_bf16(a, Bout[ks], acc, 0, 0, 0); } \
        _Pragma("unroll") for (int r = 0; r < 4; ++r) { const int tok = (tileidx) * S5_T + 16 * rt3 + 4 * (lane >> 4) + r; yg[(size_t)tok * DSSM + (lane & 15)] = f2bf(gelu_tanh(acc[r])); } } while (0)
#define S5_LD3(sl, t) do { const int tn_ = (t) < S5_NT ? (t) : S5_NT - 1; if (lane < 32) Un[sl] = *(const bf16x8*)(ubase + (size_t)(tn_ * S5_T + 16 * rt3 + (lane & 15)) * DIN + 8 * (lane >> 4)); } while (0)
#define S5_CMA(l1_, l2_, v_, c_) ((l2_) * __builtin_shufflevector((v_), (v_), 1, 0) + ((l1_) * (v_) + (c_)))
#define S5_PAIR(xa_, xb_, t_) do { const f32x2 s1_ = S5_CMA(l1, l2, sv, (xa_)); sv = S5_CMA(q1, q2, sv, (xb_));     \
        *(LAS unsigned*)(st_ + (t_) * 272 + lane * 4) = cvt_pk_bf16(s1_.x, s1_.y); *(LAS unsigned*)(st_ + ((t_) + 1) * 272 + lane * 4) = cvt_pk_bf16(sv.x, sv.y); } while (0)
#define S5_SCAN(ii) do { S5_SKIP(16) const LAS float* bu_ = (const LAS float*)(L + ((ii) & 1) * S5_BU); LAS unsigned char* st_ = L + 2 * S5_BU + ((ii) & 1) * S5_ST; \
            f32x2 xa[16], xb[16];     \
            _Pragma("unroll") for (int t = 0; t < 16; ++t) xa[t] = *(const LAS f32x2*)(bu_ + (t * 64 + lane) * 2); \
            __builtin_amdgcn_sched_barrier(0); \
            _Pragma("unroll") for (int t = 0; t < 8; t += 2) S5_PAIR(xa[t], xa[t + 1], t); \
            __builtin_amdgcn_sched_barrier(0); \
            _Pragma("unroll") for (int t = 0; t < 16; ++t) xb[t] = *(const LAS f32x2*)(bu_ + ((16 + t) * 64 + lane) * 2); \
            __builtin_amdgcn_sched_barrier(0); \
            _Pragma("unroll") for (int t = 8; t < 16; t += 2) S5_PAIR(xa[t], xa[t + 1], t); \
            _Pragma("unroll") for (int t = 0; t < 16; t += 2) S5_PAIR(xb[t], xb[t + 1], 16 + t); } while (0)
    if (wq == 3) S5_STAGE1(0, 0);
    S5_BARRIER();
#define BAR_ S5_BARRIER()
    if (wq == 0) { for (int i = 0; i < S5_NT; ++i) { S5_SCAN(i); BAR_; } }
    else if (wq == 3) {
        for (int t0 = 0; t0 < S5_NT - 8; t0 += 8) {
            S5_STAGE1(t0 + 1, 1); BAR_; S5_STAGE1(t0 + 2, 2); BAR_;
            S5_LD1(6, t0 + 6); S5_LD1(7, t0 + 7); S5_LD1(0, t0 + 8); S5_LD1(1, t0 + 9); S5_LD1(2, t0 + 10);
            S5_STAGE1(t0 + 3, 3); BAR_; S5_STAGE1(t0 + 4, 4); BAR_; S5_STAGE1(t0 + 5, 5); BAR_;
            S5_LD1(3, t0 + 11); S5_LD1(4, t0 + 12); S5_LD1(5, t0 + 13);
            S5_STAGE1(t0 + 6, 6); BAR_; S5_STAGE1(t0 + 7, 7); BAR_; S5_STAGE1(t0 + 8, 0); BAR_; }
        { constexpr int t0 = S5_NT - 8;
            S5_STAGE1(t0 + 1, 1); BAR_; S5_STAGE1(t0 + 2, 2); BAR_; S5_LD1(6, t0 + 6); S5_LD1(7, t0 + 7);
            S5_STAGE1(t0 + 3, 3); BAR_; S5_STAGE1(t0 + 4, 4); BAR_; S5_STAGE1(t0 + 5, 5); BAR_; S5_STAGE1(t0 + 6, 6); BAR_; S5_STAGE1(t0 + 7, 7); BAR_; BAR_; } }
    else {
        BAR_;
        for (int t0 = 0; t0 < S5_NT - 8; t0 += 8) {
            S5_STAGE3(t0, 0); BAR_; S5_STAGE3(t0 + 1, 1); BAR_;
            S5_LD3(5, t0 + 5); S5_LD3(6, t0 + 6); S5_LD3(7, t0 + 7); S5_LD3(0, t0 + 8); S5_LD3(1, t0 + 9);
            S5_STAGE3(t0 + 2, 2); BAR_; S5_STAGE3(t0 + 3, 3); BAR_; S5_STAGE3(t0 + 4, 4); BAR_;
            S5_LD3(2, t0 + 10); S5_LD3(3, t0 + 11); S5_LD3(4, t0 + 12);
            S5_STAGE3(t0 + 5, 5); BAR_; S5_STAGE3(t0 + 6, 6); BAR_; S5_STAGE3(t0 + 7, 7); BAR_; }
        { constexpr int t0 = S5_NT - 8;
            S5_STAGE3(t0, 0); BAR_; S5_STAGE3(t0 + 1, 1); BAR_; S5_LD3(5, t0 + 5); S5_LD3(6, t0 + 6); S5_LD3(7, t0 + 7);
            S5_STAGE3(t0 + 2, 2); BAR_; S5_STAGE3(t0 + 3, 3); BAR_; S5_STAGE3(t0 + 4, 4); BAR_; S5_STAGE3(t0 + 5, 5); BAR_; S5_STAGE3(t0 + 6, 6); BAR_; S5_STAGE3(t0 + 7, 7); } }
#undef BAR_
#undef S5_LD1
#undef S5_LD3
#undef S5_SCAN
#undef S5_PAIR
#undef S5_CMA
#ifdef S5_ONE
    __builtin_amdgcn_s_setprio(0);
#endif
#undef S5_ITER
#undef S5_STAGE1
#undef S5_STAGE3
}
struct P7In { f32x4 s0, s1; float rk; u32x4 yr, yg, cv, qv, gg; };
__device__ __forceinline__ void p7_load(P7In& in, const bf16_t* yraw, const bf16_t* proj, const float* rkb, const bf16_t* lg, const bf16_t* yglu, const float* ssq, int tok, int lane) {
    const int c0 = lane * 8, h = lane >> 3;
    in.yr = __builtin_nontemporal_load((const u32x4*)(yraw + (size_t)tok * DR + c0));
    { const bf16_t* pv = proj + (size_t)tok * DIN + COL_V + c0; in.cv = __builtin_nontemporal_load((const u32x4*)pv); in.qv = (tok & (SEQ - 1)) ? *(const u32x4*)(pv - DIN) : (u32x4){0u, 0u, 0u, 0u}; in.rk = rkb[(size_t)tok * NH + h]; }
    in.gg = __builtin_nontemporal_load((const u32x4*)(lg + (size_t)tok * DR + c0));
    in.s0 = *(const f32x4*)(ssq + (size_t)tok * 8); in.s1 = *(const f32x4*)(ssq + (size_t)tok * 8 + 4);
    in.yg = __builtin_nontemporal_load((const u32x4*)(yglu + (size_t)tok * DSSM + c0));
}
__device__ __forceinline__ void p7_mix(const Params& p, int wave, int lane) {
    const bf16_t* yraw = (const bf16_t*)(p.ws + WS_YRAW); const bf16_t* proj = (const bf16_t*)(p.ws + WS_PROJ); const float* rkb = (const float*)(p.ws + WS_RKB); const bf16_t* lg = (const bf16_t*)(p.ws + WS_LORAG); bf16_t* mixed = (bf16_t*)(p.ws + WS_MIXED);
    const bf16_t* yglu = (const bf16_t*)(p.ws + WS_YGLU); const float* ssq = (const float*)(p.ws + WS_SSQ);
    const int c0 = lane * 8;
    float lnw[8], lnb[8], muv[8]; ld8(p.in[I_LNW] + c0, lnw); ld8(p.in[I_LNB] + c0, lnb); ld8(p.in[I_MU] + COL_V + c0, muv);
    const int gw = blockIdx.x * NWAVES + wave;
    P7In cur, nxt; p7_load(cur, yraw, proj, rkb, lg, yglu, ssq, gw, lane);
    for (int tok = gw; tok < NTOK; tok += NGW) {
        if (tok + NGW < NTOK) p7_load(nxt, yraw, proj, rkb, lg, yglu, ssq, tok + NGW, lane);
        float y[8], v[8], g[8], o[8], cvv[8], qvv[8]; unpack8(cur.cv, cvv); unpack8(cur.qv, qvv); unpack8(cur.gg, g); unpack8(cur.yr, y);
#pragma unroll
        for (int j = 0; j < 8; ++j) v[j] = cvv[j] + muv[j] * (qvv[j] - cvv[j]);
        float sm = 0.f;
#pragma unroll
        for (int j = 0; j < 8; ++j) sm += y[j];
        const float mu = sum8(sm) * (1.0f / 64.0f); float sq = 0.f;
#pragma unroll
        for (int j = 0; j < 8; ++j) { y[j] -= mu; sq += y[j] * y[j]; }
        const float rstd = 1.0f / sqrtf(sum8(sq) * (1.0f / 64.0f) + 64e-5f);
#pragma unroll
        for (int j = 0; j < 8; ++j) { o[j] = (y[j] * rstd * lnw[j] + lnb[j] + cur.rk * v[j]) * g[j];
#ifdef SCRUB7
            o[j] = (o[j] == o[j] && fabsf(o[j]) < 1e30f) ? o[j] : 0.f;
#endif
        }
        u32x4 w; w.x = cvt_pk_bf16(o[0], o[1]); w.y = cvt_pk_bf16(o[2], o[3]); w.z = cvt_pk_bf16(o[4], o[5]); w.w = cvt_pk_bf16(o[6], o[7]);
        *(u32x4*)(mixed + (size_t)tok * DM + c0) = w;
        const float ss = ((cur.s0[0] + cur.s0[1]) + (cur.s0[2] + cur.s0[3])) + ((cur.s1[0] + cur.s1[1]) + (cur.s1[2] + cur.s1[3])); const float rs = 1.0f / sqrtf(ss * (1.0f / DSSM) + 1e-5f);
        float yv[8]; unpack8(cur.yg, yv);
        u32x4 w2; w2.x = cvt_pk_bf16(yv[0] * rs, yv[1] * rs); w2.y = cvt_pk_bf16(yv[2] * rs, yv[3] * rs); w2.z = cvt_pk_bf16(yv[4] * rs, yv[5] * rs); w2.w = cvt_pk_bf16(yv[6] * rs, yv[7] * rs);
        *(u32x4*)(mixed + (size_t)tok * DM + DR + c0) = w2;
        cur = nxt;
    }
}
constexpr int CT = 72;
constexpr int SLOT = 64 * CT * 2;
constexpr int SL_AH = 0, SL_BH = 1, SL_KH = 2, SL_RH = 3, SL_AHT = 4, SL_BTT = 5, SL_KTT = 6, SL_VT = 7, SL_PA = 8, SL_PAT = 9, SL_TA = 10, SL_AAK = 11, SL_ARB = 12, SL_ARK = 13, SL_XT = 14, SL_UVT = 15;
constexpr int SL_PB = 0, SL_PBT = 1, SL_TB = 2, SL_WT = 11;
constexpr int LC_OFF = SL_PA * SLOT, TOT_OFF = LC_OFF + 64 * 64 * 4;
constexpr int GT_OFF = 16 * SLOT;
constexpr int PC_OFF = GT_OFF + 256;
__device__ __forceinline__ LAS bf16_t* slot(LAS unsigned char* lds, int s) { return (LAS bf16_t*)(lds + s * SLOT); }
template <bool TR> __device__ __forceinline__ void mm2(const LAS bf16_t* X, const LAS bf16_t* YT, int mi, int ni0, int lane, f32x4 (&acc)[2]) {
    const int fr = lane & 15, fq = lane >> 4;
#pragma unroll
    for (int ks = 0; ks < 2; ++ks) { const bf16x8 a = *(const LAS bf16x8*)(X + (16 * mi + fr) * CT + 32 * ks + 8 * fq);
#pragma unroll
        for (int t = 0; t < 2; ++t) { const bf16x8 b = *(const LAS bf16x8*)(YT + (16 * (ni0 + t) + fr) * CT + 32 * ks + 8 * fq);
            acc[t] = TR ? __builtin_amdgcn_mfma_f32_16x16x32_bf16(a, b, acc[t], 0, 0, 0) : __builtin_amdgcn_mfma_f32_16x16x32_bf16(b, a, acc[t], 0, 0, 0); } }
}
__device__ __forceinline__ void ldA(const LAS bf16_t* X, int mi, int lane, bf16x8 (&a)[2]) {
#pragma unroll
    for (int ks = 0; ks < 2; ++ks) a[ks] = *(const LAS bf16x8*)(X + (16 * mi + (lane & 15)) * CT + 32 * ks + 8 * (lane >> 4)); }
__device__ __forceinline__ void ldB(const LAS bf16_t* YT, int ni0, int lane, bf16x8 (&b)[2][2]) {
#pragma unroll
    for (int t = 0; t < 2; ++t)
#pragma unroll
        for (int ks = 0; ks < 2; ++ks) b[t][ks] = *(const LAS bf16x8*)(YT + (16 * (ni0 + t) + (lane & 15)) * CT + 32 * ks + 8 * (lane >> 4)); }
template <bool TR> __device__ __forceinline__ void mma(const bf16x8 (&a)[2], const bf16x8 (&b)[2][2], f32x4 (&acc)[2]) {
#pragma unroll
    for (int ks = 0; ks < 2; ++ks)
#pragma unroll
        for (int t = 0; t < 2; ++t) acc[t] = TR ? __builtin_amdgcn_mfma_f32_16x16x32_bf16(a[ks], b[t][ks], acc[t], 0, 0, 0) : __builtin_amdgcn_mfma_f32_16x16x32_bf16(b[t][ks], a[ks], acc[t], 0, 0, 0); }
#define ZACC(x) x[0] = x[1] = (f32x4){0.f, 0.f, 0.f, 0.f}
__device__ __forceinline__ void st_rm(LAS bf16_t* Z, int mi, int ni, int lane, const f32x4 v) { u32x2 w; w.x = cvt_pk_bf16(v[0], v[1]); w.y = cvt_pk_bf16(v[2], v[3]); *(LAS u32x2*)(Z + (16 * mi + (lane & 15)) * CT + 16 * ni + 4 * (lane >> 4)) = w; }
__device__ __forceinline__ void st_tr(LAS bf16_t* ZT, int mi, int ni, int lane, const f32x4 v) {
#pragma unroll
    for (int r = 0; r < 4; ++r) ZT[(16 * ni + 4 * (lane >> 4) + r) * CT + 16 * mi + (lane & 15)] = f2bf(v[r]); }
__device__ __forceinline__ void st_trT(LAS bf16_t* ZT, int mi, int ni, int lane, const f32x4 v) { u32x2 w; w.x = cvt_pk_bf16(v[0], v[1]); w.y = cvt_pk_bf16(v[2], v[3]); *(LAS u32x2*)(ZT + (16 * ni + (lane & 15)) * CT + 16 * mi + 4 * (lane >> 4)) = w; }
__device__ __forceinline__ void ld8l(const LAS float* s, float (&d)[8]) { const f32x4 a = *(const LAS f32x4*)s, b = *(const LAS f32x4*)(s + 4); d[0] = a[0]; d[1] = a[1]; d[2] = a[2]; d[3] = a[3]; d[4] = b[0]; d[5] = b[1]; d[6] = b[2]; d[7] = b[3]; }
struct PaIn { u32x4 cr, ck, cv, qr, qk, qv, ap; float lwr[8]; };
__device__ __forceinline__ void pa_load(PaIn& in, const bf16_t* proj, const bf16_t* la, const float* lw, int job, int wave, int lane) {
    const int bh = job >> 6, c = job & 63, b = bh >> 3, h = bh & 7; const int tok0 = b * SEQ + c * 64;
    { const int t = wave * 8 + (lane >> 3), cg = lane & 7, tok = tok0 + t; const bf16_t* row = proj + (size_t)tok * DIN + h * HD + cg * 8; const bool first = (c == 0 && t == 0); const u32x4 z = (u32x4){0u, 0u, 0u, 0u};
      in.cr = *(const u32x4*)row; in.ck = *(const u32x4*)(row + COL_K); in.cv = *(const u32x4*)(row + COL_V);
      in.qr = first ? z : *(const u32x4*)(row - DIN); in.qk = first ? z : *(const u32x4*)(row - DIN + COL_K); in.qv = first ? z : *(const u32x4*)(row - DIN + COL_V);
      in.ap = *(const u32x4*)(la + (size_t)tok * DR + h * HD + cg * 8); }
#pragma unroll
    for (int i = 0; i < 8; ++i) in.lwr[i] = lw[(size_t)(tok0 + wave * 8 + i) * DR + h * HD + lane];
}
__device__ __forceinline__ float logdecay(float x) { return -0.6065306597126334f * sigmoidf_(x); }
__device__ __forceinline__ void p4_chunks(const Params& p, LAS unsigned char* lds, int wave, int lane, const int vflags) {
    const bf16_t* proj = (const bf16_t*)(p.ws + WS_PROJ); const float* lwp = (const float*)(p.ws + WS_LORAW); const bf16_t* lap = (const bf16_t*)(p.ws + WS_LORAA);
    bf16_t* QP = (bf16_t*)(p.ws + WS_QP); bf16_t* YG = (bf16_t*)(p.ws + WS_YG); float* rkb = (float*)(p.ws + WS_RKB);
    LAS float* lct = (LAS float*)(lds + LC_OFF); LAS float* tot = (LAS float*)(lds + TOT_OFF); LAS float* gtab = (LAS float*)(lds + GT_OFF); LAS bf16_t* ewt = slot(lds, SL_TA);
    const int mi = wave >> 1, ni0 = (wave & 1) * 2, fr = lane & 15, fq = lane >> 4;
    PaIn in; pa_load(in, proj, lap, lwp, blockIdx.x, wave, lane);
    bf16x8 aI[2];
    { const int m = 16 * (wave >> 1) + (lane & 15);
#pragma unroll
      for (int ks = 0; ks < 2; ++ks) { u32x4 w = (u32x4){0u, 0u, 0u, 0u}; const int e = m - 32 * ks - 8 * (lane >> 4);
          if (e >= 0 && e < 8) { const unsigned one = (e & 1) ? 0x3F800000u : 0x00003F80u; if ((e >> 1) == 0) w.x = one; else if ((e >> 1) == 1) w.y = one; else if ((e >> 1) == 2) w.z = one; else w.w = one; }
          aI[ks] = __builtin_bit_cast(bf16x8, w); } }
    LAS float* pcs = (LAS float*)(lds + PC_OFF);
    { const int tid = wave * 64 + lane;
#pragma unroll
      for (int q = 0; q < 2; ++q) { const int e = tid + q * 512, hs = e >> 9, ar = (e >> 6) & 7, k = e & 63, hh = (int)(blockIdx.x >> 6) + 4 * hs, col = hh * HD + k;
          const float* src = ar == 0 ? p.in[I_W0] + col : ar == 1 ? p.in[I_MU] + col : ar == 2 ? p.in[I_MU] + COL_K + col : ar == 3 ? p.in[I_MU] + COL_V + col : ar == 4 ? p.in[I_KK] + col : ar == 5 ? p.in[I_KA] + col : ar == 6 ? p.in[I_RK] + col : p.in[I_A0] + col;
          pcs[e] = *src; } }
    lds_barrier();
    for (int job = blockIdx.x; job < 64 * 64; job += GRID) {
        const int bh = job >> 6, c = job & 63, b = bh >> 3, h = bh & 7; const int tok0 = b * SEQ + c * 64;
        const LAS float* pch = pcs + (h >> 2) * 512;
        { const float w0k = pch[lane]; float pre[8]; float run = 0.f;
#pragma unroll
          for (int i = 0; i < 8; ++i) { const float lw_ = logdecay(w0k + in.lwr[i]); run += lw_; pre[i] = run; ewt[(wave * 8 + i) * 64 + lane] = f2bf(__expf(-lw_)); }
          tot[wave * 64 + lane] = run;
          lds_barrier();
          float off = 0.f;
#pragma unroll
          for (int w2 = 0; w2 < 7; ++w2) off += (w2 < wave) ? tot[w2 * 64 + lane] : 0.f;
#pragma unroll
          for (int i = 0; i < 8; ++i) lct[(wave * 8 + i) * 64 + lane] = off + pre[i];
          if (wave == 7) gtab[lane] = __expf(off + pre[7]); }
        lds_barrier();
        { const int t = wave * 8 + (lane >> 3), cg = lane & 7, k0 = cg * 8, col = h * HD + k0;
          float cr[8], ck[8], cv[8], qr[8], qk[8], qv[8], lc[8], gc[8], mur[8], muk[8], muv[8], kkw[8], kaw[8], rkw[8], a0c[8];
          unpack8(in.cr, cr); unpack8(in.ck, ck); unpack8(in.cv, cv); unpack8(in.qr, qr); unpack8(in.qk, qk); unpack8(in.qv, qv);
          { const f32x4 x0 = *(const LAS f32x4*)(lct + t * 64 + k0), x1 = *(const LAS f32x4*)(lct + t * 64 + k0 + 4), g0 = *(const LAS f32x4*)(gtab + k0), g1 = *(const LAS f32x4*)(gtab + k0 + 4);
#pragma unroll
            for (int j = 0; j < 4; ++j) { lc[j] = x0[j]; lc[j + 4] = x1[j]; gc[j] = g0[j]; gc[j + 4] = g1[j]; } }
          ld8l(pch + 64 + k0, mur); ld8l(pch + 128 + k0, muk); ld8l(pch + 192 + k0, muv); ld8l(pch + 256 + k0, kkw); ld8l(pch + 320 + k0, kaw); ld8l(pch + 384 + k0, rkw); ld8l(pch + 448 + k0, a0c);
          float ah[8], bh_[8], kh[8], rh[8], bt[8], kt[8], vv[8], kk[8], ew[8], apv[8]; float n2 = 0.f, rk = 0.f; unpack8(in.ap, apv);
          unpack8(*(const LAS u32x4*)(ewt + t * 64 + k0), ew);
#pragma unroll
          for (int j = 0; j < 8; ++j) { const float r = cr[j] + mur[j] * (qr[j] - cr[j]), kraw = ck[j] + muk[j] * (qk[j] - ck[j]); vv[j] = cv[j] + muv[j] * (qv[j] - cv[j]);
              const float ap = apv[j];
              const float a = sigmoidf_(a0c[j] + ap);
              kk[j] = kraw * kkw[j]; n2 += kk[j] * kk[j]; const float km = kraw * (1.0f + (a - 1.0f) * kaw[j]); rk += r * km * rkw[j];
              const float e1 = __expf(lc[j]), e2 = __builtin_amdgcn_rcpf(e1), g = gc[j];
              rh[j] = r * e1; kh[j] = km * e2; kt[j] = kh[j] * g; ah[j] = -e1 * ew[j]; bh_[j] = a * e2; bt[j] = g; }
          n2 = sum8(n2); rk = sum8(rk);
          const float inv = 1.0f / fmaxf(sqrtf(n2), 1e-12f);
#pragma unroll
          for (int j = 0; j < 8; ++j) { const float kn = kk[j] * inv; ah[j] *= kn; bh_[j] *= kn; bt[j] *= bh_[j]; }
          if (cg == 0) rkb[(size_t)(tok0 + t) * NH + h] = rk;
          u32x4 w;
          w.x = cvt_pk_bf16(ah[0], ah[1]); w.y = cvt_pk_bf16(ah[2], ah[3]); w.z = cvt_pk_bf16(ah[4], ah[5]); w.w = cvt_pk_bf16(ah[6], ah[7]); *(LAS u32x4*)(slot(lds, SL_AH) + t * CT + k0) = w;
          w.x = cvt_pk_bf16(bh_[0], bh_[1]); w.y = cvt_pk_bf16(bh_[2], bh_[3]); w.z = cvt_pk_bf16(bh_[4], bh_[5]); w.w = cvt_pk_bf16(bh_[6], bh_[7]); *(LAS u32x4*)(slot(lds, SL_BH) + t * CT + k0) = w;
          w.x = cvt_pk_bf16(kh[0], kh[1]); w.y = cvt_pk_bf16(kh[2], kh[3]); w.z = cvt_pk_bf16(kh[4], kh[5]); w.w = cvt_pk_bf16(kh[6], kh[7]); *(LAS u32x4*)(slot(lds, SL_KH) + t * CT + k0) = w;
          w.x = cvt_pk_bf16(rh[0], rh[1]); w.y = cvt_pk_bf16(rh[2], rh[3]); w.z = cvt_pk_bf16(rh[4], rh[5]); w.w = cvt_pk_bf16(rh[6], rh[7]); *(LAS u32x4*)(slot(lds, SL_RH) + t * CT + k0) = w;
          w.x = cvt_pk_bf16(bt[0], bt[1]); w.y = cvt_pk_bf16(bt[2], bt[3]); w.z = cvt_pk_bf16(bt[4], bt[5]); w.w = cvt_pk_bf16(bt[6], bt[7]); *(LAS u32x4*)(slot(lds, SL_BTT) + t * CT + k0) = w;
          w.x = cvt_pk_bf16(kt[0], kt[1]); w.y = cvt_pk_bf16(kt[2], kt[3]); w.z = cvt_pk_bf16(kt[4], kt[5]); w.w = cvt_pk_bf16(kt[6], kt[7]); *(LAS u32x4*)(slot(lds, SL_KTT) + t * CT + k0) = w;
          w.x = cvt_pk_bf16(vv[0], vv[1]); w.y = cvt_pk_bf16(vv[2], vv[3]); w.z = cvt_pk_bf16(vv[4], vv[5]); w.w = cvt_pk_bf16(vv[6], vv[7]); *(LAS u32x4*)(slot(lds, SL_XT) + t * CT + k0) = w; }
        if (job + GRID < 64 * 64) pa_load(in, proj, lap, lwp, job + GRID, wave, lane);
        lds_barrier();
#ifdef PROBE_VPHASE
        if (vflags & 4) { lds_barrier(); continue; }
#endif
        f32x4 accT[2]; ZACC(accT);
#ifdef PROBE_VPHASE
        if (!(vflags & 32))
#endif
        { bf16x8 aA[2], aR[2], bB[2][2], bK[2][2]; ldA(slot(lds, SL_AH), mi, lane, aA); ldA(slot(lds, SL_RH), mi, lane, aR); ldB(slot(lds, SL_BH), ni0, lane, bB); ldB(slot(lds, SL_KH), ni0, lane, bK);
          f32x4 c1[2], c2[2], c3[2], c4[2]; ZACC(c1); ZACC(c2); ZACC(c3); ZACC(c4);
          mma<false>(aA, bB, c1); mma<false>(aA, bK, c2); mma<false>(aR, bB, c3); mma<false>(aR, bK, c4);
          { bf16x8 bA2[2][2], bV2[2][2]; ldB(slot(lds, SL_AH), ni0, lane, bA2); ldB(slot(lds, SL_XT), ni0, lane, bV2); f32x4 t1[2], t2[2]; ZACC(t1); ZACC(t2); mma<false>(aI, bA2, t1); mma<false>(aI, bV2, t2);
#pragma unroll
            for (int t = 0; t < 2; ++t) { st_rm(slot(lds, SL_AHT), mi, ni0 + t, lane, t1[t]); st_rm(slot(lds, SL_VT), mi, ni0 + t, lane, t2[t]); } }
#pragma unroll
          for (int t = 0; t < 2; ++t) { const int m = 16 * mi + fr, n = 16 * (ni0 + t) + 4 * fq;
#pragma unroll
              for (int r = 0; r < 4; ++r) { c1[t][r] = (n + r < m) ? c1[t][r] : 0.f; c2[t][r] = (n + r < m) ? c2[t][r] : 0.f; c3[t][r] = (n + r <= m) ? c3[t][r] : 0.f; c4[t][r] = (n + r <= m) ? c4[t][r] : 0.f;
                  accT[t][r] = c1[t][r] + ((n + r == m) ? 1.0f : 0.f); }
              st_rm(slot(lds, SL_PA), mi, ni0 + t, lane, c1[t]); st_tr(slot(lds, SL_PAT), mi, ni0 + t, lane, c1[t]); st_rm(slot(lds, SL_TA), mi, ni0 + t, lane, accT[t]);
              st_rm(slot(lds, SL_AAK), mi, ni0 + t, lane, c2[t]); st_rm(slot(lds, SL_ARB), mi, ni0 + t, lane, c3[t]); st_rm(slot(lds, SL_ARK), mi, ni0 + t, lane, c4[t]); } }
        lds_barrier();
#ifdef PROBE_VPHASE
        if (!(vflags & 64))
#endif
        { bf16x8 aP[2], aK[2], bP[2][2], bV[2][2]; ldA(slot(lds, SL_PA), mi, lane, aP); ldA(slot(lds, SL_AAK), mi, lane, aK); ldB(slot(lds, SL_PAT), ni0, lane, bP); ldB(slot(lds, SL_VT), ni0, lane, bV);
          f32x4 c1[2], c2[2]; ZACC(c1); ZACC(c2); mma<false>(aP, bP, c1); mma<true>(aK, bV, c2);
#pragma unroll
          for (int t = 0; t < 2; ++t) { st_rm(slot(lds, SL_PB), mi, ni0 + t, lane, c1[t]); st_tr(slot(lds, SL_PBT), mi, ni0 + t, lane, c1[t]); st_trT(slot(lds, SL_XT), mi, ni0 + t, lane, c2[t]); } }
        lds_barrier();
#pragma unroll
        for (int it = 1; it <= 5; ++it) { const bool odd = (it & 1) != 0;
#ifdef PROBE_VPHASE
            if (vflags & 1) continue;
#endif
            LAS bf16_t* Pr = slot(lds, odd ? SL_PB : SL_PA); LAS bf16_t* PrT = slot(lds, odd ? SL_PBT : SL_PAT); LAS bf16_t* Pw = slot(lds, odd ? SL_PA : SL_PB); LAS bf16_t* PwT = slot(lds, odd ? SL_PAT : SL_PBT);
            LAS bf16_t* Tr = slot(lds, odd ? SL_TA : SL_TB); LAS bf16_t* Tw = slot(lds, odd ? SL_TB : SL_TA);
            bf16x8 aT[2], aP[2], bP[2][2]; ldA(Tr, mi, lane, aT); ldB(PrT, ni0, lane, bP); if (it < 5) ldA(Pr, mi, lane, aP);
            f32x4 c1[2]; ZACC(c1);
            mma<false>(aT, bP, accT); if (it < 5) mma<false>(aP, bP, c1);
#pragma unroll
            for (int t = 0; t < 2; ++t) { st_rm(Tw, mi, ni0 + t, lane, accT[t]); if (it < 5) { st_rm(Pw, mi, ni0 + t, lane, c1[t]); st_tr(PwT, mi, ni0 + t, lane, c1[t]); } }
            lds_barrier(); }
#ifdef PROBE_VPHASE
        if (!(vflags & 16))
#endif
        { bf16x8 aT[2], bA[2][2], bX[2][2]; ldA(slot(lds, SL_TB), mi, lane, aT); ldB(slot(lds, SL_AHT), ni0, lane, bA); ldB(slot(lds, SL_XT), ni0, lane, bX);
          f32x4 c1[2], c2[2]; ZACC(c1); ZACC(c2); mma<true>(aT, bA, c1); mma<true>(aT, bX, c2);
          { bf16x8 bB2[2][2], bK2[2][2]; ldB(slot(lds, SL_BTT), ni0, lane, bB2); ldB(slot(lds, SL_KTT), ni0, lane, bK2); f32x4 t1[2], t2[2]; ZACC(t1); ZACC(t2); mma<false>(aI, bB2, t1); mma<false>(aI, bK2, t2);
#pragma unroll
            for (int t = 0; t < 2; ++t) { st_rm(slot(lds, SL_PA), mi, ni0 + t, lane, t1[t]); st_rm(slot(lds, SL_PAT), mi, ni0 + t, lane, t2[t]); } }
#pragma unroll
          for (int t = 0; t < 2; ++t) { st_trT(slot(lds, SL_WT), mi, ni0 + t, lane, c1[t]); st_trT(slot(lds, SL_UVT), mi, ni0 + t, lane, c2[t]); } }
        lds_barrier();
#ifdef PROBE_VPHASE
        if (!(vflags & 8))
#endif
        { bf16_t* qp = QP + (size_t)job * 2 * 4096; bf16_t* yg = YG + (size_t)job * 2 * 4096; const int m = 16 * mi + fr, qs = 2 * (fq & 1) + (fq >> 1);
          bf16x8 aRB[2], aRK[2], aBT[2], aKT[2], bW[2][2], bU[2][2], bV[2][2];
          ldA(slot(lds, SL_ARB), mi, lane, aRB); ldA(slot(lds, SL_ARK), mi, lane, aRK); ldA(slot(lds, SL_PA), mi, lane, aBT); ldA(slot(lds, SL_PAT), mi, lane, aKT);
          ldB(slot(lds, SL_WT), ni0, lane, bW); ldB(slot(lds, SL_UVT), ni0, lane, bU); ldB(slot(lds, SL_VT), ni0, lane, bV);
          u32x2 rr[2];
#pragma unroll
          for (int t = 0; t < 2; ++t) rr[t] = *(const LAS u32x2*)(slot(lds, SL_RH) + m * CT + 16 * (ni0 + t) + 4 * fq);
          const float gm = gtab[m];
          f32x4 cq[2], cy[2], cp[2], cg[2]; ZACC(cq); ZACC(cy); ZACC(cp); ZACC(cg);
          mma<false>(aRB, bW, cq); mma<true>(aRB, bU, cy); mma<false>(aBT, bW, cp); mma<true>(aBT, bU, cg); mma<true>(aRK, bV, cy); mma<true>(aKT, bV, cg);
          u32x2 wq[2], wy[2], wp[2], wg[2];
#pragma unroll
          for (int t = 0; t < 2; ++t) { const int n = 16 * (ni0 + t) + 4 * fq;
              wq[t].x = cvt_pk_bf16(cq[t][0] + bflo(rr[t].x), cq[t][1] + bfhi(rr[t].x)); wq[t].y = cvt_pk_bf16(cq[t][2] + bflo(rr[t].y), cq[t][3] + bfhi(rr[t].y));
              wy[t].x = cvt_pk_bf16(cy[t][0], cy[t][1]); wy[t].y = cvt_pk_bf16(cy[t][2], cy[t][3]);
#pragma unroll
              for (int r = 0; r < 4; ++r) cp[t][r] += (n + r == m) ? gm : 0.f;
              wp[t].x = cvt_pk_bf16(cp[t][0], cp[t][1]); wp[t].y = cvt_pk_bf16(cp[t][2], cp[t][3]);
              wg[t].x = cvt_pk_bf16(cg[t][0], cg[t][1]); wg[t].y = cvt_pk_bf16(cg[t][2], cg[t][3]); }
#define SWAP32(a_, b_) do { auto r_ = __builtin_amdgcn_permlane32_swap((a_).x, (b_).x, false, false); (a_).x = r_[0]; (b_).x = r_[1]; r_ = __builtin_amdgcn_permlane32_swap((a_).y, (b_).y, false, false); (a_).y = r_[0]; (b_).y = r_[1]; } while (0)
#define SWAP16(a_, b_) do { auto r_ = __builtin_amdgcn_permlane16_swap((a_).x, (b_).x, false, false); (a_).x = r_[0]; (b_).x = r_[1]; r_ = __builtin_amdgcn_permlane16_swap((a_).y, (b_).y, false, false); (a_).y = r_[0]; (b_).y = r_[1]; } while (0)
          SWAP32(wq[0], wq[1]); SWAP32(wp[0], wp[1]); SWAP16(wy[0], wy[1]); SWAP16(wg[0], wg[1]);
#undef SWAP32
#undef SWAP16
          { const int qoff = m * 64 + 16 * (ni0 + (fq >> 1)) + 8 * (fq & 1), yoff = (16 * (ni0 + (fq & 1)) + fr) * 64 + 16 * mi + 4 * (fq & 2);
            *(u32x4*)(qp + qoff) = (u32x4){wq[0].x, wq[0].y, wq[1].x, wq[1].y}; *(u32x4*)(qp + 4096 + qoff) = (u32x4){wp[0].x, wp[0].y, wp[1].x, wp[1].y};
            *(u32x4*)(yg + yoff) = (u32x4){wy[0].x, wy[0].y, wy[1].x, wy[1].y}; *(u32x4*)(yg + 4096 + yoff) = (u32x4){wg[0].x, wg[0].y, wg[1].x, wg[1].y}; } }
        lds_barrier();
    }
}
#undef ZACC

constexpr int PB_BUF = 32768;
__device__ __forceinline__ void pb_dma(const bf16_t* qt, const bf16_t* yl, int jv, LAS unsigned char* dst, int lane) {
    const int rr = lane >> 3, cc = lane & 7;
#pragma unroll
    for (int pc = 0; pc < 16; ++pc)
        __builtin_amdgcn_global_load_lds((const unsigned*)((const char*)qt + pc * 1024 + rr * 128 + ((cc ^ rr) * 16)), (LAS unsigned*)(dst + pc * 1024), 16, 0, 0);
#pragma unroll
    for (int q = 0; q < 2; ++q)
#pragma unroll
        for (int pc = 0; pc < 4; ++pc) { const bf16_t* base = yl + q * 4096 + jv * 2048;
            const int v = pc * 8 + rr;
            __builtin_amdgcn_global_load_lds((const unsigned*)((const char*)base + v * 128 + ((cc ^ ((v >> 1) & 7)) * 16)), (LAS unsigned*)(dst + 16384 + q * 4096 + pc * 1024), 16, 0, 0); }
}
__device__ __forceinline__ void p5_seq(const Params& p, LAS unsigned char* lds, int lane) {
    const int bh = blockIdx.x >> 1, jv = blockIdx.x & 1, b = bh >> 3, h = bh & 7, r31 = lane & 31, hh = lane >> 5;
    const bf16_t* QP = (const bf16_t*)(p.ws + WS_QP) + (size_t)bh * 64 * 2 * 4096; const bf16_t* YG = (const bf16_t*)(p.ws + WS_YG) + (size_t)bh * 64 * 2 * 4096;
    bf16_t* yraw = (bf16_t*)(p.ws + WS_YRAW) + (size_t)b * SEQ * DR + h * HD + 32 * jv + r31;
    f32x16 H[2];
#pragma unroll
    for (int i = 0; i < 2; ++i)
#pragma unroll
        for (int r = 0; r < 16; ++r) H[i][r] = 0.f;
    pb_dma(QP, YG, jv, lds, lane);
    VM_WAIT();
    for (int c = 0; c < 64; ++c) { const LAS unsigned char* bp = lds + (c & 1) * PB_BUF;
        if (c + 1 < 64) pb_dma(QP + (size_t)(c + 1) * 2 * 4096, YG + (size_t)(c + 1) * 2 * 4096, jv, lds + ((c + 1) & 1) * PB_BUF, lane);
        {
            bf16x8 Bf[4];
#pragma unroll
            for (int i = 0; i < 2; ++i)
#pragma unroll
                for (int s2 = 0; s2 < 2; ++s2) { u32x4 w; w.x = cvt_pk_bf16(H[i][8 * s2 + 0], H[i][8 * s2 + 1]); w.y = cvt_pk_bf16(H[i][8 * s2 + 2], H[i][8 * s2 + 3]); w.z = cvt_pk_bf16(H[i][8 * s2 + 4], H[i][8 * s2 + 5]); w.w = cvt_pk_bf16(H[i][8 * s2 + 6], H[i][8 * s2 + 7]);
                    Bf[2 * i + s2] = __builtin_bit_cast(bf16x8, w); }
#pragma unroll
            for (int tt = 0; tt < 2; ++tt) { f32x16 acc; const int row = 32 * tt + r31;
#pragma unroll
                for (int g4 = 0; g4 < 4; ++g4) { const u32x2 w = *(const LAS u32x2*)(bp + 16384 + r31 * 128 + (((4 * tt + g4) ^ ((r31 >> 1) & 7)) * 16) + 8 * hh); acc[4 * g4] = bflo(w.x); acc[4 * g4 + 1] = bfhi(w.x); acc[4 * g4 + 2] = bflo(w.y); acc[4 * g4 + 3] = bfhi(w.y); }
#pragma unroll
                for (int kq = 0; kq < 4; ++kq) { const bf16x8 a = *(const LAS bf16x8*)(bp + row * 128 + (((2 * kq + hh) ^ (row & 7)) * 16)); acc = __builtin_amdgcn_mfma_f32_32x32x16_bf16(a, Bf[kq], acc, 0, 0, 0); }
#pragma unroll
                for (int r = 0; r < 16; ++r) yraw[(size_t)(c * 64 + 32 * tt + (r & 3) + 8 * (r >> 2) + 4 * hh) * DR] = f2bf(acc[r]); }
            f32x16 Hn[2];
#pragma unroll
            for (int i = 0; i < 2; ++i) { const int row = 32 * i + r31;
#pragma unroll
                for (int g4 = 0; g4 < 4; ++g4) { const u32x2 w = *(const LAS u32x2*)(bp + 20480 + r31 * 128 + (((4 * i + g4) ^ ((r31 >> 1) & 7)) * 16) + 8 * hh); Hn[i][4 * g4] = bflo(w.x); Hn[i][4 * g4 + 1] = bfhi(w.x); Hn[i][4 * g4 + 2] = bflo(w.y); Hn[i][4 * g4 + 3] = bfhi(w.y); }
#pragma unroll
                for (int kq = 0; kq < 4; ++kq) { const bf16x8 a = *(const LAS bf16x8*)(bp + 8192 + row * 128 + (((2 * kq + hh) ^ (row & 7)) * 16)); Hn[i] = __builtin_amdgcn_mfma_f32_32x32x16_bf16(a, Bf[kq], Hn[i], 0, 0, 0); } }
            H[0] = Hn[0]; H[1] = Hn[1];
        }
        asm volatile("s_waitcnt vmcnt(32)" ::: "memory");
    }
}
constexpr int RT_BROW = 2064, RT_LO = 32 * RT_BROW;
constexpr int RT_HIST = 147456, RT_BASE = RT_HIST + 128, RT_ETAB = RT_HIST + 256, RT_RS = RT_HIST + 256 + 2048;
__device__ __forceinline__ float rowmax16(float x) { x = fmaxf(x, dpp_mov<0xB1>(x)); x = fmaxf(x, dpp_mov<0x4E>(x)); x = fmaxf(x, dpp_mov<0x141>(x)); x = fmaxf(x, dpp_mov<0x140>(x)); return x; }
__device__ __forceinline__ float rt_key(float v, int e) { v = (v == v) ? fminf(fmaxf(v, -1.0e30f), 1.0e30f) : -1.0e30f; return __uint_as_float((__float_as_uint(v) & ~31u) | (unsigned)(31 - e)); }
__device__ __forceinline__ void p9_router(const Params& p, LAS unsigned char* lds, int wave, int lane) {
    const bf16_t* x1 = (const bf16_t*)(p.ws + WS_XB); const unsigned char* rwp = (const unsigned char*)(p.ws + WS_RWP); const float* rb = p.in[I_RB];
    int* eid = (int*)(p.ws + WS_EID); float* gate = (float*)(p.ws + WS_GATE); int* relpos = (int*)(p.ws + WS_RELPOS); int* stok = (int*)(p.ws + WS_STOK); float* srs = (float*)(p.ws + WS_SRS);
    unsigned* gcount = (unsigned*)(p.ws + WS_CTL) + CW_GCOUNT;
    const int tid = wave * 64 + lane, fr = lane & 15, q = lane >> 4;
    LAS unsigned* hist = (LAS unsigned*)(lds + RT_HIST); LAS unsigned* base = (LAS unsigned*)(lds + RT_BASE); LAS unsigned* etab = (LAS unsigned*)(lds + RT_ETAB); LAS float* rsl = (LAS float*)(lds + RT_RS);
#pragma unroll
    for (int i = 0; i < 16; ++i) { const int c = tid + 512 * i, which = c >> 12, cc = c & 4095, e = cc >> 7, kc = cc & 127; *(LAS u32x4*)(lds + which * RT_LO + e * RT_BROW + kc * 16) = *(const u32x4*)(rwp + (size_t)c * 16); }
    if (tid < 32) hist[tid] = 0u;
    const int tok0 = blockIdx.x * 128 + wave * 16;
    const bf16_t* arow = x1 + (size_t)(tok0 + fr) * DM + 8 * q;
    bf16x8 a_n[4];
#pragma unroll
    for (int k = 0; k < 4; ++k) a_n[k] = *(const bf16x8*)(arow + 32 * k);
    __syncthreads();
    f32x4 acc[2], accs; acc[0] = acc[1] = accs = (f32x4){0.f, 0.f, 0.f, 0.f};
#pragma unroll
    for (int ks = 0; ks < 32; ++ks) { const bf16x8 a = a_n[ks & 3];
        if (ks + 4 < 32) a_n[ks & 3] = *(const bf16x8*)(arow + 32 * (ks + 4));
        accs = __builtin_amdgcn_mfma_f32_16x16x32_bf16(a, a, accs, 0, 0, 0);
#pragma unroll
        for (int h2 = 0; h2 < 2; ++h2) { const LAS unsigned char* bp = lds + (16 * h2 + fr) * RT_BROW + (32 * ks + 8 * q) * 2;
            acc[h2] = __builtin_amdgcn_mfma_f32_16x16x32_bf16(a, *(const LAS bf16x8*)bp, acc[h2], 0, 0, 0);
            acc[h2] = __builtin_amdgcn_mfma_f32_16x16x32_bf16(a, *(const LAS bf16x8*)(bp + RT_LO), acc[h2], 0, 0, 0); } }
    const float rb0 = rb[fr], rb1 = rb[16 + fr];
#pragma unroll
    for (int r = 0; r < 4; ++r) { const int tl = wave * 16 + 4 * q + r, tok = blockIdx.x * 128 + tl;
        const float ss = __shfl(accs[r], 20 * q + r); const float rstd = 1.0f / sqrtf(ss * (1.0f / DM) + 1e-5f);
        float k0 = rt_key(acc[0][r] * rstd + rb0, fr), k1 = rt_key(acc[1][r] * rstd + rb1, 16 + fr);
        float tv[4]; int te[4];
#pragma unroll
        for (int rd = 0; rd < 4; ++rd) { const float m = rowmax16(fmaxf(k0, k1)); tv[rd] = m; te[rd] = 31 - (int)(__float_as_uint(m) & 31u); k0 = (k0 == m) ? -3.0e38f : k0; k1 = (k1 == m) ? -3.0e38f : k1; }
        const float ex1 = __expf(tv[1] - tv[0]), ex2 = __expf(tv[2] - tv[0]), ex3 = __expf(tv[3] - tv[0]); const float inv = 1.0f / (1.0f + ex1 + ex2 + ex3);
        if (fr < 4) { const int e = fr == 0 ? te[0] : (fr == 1 ? te[1] : (fr == 2 ? te[2] : te[3])); const float g = (fr == 0 ? 1.0f : (fr == 1 ? ex1 : (fr == 2 ? ex2 : ex3))) * inv;
            const unsigned lr = atomicAdd((unsigned*)&hist[e], 1u); eid[(size_t)tok * 4 + fr] = e; gate[(size_t)tok * 4 + fr] = g; etab[tl * 4 + fr] = (lr << 5) | (unsigned)e; }
        if (fr == 0) rsl[tl] = rstd; }
    __syncthreads();
    if (tid < 32) { const unsigned hc = hist[tid]; base[tid] = hc ? atomicAdd(&gcount[tid], hc) : 0u; }
    __syncthreads();
    { const int tl = tid >> 2, k = tid & 3, tok = blockIdx.x * 128 + tl; const unsigned pk = etab[tid]; const int e = pk & 31; const unsigned rel = base[e] + (pk >> 5);
      relpos[(size_t)tok * 4 + k] = (int)rel; stok[(size_t)e * CAP + rel] = tok; srs[(size_t)e * CAP + rel] = rsl[tl]; }
}
__device__ __forceinline__ void moe_tables(const Params& p, LAS unsigned char* lds, int wave, int lane) {
    const unsigned* gcount = (const unsigned*)(p.ws + WS_CTL) + CW_GCOUNT;
    LAS int* tsrc = (LAS int*)(lds + TAB_SRC); LAS int* tval = (LAS int*)(lds + TAB_VAL); LAS int* te = (LAS int*)(lds + TAB_E); LAS int* tbase = (LAS int*)(lds + TAB_BASE);
    if (wave == 0) {
        const int c = lane < NE ? (int)__hip_atomic_load(&gcount[lane & 31], __ATOMIC_RELAXED, __HIP_MEMORY_SCOPE_AGENT) : 0; const int nt = (c + 255) >> 8;
        int inc = nt;
#pragma unroll
        for (int o = 1; o < 32; o <<= 1) { const int v = __shfl_up(inc, o); inc += (lane & 31) >= o ? v : 0; }
        const int tb = inc - nt;
        if (lane < NE) { tbase[lane] = tb; if (lane == NE - 1) tbase[NE] = inc;
            for (int lt = 0; lt < nt; ++lt) { tsrc[tb + lt] = lane * CAP + lt * 256; const int rem = c - lt * 256; tval[tb + lt] = rem < 256 ? rem : 256; te[tb + lt] = lane; } } }
    __syncthreads();
}
typedef int i32x4 __attribute__((ext_vector_type(4)));
struct P12Meta { i32x4 e, rp; f32x4 g; };
struct P12Rows { u32x2 x[4]; u32x2 y[4][4]; f32x4 g; };
__device__ __forceinline__ void p12_meta(P12Meta& m, const int* eid, const float* gate, const int* relpos, int tok) {
    m.e = *(const i32x4*)(eid + (size_t)tok * 4); m.g = *(const f32x4*)(gate + (size_t)tok * 4); m.rp = *(const i32x4*)(relpos + (size_t)tok * 4); }
__device__ __forceinline__ void p12_rows(P12Rows& r, const P12Meta& m, const bf16_t* x1, const bf16_t* ys, const LAS int* tbase, int tok, int lane) {
#pragma unroll
    for (int j = 0; j < 4; ++j) r.x[j] = __builtin_nontemporal_load((const u32x2*)(x1 + (size_t)tok * DM + 4 * lane + 256 * j));
#pragma unroll
    for (int k = 0; k < 4; ++k) { const bf16_t* yr = ys + ((size_t)tbase[m.e[k]] * 256 + m.rp[k]) * YS_LD + 4 * lane;
#pragma unroll
        for (int j = 0; j < 4; ++j) r.y[k][j] = __builtin_nontemporal_load((const u32x2*)(yr + 256 * j)); }
    r.g = m.g;
}
__device__ __forceinline__ void p12_combine(const Params& p, LAS unsigned char* lds, int wave, int lane) {
    const bf16_t* x1 = (const bf16_t*)(p.ws + WS_XB); float* outp = p.out; const bf16_t* ys = (const bf16_t*)(p.ws + WS_YSORT); const int* eid = (const int*)(p.ws + WS_EID); const float* gate = (const float*)(p.ws + WS_GATE); const int* relpos = (const int*)(p.ws + WS_RELPOS);
    const float* fg = p.in[I_FG]; const LAS int* tbase = (const LAS int*)(lds + TAB_BASE);
    const int gw = blockIdx.x * NWAVES + wave;
    f32x4 gv[4];
#pragma unroll
    for (int j = 0; j < 4; ++j) gv[j] = *(const f32x4*)(fg + 4 * lane + 256 * j);
    P12Meta m0, m1; P12Rows rc, rn;
    p12_meta(m0, eid, gate, relpos, gw); p12_meta(m1, eid, gate, relpos, gw + NGW);
    p12_rows(rc, m0, x1, ys, tbase, gw, lane);
    for (int tok = gw; tok < NTOK; tok += NGW) {
        m0 = m1;
        if (tok + 2 * NGW < NTOK) p12_meta(m1, eid, gate, relpos, tok + 2 * NGW);
        if (tok + NGW < NTOK) p12_rows(rn, m0, x1, ys, tbase, tok + NGW, lane);
        f32x4 v[4];
#pragma unroll
        for (int j = 0; j < 4; ++j) v[j] = (f32x4){bflo(rc.x[j].x), bfhi(rc.x[j].x), bflo(rc.x[j].y), bfhi(rc.x[j].y)};
#pragma unroll
        for (int k = 0; k < 4; ++k) { const float gt = rc.g[k];
#pragma unroll
            for (int j = 0; j < 4; ++j) { const u32x2 w = rc.y[k][j]; v[j][0] += gt * bflo(w.x); v[j][1] += gt * bfhi(w.x); v[j][2] += gt * bflo(w.y); v[j][3] += gt * bfhi(w.y); } }
        float ss = 0.f;
#pragma unroll
        for (int j = 0; j < 4; ++j) ss += (v[j][0] * v[j][0] + v[j][1] * v[j][1]) + (v[j][2] * v[j][2] + v[j][3] * v[j][3]);
        ss = wave_sum(ss); const float rs = 1.0f / sqrtf(ss * (1.0f / DM) + 1e-5f);
#pragma unroll
        for (int j = 0; j < 4; ++j) { f32x4 o = v[j] * rs * gv[j];
#ifdef SCRUB_NAN
#pragma unroll
            for (int q = 0; q < 4; ++q) o[q] = (o[q] == o[q] && fabsf(o[q]) < 1e30f) ? o[q] : 0.f;
#endif
            __builtin_nontemporal_store(o, (f32x4*)(outp + (size_t)tok * DM + 4 * lane + 256 * j)); }
        rc = rn;
    }
}
#ifndef MOE_ALIGN
#define MOE_ALIGN true
#endif
#ifndef P11_ALIGN
#define P11_ALIGN true
#endif
#ifndef N_PHASES
#define N_PHASES 13
#endif
struct Args { Params p; int ph_lo, ph_hi, li, pad; };
__global__ void __launch_bounds__(NWAVES * 64, 2) hymba_fwd(Args a) {
    extern __shared__ __attribute__((aligned(16))) unsigned char lds_raw[];
    LAS unsigned char* lds = (LAS unsigned char*)lds_raw;
    const Params& p = a.p;
    const int wave = __builtin_amdgcn_readfirstlane((int)threadIdx.x >> 6);
    volatile LAS unsigned* misc = (volatile LAS unsigned*)(lds + MISC_OFF);
    if (threadIdx.x < 4) misc[threadIdx.x] = 0u;
    __syncthreads();
    unsigned* ctl = (unsigned*)(p.ws + WS_CTL);
    XcdBarrier bar = xcd_barrier_post(ctl + CW_BAR + a.li * XCD_BAR_WORDS, misc);
    const int lo = a.ph_lo & 0xFF, hi = a.ph_hi, padf = a.ph_lo >> 8;
#ifdef DIAG_A
    volatile LAS unsigned long long* tsl = (volatile LAS unsigned long long*)(lds + MISC_OFF + 64);
#define STAMP(k) do { if (blockIdx.x == 0 && wave == 0 && lane_id() == 0) tsl[k] = __builtin_amdgcn_s_memrealtime(); } while (0)
#else
#define STAMP(k) do { } while (0)
#endif
#ifndef PH_MASK
#define PH_MASK 0x1FFF
#endif
#define STAGGER_BY(grp, us) do { const unsigned long long t0_ = __builtin_amdgcn_s_memrealtime(); const unsigned long long dl_ = (unsigned long long)((grp) * (us) * 10); \
        while (__builtin_amdgcn_s_memrealtime() - t0_ < dl_) __builtin_amdgcn_s_sleep(32); } while (0)
#ifdef STAGGER_P10
#define STAGGER() STAGGER_BY(blockIdx.x & 7, STAGGER_P10)
#else
#define STAGGER() do {} while (0)
#endif
#define STAGGER1() do {} while (0)
#ifdef STAGGER_P11
#define STAGGER2() STAGGER_BY(blockIdx.x & 7, STAGGER_P11)
#else
#define STAGGER2() do {} while (0)
#endif
#define IN(k) ((((PH_MASK) >> (k)) & 1) && lo <= (k) && (k) < hi)
#define SEAM(k) do { if (IN(k) && IN((k) + 1)) xcd_barrier(bar, wave == 0 && lane_id() == 0); } while (0)
#define LN lane_id()
    unsigned char* ws = p.ws;
    STAMP(0); if (IN(0)) { p0_prologue(p, lds, wave, LN); } SEAM(0);
    STAMP(1); if (IN(1)) { pg8::Gemm g{(const bf16_t*)(ws + WS_XB), (const bf16_t*)(ws + WS_WINT), NTOK, DIN, DM}; pg8::StaticOrder S; S.init(NTOK, DIN, GRID, (int)blockIdx.x);
        EpiProj E{(bf16_t*)(ws + WS_PROJ), DIN, (const float*)(ws + WS_RSTD1), lds}; STAGGER1(); pg8::gemm_phase<EpiProj, pg8::StaticOrder, true, false>(lds, g, S, E, wave); cv_tail(p, lds, wave, LN, CW_CVT1, CV_A, CV_B - CV_A); } SEAM(1);
    STAMP(2); if (IN(2)) { p2_lora_in(p, wave, LN); } SEAM(2);
    STAMP(3); if (IN(3)) { pg8::Gemm g{(const bf16_t*)(ws + WS_LORAIN), (const bf16_t*)(ws + WS_LORAB), NTOK, 1536, 256}; pg8::StaticOrder S; S.init(NTOK, 1536, GRID, (int)blockIdx.x);
        EpiLora E{(float*)(ws + WS_LORAW), (bf16_t*)(ws + WS_LORAA), (bf16_t*)(ws + WS_LORAG)}; pg8::gemm_phase<EpiLora, pg8::StaticOrder, true, false>(lds, g, S, E, wave); } SEAM(3);
    STAMP(4); if (IN(4)) { p4_chunks(p, lds, wave, LN, padf); } SEAM(4);
    STAMP(5); if (IN(5)) {
#if defined(PROBE_PAD) && !defined(S5_ONE)
        if (blockIdx.x < 128) { if (!(padf & 2)) { if (wave == 0) p5_seq(p, lds, LN); else p5_convert(p, (LAS float*)(lds + 65536 + (wave - 1) * 8448), LN); } } else { if (!(padf & 1)) { p5_s5(p, lds, wave, LN, padf); __syncthreads(); if (!(padf & 32)) p5_convert(p, (LAS float*)(lds + wave * 8448), LN); } }
#elif defined(S5_ONE)
        { if (wave < 4 && LN == 0) ((LAS unsigned*)(lds + MISC_OFF + 256))[wave] = 0u;
          __syncthreads();
#if defined(PROBE_LO) || defined(PROBE_VPHASE)
          if (wave < 4) { if (!(padf & 1)) p5_s5(p, lds, wave, LN); }
          else if (wave == 4 && blockIdx.x < 128) { if (!(padf & 2)) { __builtin_amdgcn_s_setprio(3); p5_seq(p, lds, LN); __builtin_amdgcn_s_setprio(0); } }
#else
          if (wave < 4) p5_s5(p, lds, wave, LN);
          else if (wave == 4 && blockIdx.x < 128) { __builtin_amdgcn_s_setprio(3); p5_seq(p, lds, LN); __builtin_amdgcn_s_setprio(0); }
#endif
          if (wave != 5) p5_convert(p, (LAS float*)lds, LN); }
#else
        if (blockIdx.x < 128) { if (wave == 0) p5_seq(p, lds, LN); else p5_convert(p, (LAS float*)(lds + 65536 + (wave - 1) * 8448), LN); } else { p5_s5(p, lds, wave, LN); __syncthreads(); p5_convert(p, (LAS float*)(lds + wave * 8448), LN); }
#endif
 } SEAM(5);
    STAMP(6); if (IN(6)) { pg8::Gemm g{(const bf16_t*)(ws + WS_YGELU), (const bf16_t*)(ws + WS_WGLUT), NTOK, DSSM, DSSM}; pg8::StaticOrder S; S.init(NTOK, DSSM, GRID, (int)blockIdx.x);
        EpiGlu E{(const bf16_t*)(ws + WS_YGELU), (bf16_t*)(ws + WS_YGLU), p.in[I_BGLU], (float*)(ws + WS_SSQ)}; pg8::gemm_phase<EpiGlu, pg8::StaticOrder, false, false>(lds, g, S, E, wave); } SEAM(6);
    STAMP(7); if (IN(7)) { p7_mix(p, wave, LN); } SEAM(7);
    STAMP(8); if (IN(8)) { pg8::Gemm g{(const bf16_t*)(ws + WS_MIXED), (const bf16_t*)(ws + WS_WOUTT), NTOK, DM, DM}; pg8::StaticOrder S; S.init(NTOK, DM, GRID, (int)blockIdx.x);
        EpiOut E{(bf16_t*)(ws + WS_XB)}; pg8::gemm_phase<EpiOut, pg8::StaticOrder, true, false>(lds, g, S, E, wave); } SEAM(8);
    STAMP(9); if (IN(9)) { p9_router(p, lds, wave, LN); } SEAM(9);
    STAMP(13); if (IN(10) || IN(11) || IN(12)) moe_tables(p, lds, wave, lane_id());
    STAMP(10); if (IN(10)) { MoeOrder S{GRID, (int)blockIdx.x, 8, ((const LAS int*)(lds + TAB_BASE))[NE], (const LAS int*)(lds + TAB_SRC), (const LAS int*)(lds + TAB_VAL), (const LAS int*)(lds + TAB_E), (const int*)(ws + WS_STOK), (const LAS int*)(lds + TAB_BASE), padf};
        pg8::Gemm g{(const bf16_t*)(ws + WS_XB), (const bf16_t*)(ws + WS_W1T), 0, 0, DM};
        EpiSwiglu E{(bf16_t*)(ws + WS_ACT), (const float*)(ws + WS_B1G), (const float*)(ws + WS_B1L), (const float*)(ws + WS_SRS), (const LAS int*)(lds + TAB_SRC), (const LAS int*)(lds + TAB_VAL), padf, lds};
        STAGGER();
        pg8::gemm_phase<EpiSwiglu, MoeOrder, MOE_ALIGN, true>(lds, g, S, E, wave); cv_tail(p, lds, wave, LN, CW_CVT2, CV_C, CV_NIT - CV_C); } SEAM(10);
    STAMP(11); if (IN(11)) { MoeOrder S{GRID, (int)blockIdx.x, 4, ((const LAS int*)(lds + TAB_BASE))[NE], (const LAS int*)(lds + TAB_SRC), (const LAS int*)(lds + TAB_VAL), (const LAS int*)(lds + TAB_E), (const int*)(ws + WS_STOK), (const LAS int*)(lds + TAB_BASE), padf};
        pg8::Gemm g{(const bf16_t*)(ws + WS_ACT), (const bf16_t*)(ws + WS_W2T), 0, 0, DFF};
        EpiMoe2 E{(bf16_t*)(ws + WS_YSORT), p.in[I_B2], padf}; STAGGER2(); pg8::gemm_phase<EpiMoe2, MoeOrder, P11_ALIGN, false>(lds, g, S, E, wave); } SEAM(11);
    STAMP(12); if (IN(12)) { p12_combine(p, lds, wave, LN); }
#ifdef DIAG_A
    STAMP(14);
    xcd_barrier(bar, wave == 0 && lane_id() == 0);
    if (blockIdx.x == 0) { const int l = lane_id();
        auto dur = [&](int k) -> float { const int e = (k == 9) ? 13 : (k == 12 ? 14 : k + 1); const int b0 = (k == 10) ? 13 : k; return (float)(tsl[e] - tsl[b0]) * 0.01f; };
        const float ta = dur(DIAG_A), tb = dur(DIAG_B);
        float* o = p.out;
        for (int i = wave * 64 + l; i < (1 << 22); i += NWAVES * 64) o[i] = (i == 0) ? ta * 1.0e5f : tb * 1.0e3f; }
#endif
#undef IN
#undef SEAM
#undef LN
#undef STAMP
}
#ifndef MK_SPLIT
#define MK_SPLIT 0
#endif
extern "C" void kernel_launch(void* const* d_in, const int* in_sizes, int n_in, void* d_out, int out_size, void* d_ws, size_t ws_size, hipStream_t stream) {
    static int ready = 0;
    if (ready == 0) {
        if (n_in != 34 || out_size != NTOK * DM || ws_size < WS_END) { fprintf(stderr, "kernel_launch: unexpected shapes (n_in %d, out %d, ws %zu); nothing launched\n", n_in, out_size, ws_size); ready = -1; return; }
        if (hipFuncSetAttribute((const void*)hymba_fwd, hipFuncAttributeMaxDynamicSharedMemorySize, LDS_BYTES) != hipSuccess) { fprintf(stderr, "kernel_launch: hipFuncSetAttribute failed\n"); ready = -1; return; }
        int per_cu = 0; if (hipOccupancyMaxActiveBlocksPerMultiprocessor(&per_cu, (const void*)hymba_fwd, NWAVES * 64, LDS_BYTES) != hipSuccess || per_cu < 1) fprintf(stderr, "kernel_launch: occupancy query says %d\n", per_cu);
        (void)hipGetLastError();
        ready = 1;
    }
    if (ready < 0) return;
    (void)hipMemsetAsync((char*)d_ws + WS_CTL, 0, CTL_ZERO_BYTES, stream);
    Args a{};
    for (int i = 0; i < 34; ++i) a.p.in[i] = (const float*)d_in[i];
    a.p.out = (float*)d_out; a.p.ws = (unsigned char*)d_ws;
#if defined(PROBE_VPHASE)
    a.ph_lo = 0; a.ph_hi = PROBE_VPHASE; a.li = 0; hipLaunchKernelGGL(hymba_fwd, dim3(GRID), dim3(NWAVES * 64), LDS_BYTES, stream, a);
    a.ph_lo = PROBE_VPHASE | (PROBE_VFLAGS << 8); a.ph_hi = PROBE_VPHASE + 1; a.li = 1; hipLaunchKernelGGL(hymba_fwd, dim3(GRID), dim3(NWAVES * 64), LDS_BYTES, stream, a);
    a.ph_lo = PROBE_VPHASE; a.ph_hi = N_PHASES; a.li = 2; hipLaunchKernelGGL(hymba_fwd, dim3(GRID), dim3(NWAVES * 64), LDS_BYTES, stream, a);
#elif defined(PROBE_VARIANT)
    a.ph_lo = 0; a.ph_hi = 10; a.li = 0; hipLaunchKernelGGL(hymba_fwd, dim3(GRID), dim3(NWAVES * 64), LDS_BYTES, stream, a);
    a.ph_lo = 10 | (PROBE_VARIANT << 8); a.ph_hi = 11; a.li = 1; hipLaunchKernelGGL(hymba_fwd, dim3(GRID), dim3(NWAVES * 64), LDS_BYTES, stream, a);
    a.ph_lo = 10; a.ph_hi = N_PHASES; a.li = 2; hipLaunchKernelGGL(hymba_fwd, dim3(GRID), dim3(NWAVES * 64), LDS_BYTES, stream, a);
#elif defined(PROBE_LO)
    a.ph_lo = 0; a.ph_hi = PROBE_HI + 1; a.li = 0; hipLaunchKernelGGL(hymba_fwd, dim3(GRID), dim3(NWAVES * 64), LDS_BYTES, stream, a);
#ifndef PROBE_PAD
#define PROBE_PAD 0
#endif
    a.ph_lo = PROBE_LO | (PROBE_PAD << 8); a.ph_hi = PROBE_LO + 1; a.li = 1; hipLaunchKernelGGL(hymba_fwd, dim3(GRID), dim3(NWAVES * 64), LDS_BYTES, stream, a);
    a.ph_lo = PROBE_LO + 1; a.ph_hi = N_PHASES; a.li = 2; hipLaunchKernelGGL(hymba_fwd, dim3(GRID), dim3(NWAVES * 64), LDS_BYTES, stream, a);
#elif MK_SPLIT
    for (int ph = 0; ph < N_PHASES; ++ph) { a.ph_lo = ph; a.ph_hi = ph + 1; a.li = 0; hipLaunchKernelGGL(hymba_fwd, dim3(GRID), dim3(NWAVES * 64), LDS_BYTES, stream, a); }
#else
#ifndef RUN_HI
#define RUN_HI N_PHASES
#endif
    a.ph_lo = 0; a.ph_hi = RUN_HI; a.li = 0; hipLaunchKernelGGL(hymba_fwd, dim3(GRID), dim3(NWAVES * 64), LDS_BYTES, stream, a);
#endif
}
```
